# Optimizing an MI355X kernel written in HIP

```python
import math
import jax, jax.numpy as jnp
from jax import lax
import numpy as np

D_MODEL = 2048
BATCH = 2
SEQ = 4096
DEPTH = 1

SB_HEADS = 8
SB_HEAD_DIM = 128
SB_WIDTH = SB_HEADS * SB_HEAD_DIM
MLA_HEADS = 8
MLA_NOPE_DIM = 128
MLA_ROPE_DIM = 64
MLA_V_DIM = 128
MLA_Q_RANK = 512
MLA_KV_RANK = 256
MLA_WIDTH = MLA_HEADS * MLA_V_DIM
MLA_QK_DIM = MLA_NOPE_DIM + MLA_ROPE_DIM
MIX_WIDTH = SB_WIDTH + MLA_WIDTH
ROPE_THETA = 10000.0
Q_BLOCK = 128
IN_PROJ_WIDTH = 3 * SB_WIDTH + MLA_Q_RANK + MLA_KV_RANK + MLA_ROPE_DIM
IN_SPLITS = [SB_WIDTH, 2 * SB_WIDTH, 3 * SB_WIDTH, 3 * SB_WIDTH + MLA_Q_RANK,
             3 * SB_WIDTH + MLA_Q_RANK + MLA_KV_RANK]
PEER_HEADS = 8
PEER_N_KEYS = 128
PEER_N_EXPERTS = PEER_N_KEYS * PEER_N_KEYS
PEER_QUERY_DIM = 256
PEER_HALF = PEER_QUERY_DIM // 2
PEER_TOPK = 16
PEER_CHUNK = 128
NORM_EPS = 1e-6

kernel_name = "hymba_sba_mla_peer_adaln_block"


def rmsnorm(x, g):
    xf = x.astype(jnp.float32)
    y = xf * lax.rsqrt(jnp.mean(xf * xf, axis=-1, keepdims=True) + NORM_EPS)
    return (y * g.astype(jnp.float32)).astype(x.dtype)


def rope_tables(positions, dtype):
    inv_freq = ROPE_THETA ** (-jnp.arange(0, MLA_ROPE_DIM, 2, dtype=jnp.float32) / MLA_ROPE_DIM)
    ang = positions.astype(jnp.float32)[..., None] * inv_freq
    return jnp.cos(ang).astype(dtype), jnp.sin(ang).astype(dtype)


def apply_rope(x, cos, sin):
    half = x.shape[-1] // 2
    x1, x2 = x[..., :half], x[..., half:]
    return jnp.concatenate([x1 * cos - x2 * sin, x2 * cos + x1 * sin], axis=-1)


def stick_breaking_attention(q, k, v):
    seq = q.shape[1]
    scale = SB_HEAD_DIM ** -0.5
    outs = []
    for blk in range(seq // Q_BLOCK):
        start = blk * Q_BLOCK
        end = start + Q_BLOCK
        z = jnp.einsum('bqhd,bkhd->bhqk', q[:, start:end], k[:, :end]).astype(jnp.float32) * scale
        t_idx = start + jnp.arange(Q_BLOCK)[:, None]
        s_idx = jnp.arange(end)[None, :]
        mask = s_idx < t_idx
        log_one_minus = jnp.where(mask, jax.nn.log_sigmoid(-z), 0.0)
        between = lax.cumsum(log_one_minus, axis=3, reverse=True) - log_one_minus
        weights = jnp.where(mask, jnp.exp(jax.nn.log_sigmoid(z) + between), 0.0)
        outs.append(jnp.einsum('bhqk,bkhd->bqhd', weights.astype(v.dtype), v[:, :end]))
    return jnp.concatenate(outs, axis=1)


def mla_attention(q_nope, q_pe, k_nope, k_pe, v):
    seq = q_nope.shape[1]
    scale = MLA_QK_DIM ** -0.5
    outs = []
    for blk in range(seq // Q_BLOCK):
        start = blk * Q_BLOCK
        end = start + Q_BLOCK
        s = (jnp.einsum('bqhd,bkhd->bhqk', q_nope[:, start:end], k_nope[:, :end])
             + jnp.einsum('bqhr,bkr->bhqk', q_pe[:, start:end], k_pe[:, :end]))
        s = s.astype(jnp.float32) * scale
        t_idx = start + jnp.arange(Q_BLOCK)[:, None]
        s_idx = jnp.arange(end)[None, :]
        s = jnp.where(s_idx <= t_idx, s, -jnp.inf)
        p = jax.nn.softmax(s, axis=-1)
        outs.append(jnp.einsum('bhqk,bkhd->bqhd', p.astype(v.dtype), v[:, :end]))
    return jnp.concatenate(outs, axis=1)


def peer_ffn(h, w_q, keys1, keys2, u_tab, v_tab):
    b, s, d = h.shape
    q = jnp.einsum('bsd,dq->bsq', h, w_q).reshape(b, s, PEER_HEADS, 2, PEER_HALF)
    s1 = jnp.einsum('bshq,hnq->bshn', q[..., 0, :], keys1)
    s2 = jnp.einsum('bshq,hnq->bshn', q[..., 1, :], keys2)
    v1, i1 = lax.top_k(s1, PEER_TOPK)
    v2, i2 = lax.top_k(s2, PEER_TOPK)
    cand = (v1[..., :, None] + v2[..., None, :]).reshape(b, s, PEER_HEADS, PEER_TOPK * PEER_TOPK)
    cand_idx = (i1[..., :, None] * PEER_N_KEYS + i2[..., None, :]).reshape(b, s, PEER_HEADS, PEER_TOPK * PEER_TOPK)
    best, pos = lax.top_k(cand, PEER_TOPK)
    expert_idx = jnp.take_along_axis(cand_idx, pos, axis=-1)
    gates = jax.nn.softmax(best.astype(jnp.float32), axis=-1).astype(h.dtype)
    n_blk = (b * s) // PEER_CHUNK
    hc = h.reshape(n_blk, PEER_CHUNK, d)
    ic = expert_idx.reshape(n_blk, PEER_CHUNK, PEER_HEADS, PEER_TOPK)
    gc = gates.reshape(n_blk, PEER_CHUNK, PEER_HEADS, PEER_TOPK)

    def block_fn(args):
        hx, ix, gx = args
        u = jnp.take(u_tab, ix, axis=0)
        act = jax.nn.gelu(jnp.einsum('chkd,cd->chk', u, hx), approximate=False)
        vv = jnp.take(v_tab, ix, axis=0)
        return jnp.einsum('chk,chkd->cd', gx * act, vv)

    y = lax.map(block_fn, (hc, ic, gc))
    return y.reshape(b, s, d)


def setup_inputs(seed: int = 0) -> dict:
    key = jax.random.key(seed)
    ks = jax.random.split(key, 24)
    f32 = jnp.float32
    D = D_MODEL

    def nrm(k, shape, scale):
        return jax.random.normal(k, shape, f32) * scale

    def gain(k, shape):
        return 1.0 + 0.02 * jax.random.normal(k, shape, f32)

    offset = jax.random.randint(ks[2], (BATCH, 1), 0, 1024, dtype=jnp.int32)
    positions = (offset + jnp.arange(SEQ, dtype=jnp.int32)[None, :]).astype(jnp.int32)
    return {
        "x": nrm(ks[0], (BATCH, SEQ, D), 1.0),
        "c": nrm(ks[1], (BATCH, D), 1.0),
        "positions": positions,
        "w_ada": nrm(ks[3], (DEPTH, D, 6 * D), D ** -0.5),
        "b_ada": nrm(ks[4], (DEPTH, 6 * D), 0.02),
        "norm1_g": gain(ks[5], (DEPTH, D)),
        "w_in": nrm(ks[6], (DEPTH, D, IN_PROJ_WIDTH), D ** -0.5),
        "mla_q_norm_g": gain(ks[7], (DEPTH, MLA_Q_RANK)),
        "w_uq": nrm(ks[8], (DEPTH, MLA_Q_RANK, MLA_HEADS * MLA_QK_DIM), MLA_Q_RANK ** -0.5),
        "mla_kv_norm_g": gain(ks[9], (DEPTH, MLA_KV_RANK)),
        "w_ukv": nrm(ks[10], (DEPTH, MLA_KV_RANK, MLA_HEADS * (MLA_NOPE_DIM + MLA_V_DIM)), MLA_KV_RANK ** -0.5),
        "out_norm_sba_g": gain(ks[11], (DEPTH, SB_WIDTH)),
        "out_norm_mla_g": gain(ks[12], (DEPTH, MLA_WIDTH)),
        "w_o": nrm(ks[13], (DEPTH, MIX_WIDTH, D), MIX_WIDTH ** -0.5),
        "norm2_g": gain(ks[14], (DEPTH, D)),
        "w_peer_q": nrm(ks[15], (DEPTH, D, PEER_HEADS * PEER_QUERY_DIM), D ** -0.5),
        "peer_keys1": nrm(ks[16], (DEPTH, PEER_HEADS, PEER_N_KEYS, PEER_HALF), PEER_HALF ** -0.5),
        "peer_keys2": nrm(ks[17], (DEPTH, PEER_HEADS, PEER_N_KEYS, PEER_HALF), PEER_HALF ** -0.5),
        "peer_u": nrm(ks[18], (DEPTH, PEER_N_EXPERTS, D), D ** -0.5),
        "peer_v": nrm(ks[19], (DEPTH, PEER_N_EXPERTS, D), PEER_HEADS ** -0.5),
        "final_norm_g": gain(ks[20], (D,)),
    }


def reference(x, c, positions, w_ada, b_ada, norm1_g, w_in, mla_q_norm_g, w_uq, mla_kv_norm_g, w_ukv,
              out_norm_sba_g, out_norm_mla_g, w_o, norm2_g, w_peer_q, peer_keys1, peer_keys2,
              peer_u, peer_v, final_norm_g):
    b, s, d = x.shape
    cos, sin = rope_tables(positions, x.dtype)
    c_act = jax.nn.silu(c)
    for l in range(DEPTH):
        mod = (c_act @ w_ada[l] + b_ada[l])[:, None, :]
        sh1, sc1, g1, sh2, sc2, g2 = jnp.split(mod, 6, axis=-1)

        h = rmsnorm(x, norm1_g[l]) * (1.0 + sc1) + sh1
        proj = h @ w_in[l]
        sq, sk, sv, cq, ckv, kr = jnp.split(proj, IN_SPLITS, axis=-1)

        sb_out = stick_breaking_attention(
            sq.reshape(b, s, SB_HEADS, SB_HEAD_DIM),
            sk.reshape(b, s, SB_HEADS, SB_HEAD_DIM),
            sv.reshape(b, s, SB_HEADS, SB_HEAD_DIM)).reshape(b, s, SB_WIDTH)

        q = (rmsnorm(cq, mla_q_norm_g[l]) @ w_uq[l]).reshape(b, s, MLA_HEADS, MLA_QK_DIM)
        q_nope = q[..., :MLA_NOPE_DIM]
        q_pe = apply_rope(q[..., MLA_NOPE_DIM:], cos[:, :, None, :], sin[:, :, None, :])
        kv = (rmsnorm(ckv, mla_kv_norm_g[l]) @ w_ukv[l]).reshape(b, s, MLA_HEADS, MLA_NOPE_DIM + MLA_V_DIM)
        k_nope = kv[..., :MLA_NOPE_DIM]
        v_mla = kv[..., MLA_NOPE_DIM:]
        k_pe = apply_rope(kr, cos, sin)
        mla_out = mla_attention(q_nope, q_pe, k_nope, k_pe, v_mla).reshape(b, s, MLA_WIDTH)

        mixed = jnp.concatenate([rmsnorm(sb_out, out_norm_sba_g[l]),
                                 rmsnorm(mla_out, out_norm_mla_g[l])], axis=-1) @ w_o[l]
        x = x + g1 * mixed

        h2 = rmsnorm(x, norm2_g[l]) * (1.0 + sc2) + sh2
        x = x + g2 * peer_ffn(h2, w_peer_q[l], peer_keys1[l], peer_keys2[l], peer_u[l], peer_v[l])
    return rmsnorm(x, final_norm_g)
```

```cpp
#include <hip/hip_runtime.h>
#include <stdint.h>

#ifndef TAB_EB
#define TAB_EB 6
#endif
#ifndef ATT_ANTIPHASE
#define ATT_ANTIPHASE 1
#endif
#ifndef PEER_SPLIT
#define PEER_SPLIT 1
#endif
#ifndef PEER_SLICED
#define PEER_SLICED 0
#endif
#ifndef PROBE_ATTN_G
#define PROBE_ATTN_G 0
#endif
#ifndef PROBE_DOUBLE
#define PROBE_DOUBLE 0
#endif
#ifndef FUSED
#define FUSED 1
#endif

typedef unsigned short bf16_t;
#define LAS __attribute__((address_space(3)))
__device__ __forceinline__ int tid_fresh(int widx) { unsigned m = ~0u; asm volatile("" : "+s"(m)); int t = (widx << 6) | (int)__builtin_amdgcn_mbcnt_hi(m, __builtin_amdgcn_mbcnt_lo(m, 0u)); asm volatile("" : "+v"(t)); return t; }

constexpr int TOK = 8192, DM = 2048, SEQ = 4096, NB = 2;
constexpr int NIN = 3904, NINP = 4096;
constexpr int NEXP = 16384;
constexpr float EPS = 1e-6f;
constexpr float LOG2E = 1.4426950408889634f, LN2 = 0.6931471805599453f;
constexpr float QS_SB = 0.12751743082459868f;
constexpr float QS_MLA = 0.10411754627697264f;

constexpr size_t MiB = 1ull << 20;
constexpr size_t OFF_BAR = 0;
constexpr size_t OFF_MOD = 16384;
constexpr size_t OFF_COS = OFF_MOD + 98304;
constexpr size_t OFF_SIN = OFF_COS + MiB;
constexpr size_t OFF_RSQ = OFF_SIN + MiB;
constexpr size_t OFF_RSKV = OFF_RSQ + 32768;
constexpr size_t OFF_SSQ = OFF_RSKV + 32768;
constexpr size_t OFF_KEYS = OFF_SSQ + 524288;
constexpr size_t OFF_USC = OFF_KEYS + 524288;
constexpr size_t OFF_VSC = OFF_USC + 65536;
static_assert(OFF_VSC + 65536 <= 4 * MiB, "ws map");
constexpr size_t OFF_WIN_T = 4 * MiB;
constexpr size_t OFF_WUQ_T = OFF_WIN_T + 16 * MiB;
constexpr size_t OFF_WUKV_T = OFF_WUQ_T + 2 * MiB;
constexpr size_t OFF_WO_T = OFF_WUKV_T + 1 * MiB;
constexpr size_t OFF_WPQ_T = OFF_WO_T + 8 * MiB;
constexpr size_t OFF_H = OFF_WPQ_T + 8 * MiB;
constexpr size_t OFF_QSB = OFF_H + 32 * MiB;
constexpr size_t OFF_KSB = OFF_QSB + 16 * MiB;
constexpr size_t OFF_VSB = OFF_KSB + 16 * MiB;
constexpr size_t OFF_CQ = OFF_VSB + 16 * MiB;
constexpr size_t OFF_CKV = OFF_CQ + 8 * MiB;
constexpr size_t OFF_QMLA = OFF_CKV + 4 * MiB;
constexpr size_t OFF_KMLA = OFF_QMLA + 24 * MiB;
constexpr size_t OFF_VMLA = OFF_KMLA + 24 * MiB;
constexpr size_t OFF_O = OFF_VMLA + 16 * MiB;
constexpr size_t OFF_X1 = OFF_O + 32 * MiB;
constexpr size_t OFF_QP = OFF_X1 + 64 * MiB;
constexpr size_t OFF_RIDX = OFF_QP + 32 * MiB;
constexpr size_t OFF_RGATE = OFF_RIDX + 4 * MiB;
constexpr size_t OFF_UTAB = OFF_RGATE + 4 * MiB;
constexpr size_t OFF_VTAB = OFF_UTAB + 64 * MiB;
constexpr size_t OFF_PD = OFF_VTAB + 64 * MiB;
constexpr size_t OFF_SSQP = OFF_PD + 32 * MiB;
constexpr size_t OFF_RSP = OFF_SSQP + 1 * MiB;
constexpr size_t WS_END = OFF_RSP + 1 * MiB;

struct Params {
    const float* x; const float* c; const int* pos; const float* w_ada; const float* b_ada; const float* norm1_g;
    const float* w_in; const float* qn_g; const float* w_uq; const float* kvn_g; const float* w_ukv;
    const float* osb_g; const float* omla_g; const float* w_o; const float* norm2_g; const float* w_pq;
    const float* keys1; const float* keys2; const float* u_tab; const float* v_tab; const float* fin_g;
    float* out; unsigned char* ws;
    int widx; int pad_;
};
template <class Tp> __device__ __forceinline__ Tp* WS(const Params& p, size_t off) { return (Tp*)(p.ws + off); }

__device__ __forceinline__ float bf2f(bf16_t v) { return __uint_as_float(((unsigned)v) << 16); }
__device__ __forceinline__ bf16_t f2bf(float f) { unsigned u = __float_as_uint(f); u += 0x7fffu + ((u >> 16) & 1u); return (bf16_t)(u >> 16); }
__device__ __forceinline__ unsigned pack2(float lo, float hi) { return (unsigned)f2bf(lo) | ((unsigned)f2bf(hi) << 16); }
__device__ __forceinline__ float lo_f(unsigned u) { return __uint_as_float(u << 16); }
__device__ __forceinline__ float hi_f(unsigned u) { return __uint_as_float(u & 0xffff0000u); }
__device__ __forceinline__ float dot8(uint4 a, uint4 b) {
    float s = lo_f(a.x) * lo_f(b.x); s += hi_f(a.x) * hi_f(b.x);
    s += lo_f(a.y) * lo_f(b.y); s += hi_f(a.y) * hi_f(b.y);
    s += lo_f(a.z) * lo_f(b.z); s += hi_f(a.z) * hi_f(b.z);
    s += lo_f(a.w) * lo_f(b.w); s += hi_f(a.w) * hi_f(b.w);
    return s;
}
__device__ __forceinline__ float wave_sum(float v) {
#pragma unroll
    for (int o = 32; o > 0; o >>= 1) v += __shfl_xor(v, o);
    return v;
}
__device__ __forceinline__ float gelu_exact(float x) { return 0.5f * x * (1.0f + erff(x * 0.70710678118654752f)); }

struct EpiInProj {
    static constexpr bool HAS_MID = false;
    bf16_t *qsb, *ksb, *vsb, *cq, *ckv, *kmla; const float *cosT, *sinT; float* rsp;
    __device__ __forceinline__ float row_scale(int) const { return 1.0f; }
    __device__ __forceinline__ float mid_scale(int) const { return 1.0f; }
    __device__ __forceinline__ void store8(int row, int col0, const float (&v)[8], float) const {
        if (col0 >= NIN) return;
        uint4 w;
        if (col0 < 3840) {
            float s = col0 < 1024 ? QS_SB : 1.0f;
            w.x = pack2(v[0] * s, v[1] * s); w.y = pack2(v[2] * s, v[3] * s); w.z = pack2(v[4] * s, v[5] * s); w.w = pack2(v[6] * s, v[7] * s);
            bf16_t* dst;
            if (col0 < 1024) dst = qsb + (size_t)row * 1024 + col0;
            else if (col0 < 2048) dst = ksb + (size_t)row * 1024 + (col0 - 1024);
            else if (col0 < 3072) dst = vsb + (size_t)row * 1024 + (col0 - 2048);
            else if (col0 < 3584) dst = cq + (size_t)row * 512 + (col0 - 3072);
            else dst = ckv + (size_t)row * 256 + (col0 - 3584);
            *(uint4*)dst = w;
            if (col0 >= 3072) {
                float ss = lo_f(w.x) * lo_f(w.x) + hi_f(w.x) * hi_f(w.x) + lo_f(w.y) * lo_f(w.y) + hi_f(w.y) * hi_f(w.y)
                         + lo_f(w.z) * lo_f(w.z) + hi_f(w.z) * hi_f(w.z) + lo_f(w.w) * lo_f(w.w) + hi_f(w.w) * hi_f(w.w);
                ss += __shfl_xor(ss, 16); ss += __shfl_xor(ss, 32);
                if ((tid_fresh(0) & 48) == 0) rsp[(size_t)row * 24 + ((col0 - 3072) >> 5)] = ss;
            }
        } else {
            const int e0 = col0 - 3840, i0 = e0 >> 1;
            float o[8];
#pragma unroll
            for (int j = 0; j < 4; ++j) {
                const float cs = cosT[(size_t)row * 32 + i0 + j], sn = sinT[(size_t)row * 32 + i0 + j];
                const float x1 = v[2 * j], x2 = v[2 * j + 1];
                o[2 * j] = x1 * cs - x2 * sn; o[2 * j + 1] = x2 * cs + x1 * sn;
            }
            w.x = pack2(o[0], o[1]); w.y = pack2(o[2], o[3]); w.z = pack2(o[4], o[5]); w.w = pack2(o[6], o[7]);
#pragma unroll
            for (int h = 0; h < 8; ++h) *(uint4*)(kmla + (size_t)row * 1536 + h * 192 + 128 + e0) = w;
        }
    }
};
struct EpiUq {
    static constexpr bool HAS_MID = false;
    bf16_t* qmla; const float *rsp, *cosT, *sinT;
    __device__ __forceinline__ float mid_scale(int) const { return 1.0f; }
    __device__ __forceinline__ float row_scale(int row) const { float s = 0.f;
#pragma unroll
        for (int i = 0; i < 16; ++i) s += rsp[(size_t)row * 24 + i];
        return rsqrtf(s * (1.0f / 512.0f) + EPS) * QS_MLA; }
    __device__ __forceinline__ void store8(int row, int col0, const float (&v)[8], float r) const {
        const int d0 = col0 % 192;
        float o[8];
        if (d0 < 128) {
#pragma unroll
            for (int j = 0; j < 8; ++j) o[j] = v[j] * r;
        } else {
            const int i0 = (d0 - 128) >> 1;
#pragma unroll
            for (int j = 0; j < 4; ++j) {
                const float cs = cosT[(size_t)row * 32 + i0 + j], sn = sinT[(size_t)row * 32 + i0 + j];
                const float x1 = v[2 * j], x2 = v[2 * j + 1];
                o[2 * j] = (x1 * cs - x2 * sn) * r; o[2 * j + 1] = (x2 * cs + x1 * sn) * r;
            }
        }
        uint4 w; w.x = pack2(o[0], o[1]); w.y = pack2(o[2], o[3]); w.z = pack2(o[4], o[5]); w.w = pack2(o[6], o[7]);
        *(uint4*)(qmla + (size_t)row * 1536 + col0) = w;
    }
};
struct EpiUkv {
    static constexpr bool HAS_MID = false;
    bf16_t *kmla, *vmla; const float* rsp;
    __device__ __forceinline__ float mid_scale(int) const { return 1.0f; }
    __device__ __forceinline__ float row_scale(int row) const { float s = 0.f;
#pragma unroll
        for (int i = 0; i < 8; ++i) s += rsp[(size_t)row * 24 + 16 + i];
        return rsqrtf(s * (1.0f / 256.0f) + EPS); }
    __device__ __forceinline__ void store8(int row, int col0, const float (&v)[8], float r) const {
        const int h = col0 >> 8, j0 = col0 & 255;
        uint4 w; w.x = pack2(v[0] * r, v[1] * r); w.y = pack2(v[2] * r, v[3] * r); w.z = pack2(v[4] * r, v[5] * r); w.w = pack2(v[6] * r, v[7] * r);
        bf16_t* dst = j0 < 128 ? kmla + (size_t)row * 1536 + h * 192 + j0 : vmla + (size_t)row * 1024 + h * 128 + (j0 - 128);
        *(uint4*)dst = w;
    }
};
struct EpiWo {
    static constexpr bool HAS_MID = true;
    const float* x; const float* mod; float* x1; const float* ssq;
    __device__ __forceinline__ void rstd2(int row, float& r0, float& r1) const { float s0 = 0.f, s1 = 0.f;
#pragma unroll
        for (int h = 0; h < 8; ++h) { s0 += ssq[(size_t)row * 16 + h]; s1 += ssq[(size_t)row * 16 + 8 + h]; }
        r0 = rsqrtf(s0 * (1.0f / 1024.0f) + EPS); r1 = rsqrtf(s1 * (1.0f / 1024.0f) + EPS); }
    __device__ __forceinline__ float mid_scale(int row) const { float r0, r1; rstd2(row, r0, r1); return r0 / r1; }
    __device__ __forceinline__ float row_scale(int row) const { float r0, r1; rstd2(row, r0, r1); return r1; }
    __device__ __forceinline__ void store8(int row, int col0, const float (&vin)[8], float rsc) const {
        float v[8];
#pragma unroll
        for (int i = 0; i < 8; ++i) v[i] = vin[i] * rsc;
        const int b = row >> 12;
        const float* g1 = mod + (size_t)b * 12288 + 2 * 2048 + col0;
        const float4 xa = *(const float4*)(x + (size_t)row * DM + col0), xb = *(const float4*)(x + (size_t)row * DM + col0 + 4);
        const float4 ga = *(const float4*)g1, gb = *(const float4*)(g1 + 4);
        float4 oa, ob;
        oa.x = xa.x + ga.x * v[0]; oa.y = xa.y + ga.y * v[1]; oa.z = xa.z + ga.z * v[2]; oa.w = xa.w + ga.w * v[3];
        ob.x = xb.x + gb.x * v[4]; ob.y = xb.y + gb.y * v[5]; ob.z = xb.z + gb.z * v[6]; ob.w = xb.w + gb.w * v[7];
        *(float4*)(x1 + (size_t)row * DM + col0) = oa; *(float4*)(x1 + (size_t)row * DM + col0 + 4) = ob;
    }
};
struct EpiQp {
    static constexpr bool HAS_MID = false;
    bf16_t* qp;
    __device__ __forceinline__ float row_scale(int) const { return 1.0f; }
    __device__ __forceinline__ float mid_scale(int) const { return 1.0f; }
    __device__ __forceinline__ void store8(int row, int col0, const float (&v)[8], float) const {
        uint4 w; w.x = pack2(v[0], v[1]); w.y = pack2(v[2], v[3]); w.z = pack2(v[4], v[5]); w.w = pack2(v[6], v[7]);
        *(uint4*)(qp + (size_t)row * DM + col0) = w;
    }
};

namespace pg8 {
#define PG8_LAS __attribute__((address_space(3)))
typedef unsigned short bf16_t;
typedef short bf16x8 __attribute__((ext_vector_type(8)));
typedef float f32x4 __attribute__((ext_vector_type(4)));
typedef unsigned u32x4 __attribute__((ext_vector_type(4)));
constexpr int BM = 256, BK = 64, HALF = 128, HTB = HALF * BK * 2  , STAGE_BYTES = 8 * HTB, NXCD = 8, WGM = 8;

__host__ __device__ __forceinline__ int lds_byte(int r, int c) { const int st = (r >> 4) * 2 + (c >> 5), rr = r & 15, cc = c & 31, ob = rr * 64 + cc * 2; return st * 1024 + (ob ^ (((ob >> 9) & 1) << 5)); }
__host__ __device__ __forceinline__ void stage_rc(int b, int& R, int& C) { const int st = b / 1024, sb = b % 1024, swz = sb ^ (((sb >> 9) & 1) << 5); R = (st >> 1) * 16 + swz / 64; C = (st & 1) * 32 + (swz % 64) / 2; }
__host__ __device__ __forceinline__ int perm32(int rho) { const int n = rho >> 4, i = rho & 15; return 8 * (i >> 2) + 4 * n + (i & 3); }

struct Unit { int pm, pn; };
struct Gemm { const bf16_t* A; const bf16_t* Bt; int M, N, K, widx; };

struct StaticOrder {
    int nM, nN, nwg, G, c;
    __host__ __device__ __forceinline__ void init(int M, int N, int G_, int c_) { nM = M / BM; nN = N / BM; nwg = nM * nN; G = G_; c = c_; }
    __host__ __device__ bool next(int i, Unit& u) const {
        const long L = (long)i * G + c; if (L >= nwg) return false;
        int wgid = (int)L; { const int q = nwg / NXCD, r = nwg % NXCD, xcd = wgid % NXCD, off = wgid / NXCD; wgid = (xcd < r ? xcd * (q + 1) : r * (q + 1) + (xcd - r) * q) + off; }
        const int nig = WGM * nN, gid = wgid / nig, fm = gid * WGM, gsz = (nM - fm) < WGM ? (nM - fm) : WGM;
        u.pm = fm + ((wgid % nig) % gsz); u.pn = (wgid % nig) / gsz; return true;
    }
    __device__ __forceinline__ void a_ready(const Unit&) const {}
    __device__ __forceinline__ void done(const Unit&) const {}
};

template <class Epi, class Sched, bool ALIGN_EPI = false, bool SP2 = false>
__device__ __forceinline__ void gemm_phase(PG8_LAS unsigned char* lds, const Gemm g, const Sched& S, const Epi& E) {
    const int tid = tid_fresh(g.widx), wid = __builtin_amdgcn_readfirstlane(tid >> 6), lane = tid & 63, wr = wid >> 2, wc = wid & 3, fr = lane & 15, fq = lane >> 4;
    const int K = g.K, nt = K / BK;
    unsigned voffA[2], voffB[2];
#pragma unroll
    for (int i = 0; i < 2; ++i) { int R, C; stage_rc(tid * 16 + i * 8192, R, C); const int Rb = Epi::PERM ? ((R & ~31) + perm32(R & 31)) : R;
        voffA[i] = (unsigned)(R * K + C) * 2u; voffB[i] = (unsigned)(Rb * K + C) * 2u; }
    const size_t kstep = (size_t)(BK * 2);
    const size_t hstep = (size_t)HALF * K * 2;
    const size_t tstep = 2 * hstep;
    const unsigned ldsw = (unsigned)wid * 1024u;
    const int aoff = lds_byte(wr * 64 + fr, fq * 8), boff = lds_byte(wc * 32 + fr, fq * 8);
#define PG8_SA(b, h) (((b) * 2 + (h)) * HTB)
#define PG8_SB(b, h) ((4 + (b) * 2 + (h)) * HTB)
#define PG8_STAGE(bufoff, gbase, voff) do { _Pragma("unroll") for (int _i = 0; _i < 2; ++_i) \
        __builtin_amdgcn_global_load_lds((const unsigned*)((const char*)(gbase) + (voff)[_i]), (PG8_LAS unsigned*)(lds + (bufoff) + ldsw + _i * 8192), 16, 0, 0); } while (0)
#define PG8_LDA(dst, b, h) do { _Pragma("unroll") for (int m = 0; m < 4; ++m) _Pragma("unroll") for (int k = 0; k < 2; ++k) dst[m][k] = *(const PG8_LAS bf16x8*)(lds + PG8_SA(b, h) + aoff + m * 2048 + k * 1024); } while (0)
#define PG8_LDB(dst, b, h) do { _Pragma("unroll") for (int n = 0; n < 2; ++n) _Pragma("unroll") for (int k = 0; k < 2; ++k) dst[n][k] = *(const PG8_LAS bf16x8*)(lds + PG8_SB(b, h) + boff + n * 2048 + k * 1024); } while (0)
#define PG8_MMA(ai, bj, At, Bt) do { __builtin_amdgcn_s_setprio(1); _Pragma("unroll") for (int m = 0; m < 4; ++m) _Pragma("unroll") for (int n = 0; n < 2; ++n) _Pragma("unroll") for (int k = 0; k < 2; ++k) \
        acc[ai][bj][m][n] = __builtin_amdgcn_mfma_f32_16x16x32_bf16(Bt[n][k], At[m][k], acc[ai][bj][m][n], 0, 0, 0); __builtin_amdgcn_s_setprio(0); } while (0)
#define PG8_WAIT_V(n) asm volatile("s_waitcnt vmcnt(" #n ")" ::: "memory")
#define PG8_WAIT_L(n) asm volatile("s_waitcnt lgkmcnt(" #n ")" ::: "memory")
#define PG8_BAR __builtin_amdgcn_s_barrier()
#define PG8_SCHED __builtin_amdgcn_sched_barrier(0)
    Unit cur, nxt; int ui = 0;
    if (!S.next(0, cur)) return;
    f32x4 acc[2][2][4][2];
#pragma unroll
    for (int a = 0; a < 2; ++a)
#pragma unroll
        for (int b = 0; b < 2; ++b)
#pragma unroll
            for (int m = 0; m < 4; ++m)
#pragma unroll
                for (int n = 0; n < 2; ++n) acc[a][b][m][n] = (f32x4){0.f, 0.f, 0.f, 0.f};
    bf16x8 At[4][2], B0[2][2], B1[2][2];
    const char* cA = (const char*)g.A + (size_t)cur.pm * tstep; const char* cB = (const char*)g.Bt + (size_t)cur.pn * tstep;
    S.a_ready(cur);
    if constexpr (SP2) {
        PG8_STAGE(PG8_SB(0, 0), cB, voffB); PG8_STAGE(PG8_SB(0, 1), cB + hstep, voffB); PG8_STAGE(PG8_SA(0, 0), cA, voffA); PG8_STAGE(PG8_SA(0, 1), cA + hstep, voffA);
        if (wr == 1) PG8_BAR;
        PG8_WAIT_V(2); PG8_BAR;
        PG8_STAGE(PG8_SB(1, 0), cB + kstep, voffB); PG8_STAGE(PG8_SA(1, 0), cA + kstep, voffA); PG8_STAGE(PG8_SB(1, 1), cB + hstep + kstep, voffB);
        PG8_WAIT_V(6); PG8_BAR;
    } else {
        PG8_STAGE(PG8_SB(0, 0), cB, voffB); PG8_STAGE(PG8_SA(0, 0), cA, voffA); PG8_STAGE(PG8_SB(0, 1), cB + hstep, voffB); PG8_STAGE(PG8_SA(0, 1), cA + hstep, voffA);
        if (wr == 1) PG8_BAR;
        PG8_WAIT_V(4); PG8_BAR;
        PG8_STAGE(PG8_SB(1, 0), cB + kstep, voffB); PG8_STAGE(PG8_SA(1, 0), cA + kstep, voffA); PG8_STAGE(PG8_SB(1, 1), cB + hstep + kstep, voffB);
        PG8_WAIT_V(6); PG8_BAR;
    }
    for (;;) {
        const bool has_next = S.next(ui + 1, nxt);
        const char* nA = has_next ? (const char*)g.A + (size_t)nxt.pm * tstep : cA; const char* nB = has_next ? (const char*)g.Bt + (size_t)nxt.pn * tstep : cB;
        for (int t = 0; t < nt; t += 2) {
            const bool last = (t == nt - 2);
            const char* a1 = cA + (size_t)(t + 1) * kstep;
            const char* a2 = last ? nA : cA + (size_t)(t + 2) * kstep; const char* b2 = last ? nB : cB + (size_t)(t + 2) * kstep;
            const char* a3 = a2 + kstep; const char* b3 = b2 + kstep;
            if (last && has_next) S.a_ready(nxt);
            if constexpr (Epi::HAS_MID) { if (t == (nt >> 1)) E.mid(acc, cur, wr, wc, fr, fq); }
            if constexpr (SP2) {
            PG8_LDB(B0, 0, 0); PG8_LDB(B1, 0, 1); PG8_SCHED; PG8_LDA(At, 0, 0); PG8_STAGE(PG8_SA(1, 1), a1 + hstep, voffA);
            PG8_WAIT_V(8); PG8_WAIT_L(0); PG8_BAR; PG8_MMA(0, 0, At, B0); PG8_MMA(0, 1, At, B1); PG8_BAR; PG8_SCHED;
            PG8_LDA(At, 0, 1); PG8_STAGE(PG8_SB(0, 0), b2, voffB); PG8_STAGE(PG8_SB(0, 1), b2 + hstep, voffB); PG8_STAGE(PG8_SA(0, 0), a2, voffA);
            PG8_WAIT_V(8); PG8_WAIT_L(0); PG8_BAR; PG8_MMA(1, 0, At, B0); PG8_MMA(1, 1, At, B1); PG8_BAR; PG8_SCHED;
            PG8_LDB(B0, 1, 0); PG8_LDB(B1, 1, 1); PG8_SCHED; PG8_LDA(At, 1, 0); PG8_STAGE(PG8_SA(0, 1), a2 + hstep, voffA);
            PG8_WAIT_V(8); PG8_WAIT_L(0); PG8_BAR; PG8_MMA(0, 0, At, B0); PG8_MMA(0, 1, At, B1); PG8_BAR; PG8_SCHED;
            PG8_LDA(At, 1, 1); PG8_STAGE(PG8_SB(1, 0), b3, voffB); PG8_STAGE(PG8_SB(1, 1), b3 + hstep, voffB); PG8_STAGE(PG8_SA(1, 0), a3, voffA);
            PG8_WAIT_V(8); PG8_WAIT_L(0); PG8_BAR; PG8_MMA(1, 0, At, B0); PG8_MMA(1, 1, At, B1); PG8_BAR; PG8_SCHED;
            } else {
            PG8_LDB(B0, 0, 0); PG8_SCHED; PG8_LDA(At, 0, 0); PG8_STAGE(PG8_SA(1, 1), a1 + hstep, voffA);
            PG8_WAIT_L(8); PG8_BAR; PG8_WAIT_L(0); PG8_MMA(0, 0, At, B0); PG8_BAR; PG8_SCHED;
            PG8_LDB(B1, 0, 1); PG8_STAGE(PG8_SB(0, 0), b2, voffB);
            PG8_BAR; PG8_WAIT_L(0); PG8_MMA(0, 1, At, B1); PG8_BAR;
            PG8_LDA(At, 0, 1); PG8_STAGE(PG8_SA(0, 0), a2, voffA);
            PG8_BAR; PG8_WAIT_L(0); PG8_MMA(1, 0, At, B0); PG8_BAR; PG8_SCHED;
            PG8_STAGE(PG8_SB(0, 1), b2 + hstep, voffB);
            PG8_WAIT_V(6); PG8_BAR; PG8_MMA(1, 1, At, B1); PG8_BAR;
            PG8_LDB(B0, 1, 0); PG8_SCHED; PG8_LDA(At, 1, 0); PG8_STAGE(PG8_SA(0, 1), a2 + hstep, voffA);
            PG8_WAIT_L(8); PG8_BAR; PG8_WAIT_L(0); PG8_MMA(0, 0, At, B0); PG8_BAR; PG8_SCHED;
            PG8_LDB(B1, 1, 1); PG8_STAGE(PG8_SB(1, 0), b3, voffB);
            PG8_BAR; PG8_WAIT_L(0); PG8_MMA(0, 1, At, B1); PG8_BAR;
            PG8_LDA(At, 1, 1); PG8_STAGE(PG8_SA(1, 0), a3, voffA);
            PG8_BAR; PG8_WAIT_L(0); PG8_MMA(1, 0, At, B0); PG8_BAR; PG8_SCHED;
            PG8_STAGE(PG8_SB(1, 1), b3 + hstep, voffB);
            PG8_WAIT_V(6); PG8_BAR; PG8_MMA(1, 1, At, B1); PG8_BAR;
            }
        }
        if constexpr (ALIGN_EPI) { if (wr == 0) PG8_BAR; }
        if constexpr (!Epi::AFTER_DRAIN) { E(acc, cur, wr, wc, fr, fq); S.done(cur); }
        if (!has_next) break;
#pragma unroll
        for (int a = 0; a < 2; ++a)
#pragma unroll
            for (int b = 0; b < 2; ++b)
#pragma unroll
                for (int m = 0; m < 4; ++m)
#pragma unroll
                    for (int n = 0; n < 2; ++n) acc[a][b][m][n] = (f32x4){0.f, 0.f, 0.f, 0.f};
        cur = nxt; cA = nA; cB = nB; ++ui;
        if constexpr (ALIGN_EPI) { if (wr == 1) PG8_BAR; }
    }
    PG8_WAIT_V(0);
    if constexpr (!ALIGN_EPI) { if (wr == 0) PG8_BAR; }
    PG8_BAR;
    if constexpr (Epi::AFTER_DRAIN) { E.fused(acc, cur, wr, wc, fr, fq, lds, wid, lane); S.done(cur); }
#undef PG8_SA
#undef PG8_SB
#undef PG8_STAGE
#undef PG8_LDA
#undef PG8_LDB
#undef PG8_MMA
#undef PG8_WAIT_V
#undef PG8_WAIT_L
#undef PG8_BAR
#undef PG8_SCHED
}
}

template <class C> struct EpiChunk {
    static constexpr bool PERM = true, AFTER_DRAIN = false, HAS_MID = C::HAS_MID;
    C c;
    __device__ __forceinline__ void mid(pg8::f32x4 (&acc)[2][2][4][2], const pg8::Unit& u, int wr, int wc, int fr, int fq) const {
#pragma unroll
        for (int ai = 0; ai < 2; ++ai)
#pragma unroll
            for (int m = 0; m < 4; ++m) { const float f = c.mid_scale(u.pm * 256 + ai * 128 + wr * 64 + m * 16 + fr);
#pragma unroll
                for (int bj = 0; bj < 2; ++bj)
#pragma unroll
                    for (int n = 0; n < 2; ++n) acc[ai][bj][m][n] = acc[ai][bj][m][n] * f; }
    }
    __device__ __forceinline__ void operator()(const pg8::f32x4 (&acc)[2][2][4][2], const pg8::Unit& u, int wr, int wc, int fr, int fq) const {
#pragma unroll
        for (int ai = 0; ai < 2; ++ai)
#pragma unroll
            for (int m = 0; m < 4; ++m) {
                const int row = u.pm * 256 + ai * 128 + wr * 64 + m * 16 + fr;
                const float rsc = c.row_scale(row);
#pragma unroll
                for (int bj = 0; bj < 2; ++bj) {
                    const int col0 = u.pn * 256 + bj * 128 + wc * 32 + 8 * fq;
                    const pg8::f32x4 a = acc[ai][bj][m][0], b = acc[ai][bj][m][1];
                    const float v[8] = {a[0], a[1], a[2], a[3], b[0], b[1], b[2], b[3]};
                    c.store8(row, col0, v, rsc);
                }
                asm volatile("" ::: "memory");
            }
    }
};
template <class C> __device__ __forceinline__ void gemm_mfma(const bf16_t* A, const bf16_t* Bt, int M, int N, int K, const C& c, int bid, int nblk, unsigned char* lds, int widx) {
    pg8::Gemm g; g.A = A; g.Bt = Bt; g.M = M; g.N = N; g.K = K; g.widx = widx;
    pg8::StaticOrder S; S.init(M, N, nblk, bid);
    EpiChunk<C> E{c};
    pg8::gemm_phase<EpiChunk<C>, pg8::StaticOrder, true, true>((PG8_LAS unsigned char*)lds, g, S, E);
}

template <class Epi>
__device__ __forceinline__ void gemm_ref(const bf16_t* A, int lda, const bf16_t* Bt, int ldb, int M, int N, int K, const Epi& E, int bid, int nblk) {
    const int tid = (int)threadIdx.x, tn = N / 64, ntile = (M / 64) * tn;
    for (int tile = bid; tile < ntile; tile += nblk) {
        const int row = (tile / tn) * 64 + (tid >> 3), col0 = (tile % tn) * 64 + (tid & 7) * 8;
        float acc[8];
#pragma unroll
        for (int j = 0; j < 8; ++j) acc[j] = 0.f;
        const bf16_t* ap = A + (size_t)row * lda; const bf16_t* bp = Bt + (size_t)col0 * ldb;
        for (int k0 = 0; k0 < K; k0 += 8) {
            const uint4 av = *(const uint4*)(ap + k0);
#pragma unroll
            for (int j = 0; j < 8; ++j) { const uint4 bv = *(const uint4*)(bp + (size_t)j * ldb + k0); acc[j] += dot8(av, bv); }
        }
        E.store8(row, col0, acc, E.row_scale(row));
    }
}

constexpr int J_ADA = 192, J_WIN = 64, J_WO = 32, J_WPQ = 32, J_WUQ = 24, J_WUKV = 32, J_KEYS = 16, J_ROPE = 16;
constexpr int J0_END = J_ADA, J1_END = J0_END + J_WIN, J2_END = J1_END + J_WO, J3_END = J2_END + J_WPQ, J4_END = J3_END + J_WUQ,
              J5_END = J4_END + J_WUKV, J6_END = J5_END + J_KEYS, J7_END = J6_END + J_ROPE, J8_END = J7_END + 1024;

__device__ __forceinline__ void job_ada(const Params& p, int it, float* lds) {
    const int tid = tid_fresh(p.widx);
    float* sc = lds;
    float* red = lds + 4096;
    for (int i = tid; i < 4096; i += 512) { const float v = p.c[i]; sc[i] = v / (1.0f + __expf(-v)); }
    __syncthreads();
    const int cg = tid & 15, rl = tid >> 4, c0 = it * 64 + cg * 4;
    float4 a0 = {0.f, 0.f, 0.f, 0.f}, a1 = {0.f, 0.f, 0.f, 0.f};
#pragma unroll 8
    for (int i = 0; i < 64; ++i) {
        const int k = rl + 32 * i;
        const float4 w = *(const float4*)(p.w_ada + (size_t)k * 12288 + c0);
        const float s0 = sc[k], s1 = sc[2048 + k];
        a0.x += s0 * w.x; a0.y += s0 * w.y; a0.z += s0 * w.z; a0.w += s0 * w.w;
        a1.x += s1 * w.x; a1.y += s1 * w.y; a1.z += s1 * w.z; a1.w += s1 * w.w;
    }
    float* r0 = red + rl * 128 + cg * 4;
    r0[0] = a0.x; r0[1] = a0.y; r0[2] = a0.z; r0[3] = a0.w; r0[64] = a1.x; r0[65] = a1.y; r0[66] = a1.z; r0[67] = a1.w;
    __syncthreads();
    if (tid < 128) {
        float s = 0.f;
        for (int r = 0; r < 32; ++r) s += red[r * 128 + tid];
        const int b = tid >> 6, col = it * 64 + (tid & 63);
        WS<float>(p, OFF_MOD)[(size_t)b * 12288 + col] = s + p.b_ada[col];
    }
    __syncthreads();
}

template <int W> __device__ __forceinline__ int tr_dst_row(int n) {
    if (W == 0) { if (n < 3840) return n; const int e = n - 3840; return 3840 + 2 * (e & 31) + (e >> 5); }
    if (W == 3) { const int h = n / 192, d = n % 192; if (d < 128) return n; const int e = d - 128; return h * 192 + 128 + 2 * (e & 31) + (e >> 5); }
    return n;
}
template <int W> __device__ __forceinline__ float tr_scale(const Params& p, int k) {
    if (W == 1) return k < 1024 ? p.osb_g[k] : p.omla_g[k - 1024];
    if (W == 3) return p.qn_g[k];
    if (W == 4) return p.kvn_g[k];
    return 1.0f;
}
template <int W> __device__ __forceinline__ void job_transpose(const Params& p, int it, float* tile) {
    constexpr int K = (W == 3) ? 512 : (W == 4) ? 256 : 2048;
    constexpr int NS = (W == 0) ? NIN : (W == 3) ? 1536 : 2048;
    constexpr int TS = 68;
    const float* src = (W == 0) ? p.w_in : (W == 1) ? p.w_o : (W == 2) ? p.w_pq : (W == 3) ? p.w_uq : p.w_ukv;
    bf16_t* dst = WS<bf16_t>(p, (W == 0) ? OFF_WIN_T : (W == 1) ? OFF_WO_T : (W == 2) ? OFF_WPQ_T : (W == 3) ? OFF_WUQ_T : OFF_WUKV_T);
    const int tid = tid_fresh(p.widx), n0 = it * 64;
    if (W == 0 && n0 >= NIN) {
        const uint4 z = {0u, 0u, 0u, 0u};
        for (int i = tid; i < 64 * K / 8; i += 512) *(uint4*)(dst + (size_t)n0 * K + (size_t)i * 8) = z;
        return;
    }
    const int lr = tid >> 4, lc = (tid & 15) * 4;
    const int sn = tid >> 3, skc = tid & 7;
    const size_t drow = (size_t)tr_dst_row<W>(n0 + sn) * K;
    for (int k0 = 0; k0 < K; k0 += 256) {
        float4 r[8];
#pragma unroll
        for (int i = 0; i < 8; ++i) r[i] = *(const float4*)(src + (size_t)(k0 + lr + 32 * i) * NS + n0 + lc);
#pragma unroll
        for (int i = 0; i < 8; ++i) *(float4*)(tile + (lr + 32 * i) * TS + lc) = r[i];
        __syncthreads();
#pragma unroll
        for (int q = 0; q < 4; ++q) {
            const int kk = skc * 32 + q * 8;
            float v[8];
#pragma unroll
            for (int j = 0; j < 8; ++j) v[j] = tile[(kk + j) * TS + sn] * tr_scale<W>(p, k0 + kk + j);
            uint4 w; w.x = pack2(v[0], v[1]); w.y = pack2(v[2], v[3]); w.z = pack2(v[4], v[5]); w.w = pack2(v[6], v[7]);
            *(uint4*)(dst + drow + k0 + kk) = w;
        }
        __syncthreads();
    }
}
__device__ __forceinline__ void job_keys(const Params& p, int slot) {
    const float* src = ((slot & 1) ? p.keys2 : p.keys1) + (size_t)(slot >> 1) * 16384;
    bf16_t* dst = WS<bf16_t>(p, OFF_KEYS) + (size_t)slot * 16384;
    for (int i = tid_fresh(p.widx); i < 16384; i += 512) dst[i] = f2bf(src[i]);
}
__device__ __forceinline__ void job_rope(const Params& p, int it) {
    float* cosT = WS<float>(p, OFF_COS); float* sinT = WS<float>(p, OFF_SIN);
    for (int j = 0; j < 32; ++j) {
        const int idx = tid_fresh(p.widx) + 512 * j, t = it * 512 + (idx >> 5), i = idx & 31;
        double inv = 1.0;
        for (int q = 0; q < i; ++q) inv *= 0.7498942093324559;
        const double ang = (double)p.pos[t] * inv;
        const double n = rint(ang * 0.15915494309189535);
        const double r = fma(-n, 6.283185307179586, ang) - n * 2.4492935982947064e-16;
        const float rf = (float)r;
        cosT[(size_t)t * 32 + i] = cosf(rf); sinT[(size_t)t * 32 + i] = sinf(rf);
    }
}
template <int EB> __device__ __forceinline__ void job_table(const Params& p, int it);
__device__ __forceinline__ void job_table6(const Params& p, int it);
__device__ __forceinline__ void phase0(const Params& p, int bid, int nblk, float* lds) {
    for (int it = bid; it < J7_END; it += nblk) {
        if (it < J0_END) job_ada(p, it, lds);
        else if (it < J1_END) job_transpose<0>(p, it - J0_END, lds);
        else if (it < J2_END) job_transpose<1>(p, it - J1_END, lds);
        else if (it < J3_END) job_transpose<2>(p, it - J2_END, lds);
        else if (it < J4_END) job_transpose<3>(p, it - J3_END, lds);
        else if (it < J5_END) job_transpose<4>(p, it - J4_END, lds);
        else if (it < J6_END) job_keys(p, it - J5_END);
        else if (it < J7_END) job_rope(p, it - J6_END);
        else if (TAB_EB == 6) job_table6(p, it - J7_END);
        else job_table<TAB_EB == 6 ? 1 : TAB_EB>(p, it - J7_END);
    }
}

__device__ __forceinline__ void phase_norm_mod(const Params& p, const float* src, const float* gain, int sh_idx, int sc_idx, bf16_t* dst, int bid, int nblk, float* lds) {
    const int tid = tid_fresh(p.widx), lane = tid & 63, wid = tid >> 6;
    const float* mod = WS<float>(p, OFF_MOD);
    float* av = lds;
    float* sv = lds + 4096;
    for (int i = tid; i < 4096; i += 512) { const int b = i >> 11, col = i & 2047;
        av[i] = gain[col] * (1.0f + mod[(size_t)b * 12288 + sc_idx * 2048 + col]); sv[i] = mod[(size_t)b * 12288 + sh_idx * 2048 + col]; }
    __syncthreads();
    for (int t = bid * 8 + wid; t < TOK; t += nblk * 8) {
        const int b = t >> 12;
        const float* xr = src + (size_t)t * DM;
        float4 v[8]; float ss = 0.f;
#pragma unroll
        for (int j = 0; j < 8; ++j) { v[j] = *(const float4*)(xr + (j * 64 + lane) * 4); ss += v[j].x * v[j].x + v[j].y * v[j].y + v[j].z * v[j].z + v[j].w * v[j].w; }
        ss = wave_sum(ss);
        const float rstd = rsqrtf(ss * (1.0f / DM) + EPS);
#pragma unroll
        for (int j = 0; j < 8; ++j) {
            const int col = (j * 64 + lane) * 4;
            const float4 a = *(const float4*)(av + b * 2048 + col), s = *(const float4*)(sv + b * 2048 + col);
            uint2 w; w.x = pack2(v[j].x * rstd * a.x + s.x, v[j].y * rstd * a.y + s.y); w.y = pack2(v[j].z * rstd * a.z + s.z, v[j].w * rstd * a.w + s.w);
            *(uint2*)(dst + (size_t)t * DM + col) = w;
        }
    }
    __syncthreads();
}

__device__ __forceinline__ void phase_rowstats(const Params& p, int bid, int nblk) {
    const int tidf = tid_fresh(p.widx), lane = tidf & 63, wid = tidf >> 6;
    const bf16_t* cq = WS<bf16_t>(p, OFF_CQ); const bf16_t* ckv = WS<bf16_t>(p, OFF_CKV);
    for (int t = bid * 8 + wid; t < TOK; t += nblk * 8) {
        const uint4 a = *(const uint4*)(cq + (size_t)t * 512 + lane * 8);
        float s1 = dot8(a, a), s2 = 0.f;
        if (lane < 32) { const uint4 b = *(const uint4*)(ckv + (size_t)t * 256 + lane * 8); s2 = dot8(b, b); }
        s1 = wave_sum(s1); s2 = wave_sum(s2);
        if (lane == 0) { WS<float>(p, OFF_RSQ)[t] = rsqrtf(s1 * (1.0f / 512.0f) + EPS); WS<float>(p, OFF_RSKV)[t] = rsqrtf(s2 * (1.0f / 256.0f) + EPS); }
    }
}

__device__ __forceinline__ void phase_attn_ref(const Params& p, int bid, int nblk) {
    const int tid = tid_fresh(p.widx), ql = tid >> 2, part = tid & 3;
    const bf16_t* qsb = WS<bf16_t>(p, OFF_QSB); const bf16_t* ksb = WS<bf16_t>(p, OFF_KSB); const bf16_t* vsb = WS<bf16_t>(p, OFF_VSB);
    const bf16_t* qml = WS<bf16_t>(p, OFF_QMLA); const bf16_t* kml = WS<bf16_t>(p, OFF_KMLA); const bf16_t* vml = WS<bf16_t>(p, OFF_VMLA);
    bf16_t* O = WS<bf16_t>(p, OFF_O); float* ssq = WS<float>(p, OFF_SSQ);
    for (int it = bid; it < 1024; it += nblk) {
        const int g = it >> 9, rem = it & 511, b = rem >> 8, h = (rem >> 5) & 7, qb = 31 - (rem & 31);
        const int t = qb * 128 + ql; const size_t tok = (size_t)b * SEQ + t;
        const int tmax = qb * 128 + (ql | 15);
        float o[32];
#pragma unroll
        for (int d = 0; d < 32; ++d) o[d] = 0.f;
        if (g == 0) {
            uint4 q[4];
#pragma unroll
            for (int j = 0; j < 4; ++j) q[j] = *(const uint4*)(qsb + tok * 1024 + h * 128 + part * 32 + j * 8);
            float between = 0.f;
            for (int s = tmax - 1; s >= 0; --s) {
                const size_t kt = (size_t)b * SEQ + s;
                float z2 = 0.f;
#pragma unroll
                for (int j = 0; j < 4; ++j) z2 += dot8(q[j], *(const uint4*)(ksb + kt * 1024 + h * 128 + part * 32 + j * 8));
                z2 += __shfl_xor(z2, 1); z2 += __shfl_xor(z2, 2);
                if (s < t) {
                    const float z = z2 * LN2;
                    const float l1p = log1pf(__expf(-fabsf(z)));
                    const float lsig = fminf(z, 0.f) - l1p, lsign = -fmaxf(z, 0.f) - l1p;
                    const float w = __expf(lsig + between);
                    between += lsign;
#pragma unroll
                    for (int j = 0; j < 4; ++j) { const uint4 vv = *(const uint4*)(vsb + kt * 1024 + h * 128 + part * 32 + j * 8);
                        o[j * 8 + 0] += w * lo_f(vv.x); o[j * 8 + 1] += w * hi_f(vv.x); o[j * 8 + 2] += w * lo_f(vv.y); o[j * 8 + 3] += w * hi_f(vv.y);
                        o[j * 8 + 4] += w * lo_f(vv.z); o[j * 8 + 5] += w * hi_f(vv.z); o[j * 8 + 6] += w * lo_f(vv.w); o[j * 8 + 7] += w * hi_f(vv.w); }
                }
            }
        } else {
            uint4 q[6];
#pragma unroll
            for (int j = 0; j < 6; ++j) q[j] = *(const uint4*)(qml + tok * 1536 + h * 192 + part * 48 + j * 8);
            float m = -1e30f, l = 0.f;
            for (int s = 0; s <= tmax; ++s) {
                const size_t kt = (size_t)b * SEQ + s;
                float sc = 0.f;
#pragma unroll
                for (int j = 0; j < 6; ++j) sc += dot8(q[j], *(const uint4*)(kml + kt * 1536 + h * 192 + part * 48 + j * 8));
                sc += __shfl_xor(sc, 1); sc += __shfl_xor(sc, 2);
                if (s <= t) {
                    const float mn = fmaxf(m, sc), alpha = exp2f(m - mn), pw = exp2f(sc - mn);
                    l = l * alpha + pw; m = mn;
#pragma unroll
                    for (int j = 0; j < 4; ++j) { const uint4 vv = *(const uint4*)(vml + kt * 1024 + h * 128 + part * 32 + j * 8);
                        o[j * 8 + 0] = o[j * 8 + 0] * alpha + pw * lo_f(vv.x); o[j * 8 + 1] = o[j * 8 + 1] * alpha + pw * hi_f(vv.x);
                        o[j * 8 + 2] = o[j * 8 + 2] * alpha + pw * lo_f(vv.y); o[j * 8 + 3] = o[j * 8 + 3] * alpha + pw * hi_f(vv.y);
                        o[j * 8 + 4] = o[j * 8 + 4] * alpha + pw * lo_f(vv.z); o[j * 8 + 5] = o[j * 8 + 5] * alpha + pw * hi_f(vv.z);
                        o[j * 8 + 6] = o[j * 8 + 6] * alpha + pw * lo_f(vv.w); o[j * 8 + 7] = o[j * 8 + 7] * alpha + pw * hi_f(vv.w); }
                }
            }
            const float inv = 1.0f / l;
#pragma unroll
            for (int d = 0; d < 32; ++d) o[d] *= inv;
        }
        float ss = 0.f;
#pragma unroll
        for (int d = 0; d < 32; ++d) ss += o[d] * o[d];
        ss += __shfl_xor(ss, 1); ss += __shfl_xor(ss, 2);
        if (part == 0) ssq[tok * 16 + g * 8 + h] = ss;
        bf16_t* op = O + tok * 2048 + g * 1024 + h * 128 + part * 32;
#pragma unroll
        for (int j = 0; j < 4; ++j) { uint4 w; w.x = pack2(o[j * 8], o[j * 8 + 1]); w.y = pack2(o[j * 8 + 2], o[j * 8 + 3]); w.z = pack2(o[j * 8 + 4], o[j * 8 + 5]); w.w = pack2(o[j * 8 + 6], o[j * 8 + 7]);
            *(uint4*)(op + j * 8) = w; }
    }
}


typedef short bf16x8_t __attribute__((ext_vector_type(8)));
typedef short s16x4_t __attribute__((ext_vector_type(4)));
typedef float f32x16_t __attribute__((ext_vector_type(16)));
typedef float f32x2_t __attribute__((ext_vector_type(2)));
typedef unsigned u32x4_t __attribute__((ext_vector_type(4)));
typedef __bf16 bf16x2_t __attribute__((ext_vector_type(2)));
__device__ __forceinline__ unsigned cvt_pk_bf16(float lo, float hi) { f32x2_t v = {lo, hi}; bf16x2_t b = __builtin_convertvector(v, bf16x2_t); return __builtin_bit_cast(unsigned, b); }
__device__ __forceinline__ void swap32(float a, float& lo, float& hi) {
    auto r = __builtin_amdgcn_permlane32_swap(__float_as_uint(a), __float_as_uint(a), false, false);
    lo = __uint_as_float(r[0]); hi = __uint_as_float(r[1]);
}
constexpr int ATT_VSTR = 320;
constexpr int ATT_STAGE_MAX = 64 * (192 * 2 + 16) + 64 * ATT_VSTR;
constexpr int ATT_BC_OFF = 2 * 64 * (192 * 2 + 16) + 3 * 64 * ATT_VSTR;
constexpr int ATT_HEAD_WORD = 3840;

template <int G>
__device__ __forceinline__ void attn_qk(const LAS unsigned char* kbuf, const bf16x8_t (&qf)[G ? 12 : 8], f32x16_t& s0, f32x16_t& s1, unsigned kread) {
    constexpr int DK = G ? 192 : 128, NKS = DK / 16, KSTR = DK * 2 + 16;
#pragma unroll
    for (int r = 0; r < 16; ++r) { s0[r] = 0.f; s1[r] = 0.f; }
    const LAS unsigned char* kp = kbuf + kread;
#pragma unroll
    for (int ks = 0; ks < NKS; ++ks) {
        const bf16x8_t a0 = *(const LAS bf16x8_t*)(kp + ks * 32), a1 = *(const LAS bf16x8_t*)(kp + 32 * KSTR + ks * 32);
        s0 = __builtin_amdgcn_mfma_f32_32x32x16_bf16(a0, qf[ks], s0, 0, 0, 0);
        s1 = __builtin_amdgcn_mfma_f32_32x32x16_bf16(a1, qf[ks], s1, 0, 0, 0);
    }
    __builtin_amdgcn_sched_group_barrier(0x100, 6, 0);
#pragma unroll
    for (int i = 0; i < 2 * NKS - 6; ++i) { __builtin_amdgcn_sched_group_barrier(0x8, 1, 0); __builtin_amdgcn_sched_group_barrier(0x100, 1, 0); }
#pragma unroll
    for (int i = 0; i < 6; ++i) __builtin_amdgcn_sched_group_barrier(0x8, 1, 0);
}
template <int G>
__device__ __forceinline__ void attn_sm(bool need_mask, f32x16_t& s0, f32x16_t& s1, unsigned (&pk)[2][8], f32x16_t (&o)[4], float& st0, float& st1, int lim, int hh) {
    if (need_mask) {
        asm volatile("" ::: "memory");
        const float neg = G ? -INFINITY : -100.0f;
#pragma unroll
        for (int r = 0; r < 16; ++r) { const int kr = (r & 3) + 8 * (r >> 2) + 4 * hh;
            s0[r] = (G ? (kr <= lim) : (kr < lim)) ? s0[r] : neg; s1[r] = (G ? (32 + kr <= lim) : (32 + kr < lim)) ? s1[r] : neg; }
    }
    if (G == 0) {
        float R = st0;
#pragma unroll
        for (int kb = 1; kb >= 0; --kb) {
#pragma unroll
            for (int g = 3; g >= 0; --g) {
                float sg[4], om[4];
#pragma unroll
                for (int rr = 0; rr < 4; ++rr) {
                    const float z2 = kb ? s1[4 * g + rr] : s0[4 * g + rr];
                    const float e = __builtin_amdgcn_exp2f(-z2);
                    const float sig = __builtin_amdgcn_rcpf(1.0f + e);
                    sg[rr] = sig; om[rr] = e * sig;
                }
                const float gown = (om[0] * om[1]) * (om[2] * om[3]);
                float glo, ghi; swap32(gown, glo, ghi);
                const float E = hh ? R : R * ghi;
                const float e2 = E * om[3], e1 = e2 * om[2], e0 = e1 * om[1];
                pk[kb][2 * g] = cvt_pk_bf16(sg[0] * e0, sg[1] * e1); pk[kb][2 * g + 1] = cvt_pk_bf16(sg[2] * e2, sg[3] * E);
                R = R * (glo * ghi);
            }
        }
        st0 = R;
    } else {
        float mx = fmaxf(s0[0], s1[0]);
#pragma unroll
        for (int r = 1; r < 16; ++r) mx = fmaxf(mx, fmaxf(s0[r], s1[r]));
        float mlo, mhi; swap32(mx, mlo, mhi);
        const float mn = fmaxf(st0, fmaxf(mlo, mhi)), alpha = __builtin_amdgcn_exp2f(st0 - mn);
        st0 = mn;
        float ls = 0.f;
#pragma unroll
        for (int g = 0; g < 4; ++g) {
            float a[4], bq[4];
#pragma unroll
            for (int rr = 0; rr < 4; ++rr) { a[rr] = __builtin_amdgcn_exp2f(s0[4 * g + rr] - mn); bq[rr] = __builtin_amdgcn_exp2f(s1[4 * g + rr] - mn); ls += a[rr] + bq[rr]; }
            pk[0][2 * g] = cvt_pk_bf16(a[0], a[1]); pk[0][2 * g + 1] = cvt_pk_bf16(a[2], a[3]);
            pk[1][2 * g] = cvt_pk_bf16(bq[0], bq[1]); pk[1][2 * g + 1] = cvt_pk_bf16(bq[2], bq[3]);
        }
        st1 = st1 * alpha + ls;
        if (__builtin_amdgcn_ballot_w64(alpha != 1.0f) != 0ull) {
#pragma unroll
            for (int d = 0; d < 4; ++d) o[d] = o[d] * alpha;
        }
    }
}
__device__ __forceinline__ void attn_pv(const LAS unsigned char* vbuf, const unsigned (&pk)[2][8], f32x16_t (&o)[4], unsigned vread) {
    constexpr int VSTR = ATT_VSTR;
    const LAS unsigned char* vp = vbuf + vread;
#pragma unroll
    for (int kb = 0; kb < 2; ++kb)
#pragma unroll
        for (int s = 0; s < 2; ++s) {
            bf16x8_t pf;
            { const unsigned w0 = pk[kb][4 * s], w1 = pk[kb][4 * s + 1], w2 = pk[kb][4 * s + 2], w3 = pk[kb][4 * s + 3];
              pf[0] = (short)(w0 & 0xffff); pf[1] = (short)(w0 >> 16); pf[2] = (short)(w1 & 0xffff); pf[3] = (short)(w1 >> 16);
              pf[4] = (short)(w2 & 0xffff); pf[5] = (short)(w2 >> 16); pf[6] = (short)(w3 & 0xffff); pf[7] = (short)(w3 >> 16); }
#pragma unroll
            for (int d = 0; d < 4; ++d) {
                const LAS unsigned char* vq = vp + (32 * kb + 16 * s) * VSTR + d * 64;
                const s16x4_t lo = __builtin_amdgcn_ds_read_tr16_b64_v4i16((LAS s16x4_t*)(vq));
                const s16x4_t hi = __builtin_amdgcn_ds_read_tr16_b64_v4i16((LAS s16x4_t*)(vq + 8 * VSTR));
                const bf16x8_t vf = {lo[0], lo[1], lo[2], lo[3], hi[0], hi[1], hi[2], hi[3]};
                o[d] = __builtin_amdgcn_mfma_f32_32x32x16_bf16(vf, pf, o[d], 0, 0, 0);
            }
        }
    __builtin_amdgcn_sched_group_barrier(0x100, 6, 0);
#pragma unroll
    for (int i = 0; i < 13; ++i) { __builtin_amdgcn_sched_group_barrier(0x8, 1, 0); __builtin_amdgcn_sched_group_barrier(0x100, 2, 0); }
#pragma unroll
    for (int i = 0; i < 3; ++i) __builtin_amdgcn_sched_group_barrier(0x8, 1, 0);
}

__device__ __forceinline__ void sb_half_math(const f32x16_t& s, unsigned (&pkh)[8], float& R, int hh) {
#pragma unroll
    for (int g = 3; g >= 0; --g) {
        float sg[4], om[4];
#pragma unroll
        for (int rr = 0; rr < 4; ++rr) { const float e = __builtin_amdgcn_exp2f(-s[4 * g + rr]); const float sig = __builtin_amdgcn_rcpf(1.0f + e); sg[rr] = sig; om[rr] = e * sig; }
        const float gown = (om[0] * om[1]) * (om[2] * om[3]);
        float glo, ghi; swap32(gown, glo, ghi);
        const float E = hh ? R : R * ghi;
        const float e2 = E * om[3], e1 = e2 * om[2], e0 = e1 * om[1];
        pkh[2 * g] = cvt_pk_bf16(sg[0] * e0, sg[1] * e1); pkh[2 * g + 1] = cvt_pk_bf16(sg[2] * e2, sg[3] * E);
        R = R * (glo * ghi);
    }
}
__device__ __forceinline__ void pv_half(const LAS unsigned char* vp, int kb, const unsigned (&pkh)[8], f32x16_t (&o)[4]) {
    constexpr int VSTR = ATT_VSTR;
#pragma unroll
    for (int s = 0; s < 2; ++s) {
        bf16x8_t pf;
        { const unsigned w0 = pkh[4 * s], w1 = pkh[4 * s + 1], w2 = pkh[4 * s + 2], w3 = pkh[4 * s + 3];
          pf[0] = (short)(w0 & 0xffff); pf[1] = (short)(w0 >> 16); pf[2] = (short)(w1 & 0xffff); pf[3] = (short)(w1 >> 16);
          pf[4] = (short)(w2 & 0xffff); pf[5] = (short)(w2 >> 16); pf[6] = (short)(w3 & 0xffff); pf[7] = (short)(w3 >> 16); }
#pragma unroll
        for (int d = 0; d < 4; ++d) {
            const LAS unsigned char* vq = vp + (32 * kb + 16 * s) * VSTR + d * 64;
            const s16x4_t lo = __builtin_amdgcn_ds_read_tr16_b64_v4i16((LAS s16x4_t*)(vq));
            const s16x4_t hi = __builtin_amdgcn_ds_read_tr16_b64_v4i16((LAS s16x4_t*)(vq + 8 * VSTR));
            const bf16x8_t vf = {lo[0], lo[1], lo[2], lo[3], hi[0], hi[1], hi[2], hi[3]};
            o[d] = __builtin_amdgcn_mfma_f32_32x32x16_bf16(vf, pf, o[d], 0, 0, 0);
        }
    }
}
__device__ __forceinline__ void attn_tile_sb(bool need_mask, const LAS unsigned char* base, const bf16x8_t (&qf)[8], f32x16_t (&o)[4], float& st0, int lim, unsigned kread, unsigned vread, int hh) {
    constexpr int KSTR = 128 * 2 + 16;
    const LAS unsigned char* kp = base + kread;
    f32x16_t s0, s1;
#pragma unroll
    for (int r = 0; r < 16; ++r) { s0[r] = 0.f; s1[r] = 0.f; }
#pragma unroll
    for (int ks = 0; ks < 8; ++ks) s1 = __builtin_amdgcn_mfma_f32_32x32x16_bf16(*(const LAS bf16x8_t*)(kp + 32 * KSTR + ks * 32), qf[ks], s1, 0, 0, 0);
#pragma unroll
    for (int ks = 0; ks < 8; ++ks) s0 = __builtin_amdgcn_mfma_f32_32x32x16_bf16(*(const LAS bf16x8_t*)(kp + ks * 32), qf[ks], s0, 0, 0, 0);
    if (need_mask) {
        asm volatile("" ::: "memory");
#pragma unroll
        for (int r = 0; r < 16; ++r) { const int kr = (r & 3) + 8 * (r >> 2) + 4 * hh; s0[r] = (kr < lim) ? s0[r] : -100.0f; s1[r] = (32 + kr < lim) ? s1[r] : -100.0f; }
    }
    unsigned pk1[8], pk0[8]; float R = st0;
    sb_half_math(s1, pk1, R, hh);
    pv_half(base + vread, 1, pk1, o);
    sb_half_math(s0, pk0, R, hh);
    pv_half(base + vread, 0, pk0, o);
    st0 = R;
}

__device__ __forceinline__ void attn_tile_mla(bool need_mask, const LAS unsigned char* base, const bf16x8_t (&qf)[12], f32x16_t (&o)[4], float& st0, float& st1, int lim, unsigned kread, unsigned vread, int hh) {
    f32x16_t s0, s1;
    attn_qk<1>(base, qf, s0, s1, kread);
    if (need_mask) {
        asm volatile("" ::: "memory");
#pragma unroll
        for (int r = 0; r < 16; ++r) { const int kr = (r & 3) + 8 * (r >> 2) + 4 * hh; s0[r] = (kr <= lim) ? s0[r] : -INFINITY; s1[r] = (32 + kr <= lim) ? s1[r] : -INFINITY; }
    }
    float mx = fmaxf(s0[0], s1[0]);
#pragma unroll
    for (int r = 1; r < 16; ++r) mx = fmaxf(mx, fmaxf(s0[r], s1[r]));
    float mlo, mhi; swap32(mx, mlo, mhi);
    const float mn = fmaxf(st0, fmaxf(mlo, mhi)), alpha = __builtin_amdgcn_exp2f(st0 - mn);
    st0 = mn;
    if (__builtin_amdgcn_ballot_w64(alpha != 1.0f) != 0ull) {
#pragma unroll
        for (int d = 0; d < 4; ++d) o[d] = o[d] * alpha;
    }
    unsigned pk1[8], pk0[8]; float ls = 0.f;
#pragma unroll
    for (int g = 0; g < 4; ++g) { float a[4];
#pragma unroll
        for (int rr = 0; rr < 4; ++rr) { a[rr] = __builtin_amdgcn_exp2f(s1[4 * g + rr] - mn); ls += a[rr]; }
        pk1[2 * g] = cvt_pk_bf16(a[0], a[1]); pk1[2 * g + 1] = cvt_pk_bf16(a[2], a[3]); }
    pv_half(base + vread, 1, pk1, o);
#pragma unroll
    for (int g = 0; g < 4; ++g) { float a[4];
#pragma unroll
        for (int rr = 0; rr < 4; ++rr) { a[rr] = __builtin_amdgcn_exp2f(s0[4 * g + rr] - mn); ls += a[rr]; }
        pk0[2 * g] = cvt_pk_bf16(a[0], a[1]); pk0[2 * g + 1] = cvt_pk_bf16(a[2], a[3]); }
    pv_half(base + vread, 0, pk0, o);
    st1 = st1 * alpha + ls;
}
template <int G>
__device__ __forceinline__ void attn_tile(bool need_mask, const LAS unsigned char* base, const bf16x8_t (&qf)[G ? 12 : 8], f32x16_t (&o)[4], float& st0, float& st1, int lim, unsigned kread, unsigned vread, int hh) {
    f32x16_t s0, s1; unsigned pk[2][8];
    attn_qk<G>(base, qf, s0, s1, kread);
    attn_sm<G>(need_mask, s0, s1, pk, o, st0, st1, lim, hh);
    attn_pv(base, pk, o, vread);
}
template <int G>
__device__ __forceinline__ void attn_unit2(const Params& p, int b, int h, int qb, LAS unsigned char* lds, int tid_in) {
    int tid = tid_in; asm volatile("" : "+v"(tid));
    constexpr int DK = G ? 192 : 128, NKS = DK / 16, KCH = DK / 8, KSTR = DK * 2 + 16, VSTR = ATT_VSTR;
    constexpr int KTILE = 64 * KSTR, VTILE = 64 * VSTR, NKL = KCH * 64 / 512, QP = G ? 1536 : 1024;
    const int lane = tid & 63, wid = __builtin_amdgcn_readfirstlane(tid >> 6), c = lane & 31, hh = lane >> 5, H = wid >> 2;
    const bf16_t* Qg = WS<bf16_t>(p, G ? OFF_QMLA : OFF_QSB); const bf16_t* Kg = WS<bf16_t>(p, G ? OFF_KMLA : OFF_KSB); const bf16_t* Vg = WS<bf16_t>(p, G ? OFF_VMLA : OFF_VSB);
    const size_t tok0 = (size_t)b * SEQ;
    const int trow = qb * 256 + wid * 32 + c;
    bf16x8_t qf[NKS];
    { const bf16_t* qp = Qg + (tok0 + trow) * QP + h * DK + hh * 8;
#pragma unroll
      for (int ks = 0; ks < NKS; ++ks) qf[ks] = *(const bf16x8_t*)(qp + ks * 16); }
    f32x16_t o[4];
#pragma unroll
    for (int d = 0; d < 4; ++d)
#pragma unroll
        for (int r = 0; r < 16; ++r) o[d][r] = 0.f;
    float st0 = G ? -1e30f : 1.0f, st1 = 0.f;
    const int srow = tid >> 3, sch = tid & 7;
    const bf16_t* Kb = Kg + tok0 * QP + (size_t)srow * QP + h * DK + sch * 8; const bf16_t* Vb = Vg + tok0 * 1024 + (size_t)srow * 1024 + h * 128 + sch * 8;
    const unsigned klds0 = (unsigned)(srow * KSTR + sch * 16), vlds0 = (unsigned)(2 * KTILE + srow * VSTR + sch * 16);
    const unsigned kread = (unsigned)(c * KSTR + hh * 16);
    const unsigned vread = (unsigned)(2 * KTILE + (4 * hh + ((lane & 15) >> 2)) * VSTR + (16 * ((lane >> 4) & 1) + 4 * (lane & 3)) * 2);
    const int jmax = 4 * qb + 3, T = jmax + 1, wb = wid >> 1;
    u32x4_t kreg[NKL], vreg[2];
#pragma unroll
    for (int i = 0; i < NKL; ++i) kreg[i] = *(const u32x4_t*)(Kb + (size_t)jmax * 64 * QP + i * 64);
#pragma unroll
    for (int i = 0; i < NKL; ++i) *(LAS u32x4_t*)(lds + klds0 + i * 128) = kreg[i];
#pragma unroll
    for (int i = 0; i < NKL; ++i) kreg[i] = *(const u32x4_t*)(Kb + (size_t)(jmax - 1) * 64 * QP + i * 64);
#pragma unroll
    for (int i = 0; i < 2; ++i) vreg[i] = *(const u32x4_t*)(Vb + (size_t)jmax * 64 * 1024 + i * 64);
    __syncthreads();
    f32x16_t s0, s1; unsigned pk[2][8];
#pragma unroll
    for (int r = 0; r < 16; ++r) { s0[r] = 0.f; s1[r] = 0.f; }
#pragma unroll
    for (int i = 0; i < 8; ++i) { pk[0][i] = 0u; pk[1][i] = 0u; }
#pragma unroll 1
    for (int slot = 0; slot < 2 * T + 2; ++slot) {
        if ((slot & 1) == 0) {
            const int s = slot >> 1;
            if (s + 1 < T) {
#pragma unroll
                for (int i = 0; i < NKL; ++i) *(LAS u32x4_t*)(lds + ((s + 1) & 1) * KTILE + klds0 + i * 128) = kreg[i];
            }
            if (s < T) {
#pragma unroll
                for (int i = 0; i < 2; ++i) *(LAS u32x4_t*)(lds + (s & 1) * VTILE + vlds0 + i * 128) = vreg[i];
            }
            if (s + 2 < T) {
#pragma unroll
                for (int i = 0; i < NKL; ++i) kreg[i] = *(const u32x4_t*)(Kb + (size_t)(jmax - s - 2) * 64 * QP + i * 64);
            }
            if (s + 1 < T) {
#pragma unroll
                for (int i = 0; i < 2; ++i) vreg[i] = *(const u32x4_t*)(Vb + (size_t)(jmax - s - 1) * 64 * 1024 + i * 64);
            }
        }
        if ((slot & 1) == H) {
            const int sm = (slot - H) >> 1;
            if (sm >= 1) { const int sp = sm - 1, jb = (jmax - sp) - 4 * qb; if (jb <= wb) attn_pv(lds + (sp & 1) * VTILE, pk, o, vread); }
            if (sm < T) { const int jb = (jmax - sm) - 4 * qb; if (jb <= wb) attn_qk<G>(lds + (sm & 1) * KTILE, qf, s0, s1, kread); }
        } else if (slot >= 1 + H) {
            const int sv = (slot - 1 - H) >> 1;
            if (sv < T) { const int j = jmax - sv, jb = j - 4 * qb; if (jb <= wb) attn_sm<G>(jb == wb, s0, s1, pk, o, st0, st1, trow - 64 * j, hh); }
        }
        __syncthreads();
    }
    if (G == 1) { float llo, lhi; swap32(st1, llo, lhi); const float inv = 1.0f / (llo + lhi);
#pragma unroll
        for (int d = 0; d < 4; ++d) o[d] = o[d] * inv; }
    float ss = 0.f;
    bf16_t* op = WS<bf16_t>(p, OFF_O) + (tok0 + trow) * 2048 + G * 1024 + h * 128 + 4 * hh;
#pragma unroll
    for (int d = 0; d < 4; ++d)
#pragma unroll
        for (int g = 0; g < 4; ++g) {
            const float v0 = o[d][4 * g], v1 = o[d][4 * g + 1], v2 = o[d][4 * g + 2], v3 = o[d][4 * g + 3];
            ss += v0 * v0 + v1 * v1 + v2 * v2 + v3 * v3;
            uint2 w; w.x = cvt_pk_bf16(v0, v1); w.y = cvt_pk_bf16(v2, v3);
            *(uint2*)(op + 32 * d + 8 * g) = w;
        }
    float slo, shi; swap32(ss, slo, shi);
    if (hh == 0) WS<float>(p, OFF_SSQ)[(tok0 + trow) * 16 + G * 8 + h] = slo + shi;
}

template <int G>
__device__ __forceinline__ void attn_unit(const Params& p, int b, int h, int qb, LAS unsigned char* lds, int tid_in) {
    int tid = tid_in; asm volatile("" : "+v"(tid));
    constexpr int DK = G ? 192 : 128, NKS = DK / 16, KCH = DK / 8, KSTR = DK * 2 + 16, VSTR = ATT_VSTR;
    constexpr int KTILE = 64 * KSTR, VTILE = 64 * VSTR, STAGE = KTILE + VTILE, NKL = KCH * 64 / 512, QP = G ? 1536 : 1024;
    const int lane = tid & 63, wid = __builtin_amdgcn_readfirstlane(tid >> 6), c = lane & 31, hh = lane >> 5;
    const bf16_t* Qg = WS<bf16_t>(p, G ? OFF_QMLA : OFF_QSB); const bf16_t* Kg = WS<bf16_t>(p, G ? OFF_KMLA : OFF_KSB); const bf16_t* Vg = WS<bf16_t>(p, G ? OFF_VMLA : OFF_VSB);
    const size_t tok0 = (size_t)b * SEQ;
    const int trow = qb * 256 + wid * 32 + c;
    bf16x8_t qf[NKS];
    { const bf16_t* qp = Qg + (tok0 + trow) * QP + h * DK + hh * 8;
#pragma unroll
      for (int ks = 0; ks < NKS; ++ks) qf[ks] = *(const bf16x8_t*)(qp + ks * 16); }
    f32x16_t o[4];
#pragma unroll
    for (int d = 0; d < 4; ++d)
#pragma unroll
        for (int r = 0; r < 16; ++r) o[d][r] = 0.f;
    float st0 = G ? -1e30f : 1.0f, st1 = 0.f;
    const int srow = tid >> 3, sch = tid & 7;
    const bf16_t* Kb = Kg + tok0 * QP + (size_t)srow * QP + h * DK + sch * 8; const bf16_t* Vb = Vg + tok0 * 1024 + (size_t)srow * 1024 + h * 128 + sch * 8;
    const unsigned klds0 = (unsigned)(srow * KSTR + sch * 16), vlds0 = (unsigned)(KTILE + srow * VSTR + sch * 16);
    u32x4_t kreg[NKL], vreg[2];
    const int jmax = 4 * qb + 3;
#pragma unroll
    for (int i = 0; i < NKL; ++i) kreg[i] = *(const u32x4_t*)(Kb + (size_t)jmax * 64 * QP + i * 64);
#pragma unroll
    for (int i = 0; i < 2; ++i) vreg[i] = *(const u32x4_t*)(Vb + (size_t)jmax * 64 * 1024 + i * 64);
    const unsigned kread = (unsigned)(c * KSTR + hh * 16);
    const unsigned vread = (unsigned)(KTILE + (4 * hh + ((lane & 15) >> 2)) * VSTR + (16 * ((lane >> 4) & 1) + 4 * (lane & 3)) * 2);
    LAS unsigned* aflag = (LAS unsigned*)(lds + ATT_BC_OFF + 16);
    if (G == 0) { if (tid < 3) aflag[tid] = 0u; }
    int f_cur = 0, f_prev = 2, f_next = 1;
    for (int j = jmax; j >= 0; --j) {
        LAS unsigned char* base = lds + ((jmax - j) & 1) * STAGE;
#pragma unroll
        for (int i = 0; i < NKL; ++i) *(LAS u32x4_t*)(base + klds0 + i * 128) = kreg[i];
#pragma unroll
        for (int i = 0; i < 2; ++i) *(LAS u32x4_t*)(base + vlds0 + i * 128) = vreg[i];
        __syncthreads();
        if (G == 0) {
            if (j < jmax) { const unsigned alive = (unsigned)__builtin_amdgcn_readfirstlane((int)aflag[f_prev]); if (alive == 0u) break; }
            if (tid == 0) aflag[f_next] = 0u;
        }
        if (j > 0) {
#pragma unroll
            for (int i = 0; i < NKL; ++i) kreg[i] = *(const u32x4_t*)(Kb + (size_t)(j - 1) * 64 * QP + i * 64);
#pragma unroll
            for (int i = 0; i < 2; ++i) vreg[i] = *(const u32x4_t*)(Vb + (size_t)(j - 1) * 64 * 1024 + i * 64);
        }
        const int jb = j - 4 * qb;
        if (jb <= (wid >> 1)) {
            const bool need_mask = (jb == (wid >> 1));
            const int lim = trow - 64 * j;
            if constexpr (G == 0) attn_tile_sb(need_mask, base, qf, o, st0, lim, kread, vread, hh); else attn_tile_mla(need_mask, base, qf, o, st0, st1, lim, kread, vread, hh);
        }
        if (G == 0) {
            if (__builtin_amdgcn_ballot_w64(st0 >= 9.094947e-13f) != 0ull) { if (lane == 0) aflag[f_cur] = 1u; }
            const int t_ = f_prev; f_prev = f_cur; f_cur = f_next; f_next = t_;
        }
    }
    if (G == 1) { float llo, lhi; swap32(st1, llo, lhi); const float inv = 1.0f / (llo + lhi);
#pragma unroll
        for (int d = 0; d < 4; ++d) o[d] = o[d] * inv; }
    float ss = 0.f;
    bf16_t* op = WS<bf16_t>(p, OFF_O) + (tok0 + trow) * 2048 + G * 1024 + h * 128 + 4 * hh;
#pragma unroll
    for (int d = 0; d < 4; ++d)
#pragma unroll
        for (int g = 0; g < 4; ++g) {
            const float v0 = o[d][4 * g], v1 = o[d][4 * g + 1], v2 = o[d][4 * g + 2], v3 = o[d][4 * g + 3];
            ss += v0 * v0 + v1 * v1 + v2 * v2 + v3 * v3;
            uint2 w; w.x = cvt_pk_bf16(v0, v1); w.y = cvt_pk_bf16(v2, v3);
            *(uint2*)(op + 32 * d + 8 * g) = w;
        }
    float slo, shi; swap32(ss, slo, shi);
    if (hh == 0) WS<float>(p, OFF_SSQ)[(tok0 + trow) * 16 + G * 8 + h] = slo + shi;
    __syncthreads();
}


template <int G, int NKL>
__device__ __forceinline__ void att3_step(int s, int T, int jmax, int s_first, int trow, int hh, LAS unsigned char* lds, int& vslot,
        u32x4_t (&kreg)[NKL], u32x4_t (&vreg)[2], const bf16_t* Kb, const bf16_t* Vb, unsigned klds0, unsigned vlds0, unsigned kread, unsigned vread,
        const bf16x8_t (&qf)[G ? 12 : 8], f32x16_t (&o)[4], float& st0, float& st1, f32x16_t& n0, f32x16_t& n1, f32x16_t& p0, f32x16_t& p1, unsigned (&pk)[2][8]) {
    constexpr int DK = G ? 192 : 128, KSTR = DK * 2 + 16, KTILE = 64 * KSTR, VTILE = 64 * ATT_VSTR, QP = G ? 1536 : 1024;
#pragma unroll
    for (int i = 0; i < NKL; ++i) *(LAS u32x4_t*)(lds + (s & 1) * KTILE + klds0 + i * 128) = kreg[i];
#pragma unroll
    for (int i = 0; i < 2; ++i) *(LAS u32x4_t*)(lds + vslot * VTILE + vlds0 + i * 128) = vreg[i];
    __syncthreads();
    if (s + 1 < T) {
#pragma unroll
        for (int i = 0; i < NKL; ++i) kreg[i] = *(const u32x4_t*)(Kb + (size_t)(jmax - s - 1) * 64 * QP + i * 64);
#pragma unroll
        for (int i = 0; i < 2; ++i) vreg[i] = *(const u32x4_t*)(Vb + (size_t)(jmax - s - 1) * 64 * 1024 + i * 64);
    }
    const int vprev = vslot == 0 ? 2 : vslot - 1;
    if (s > s_first + 1) {
        attn_qk<G>(lds + (s & 1) * KTILE, qf, n0, n1, kread);
        attn_sm<G>(false, p0, p1, pk, o, st0, st1, 0, hh);
        attn_pv(lds + vprev * VTILE, pk, o, vread);
    } else {
        if (s >= s_first) attn_qk<G>(lds + (s & 1) * KTILE, qf, n0, n1, kread);
        if (s - 1 >= s_first) { attn_sm<G>(s - 1 == s_first, p0, p1, pk, o, st0, st1, trow - 64 * (jmax - s + 1), hh); attn_pv(lds + vprev * VTILE, pk, o, vread); }
    }
    vslot = vslot == 2 ? 0 : vslot + 1;
}
template <int G>
__device__ __forceinline__ void attn_unit3(const Params& p, int b, int h, int qb, LAS unsigned char* lds, int tid_in) {
    int tid = tid_in; asm volatile("" : "+v"(tid));
    constexpr int DK = G ? 192 : 128, NKS = DK / 16, KCH = DK / 8, KSTR = DK * 2 + 16, VSTR = ATT_VSTR;
    constexpr int KTILE = 64 * KSTR, VTILE = 64 * VSTR, NKL = KCH * 64 / 512, QP = G ? 1536 : 1024;
    const int lane = tid & 63, wid = __builtin_amdgcn_readfirstlane(tid >> 6), c = lane & 31, hh = lane >> 5;
    const bf16_t* Qg = WS<bf16_t>(p, G ? OFF_QMLA : OFF_QSB); const bf16_t* Kg = WS<bf16_t>(p, G ? OFF_KMLA : OFF_KSB); const bf16_t* Vg = WS<bf16_t>(p, G ? OFF_VMLA : OFF_VSB);
    const size_t tok0 = (size_t)b * SEQ;
    const int trow = qb * 256 + wid * 32 + c;
    bf16x8_t qf[NKS];
    { const bf16_t* qp = Qg + (tok0 + trow) * QP + h * DK + hh * 8;
#pragma unroll
      for (int ks = 0; ks < NKS; ++ks) qf[ks] = *(const bf16x8_t*)(qp + ks * 16); }
    f32x16_t o[4];
#pragma unroll
    for (int d = 0; d < 4; ++d)
#pragma unroll
        for (int r = 0; r < 16; ++r) o[d][r] = 0.f;
    float st0 = G ? -1e30f : 1.0f, st1 = 0.f;
    const int srow = tid >> 3, sch = tid & 7;
    const bf16_t* Kb = Kg + tok0 * QP + (size_t)srow * QP + h * DK + sch * 8; const bf16_t* Vb = Vg + tok0 * 1024 + (size_t)srow * 1024 + h * 128 + sch * 8;
    const unsigned klds0 = (unsigned)(srow * KSTR + sch * 16), vlds0 = (unsigned)(2 * KTILE + srow * VSTR + sch * 16);
    const unsigned kread = (unsigned)(c * KSTR + hh * 16);
    const unsigned vread = (unsigned)(2 * KTILE + (4 * hh + ((lane & 15) >> 2)) * VSTR + (16 * ((lane >> 4) & 1) + 4 * (lane & 3)) * 2);
    const int jmax = 4 * qb + 3, T = jmax + 1, s_first = 3 - (wid >> 1);
    u32x4_t kreg[NKL], vreg[2];
#pragma unroll
    for (int i = 0; i < NKL; ++i) kreg[i] = *(const u32x4_t*)(Kb + (size_t)jmax * 64 * QP + i * 64);
#pragma unroll
    for (int i = 0; i < 2; ++i) vreg[i] = *(const u32x4_t*)(Vb + (size_t)jmax * 64 * 1024 + i * 64);
    f32x16_t sa0, sa1, sb0, sb1; unsigned pk[2][8];
#pragma unroll
    for (int r = 0; r < 16; ++r) { sa0[r] = 0.f; sa1[r] = 0.f; sb0[r] = 0.f; sb1[r] = 0.f; }
    int vslot = 0;
#pragma unroll 1
    for (int s = 0; s < T; s += 2) {
        att3_step<G, NKL>(s, T, jmax, s_first, trow, hh, lds, vslot, kreg, vreg, Kb, Vb, klds0, vlds0, kread, vread, qf, o, st0, st1, sa0, sa1, sb0, sb1, pk);
        att3_step<G, NKL>(s + 1, T, jmax, s_first, trow, hh, lds, vslot, kreg, vreg, Kb, Vb, klds0, vlds0, kread, vread, qf, o, st0, st1, sb0, sb1, sa0, sa1, pk);
    }
    { const int vprev = vslot == 0 ? 2 : vslot - 1;
      attn_sm<G>(T - 1 == s_first, sb0, sb1, pk, o, st0, st1, trow, hh);
      attn_pv(lds + vprev * VTILE, pk, o, vread); }
    if (G == 1) { float llo, lhi; swap32(st1, llo, lhi); const float inv = 1.0f / (llo + lhi);
#pragma unroll
        for (int d = 0; d < 4; ++d) o[d] = o[d] * inv; }
    float ss = 0.f;
    bf16_t* op = WS<bf16_t>(p, OFF_O) + (tok0 + trow) * 2048 + G * 1024 + h * 128 + 4 * hh;
#pragma unroll
    for (int d = 0; d < 4; ++d)
#pragma unroll
        for (int g = 0; g < 4; ++g) {
            const float v0 = o[d][4 * g], v1 = o[d][4 * g + 1], v2 = o[d][4 * g + 2], v3 = o[d][4 * g + 3];
            ss += v0 * v0 + v1 * v1 + v2 * v2 + v3 * v3;
            uint2 w; w.x = cvt_pk_bf16(v0, v1); w.y = cvt_pk_bf16(v2, v3);
            *(uint2*)(op + 32 * d + 8 * g) = w;
        }
    float slo, shi; swap32(ss, slo, shi);
    if (hh == 0) WS<float>(p, OFF_SSQ)[(tok0 + trow) * 16 + G * 8 + h] = slo + shi;
    __syncthreads();
}

__device__ __forceinline__ void phase_attn_mfma(const Params& p, float* ldsf, int headw = 0) {
    LAS unsigned char* lds = (LAS unsigned char*)ldsf;
    unsigned* head = WS<unsigned>(p, OFF_BAR) + ATT_HEAD_WORD + 64 * headw;
    for (;;) {
        const int tid = tid_fresh(p.widx);
        LAS unsigned* bc = (LAS unsigned*)(lds + ATT_BC_OFF);
        if (tid == 0) *bc = __hip_atomic_fetch_add(head, 1u, __ATOMIC_RELAXED, __HIP_MEMORY_SCOPE_AGENT);
        __syncthreads();
        const unsigned u = (unsigned)__builtin_amdgcn_readfirstlane((int)*bc);
        __syncthreads();
        if (u >= 1536u) break;
        const unsigned u3 = u / 3u, um = u - 3u * u3;
        if (headw != 0 && (um != 0u || (int)(u3 & 1u) != (PROBE_ATTN_G))) continue;
        if (um != 0u) { if (TAB_EB == 6) job_table6(p, (int)(2u * u3 + um - 1u)); else job_table<TAB_EB == 6 ? 1 : TAB_EB>(p, (int)(2u * u3 + um - 1u)); continue; }
        const int qb = 15 - (int)(u3 >> 5), rest = (int)(u3 & 31u), g = rest & 1, b = (rest >> 1) & 1, h = rest >> 2;
#if ATT_ANTIPHASE
        if (g == 0) attn_unit<0>(p, b, h, qb, lds, tid); else attn_unit<1>(p, b, h, qb, lds, tid);
#else
        if (g == 0) attn_unit<0>(p, b, h, qb, lds, tid); else attn_unit<1>(p, b, h, qb, lds, tid);
#endif
    }
}

__device__ __forceinline__ void phase_onorm(const Params& p, int bid, int nblk) {
    const int tidf = tid_fresh(p.widx), lane = tidf & 63, wid = tidf >> 6;
    bf16_t* O = WS<bf16_t>(p, OFF_O); const float* ssq = WS<float>(p, OFF_SSQ);
    for (int t = bid * 8 + wid; t < TOK; t += nblk * 8) {
        float s0 = 0.f, s1 = 0.f;
#pragma unroll
        for (int h = 0; h < 8; ++h) { s0 += ssq[(size_t)t * 16 + h]; s1 += ssq[(size_t)t * 16 + 8 + h]; }
        const float r0 = rsqrtf(s0 * (1.0f / 1024.0f) + EPS), r1 = rsqrtf(s1 * (1.0f / 1024.0f) + EPS);
#pragma unroll
        for (int j = 0; j < 4; ++j) {
            const int off = (j * 64 + lane) * 8; const float r = off < 1024 ? r0 : r1;
            uint4 v = *(uint4*)(O + (size_t)t * 2048 + off);
            v.x = pack2(lo_f(v.x) * r, hi_f(v.x) * r); v.y = pack2(lo_f(v.y) * r, hi_f(v.y) * r); v.z = pack2(lo_f(v.z) * r, hi_f(v.z) * r); v.w = pack2(lo_f(v.w) * r, hi_f(v.w) * r);
            *(uint4*)(O + (size_t)t * 2048 + off) = v;
        }
    }
}

__device__ __forceinline__ void wave_argmax(float& v, int& i) {
#pragma unroll
    for (int o = 32; o > 0; o >>= 1) { const float ov = __shfl_xor(v, o); const int oi = __shfl_xor(i, o); if (ov > v || (ov == v && oi < i)) { v = ov; i = oi; } }
}
__device__ __forceinline__ void phase_route_ref(const Params& p, int bid, int nblk) {
    const int tidf = tid_fresh(p.widx), lane = tidf & 63, wid = tidf >> 6;
    const bf16_t* qp = WS<bf16_t>(p, OFF_QP); const bf16_t* keys = WS<bf16_t>(p, OFF_KEYS);
    int* ridx = WS<int>(p, OFF_RIDX); float* rgate = WS<float>(p, OFF_RGATE);
    for (int it = bid * 8 + wid; it < TOK * 8; it += nblk * 8) {
        const int t = it >> 3, h = it & 7;
        float tv[2]; int ti[2];
#pragma unroll
        for (int half = 0; half < 2; ++half) {
            const bf16_t* q = qp + (size_t)t * 2048 + h * 256 + half * 128;
            const bf16_t* kb = keys + (size_t)(h * 2 + half) * 16384;
            float s0 = 0.f, s1 = 0.f;
            for (int d = 0; d < 128; d += 8) { const uint4 qv = *(const uint4*)(q + d);
                s0 += dot8(qv, *(const uint4*)(kb + (size_t)lane * 128 + d)); s1 += dot8(qv, *(const uint4*)(kb + (size_t)(lane + 64) * 128 + d)); }
            float mv = 0.f; int mi = 0;
            for (int r = 0; r < 16; ++r) {
                float v; int i;
                if (s0 >= s1) { v = s0; i = lane; } else { v = s1; i = lane + 64; }
                wave_argmax(v, i);
                if (i == lane) s0 = -INFINITY;
                if (i == lane + 64) s1 = -INFINITY;
                if (lane == r) { mv = v; mi = i; }
            }
            tv[half] = mv; ti[half] = mi;
        }
        float cv[4];
#pragma unroll
        for (int j = 0; j < 4; ++j) { const int c = lane * 4 + j; cv[j] = __shfl(tv[0], c >> 4) + __shfl(tv[1], c & 15); }
        float bv = 0.f; int bc = 0;
        for (int r = 0; r < 16; ++r) {
            float v = cv[0]; int i = lane * 4;
#pragma unroll
            for (int j = 1; j < 4; ++j) if (cv[j] > v) { v = cv[j]; i = lane * 4 + j; }
            wave_argmax(v, i);
#pragma unroll
            for (int j = 0; j < 4; ++j) if (i == lane * 4 + j) cv[j] = -INFINITY;
            if (lane == r) { bv = v; bc = i; }
        }
        const float mx = __shfl(bv, 0);
        float e = lane < 16 ? __expf(bv - mx) : 0.f;
        const float sum = wave_sum(e);
        const int i1 = __shfl(ti[0], bc >> 4), i2 = __shfl(ti[1], bc & 15);
        if (lane < 16) { ridx[(size_t)t * 128 + h * 16 + lane] = i1 * 128 + i2; rgate[(size_t)t * 128 + h * 16 + lane] = e / sum; }
    }
}


__device__ __forceinline__ unsigned f2key(float f) { const unsigned u = __float_as_uint(f); return (u & 0x80000000u) ? ~u : (u | 0x80000000u); }
__device__ __forceinline__ float key2f(unsigned k) { return __uint_as_float((k & 0x80000000u) ? (k & 0x7fffffffu) : ~k); }
#define RT_CE(a, b) do { const unsigned _h = max((a), (b)), _l = min((a), (b)); (a) = _h; (b) = _l; } while (0)
__device__ __forceinline__ void sort16_desc(unsigned* a) {
#pragma unroll
    for (int k = 2; k <= 16; k <<= 1)
#pragma unroll
        for (int j = k >> 1; j > 0; j >>= 1)
#pragma unroll
            for (int i = 0; i < 16; ++i) { const int l = i ^ j; if (l > i) { if ((i & k) == 0) RT_CE(a[i], a[l]); else RT_CE(a[l], a[i]); } }
}
__device__ __forceinline__ void merge16_desc(unsigned* a, const unsigned* b) {
#pragma unroll
    for (int i = 0; i < 16; ++i) a[i] = max(a[i], b[15 - i]);
#pragma unroll
    for (int j = 8; j > 0; j >>= 1)
#pragma unroll
        for (int i = 0; i < 16; ++i) { const int l = i ^ j; if (l > i) RT_CE(a[i], a[l]); }
}
__device__ __forceinline__ void top16_of_64(unsigned* v) {
    sort16_desc(v); sort16_desc(v + 16); sort16_desc(v + 32); sort16_desc(v + 48);
    merge16_desc(v, v + 16); merge16_desc(v + 32, v + 48); merge16_desc(v, v + 32);
}
constexpr int rt_cand_pos(int i, int j) { int n = 0; for (int a = 0; a < 16; ++a) for (int b = 0; b < 16; ++b) { if (a == i && b == j) return n; if ((a + 1) * (b + 1) <= 16) ++n; } return n; }
static_assert(rt_cand_pos(15, 1) == 50, "50 staircase candidates");

__device__ __forceinline__ void phase_route_mfma(const Params& p, int bid, int nblk, float* ldsf) {
    const int tidf = tid_fresh(p.widx), lane = tidf & 63, wid = __builtin_amdgcn_readfirstlane(tidf >> 6), c = lane & 31, hh = lane >> 5;
    const bf16_t* qp = WS<bf16_t>(p, OFF_QP); const bf16_t* keys = WS<bf16_t>(p, OFF_KEYS);
    int* ridx = WS<int>(p, OFF_RIDX); float* rgate = WS<float>(p, OFF_RGATE);
    LAS unsigned* tbl = (LAS unsigned*)ldsf + wid * 2048;
    for (int it = bid * 8 + wid; it < 2048; it += nblk * 8) {
        const int tile = it >> 3, h = it & 7, t = tile * 32 + c;
#pragma unroll 1
        for (int half = 0; half < 2; ++half) {
            const bf16_t* kb = keys + (size_t)(h * 2 + half) * 16384 + (size_t)c * 128 + hh * 8;
            const bf16_t* qq = qp + (size_t)t * 2048 + h * 256 + half * 128 + hh * 8;
            bf16x8_t qf[8];
#pragma unroll
            for (int ks = 0; ks < 8; ++ks) qf[ks] = *(const bf16x8_t*)(qq + ks * 16);
            unsigned v[64];
#pragma unroll
            for (int blk = 0; blk < 4; ++blk) {
                f32x16_t s;
#pragma unroll
                for (int r = 0; r < 16; ++r) s[r] = 0.f;
#pragma unroll
                for (int ks = 0; ks < 8; ++ks) { const bf16x8_t a = *(const bf16x8_t*)(kb + (size_t)blk * 32 * 128 + ks * 16); s = __builtin_amdgcn_mfma_f32_32x32x16_bf16(a, qf[ks], s, 0, 0, 0); }
#pragma unroll
                for (int r = 0; r < 16; ++r) { const int n = 32 * blk + (r & 3) + 8 * (r >> 2) + 4 * hh; v[blk * 16 + r] = (f2key(s[r]) & ~127u) | (unsigned)(127 - n); }
                asm volatile("" ::: "memory");
            }
            top16_of_64(v);
            unsigned o[16];
#pragma unroll
            for (int i = 0; i < 16; ++i) { auto r2 = __builtin_amdgcn_permlane32_swap(v[i], v[i], false, false); o[i] = hh ? r2[0] : r2[1]; }
            merge16_desc(v, o);
#pragma unroll
            for (int i = 0; i < 16; ++i) tbl[(half * 16 + i) * 64 + lane] = v[i];
        }
        float f1[16], f2[16];
#pragma unroll
        for (int i = 0; i < 16; ++i) { f1[i] = key2f(tbl[i * 64 + lane] & ~127u); f2[i] = key2f(tbl[(16 + i) * 64 + lane] & ~127u); }
        unsigned cd[64];
#pragma unroll
        for (int i = 0; i < 64; ++i) cd[i] = 0u;
#pragma unroll
        for (int i = 0; i < 16; ++i)
#pragma unroll
            for (int j = 0; j < 16; ++j)
                if ((i + 1) * (j + 1) <= 16) cd[rt_cand_pos(i, j)] = (f2key(f1[i] + f2[j]) & ~255u) | (unsigned)(255 - (i * 16 + j));
        top16_of_64(cd);
        float e[16], sum = 0.f; const float mx = key2f(cd[0] & ~255u);
#pragma unroll
        for (int k = 0; k < 16; ++k) { e[k] = __expf(key2f(cd[k] & ~255u) - mx); sum += e[k]; }
        const float inv = 1.0f / sum;
        if (hh == 0) {
#pragma unroll
            for (int k = 0; k < 16; ++k) {
                const int pid = 255 - (int)(cd[k] & 255u), i = pid >> 4, j = pid & 15;
                const int n1 = 127 - (int)(tbl[i * 64 + lane] & 127u), n2 = 127 - (int)(tbl[(16 + j) * 64 + lane] & 127u);
                ridx[(size_t)t * 128 + h * 16 + k] = n1 * 128 + n2; rgate[(size_t)t * 128 + h * 16 + k] = e[k] * inv;
            }
        }
    }
}

__device__ __forceinline__ void phase_peer_ref(const Params& p, int bid, int nblk) {
    const int tidf = tid_fresh(p.widx), lane = tidf & 63, wid = tidf >> 6;
    const bf16_t* h2 = WS<bf16_t>(p, OFF_H); const float* x1 = WS<float>(p, OFF_X1); const float* mod = WS<float>(p, OFF_MOD);
    const int* ridx = WS<int>(p, OFF_RIDX); const float* rgate = WS<float>(p, OFF_RGATE);
    for (int t = bid * 8 + wid; t < TOK; t += nblk * 8) {
        const int b = t >> 12;
        float4 hv[8], y[8];
#pragma unroll
        for (int j = 0; j < 8; ++j) { const uint2 w = *(const uint2*)(h2 + (size_t)t * DM + (j * 64 + lane) * 4);
            hv[j].x = lo_f(w.x); hv[j].y = hi_f(w.x); hv[j].z = lo_f(w.y); hv[j].w = hi_f(w.y); y[j] = (float4){0.f, 0.f, 0.f, 0.f}; }
        for (int e = 0; e < 128; ++e) {
            const int ex = ridx[(size_t)t * 128 + e]; const float gt = rgate[(size_t)t * 128 + e];
            const float* ur = p.u_tab + (size_t)ex * DM; const float* vr = p.v_tab + (size_t)ex * DM;
            float d = 0.f;
#pragma unroll
            for (int j = 0; j < 8; ++j) { const float4 u = *(const float4*)(ur + (j * 64 + lane) * 4); d += u.x * hv[j].x + u.y * hv[j].y + u.z * hv[j].z + u.w * hv[j].w; }
            d = wave_sum(d);
            const float cf = gt * gelu_exact(d);
#pragma unroll
            for (int j = 0; j < 8; ++j) { const float4 v = *(const float4*)(vr + (j * 64 + lane) * 4); y[j].x += cf * v.x; y[j].y += cf * v.y; y[j].z += cf * v.z; y[j].w += cf * v.w; }
        }
        float ss = 0.f;
#pragma unroll
        for (int j = 0; j < 8; ++j) { const int col = (j * 64 + lane) * 4;
            const float4 xv = *(const float4*)(x1 + (size_t)t * DM + col); const float4 g2 = *(const float4*)(mod + (size_t)b * 12288 + 5 * 2048 + col);
            y[j].x = xv.x + g2.x * y[j].x; y[j].y = xv.y + g2.y * y[j].y; y[j].z = xv.z + g2.z * y[j].z; y[j].w = xv.w + g2.w * y[j].w;
            ss += y[j].x * y[j].x + y[j].y * y[j].y + y[j].z * y[j].z + y[j].w * y[j].w; }
        ss = wave_sum(ss);
        const float rstd = rsqrtf(ss * (1.0f / DM) + EPS);
#pragma unroll
        for (int j = 0; j < 8; ++j) { const int col = (j * 64 + lane) * 4; const float4 fg = *(const float4*)(p.fin_g + col);
            float4 o; o.x = y[j].x * rstd * fg.x; o.y = y[j].y * rstd * fg.y; o.z = y[j].z * rstd * fg.z; o.w = y[j].w * rstd * fg.w;
            *(float4*)(p.out + (size_t)t * DM + col) = o; }
    }
}


template <int EB> __device__ __forceinline__ void job_table(const Params& p, int it) {
    const int tidf = tid_fresh(p.widx), lane = tidf & 63, wid = tidf >> 6;
    const int tab = it >> 9, r0 = (it & 511) * 32;
    const float* src = tab ? p.v_tab : p.u_tab;
    unsigned char* dst = p.ws + (tab ? OFF_VTAB : OFF_UTAB);
    float* scl = WS<float>(p, tab ? OFF_VSC : OFF_USC);
#pragma unroll 1
    for (int rr = 0; rr < 4; ++rr) {
        const int row = r0 + wid * 4 + rr;
        float4 v[8]; float am = 0.f;
#pragma unroll
        for (int j = 0; j < 8; ++j) { v[j] = *(const float4*)(src + (size_t)row * DM + (j * 64 + lane) * 4);
            am = fmaxf(am, fmaxf(fmaxf(fabsf(v[j].x), fabsf(v[j].y)), fmaxf(fabsf(v[j].z), fabsf(v[j].w)))); }
#pragma unroll
        for (int o = 32; o > 0; o >>= 1) am = fmaxf(am, __shfl_xor(am, o));
        if (EB == 1) {
            const int e = (int)((__float_as_uint(am) >> 23) & 255u) - 127;
            const float sc = am > 0.f ? __uint_as_float((unsigned)(127 + 7 - e) << 23) : 1.0f;
            if (lane == 0) scl[row] = am > 0.f ? __uint_as_float((unsigned)(127 - 7 + e) << 23) : 1.0f;
#pragma unroll
            for (int j = 0; j < 8; ++j) {
                int w = __builtin_amdgcn_cvt_pk_fp8_f32(v[j].x * sc, v[j].y * sc, 0, false);
                w = __builtin_amdgcn_cvt_pk_fp8_f32(v[j].z * sc, v[j].w * sc, w, true);
                *(int*)(dst + (size_t)row * 2048 + (j * 64 + lane) * 4) = w;
            }
        } else {
            if (lane == 0) scl[row] = 1.0f;
#pragma unroll
            for (int j = 0; j < 8; ++j) { uint2 w; w.x = pack2(v[j].x, v[j].y); w.y = pack2(v[j].z, v[j].w);
                *(uint2*)(dst + (size_t)row * 4096 + (j * 64 + lane) * 8) = w; }
        }
    }
}

template <int EB> __device__ __forceinline__ void dec_chunk(const u32x4_t r, float* f) {
    if (EB == 1) {
#pragma unroll
        for (int w = 0; w < 4; ++w) { const f32x2_t a = __builtin_amdgcn_cvt_pk_f32_fp8((int)r[w], false), b = __builtin_amdgcn_cvt_pk_f32_fp8((int)r[w], true);
            f[4 * w] = a[0]; f[4 * w + 1] = a[1]; f[4 * w + 2] = b[0]; f[4 * w + 3] = b[1]; }
    } else {
#pragma unroll
        for (int w = 0; w < 4; ++w) { f[2 * w] = lo_f(r[w]); f[2 * w + 1] = hi_f(r[w]); }
    }
}

template <int EB> __device__ __forceinline__ void phase_peer_gather(const Params& p, int bid, int nblk) {
    constexpr int EPC = 16 / EB, NCH = 32 / EPC, ROWB = 2048 * EB;
    const int tidf = tid_fresh(p.widx), lane = tidf & 63, wid = tidf >> 6;
    const unsigned char* utab = p.ws + OFF_UTAB; const unsigned char* vtab = p.ws + OFF_VTAB;
    const float* usc = WS<float>(p, OFF_USC); const float* vsc = WS<float>(p, OFF_VSC);
    const bf16_t* h2 = WS<bf16_t>(p, OFF_H); const float* x1 = WS<float>(p, OFF_X1); const float* mod = WS<float>(p, OFF_MOD);
    const int* ridx = WS<int>(p, OFF_RIDX); const float* rgate = WS<float>(p, OFF_RGATE);
    for (int t = bid * 8 + wid; t < TOK; t += nblk * 8) {
        const int b = t >> 12;
        float hv[32];
#pragma unroll
        for (int j = 0; j < NCH; ++j) {
            const bf16_t* hp = h2 + (size_t)t * DM + (j * 64 + lane) * EPC;
#pragma unroll
            for (int q8 = 0; q8 < EPC / 8; ++q8) { const uint4 w = *(const uint4*)(hp + q8 * 8);
                float* f = hv + j * EPC + q8 * 8;
                f[0] = lo_f(w.x); f[1] = hi_f(w.x); f[2] = lo_f(w.y); f[3] = hi_f(w.y); f[4] = lo_f(w.z); f[5] = hi_f(w.z); f[6] = lo_f(w.w); f[7] = hi_f(w.w); }
        }
        const int myi0 = ridx[(size_t)t * 128 + lane], myi1 = ridx[(size_t)t * 128 + 64 + lane];
        const float myg0 = rgate[(size_t)t * 128 + lane], myg1 = rgate[(size_t)t * 128 + 64 + lane];
        float dots0 = 0.f, dots1 = 0.f;
#pragma unroll 1
        for (int eb = 0; eb < 128; eb += 8) {
            const int idxv = eb < 64 ? myi0 : myi1;
            u32x4_t r[8][NCH];
#pragma unroll
            for (int k = 0; k < 8; ++k) {
                const int idx = __builtin_amdgcn_readlane(idxv, (eb & 63) + k);
                const unsigned char* row = utab + (size_t)idx * ROWB + lane * 16;
#pragma unroll
                for (int j = 0; j < NCH; ++j) r[k][j] = *(const u32x4_t*)(row + j * 1024);
            }
            float d[8];
#pragma unroll
            for (int k = 0; k < 8; ++k) {
                float s = 0.f;
#pragma unroll
                for (int j = 0; j < NCH; ++j) { float f[EPC]; dec_chunk<EB>(r[k][j], f);
#pragma unroll
                    for (int q = 0; q < EPC; ++q) s += f[q] * hv[j * EPC + q]; }
                asm volatile("" : "+v"(s));
                d[k] = s;
                __builtin_amdgcn_sched_barrier(0);
            }
            float n4[4], n2[2];
#pragma unroll
            for (int i = 0; i < 4; ++i) { const bool hi = lane & 1; const float send = hi ? d[2 * i] : d[2 * i + 1], keep = hi ? d[2 * i + 1] : d[2 * i]; n4[i] = keep + __shfl_xor(send, 1); }
#pragma unroll
            for (int i = 0; i < 2; ++i) { const bool hi = lane & 2; const float send = hi ? n4[2 * i] : n4[2 * i + 1], keep = hi ? n4[2 * i + 1] : n4[2 * i]; n2[i] = keep + __shfl_xor(send, 2); }
            float tot;
            { const bool hi = lane & 4; const float send = hi ? n2[0] : n2[1], keep = hi ? n2[1] : n2[0]; tot = keep + __shfl_xor(send, 4); }
            tot += __shfl_xor(tot, 8); tot += __shfl_xor(tot, 16); tot += __shfl_xor(tot, 32);
            const bool mine = (lane >> 3) == ((eb & 63) >> 3);
            if (eb < 64) dots0 = mine ? tot : dots0; else dots1 = mine ? tot : dots1;
        }
        const float cf0 = myg0 * gelu_exact(dots0 * usc[myi0]) * vsc[myi0], cf1 = myg1 * gelu_exact(dots1 * usc[myi1]) * vsc[myi1];
        float y[32];
#pragma unroll
        for (int q = 0; q < 32; ++q) y[q] = 0.f;
#pragma unroll 1
        for (int eb = 0; eb < 128; eb += 8) {
            const int idxv = eb < 64 ? myi0 : myi1; const float cfv = eb < 64 ? cf0 : cf1;
            u32x4_t r[8][NCH];
#pragma unroll
            for (int k = 0; k < 8; ++k) {
                const int idx = __builtin_amdgcn_readlane(idxv, (eb & 63) + k);
                const unsigned char* row = vtab + (size_t)idx * ROWB + lane * 16;
#pragma unroll
                for (int j = 0; j < NCH; ++j) r[k][j] = *(const u32x4_t*)(row + j * 1024);
            }
#pragma unroll
            for (int k = 0; k < 8; ++k) {
                const float cf = __uint_as_float((unsigned)__builtin_amdgcn_readlane((int)__float_as_uint(cfv), (eb & 63) + k));
#pragma unroll
                for (int j = 0; j < NCH; ++j) { float f[EPC]; dec_chunk<EB>(r[k][j], f);
#pragma unroll
                    for (int q = 0; q < EPC; ++q) y[j * EPC + q] += cf * f[q]; }
                asm volatile("" : "+v"(y[0]), "+v"(y[1]), "+v"(y[2]), "+v"(y[3]), "+v"(y[4]), "+v"(y[5]), "+v"(y[6]), "+v"(y[7]), "+v"(y[8]), "+v"(y[9]), "+v"(y[10]), "+v"(y[11]), "+v"(y[12]), "+v"(y[13]), "+v"(y[14]), "+v"(y[15]));
                asm volatile("" : "+v"(y[16]), "+v"(y[17]), "+v"(y[18]), "+v"(y[19]), "+v"(y[20]), "+v"(y[21]), "+v"(y[22]), "+v"(y[23]), "+v"(y[24]), "+v"(y[25]), "+v"(y[26]), "+v"(y[27]), "+v"(y[28]), "+v"(y[29]), "+v"(y[30]), "+v"(y[31]));
                __builtin_amdgcn_sched_barrier(0);
            }
        }
        float ss = 0.f;
#pragma unroll
        for (int j = 0; j < NCH; ++j)
#pragma unroll
            for (int q4 = 0; q4 < EPC / 4; ++q4) {
                const int col = (j * 64 + lane) * EPC + q4 * 4;
                const float4 xv = *(const float4*)(x1 + (size_t)t * DM + col); const float4 g2 = *(const float4*)(mod + (size_t)b * 12288 + 5 * 2048 + col);
                float* yy = y + j * EPC + q4 * 4;
                yy[0] = xv.x + g2.x * yy[0]; yy[1] = xv.y + g2.y * yy[1]; yy[2] = xv.z + g2.z * yy[2]; yy[3] = xv.w + g2.w * yy[3];
                ss += yy[0] * yy[0] + yy[1] * yy[1] + yy[2] * yy[2] + yy[3] * yy[3];
                if (q4 & 1) __builtin_amdgcn_sched_barrier(0);
            }
        ss = wave_sum(ss);
        const float rstd = rsqrtf(ss * (1.0f / DM) + EPS);
#pragma unroll
        for (int j = 0; j < NCH; ++j)
#pragma unroll
            for (int q4 = 0; q4 < EPC / 4; ++q4) {
                const int col = (j * 64 + lane) * EPC + q4 * 4; const float4 fg = *(const float4*)(p.fin_g + col);
                const float* yy = y + j * EPC + q4 * 4;
                float4 o; o.x = yy[0] * rstd * fg.x; o.y = yy[1] * rstd * fg.y; o.z = yy[2] * rstd * fg.z; o.w = yy[3] * rstd * fg.w;
                *(float4*)(p.out + (size_t)t * DM + col) = o;
                if (q4 & 1) __builtin_amdgcn_sched_barrier(0);
            }
    }
}


typedef float v32f_t __attribute__((ext_vector_type(32)));
typedef float v16f_t __attribute__((ext_vector_type(16)));
typedef unsigned v6u_t __attribute__((ext_vector_type(6)));
typedef _Float16 v32h_t __attribute__((ext_vector_type(32)));
typedef _Float16 h2_t __attribute__((ext_vector_type(2)));
typedef unsigned u32x2_t __attribute__((ext_vector_type(2)));
__device__ __forceinline__ float wave_max_noaddr(float v) {
    v = fmaxf(v, __int_as_float(__builtin_amdgcn_ds_swizzle(__float_as_int(v), (1 << 10) | 0x1f)));
    v = fmaxf(v, __int_as_float(__builtin_amdgcn_ds_swizzle(__float_as_int(v), (2 << 10) | 0x1f)));
    v = fmaxf(v, __int_as_float(__builtin_amdgcn_ds_swizzle(__float_as_int(v), (4 << 10) | 0x1f)));
    v = fmaxf(v, __int_as_float(__builtin_amdgcn_ds_swizzle(__float_as_int(v), (8 << 10) | 0x1f)));
    v = fmaxf(v, __int_as_float(__builtin_amdgcn_ds_swizzle(__float_as_int(v), (16 << 10) | 0x1f)));
    auto r = __builtin_amdgcn_permlane32_swap(__float_as_uint(v), __float_as_uint(v), false, false);
    return fmaxf(__uint_as_float(r[0]), __uint_as_float(r[1]));
}
__device__ __forceinline__ void job_table6(const Params& p, int it) {
    const int tidf = tid_fresh(p.widx), lane = tidf & 63, wid = tidf >> 6;
    const int tab = it >> 9, r0 = (it & 511) * 32;
    const float* src = tab ? p.v_tab : p.u_tab;
    unsigned char* dst = p.ws + (tab ? OFF_VTAB : OFF_UTAB);
    float* scl = WS<float>(p, tab ? OFF_VSC : OFF_USC);
    typedef float f32x4v __attribute__((ext_vector_type(4)));
    f32x4v v[4][8];
#pragma unroll
    for (int rr = 0; rr < 4; ++rr)
#pragma unroll
        for (int j = 0; j < 8; ++j) v[rr][j] = __builtin_nontemporal_load((const f32x4v*)(src + (size_t)(r0 + wid * 4 + rr) * DM + (j * 64 + lane) * 4));
#pragma unroll
    for (int rr = 0; rr < 4; ++rr) {
        const int row = r0 + wid * 4 + rr;
        v16f_t a, b; float am = 0.f;
#pragma unroll
        for (int j = 0; j < 8; ++j) { const f32x4v w = v[rr][j];
            a[2 * j] = w.x; b[2 * j] = w.y; a[2 * j + 1] = w.z; b[2 * j + 1] = w.w; am = fmaxf(am, fmaxf(fmaxf(fabsf(w.x), fabsf(w.y)), fmaxf(fabsf(w.z), fabsf(w.w)))); }
        am = wave_max_noaddr(am);
        const int e = (int)((__float_as_uint(am) >> 23) & 255u) - 127;
        const float sc = am > 0.f ? __uint_as_float((unsigned)(127 + 2 - e) << 23) : 1.0f;
        if (lane == 0) scl[row] = am > 0.f ? __uint_as_float((unsigned)(127 - 2 + e) << 23) : 1.0f;
        a = a * sc; b = b * sc;
        const v6u_t pk = __builtin_amdgcn_cvt_scalef32_2xpk16_fp6_f32(a, b, 1.0f);
#if PEER_SLICED
        { unsigned char* d6 = dst + ((size_t)(lane >> 3) * NEXP + row) * 192;
          u32x4_t w0 = {pk[0], pk[1], pk[2], pk[3]}; u32x2_t w1 = {pk[4], pk[5]};
          *(u32x4_t*)(d6 + (lane & 7) * 16) = w0; *(u32x2_t*)(d6 + 128 + (lane & 7) * 8) = w1; }
#else
        u32x4_t w0 = {pk[0], pk[1], pk[2], pk[3]}; u32x2_t w1 = {pk[4], pk[5]};
        *(u32x4_t*)(dst + (size_t)row * 1536 + lane * 16) = w0;
        *(u32x2_t*)(dst + (size_t)row * 1536 + 1024 + lane * 8) = w1;
#endif
    }
}

#define PG6_LOAD(RA, RB, tab, iv, e0) do { _Pragma("unroll") for (int k = 0; k < 8; ++k) { \
        const int idx_ = __builtin_amdgcn_readlane((iv), (e0) + k); const unsigned char* row_ = (tab) + (size_t)idx_ * 1536; \
        RA[k] = *(const u32x4_t*)(row_ + lane * 16); RB[k] = *(const u32x2_t*)(row_ + 1024 + lane * 8); } } while (0)
#define PG6_CU(RA, RB, eb) do { float d[8]; \
        _Pragma("unroll") for (int k = 0; k < 8; ++k) { \
            const v6u_t pk_ = {RA[k][0], RA[k][1], RA[k][2], RA[k][3], RB[k][0], RB[k][1]}; \
            const v32h_t f_ = __builtin_amdgcn_cvt_scalef32_pk32_f16_fp6(pk_, 1.0f); float s0_ = 0.f, s1_ = 0.f, s2_ = 0.f, s3_ = 0.f; \
            _Pragma("unroll") for (int q = 0; q < 16; q += 4) { \
                s0_ = __builtin_amdgcn_fdot2((h2_t){f_[2 * q], f_[2 * q + 1]}, hvh[q], s0_, false); s1_ = __builtin_amdgcn_fdot2((h2_t){f_[2 * q + 2], f_[2 * q + 3]}, hvh[q + 1], s1_, false); \
                s2_ = __builtin_amdgcn_fdot2((h2_t){f_[2 * q + 4], f_[2 * q + 5]}, hvh[q + 2], s2_, false); s3_ = __builtin_amdgcn_fdot2((h2_t){f_[2 * q + 6], f_[2 * q + 7]}, hvh[q + 3], s3_, false); } \
            float s_ = (s0_ + s1_) + (s2_ + s3_);             \
            asm volatile("" : "+v"(s_)); d[k] = s_; __builtin_amdgcn_sched_barrier(0); } \
        float n4[4], n2[2], tot; \
        _Pragma("unroll") for (int i_ = 0; i_ < 4; ++i_) { const bool hi_ = lane & 1; const float send = hi_ ? d[2 * i_] : d[2 * i_ + 1], keep = hi_ ? d[2 * i_ + 1] : d[2 * i_]; n4[i_] = keep + __shfl_xor(send, 1); } \
        _Pragma("unroll") for (int i_ = 0; i_ < 2; ++i_) { const bool hi_ = lane & 2; const float send = hi_ ? n4[2 * i_] : n4[2 * i_ + 1], keep = hi_ ? n4[2 * i_ + 1] : n4[2 * i_]; n2[i_] = keep + __shfl_xor(send, 2); } \
        { const bool hi_ = lane & 4; const float send = hi_ ? n2[0] : n2[1], keep = hi_ ? n2[1] : n2[0]; tot = keep + __shfl_xor(send, 4); } \
        tot += __shfl_xor(tot, 8); tot += __shfl_xor(tot, 16); tot += __shfl_xor(tot, 32); \
        const bool mine_ = (lane >> 3) == (((eb) & 63) >> 3); \
        if ((eb) < 64) dots0 = mine_ ? tot : dots0; else dots1 = mine_ ? tot : dots1; } while (0)
#define PG6_CV(RA, RB, eb) do { const float cfv_ = (eb) < 64 ? cf0 : cf1; \
        _Pragma("unroll") for (int k = 0; k < 8; ++k) { \
            const _Float16 ch_ = (_Float16)__uint_as_float((unsigned)__builtin_amdgcn_readlane((int)__float_as_uint(cfv_), ((eb) & 63) + k)); const h2_t c2_ = {ch_, ch_}; \
            const v6u_t pk_ = {RA[k][0], RA[k][1], RA[k][2], RA[k][3], RB[k][0], RB[k][1]}; \
            const v32h_t f_ = __builtin_amdgcn_cvt_scalef32_pk32_f16_fp6(pk_, 1.0f); \
            _Pragma("unroll") for (int q = 0; q < 16; ++q) yh[q] = (h2_t){f_[2 * q], f_[2 * q + 1]} * c2_ + yh[q]; \
            asm volatile("" : "+v"(yh[0]), "+v"(yh[1]), "+v"(yh[2]), "+v"(yh[3]), "+v"(yh[4]), "+v"(yh[5]), "+v"(yh[6]), "+v"(yh[7]), "+v"(yh[8]), "+v"(yh[9]), "+v"(yh[10]), "+v"(yh[11]), "+v"(yh[12]), "+v"(yh[13]), "+v"(yh[14]), "+v"(yh[15])); \
            __builtin_amdgcn_sched_barrier(0); } } while (0)
__device__ __forceinline__ void phase_peer_gather6(const Params& p, int bid, int nblk) {
    const int tidf = tid_fresh(p.widx), lane = tidf & 63, wid = tidf >> 6;
    const unsigned char* utab = p.ws + OFF_UTAB; const unsigned char* vtab = p.ws + OFF_VTAB;
    const float* usc = WS<float>(p, OFF_USC); const float* vsc = WS<float>(p, OFF_VSC);
    const bf16_t* h2 = WS<bf16_t>(p, OFF_H); const float* x1 = WS<float>(p, OFF_X1); const float* mod = WS<float>(p, OFF_MOD);
    const int* ridx = WS<int>(p, OFF_RIDX); const float* rgate = WS<float>(p, OFF_RGATE);
    const int tstep = nblk * 8;
    int t = bid * 8 + wid;
    if (t >= TOK) return;
    int myi0 = ridx[(size_t)t * 128 + lane], myi1 = ridx[(size_t)t * 128 + 64 + lane];
    u32x4_t a4[8], b4[8]; u32x2_t a2[8], b2[8];
    PG6_LOAD(a4, a2, utab, myi0, 0);
    for (; t < TOK; t += tstep) {
        const int b = t >> 12;
        const int tn = t + tstep; const bool more = tn < TOK;
        const int ni0 = more ? ridx[(size_t)tn * 128 + lane] : 0, ni1 = more ? ridx[(size_t)tn * 128 + 64 + lane] : 0;
        const float myg0 = rgate[(size_t)t * 128 + lane], myg1 = rgate[(size_t)t * 128 + 64 + lane];
        float hv[32];
        { const bf16_t* hp = h2 + (size_t)t * DM + lane * 4;
#pragma unroll
          for (int j = 0; j < 8; ++j) { const uint2 w = *(const uint2*)(hp + j * 256); float* f = hv + j * 4;
              f[0] = lo_f(w.x); f[1] = hi_f(w.x); f[2] = lo_f(w.y); f[3] = hi_f(w.y); } }
        h2_t hvh[16];
#pragma unroll
        for (int q = 0; q < 16; ++q) hvh[q] = (h2_t){(_Float16)hv[2 * q], (_Float16)hv[2 * q + 1]};
        float dots0 = 0.f, dots1 = 0.f;
#pragma unroll 1
        for (int eb = 0; eb < 128; eb += 16) {
            { const int e1 = eb + 8; PG6_LOAD(b4, b2, utab, (e1 < 64 ? myi0 : myi1), (e1 & 63)); }
            PG6_CU(a4, a2, eb);
            if (eb + 16 < 128) { const int e2 = eb + 16; PG6_LOAD(a4, a2, utab, (e2 < 64 ? myi0 : myi1), (e2 & 63)); }
            else PG6_LOAD(a4, a2, vtab, myi0, 0);
            PG6_CU(b4, b2, eb + 8);
        }
        const float cf0 = myg0 * gelu_exact(dots0 * usc[myi0]) * vsc[myi0], cf1 = myg1 * gelu_exact(dots1 * usc[myi1]) * vsc[myi1];
        h2_t yh[16];
#pragma unroll
        for (int q = 0; q < 16; ++q) yh[q] = (h2_t){(_Float16)0.f, (_Float16)0.f};
#pragma unroll 1
        for (int eb = 0; eb < 128; eb += 16) {
            { const int e1 = eb + 8; PG6_LOAD(b4, b2, vtab, (e1 < 64 ? myi0 : myi1), (e1 & 63)); }
            PG6_CV(a4, a2, eb);
            if (eb + 16 < 128) { const int e2 = eb + 16; PG6_LOAD(a4, a2, vtab, (e2 < 64 ? myi0 : myi1), (e2 & 63)); }
            else if (more) PG6_LOAD(a4, a2, utab, ni0, 0);
            PG6_CV(b4, b2, eb + 8);
        }
        myi0 = ni0; myi1 = ni1;
        float y[32];
#pragma unroll
        for (int q = 0; q < 16; ++q) { y[2 * q] = (float)yh[q][0]; y[2 * q + 1] = (float)yh[q][1]; }
        float ss = 0.f;
#pragma unroll
        for (int q4 = 0; q4 < 8; ++q4) {
            const int col = (q4 * 64 + lane) * 4;
            const float4 xv = *(const float4*)(x1 + (size_t)t * DM + col); const float4 g2 = *(const float4*)(mod + (size_t)b * 12288 + 5 * 2048 + col);
            float* yy = y + q4 * 4;
            yy[0] = xv.x + g2.x * yy[0]; yy[1] = xv.y + g2.y * yy[1]; yy[2] = xv.z + g2.z * yy[2]; yy[3] = xv.w + g2.w * yy[3];
            ss += yy[0] * yy[0] + yy[1] * yy[1] + yy[2] * yy[2] + yy[3] * yy[3];
            if (q4 & 1) __builtin_amdgcn_sched_barrier(0);
        }
        ss = wave_sum(ss);
        const float rstd = rsqrtf(ss * (1.0f / DM) + EPS);
#pragma unroll
        for (int q4 = 0; q4 < 8; ++q4) {
            const int col = (q4 * 64 + lane) * 4; const float4 fg = *(const float4*)(p.fin_g + col);
            const float* yy = y + q4 * 4;
            float4 o; o.x = yy[0] * rstd * fg.x; o.y = yy[1] * rstd * fg.y; o.z = yy[2] * rstd * fg.z; o.w = yy[3] * rstd * fg.w;
            *(float4*)(p.out + (size_t)t * DM + col) = o;
            if (q4 & 1) __builtin_amdgcn_sched_barrier(0);
        }
    }
}


__device__ __forceinline__ void phase_peer_u6(const Params& p, int bid, int nblk) {
    const int tidf = tid_fresh(p.widx), lane = tidf & 63, wid = tidf >> 6;
    const unsigned char* utab = p.ws + OFF_UTAB;
    const float* usc = WS<float>(p, OFF_USC); const float* vsc = WS<float>(p, OFF_VSC);
    const bf16_t* h2 = WS<bf16_t>(p, OFF_H); const int* ridx = WS<int>(p, OFF_RIDX); const float* rgate = WS<float>(p, OFF_RGATE); float* cfo = WS<float>(p, OFF_PD);
    const int tstep = nblk * 8;
    int t = bid * 8 + wid;
    if (t >= TOK) return;
    int myi0 = ridx[(size_t)t * 128 + lane], myi1 = ridx[(size_t)t * 128 + 64 + lane];
    u32x4_t a4[8], b4[8]; u32x2_t a2[8], b2[8];
    PG6_LOAD(a4, a2, utab, myi0, 0);
    for (; t < TOK; t += tstep) {
        const int tn = t + tstep; const bool more = tn < TOK;
        const int ni0 = more ? ridx[(size_t)tn * 128 + lane] : 0, ni1 = more ? ridx[(size_t)tn * 128 + 64 + lane] : 0;
        const float myg0 = rgate[(size_t)t * 128 + lane], myg1 = rgate[(size_t)t * 128 + 64 + lane];
        h2_t hvh[16];
        { const bf16_t* hp = h2 + (size_t)t * DM + lane * 4;
#pragma unroll
          for (int j = 0; j < 8; ++j) { const uint2 w = *(const uint2*)(hp + j * 256);
              hvh[2 * j] = (h2_t){(_Float16)lo_f(w.x), (_Float16)hi_f(w.x)}; hvh[2 * j + 1] = (h2_t){(_Float16)lo_f(w.y), (_Float16)hi_f(w.y)}; } }
        float dots0 = 0.f, dots1 = 0.f;
#pragma unroll 1
        for (int eb = 0; eb < 128; eb += 16) {
            { const int e1 = eb + 8; PG6_LOAD(b4, b2, utab, (e1 < 64 ? myi0 : myi1), (e1 & 63)); }
            PG6_CU(a4, a2, eb);
            if (eb + 16 < 128) { const int e2 = eb + 16; PG6_LOAD(a4, a2, utab, (e2 < 64 ? myi0 : myi1), (e2 & 63)); }
            else if (more) PG6_LOAD(a4, a2, utab, ni0, 0);
            PG6_CU(b4, b2, eb + 8);
        }
        cfo[(size_t)t * 128 + lane] = myg0 * gelu_exact(dots0 * usc[myi0]) * vsc[myi0];
        cfo[(size_t)t * 128 + 64 + lane] = myg1 * gelu_exact(dots1 * usc[myi1]) * vsc[myi1];
        myi0 = ni0; myi1 = ni1;
    }
}
__device__ __forceinline__ void phase_peer_v6(const Params& p, int bid, int nblk) {
    const int tidf = tid_fresh(p.widx), lane = tidf & 63, wid = tidf >> 6;
    const unsigned char* vtab = p.ws + OFF_VTAB;
    const float* x1 = WS<float>(p, OFF_X1); const float* mod = WS<float>(p, OFF_MOD);
    const int* ridx = WS<int>(p, OFF_RIDX); const float* cfi = WS<float>(p, OFF_PD);
    const int tstep = nblk * 8;
    int t = bid * 8 + wid;
    if (t >= TOK) return;
    int myi0 = ridx[(size_t)t * 128 + lane], myi1 = ridx[(size_t)t * 128 + 64 + lane];
    float cf0 = cfi[(size_t)t * 128 + lane], cf1 = cfi[(size_t)t * 128 + 64 + lane];
    u32x4_t a4[8], b4[8]; u32x2_t a2[8], b2[8];
    PG6_LOAD(a4, a2, vtab, myi0, 0);
    for (; t < TOK; t += tstep) {
        const int b = t >> 12;
        const int tn = t + tstep; const bool more = tn < TOK;
        const int ni0 = more ? ridx[(size_t)tn * 128 + lane] : 0, ni1 = more ? ridx[(size_t)tn * 128 + 64 + lane] : 0;
        const float nc0 = more ? cfi[(size_t)tn * 128 + lane] : 0.f, nc1 = more ? cfi[(size_t)tn * 128 + 64 + lane] : 0.f;
        h2_t yh[16];
#pragma unroll
        for (int q = 0; q < 16; ++q) yh[q] = (h2_t){(_Float16)0.f, (_Float16)0.f};
#pragma unroll 1
        for (int eb = 0; eb < 128; eb += 16) {
            { const int e1 = eb + 8; PG6_LOAD(b4, b2, vtab, (e1 < 64 ? myi0 : myi1), (e1 & 63)); }
            PG6_CV(a4, a2, eb);
            if (eb + 16 < 128) { const int e2 = eb + 16; PG6_LOAD(a4, a2, vtab, (e2 < 64 ? myi0 : myi1), (e2 & 63)); }
            else if (more) PG6_LOAD(a4, a2, vtab, ni0, 0);
            PG6_CV(b4, b2, eb + 8);
        }
        myi0 = ni0; myi1 = ni1; cf0 = nc0; cf1 = nc1;
        float y[32];
#pragma unroll
        for (int q = 0; q < 16; ++q) { y[2 * q] = (float)yh[q][0]; y[2 * q + 1] = (float)yh[q][1]; }
        float ss = 0.f;
#pragma unroll
        for (int q4 = 0; q4 < 8; ++q4) {
            const int col = (q4 * 64 + lane) * 4;
            const float4 xv = *(const float4*)(x1 + (size_t)t * DM + col); const float4 g2 = *(const float4*)(mod + (size_t)b * 12288 + 5 * 2048 + col);
            float* yy = y + q4 * 4;
            yy[0] = xv.x + g2.x * yy[0]; yy[1] = xv.y + g2.y * yy[1]; yy[2] = xv.z + g2.z * yy[2]; yy[3] = xv.w + g2.w * yy[3];
            ss += yy[0] * yy[0] + yy[1] * yy[1] + yy[2] * yy[2] + yy[3] * yy[3];
            if (q4 & 1) __builtin_amdgcn_sched_barrier(0);
        }
        ss = wave_sum(ss);
        const float rstd = rsqrtf(ss * (1.0f / DM) + EPS);
#pragma unroll
        for (int q4 = 0; q4 < 8; ++q4) {
            const int col = (q4 * 64 + lane) * 4; const float4 fg = *(const float4*)(p.fin_g + col);
            const float* yy = y + q4 * 4;
            float4 o; o.x = yy[0] * rstd * fg.x; o.y = yy[1] * rstd * fg.y; o.z = yy[2] * rstd * fg.z; o.w = yy[3] * rstd * fg.w;
            *(float4*)(p.out + (size_t)t * DM + col) = o;
            if (q4 & 1) __builtin_amdgcn_sched_barrier(0);
        }
    }
}

#define XB_TMO      128
#define XB_XCNT(j)  (256  + 64 * (j))
#define XB_XSUB(j)  (1280 + 64 * (j))
#define XB_XGEN(j)  (2304 + 64 * (j))
#define XB_TOP      3328
#define XB_TOPGEN   3392
#define XCD_BAR_WORDS 3456
#define XB_SPIN_CAP (1u << 18)

__device__ __forceinline__ unsigned xb_ld(unsigned* p)              { return __hip_atomic_load(p, __ATOMIC_RELAXED, __HIP_MEMORY_SCOPE_AGENT); }
__device__ __forceinline__ unsigned xb_add(unsigned* p, unsigned v) { return __hip_atomic_fetch_add(p, v, __ATOMIC_RELAXED, __HIP_MEMORY_SCOPE_AGENT); }
__device__ __forceinline__ unsigned xb_xcc_id() { return (unsigned)__builtin_amdgcn_s_getreg((3 << 11) | 20) & 0xFu; }
#define XB_SPIN(cond, bar) do { unsigned _sp = 0; while (cond) { __builtin_amdgcn_s_sleep(1); \
    if ((++_sp & 255u) == 0u) { if (xb_ld(&(bar)[XB_TMO])) break; if (_sp > XB_SPIN_CAP) { atomicAdd(&(bar)[XB_TMO], 1u); break; } } } } while (0)

struct XcdBarrier {
    int widx;
    unsigned* bar; unsigned x;
    volatile LAS unsigned* st;
};

__device__ __forceinline__ bool xb_thread0(int widx) { unsigned m = ~0u; asm volatile("" : "+s"(m)); return widx == 0 && __builtin_amdgcn_mbcnt_hi(m, __builtin_amdgcn_mbcnt_lo(m, 0u)) == 0u; }
__device__ __forceinline__ XcdBarrier xcd_barrier_post(unsigned* bar, volatile LAS unsigned* st, int widx) {
    XcdBarrier b; b.widx = widx; b.bar = bar; b.x = xb_xcc_id(); b.st = st;
    if (xb_thread0(widx)) (void)xb_add(&bar[XB_XCNT(b.x)], 1u);
    return b;
}
__device__ __forceinline__ void xcd_barrier_complete(unsigned* bar, unsigned x, unsigned& nloc, unsigned& nx) {
    const unsigned G = gridDim.x * gridDim.y * gridDim.z;
    unsigned sum, cnt, mine, sp = 0u;
    for (;;) {
        sum = 0u; cnt = 0u; mine = 0u;
#pragma unroll
        for (unsigned j = 0; j < 16; ++j) { const unsigned c = xb_ld(&bar[XB_XCNT(j)]); sum += c; cnt += (c > 0u) ? 1u : 0u; mine = (j == x) ? c : mine; }
        if (sum == G) break;
        __builtin_amdgcn_s_sleep(1);
        if ((++sp & 255u) == 0u) { if (xb_ld(&bar[XB_TMO])) break; if (sp > XB_SPIN_CAP) { atomicAdd(&bar[XB_TMO], 1u); break; } }
    }
    nloc = mine > 0u ? mine : 1u; nx = cnt > 0u ? cnt : 1u;
}

__device__ __forceinline__ void xcd_barrier(const XcdBarrier& b) {
    asm volatile("s_waitcnt vmcnt(0)" ::: "memory");
    __syncthreads();
    if (xb_thread0(b.widx)) {
        unsigned* bar = b.bar;
        __builtin_amdgcn_s_waitcnt(0);
        unsigned nloc = b.st[0], nx = b.st[1];
        if (nloc == 0u) { xcd_barrier_complete(bar, b.x, nloc, nx); b.st[0] = nloc; b.st[1] = nx; }
        const unsigned old = xb_add(&bar[XB_XSUB(b.x)], 1u);
        const unsigned gen = old / nloc;
        if (old + 1u == (gen + 1u) * nloc) {
            __builtin_amdgcn_fence(__ATOMIC_RELEASE, "agent");
            asm volatile("s_waitcnt vmcnt(0)" ::: "memory");
            const unsigned og = xb_add(&bar[XB_TOP], 1u);
            const unsigned tg = og / nx;
            if (og + 1u == (tg + 1u) * nx) xb_add(&bar[XB_TOPGEN], 1u);
            else XB_SPIN(xb_ld(&bar[XB_TOPGEN]) == tg, bar);
            __builtin_amdgcn_fence(__ATOMIC_ACQUIRE, "agent");
            xb_add(&bar[XB_XGEN(b.x)], 1u);
            asm volatile("s_waitcnt vmcnt(0)" ::: "memory");
        } else {
            XB_SPIN(xb_ld(&bar[XB_XGEN(b.x)]) == gen, bar);
            __builtin_amdgcn_fence(__ATOMIC_ACQUIRE, "agent");
            asm volatile("s_waitcnt vmcnt(0)" ::: "memory");
        }
    }
    __syncthreads();
}


constexpr int PS_Q_WORD = 3968;
__device__ __forceinline__ unsigned ps_next(unsigned* q, LAS unsigned* bc, int tid) {
    if (tid == 0) *bc = __hip_atomic_fetch_add(q, 1u, __ATOMIC_RELAXED, __HIP_MEMORY_SCOPE_AGENT);
    __syncthreads();
    const unsigned u = (unsigned)__builtin_amdgcn_readfirstlane((int)*bc);
    __syncthreads();
    return u;
}
#define PS_LOADH(RA, RB, tb, idv) do { _Pragma("unroll") for (int bt = 0; bt < 8; ++bt) { const int idx_ = __shfl((idv), bt * 8 + g); const unsigned char* rp_ = (tb) + (size_t)idx_ * 192; \
        RA[bt] = *(const u32x4_t*)(rp_ + j * 16); RB[bt] = *(const u32x2_t*)(rp_ + 128 + j * 8); } } while (0)
#define PS_CU(RA, RB, outp) do { float mine_ = 0.f; \
        _Pragma("unroll") for (int bt = 0; bt < 8; ++bt) { \
            const v6u_t pk_ = {RA[bt][0], RA[bt][1], RA[bt][2], RA[bt][3], RB[bt][0], RB[bt][1]}; \
            const v32f_t f_ = __builtin_amdgcn_cvt_scalef32_pk32_f32_fp6(pk_, 1.0f); float sd_ = 0.f; \
            _Pragma("unroll") for (int qq = 0; qq < 32; ++qq) sd_ += f_[qq] * hv[qq]; \
            sd_ += __shfl_xor(sd_, 1); sd_ += __shfl_xor(sd_, 2); sd_ += __shfl_xor(sd_, 4); \
            mine_ = (j == bt) ? sd_ : mine_; __builtin_amdgcn_sched_barrier(0); } \
        __builtin_nontemporal_store(mine_, (outp) + j * 8 + g); } while (0)
#define PS_CV(RA, RB, cfv) do { \
        _Pragma("unroll") for (int bt = 0; bt < 8; ++bt) { const float cf_ = __shfl((cfv), bt * 8 + g); \
            const v6u_t pk_ = {RA[bt][0], RA[bt][1], RA[bt][2], RA[bt][3], RB[bt][0], RB[bt][1]}; \
            const v32f_t f_ = __builtin_amdgcn_cvt_scalef32_pk32_f32_fp6(pk_, 1.0f); \
            _Pragma("unroll") for (int qq = 0; qq < 32; ++qq) y[qq] += cf_ * f_[qq]; \
            asm volatile("" : "+v"(y[0]), "+v"(y[1]), "+v"(y[2]), "+v"(y[3]), "+v"(y[4]), "+v"(y[5]), "+v"(y[6]), "+v"(y[7]), "+v"(y[8]), "+v"(y[9]), "+v"(y[10]), "+v"(y[11]), "+v"(y[12]), "+v"(y[13]), "+v"(y[14]), "+v"(y[15])); \
            asm volatile("" : "+v"(y[16]), "+v"(y[17]), "+v"(y[18]), "+v"(y[19]), "+v"(y[20]), "+v"(y[21]), "+v"(y[22]), "+v"(y[23]), "+v"(y[24]), "+v"(y[25]), "+v"(y[26]), "+v"(y[27]), "+v"(y[28]), "+v"(y[29]), "+v"(y[30]), "+v"(y[31])); \
            __builtin_amdgcn_sched_barrier(0); } } while (0)
constexpr int PS_CHUNK = 64;
__device__ __forceinline__ void phase_peer_u_sliced(const Params& p, float* ldsf) {
    const int tid = tid_fresh(p.widx), lane = tid & 63, wid = tid >> 6, g = lane >> 3, j = lane & 7;
    LAS unsigned* bc = (LAS unsigned*)ldsf;
    const unsigned char* utab = p.ws + OFF_UTAB;
    const bf16_t* h2 = WS<bf16_t>(p, OFF_H); const int* ridx = WS<int>(p, OFF_RIDX); float* pd = WS<float>(p, OFF_PD);
    const int x0 = (int)(xb_xcc_id() & 7u);
#pragma unroll 1
    for (int so = 0; so < 8; ++so) {
        const int s = (x0 + so) & 7;
        unsigned* q = WS<unsigned>(p, OFF_BAR) + PS_Q_WORD + 8 * s;
        const unsigned char* tb = utab + (size_t)s * NEXP * 192;
        const bf16_t* hb = h2 + s * 256 + j * 32;
#pragma unroll 1
        for (;;) {
            const unsigned ch = ps_next(q, bc, tid);
            if (ch >= TOK / PS_CHUNK) break;
            int t = (int)ch * PS_CHUNK + wid;
            int i0 = __builtin_nontemporal_load(ridx + (size_t)t * 128 + lane), i1 = __builtin_nontemporal_load(ridx + (size_t)t * 128 + 64 + lane);
            uint4 hp[4];
#pragma unroll
            for (int q8 = 0; q8 < 4; ++q8) hp[q8] = *(const uint4*)(hb + (size_t)t * DM + q8 * 8);
            u32x4_t a4[8], b4[8]; u32x2_t a2[8], b2[8];
            PS_LOADH(a4, a2, tb, i0);
#pragma unroll 1
            for (int k = 0; k < PS_CHUNK / 8; ++k, t += 8) {
                float hv[32];
#pragma unroll
                for (int q8 = 0; q8 < 4; ++q8) { const uint4 w = hp[q8]; float* f = hv + q8 * 8;
                    f[0] = lo_f(w.x); f[1] = hi_f(w.x); f[2] = lo_f(w.y); f[3] = hi_f(w.y); f[4] = lo_f(w.z); f[5] = hi_f(w.z); f[6] = lo_f(w.w); f[7] = hi_f(w.w); }
                const bool more = k + 1 < PS_CHUNK / 8; const int tn = more ? t + 8 : t;
                const int n0 = __builtin_nontemporal_load(ridx + (size_t)tn * 128 + lane), n1 = __builtin_nontemporal_load(ridx + (size_t)tn * 128 + 64 + lane);
#pragma unroll
                for (int q8 = 0; q8 < 4; ++q8) hp[q8] = *(const uint4*)(hb + (size_t)tn * DM + q8 * 8);
                PS_LOADH(b4, b2, tb, i1);
                PS_CU(a4, a2, pd + ((size_t)s * TOK + t) * 128);
                if (more) PS_LOADH(a4, a2, tb, n0);
                PS_CU(b4, b2, pd + ((size_t)s * TOK + t) * 128 + 64);
                i0 = n0; i1 = n1;
            }
        }
    }
}
__device__ __forceinline__ void phase_peer_v_sliced(const Params& p, float* ldsf) {
    const int tid = tid_fresh(p.widx), lane = tid & 63, wid = tid >> 6, g = lane >> 3, j = lane & 7;
    LAS unsigned* bc = (LAS unsigned*)ldsf;
    const unsigned char* vtab = p.ws + OFF_VTAB;
    const float* usc = WS<float>(p, OFF_USC); const float* vsc = WS<float>(p, OFF_VSC);
    const int* ridx = WS<int>(p, OFF_RIDX); const float* rgate = WS<float>(p, OFF_RGATE); const float* pd = WS<float>(p, OFF_PD);
    float* x1 = WS<float>(p, OFF_X1); const float* mod = WS<float>(p, OFF_MOD); float* ssqp = WS<float>(p, OFF_SSQP);
    const int x0 = (int)(xb_xcc_id() & 7u);
    const int cofs = j * 32 + 16 * (g & 1) + 8 * ((g >> 1) & 1) + 4 * (g >> 2);
#pragma unroll 1
    for (int so = 0; so < 8; ++so) {
        const int s = (x0 + so) & 7;
        unsigned* q = WS<unsigned>(p, OFF_BAR) + PS_Q_WORD + 64 + 8 * s;
        const unsigned char* tb = vtab + (size_t)s * NEXP * 192;
#pragma unroll 1
        for (;;) {
            const unsigned ch = ps_next(q, bc, tid);
            if (ch >= TOK / PS_CHUNK) break;
            int t = (int)ch * PS_CHUNK + wid;
            int i0 = __builtin_nontemporal_load(ridx + (size_t)t * 128 + lane), i1 = __builtin_nontemporal_load(ridx + (size_t)t * 128 + 64 + lane);
            float d0 = 0.f, d1 = 0.f;
#pragma unroll
            for (int x = 0; x < 8; ++x) { d0 += __builtin_nontemporal_load(pd + ((size_t)x * TOK + t) * 128 + lane); d1 += __builtin_nontemporal_load(pd + ((size_t)x * TOK + t) * 128 + 64 + lane); }
            float g0 = __builtin_nontemporal_load(rgate + (size_t)t * 128 + lane), g1 = __builtin_nontemporal_load(rgate + (size_t)t * 128 + 64 + lane);
            u32x4_t a4[8], b4[8]; u32x2_t a2[8], b2[8];
            PS_LOADH(a4, a2, tb, i0);
#pragma unroll 1
            for (int k = 0; k < PS_CHUNK / 8; ++k, t += 8) {
                const int b = t >> 12, col = s * 256 + cofs;
                const float cf0 = g0 * gelu_exact(d0 * usc[i0]) * vsc[i0], cf1 = g1 * gelu_exact(d1 * usc[i1]) * vsc[i1];
                const float4 xv = *(const float4*)(x1 + (size_t)t * DM + col); const float4 gg = *(const float4*)(mod + (size_t)b * 12288 + 5 * 2048 + col);
                const bool more = k + 1 < PS_CHUNK / 8; const int tn = more ? t + 8 : t;
                const int n0 = __builtin_nontemporal_load(ridx + (size_t)tn * 128 + lane), n1 = __builtin_nontemporal_load(ridx + (size_t)tn * 128 + 64 + lane);
                float e0 = 0.f, e1 = 0.f;
#pragma unroll
                for (int x = 0; x < 8; ++x) { e0 += __builtin_nontemporal_load(pd + ((size_t)x * TOK + tn) * 128 + lane); e1 += __builtin_nontemporal_load(pd + ((size_t)x * TOK + tn) * 128 + 64 + lane); }
                const float ng0 = __builtin_nontemporal_load(rgate + (size_t)tn * 128 + lane), ng1 = __builtin_nontemporal_load(rgate + (size_t)tn * 128 + 64 + lane);
                float y[32];
#pragma unroll
                for (int qq = 0; qq < 32; ++qq) y[qq] = 0.f;
                PS_LOADH(b4, b2, tb, i1);
                PS_CV(a4, a2, cf0);
                if (more) PS_LOADH(a4, a2, tb, n0);
                PS_CV(b4, b2, cf1);
                float w16[16], w8[8], w4[4];
                { const bool hi = (g & 1) != 0;
#pragma unroll
                  for (int i = 0; i < 16; ++i) { const float send = hi ? y[i] : y[16 + i], keep = hi ? y[16 + i] : y[i]; w16[i] = keep + __shfl_xor(send, 8); } }
                { const bool hi = (g & 2) != 0;
#pragma unroll
                  for (int i = 0; i < 8; ++i) { const float send = hi ? w16[i] : w16[8 + i], keep = hi ? w16[8 + i] : w16[i]; w8[i] = keep + __shfl_xor(send, 16); } }
                { const bool hi = (g & 4) != 0;
#pragma unroll
                  for (int i = 0; i < 4; ++i) { const float send = hi ? w8[i] : w8[4 + i], keep = hi ? w8[4 + i] : w8[i]; w4[i] = keep + __shfl_xor(send, 32); } }
                float4 o; o.x = xv.x + gg.x * w4[0]; o.y = xv.y + gg.y * w4[1]; o.z = xv.z + gg.z * w4[2]; o.w = xv.w + gg.w * w4[3];
                *(float4*)(x1 + (size_t)t * DM + col) = o;
                const float ss = wave_sum(o.x * o.x + o.y * o.y + o.z * o.z + o.w * o.w);
                if (lane == 0) ssqp[(size_t)s * TOK + t] = ss;
                i0 = n0; i1 = n1; d0 = e0; d1 = e1; g0 = ng0; g1 = ng1;
            }
        }
    }
}
__device__ __forceinline__ void phase_peer_final(const Params& p, int bid, int nblk) {
    const int tidf = tid_fresh(p.widx), lane = tidf & 63, wid = tidf >> 6;
    const float* x2 = WS<float>(p, OFF_X1); const float* ssqp = WS<float>(p, OFF_SSQP);
    for (int t = bid * 8 + wid; t < TOK; t += nblk * 8) {
        float ss = 0.f;
#pragma unroll
        for (int s = 0; s < 8; ++s) ss += ssqp[(size_t)s * TOK + t];
        const float rstd = rsqrtf(ss * (1.0f / DM) + EPS);
#pragma unroll
        for (int jj = 0; jj < 8; ++jj) { const int col = (jj * 64 + lane) * 4;
            const float4 v = *(const float4*)(x2 + (size_t)t * DM + col), fg = *(const float4*)(p.fin_g + col);
            float4 o; o.x = v.x * rstd * fg.x; o.y = v.y * rstd * fg.y; o.z = v.z * rstd * fg.z; o.w = v.w * rstd * fg.w;
            *(float4*)(p.out + (size_t)t * DM + col) = o; }
    }
}

constexpr int NPHASE = 12;
#ifndef USE_FAST_ROUTE
#define USE_FAST_ROUTE 1
#endif
#ifndef USE_FAST_PEER
#define USE_FAST_PEER 1
#endif
#ifndef USE_MFMA_ATTN
#define USE_MFMA_ATTN 1
#endif
#ifndef USE_MFMA_GEMM
#define USE_MFMA_GEMM 1
#endif
#if USE_MFMA_GEMM
#define GEMM(A, Bt, M, N, K, E) gemm_mfma(A, Bt, M, N, K, E, bid, nblk, (unsigned char*)lds, p.widx)
#else
#define GEMM(A, Bt, M, N, K, E) gemm_ref(A, K, Bt, K, M, N, K, E, bid, nblk)
#endif
template <int PH, int RERUN = 0> __device__ __forceinline__ void run_phase(const Params& p, int bid, int nblk, float* lds) {
    if (PH == 0) phase0(p, bid, nblk, lds);
    if (PH == 1) phase_norm_mod(p, p.x, p.norm1_g, 0, 1, WS<bf16_t>(p, OFF_H), bid, nblk, lds);
    if (PH == 2) { EpiInProj E{WS<bf16_t>(p, OFF_QSB), WS<bf16_t>(p, OFF_KSB), WS<bf16_t>(p, OFF_VSB), WS<bf16_t>(p, OFF_CQ), WS<bf16_t>(p, OFF_CKV), WS<bf16_t>(p, OFF_KMLA),
                                WS<float>(p, OFF_COS), WS<float>(p, OFF_SIN), WS<float>(p, OFF_RSP)};
        GEMM(WS<bf16_t>(p, OFF_H), WS<bf16_t>(p, OFF_WIN_T), TOK, NINP, DM, E); }
    if (PH == 3) phase_rowstats(p, bid, nblk);
    if (PH == 4) { EpiUq E1{WS<bf16_t>(p, OFF_QMLA), WS<float>(p, OFF_RSP), WS<float>(p, OFF_COS), WS<float>(p, OFF_SIN)};
        GEMM(WS<bf16_t>(p, OFF_CQ), WS<bf16_t>(p, OFF_WUQ_T), TOK, 1536, 512, E1);
        EpiUkv E2{WS<bf16_t>(p, OFF_KMLA), WS<bf16_t>(p, OFF_VMLA), WS<float>(p, OFF_RSP)};
        GEMM(WS<bf16_t>(p, OFF_CKV), WS<bf16_t>(p, OFF_WUKV_T), TOK, 2048, 256, E2); }
#if USE_MFMA_ATTN
    if (PH == 5) phase_attn_mfma(p, lds, RERUN);
#else
    if (PH == 5) phase_attn_ref(p, bid, nblk);
#endif
    if (PH == 6) phase_onorm(p, bid, nblk);
    if (PH == 7) { EpiWo E{p.x, WS<float>(p, OFF_MOD), WS<float>(p, OFF_X1), WS<float>(p, OFF_SSQ)};
        GEMM(WS<bf16_t>(p, OFF_O), WS<bf16_t>(p, OFF_WO_T), TOK, DM, DM, E); }
    if (PH == 8) phase_norm_mod(p, WS<float>(p, OFF_X1), p.norm2_g, 3, 4, WS<bf16_t>(p, OFF_H), bid, nblk, lds);
    if (PH == 9) { EpiQp E{WS<bf16_t>(p, OFF_QP)};
        GEMM(WS<bf16_t>(p, OFF_H), WS<bf16_t>(p, OFF_WPQ_T), TOK, DM, DM, E); }
#if USE_FAST_ROUTE
    if (PH == 10) phase_route_mfma(p, bid, nblk, lds);
#else
    if (PH == 10) phase_route_ref(p, bid, nblk);
#endif
#if USE_FAST_PEER && PEER_SLICED
    if (PH == 11) phase_peer_u_sliced(p, lds);
    if (PH == 12) phase_peer_v_sliced(p, lds);
    if (PH == 13) phase_peer_final(p, bid, nblk);
#elif USE_FAST_PEER && PEER_SPLIT && TAB_EB == 6
    if (PH == 11) phase_peer_u6(p, bid, nblk);
    if (PH == 12) phase_peer_v6(p, bid, nblk);
#elif USE_FAST_PEER
    if (PH == 11) { if (TAB_EB == 6) phase_peer_gather6(p, bid, nblk); else phase_peer_gather<TAB_EB == 6 ? 1 : TAB_EB>(p, bid, nblk); }
#else
    if (PH == 11) phase_peer_ref(p, bid, nblk);
#endif
}

extern __shared__ __attribute__((aligned(16))) unsigned char dynlds[];
constexpr int LDS_MAIN = 131072;
constexpr int LDS_BYTES = LDS_MAIN + 16;

template <int PH> __global__ void __launch_bounds__(512, 2) k_phase(Params pin) {
    Params p = pin; p.widx = __builtin_amdgcn_readfirstlane((int)(threadIdx.x >> 6));
    run_phase<PH>(p, blockIdx.x, gridDim.x, (float*)dynlds);
}

__global__ void __launch_bounds__(512, 2) k_fused(Params pin) {
    Params p = pin; p.widx = __builtin_amdgcn_readfirstlane((int)(threadIdx.x >> 6));
    float* lds = (float*)dynlds;
    volatile LAS unsigned* xbw = (volatile LAS unsigned*)(dynlds + LDS_MAIN);
    if (xb_thread0(p.widx)) { xbw[0] = 0u; xbw[1] = 0u; xbw[2] = 0u; xbw[3] = 0u; }
    __syncthreads();
    XcdBarrier bar = xcd_barrier_post(WS<unsigned>(p, OFF_BAR), xbw, p.widx);
    const int bid = blockIdx.x, nblk = gridDim.x;
    run_phase<0>(p, bid, nblk, lds); if (PROBE_DOUBLE & (1 << 0)) run_phase<0, 1>(p, bid, nblk, lds); xcd_barrier(bar);
    run_phase<1>(p, bid, nblk, lds); if (PROBE_DOUBLE & (1 << 1)) run_phase<1, 1>(p, bid, nblk, lds); xcd_barrier(bar);
    run_phase<2>(p, bid, nblk, lds); if (PROBE_DOUBLE & (1 << 2)) run_phase<2, 1>(p, bid, nblk, lds); xcd_barrier(bar);
    run_phase<4>(p, bid, nblk, lds); if (PROBE_DOUBLE & (1 << 4)) run_phase<4, 1>(p, bid, nblk, lds); xcd_barrier(bar);
    run_phase<5>(p, bid, nblk, lds); if (PROBE_DOUBLE & (1 << 5)) run_phase<5, 1>(p, bid, nblk, lds); xcd_barrier(bar);
    run_phase<7>(p, bid, nblk, lds); if (PROBE_DOUBLE & (1 << 7)) run_phase<7, 1>(p, bid, nblk, lds); xcd_barrier(bar);
    run_phase<8>(p, bid, nblk, lds); if (PROBE_DOUBLE & (1 << 8)) run_phase<8, 1>(p, bid, nblk, lds); xcd_barrier(bar);
    run_phase<9>(p, bid, nblk, lds); if (PROBE_DOUBLE & (1 << 9)) run_phase<9, 1>(p, bid, nblk, lds); xcd_barrier(bar);
    run_phase<10>(p, bid, nblk, lds); if (PROBE_DOUBLE & (1 << 10)) run_phase<10, 1>(p, bid, nblk, lds); xcd_barrier(bar);
    run_phase<11>(p, bid, nblk, lds); if (PROBE_DOUBLE & (1 << 11)) run_phase<11, 1>(p, bid, nblk, lds);
#if USE_FAST_PEER && PEER_SLICED
    xcd_barrier(bar); run_phase<12>(p, bid, nblk, lds);
    xcd_barrier(bar); run_phase<13>(p, bid, nblk, lds);
#elif USE_FAST_PEER && PEER_SPLIT && TAB_EB == 6
    xcd_barrier(bar); run_phase<12>(p, bid, nblk, lds);
#endif
}

template <int PH> static void launch_phase(const Params& p, int grid, hipStream_t st) {
    hipLaunchKernelGGL((k_phase<PH>), dim3(grid), dim3(512), LDS_BYTES, st, p);
}

extern "C" void kernel_launch(void* const* d_in, const int* in_sizes, int n_in, void* d_out, int out_size, void* d_ws, size_t ws_size, hipStream_t stream) {
    Params p{};
    p.x = (const float*)d_in[0]; p.c = (const float*)d_in[1]; p.pos = (const int*)d_in[2]; p.w_ada = (const float*)d_in[3]; p.b_ada = (const float*)d_in[4];
    p.norm1_g = (const float*)d_in[5]; p.w_in = (const float*)d_in[6]; p.qn_g = (const float*)d_in[7]; p.w_uq = (const float*)d_in[8]; p.kvn_g = (const float*)d_in[9];
    p.w_ukv = (const float*)d_in[10]; p.osb_g = (const float*)d_in[11]; p.omla_g = (const float*)d_in[12]; p.w_o = (const float*)d_in[13]; p.norm2_g = (const float*)d_in[14];
    p.w_pq = (const float*)d_in[15]; p.keys1 = (const float*)d_in[16]; p.keys2 = (const float*)d_in[17]; p.u_tab = (const float*)d_in[18]; p.v_tab = (const float*)d_in[19];
    p.fin_g = (const float*)d_in[20]; p.out = (float*)d_out; p.ws = (unsigned char*)d_ws;
#if FUSED
    static int grid = 0;
    if (!grid) {
        int dev = 0, cus = 0, per_cu = 0;
        hipGetDevice(&dev);
        hipDeviceGetAttribute(&cus, hipDeviceAttributeMultiprocessorCount, dev);
        hipFuncSetAttribute((const void*)k_fused, hipFuncAttributeMaxDynamicSharedMemorySize, LDS_BYTES);
        hipOccupancyMaxActiveBlocksPerMultiprocessor(&per_cu, k_fused, 512, LDS_BYTES);
        grid = per_cu >= 1 ? cus : 0;
    }
    hipMemsetAsync((unsigned char*)d_ws + OFF_BAR, 0, 16384, stream);
    if (grid) hipLaunchKernelGGL(k_fused, dim3(grid), dim3(512), LDS_BYTES, stream, p);
#else
    const int G = 1024;
    launch_phase<0>(p, G, stream); launch_phase<1>(p, G, stream); launch_phase<2>(p, G, stream); launch_phase<3>(p, G, stream);
    launch_phase<4>(p, G, stream); launch_phase<5>(p, G, stream); launch_phase<6>(p, G, stream); launch_phase<7>(p, G, stream);
    launch_phase<8>(p, G, stream); launch_phase<9>(p, G, stream); launch_phase<10>(p, G, stream); launch_phase<11>(p, G, stream);
#endif
}
```

```cpp
#include <hip/hip_runtime.h>
#include <stdint.h>

#ifndef TAB_EB
#define TAB_EB 6
#endif
#ifndef ATT_ANTIPHASE
#define ATT_ANTIPHASE 1
#endif
#ifndef PEER_SPLIT
#define PEER_SPLIT 1
#endif
#ifndef PEER_SLICED
#define PEER_SLICED 0
#endif
#ifndef PROBE_ATTN_G
#define PROBE_ATTN_G 0
#endif
#ifndef PROBE_DOUBLE
#define PROBE_DOUBLE 0
#endif
#ifndef FUSED
#define FUSED 1
#endif

typedef unsigned short bf16_t;
#define LAS __attribute__((address_space(3)))
__device__ __forceinline__ int tid_fresh(int widx) { unsigned m = ~0u; asm volatile("" : "+s"(m)); int t = (widx << 6) | (int)__builtin_amdgcn_mbcnt_hi(m, __builtin_amdgcn_mbcnt_lo(m, 0u)); asm volatile("" : "+v"(t)); return t; }

constexpr int TOK = 8192, DM = 2048, SEQ = 4096, NB = 2;
constexpr int NIN = 3904, NINP = 4096;
constexpr int NEXP = 16384;
constexpr float EPS = 1e-6f;
constexpr float LOG2E = 1.4426950408889634f, LN2 = 0.6931471805599453f;
constexpr float QS_SB = 0.12751743082459868f;
constexpr float QS_MLA = 0.10411754627697264f;

constexpr size_t MiB = 1ull << 20;
constexpr size_t OFF_BAR = 0;
constexpr size_t OFF_MOD = 16384;
constexpr size_t OFF_COS = OFF_MOD + 98304;
constexpr size_t OFF_SIN = OFF_COS + MiB;
constexpr size_t OFF_RSQ = OFF_SIN + MiB;
constexpr size_t OFF_RSKV = OFF_RSQ + 32768;
constexpr size_t OFF_SSQ = OFF_RSKV + 32768;
constexpr size_t OFF_KEYS = OFF_SSQ + 524288;
constexpr size_t OFF_USC = OFF_KEYS + 524288;
constexpr size_t OFF_VSC = OFF_USC + 65536;
static_assert(OFF_VSC + 65536 <= 4 * MiB, "ws map");
constexpr size_t OFF_WIN_T = 4 * MiB;
constexpr size_t OFF_WUQ_T = OFF_WIN_T + 16 * MiB;
constexpr size_t OFF_WUKV_T = OFF_WUQ_T + 2 * MiB;
constexpr size_t OFF_WO_T = OFF_WUKV_T + 1 * MiB;
constexpr size_t OFF_WPQ_T = OFF_WO_T + 8 * MiB;
constexpr size_t OFF_H = OFF_WPQ_T + 8 * MiB;
constexpr size_t OFF_QSB = OFF_H + 32 * MiB;
constexpr size_t OFF_KSB = OFF_QSB + 16 * MiB;
constexpr size_t OFF_VSB = OFF_KSB + 16 * MiB;
constexpr size_t OFF_CQ = OFF_VSB + 16 * MiB;
constexpr size_t OFF_CKV = OFF_CQ + 8 * MiB;
constexpr size_t OFF_QMLA = OFF_CKV + 4 * MiB;
constexpr size_t OFF_KMLA = OFF_QMLA + 24 * MiB;
constexpr size_t OFF_VMLA = OFF_KMLA + 24 * MiB;
constexpr size_t OFF_O = OFF_VMLA + 16 * MiB;
constexpr size_t OFF_X1 = OFF_O + 32 * MiB;
constexpr size_t OFF_QP = OFF_X1 + 64 * MiB;
constexpr size_t OFF_RIDX = OFF_QP + 32 * MiB;
constexpr size_t OFF_RGATE = OFF_RIDX + 4 * MiB;
constexpr size_t OFF_UTAB = OFF_RGATE + 4 * MiB;
constexpr size_t OFF_VTAB = OFF_UTAB + 64 * MiB;
constexpr size_t OFF_PD = OFF_VTAB + 64 * MiB;
constexpr size_t OFF_SSQP = OFF_PD + 32 * MiB;
constexpr size_t OFF_RSP = OFF_SSQP + 1 * MiB;
constexpr size_t WS_END = OFF_RSP + 1 * MiB;

struct Params {
    const float* x; const float* c; const int* pos; const float* w_ada; const float* b_ada; const float* norm1_g;
    const float* w_in; const float* qn_g; const float* w_uq; const float* kvn_g; const float* w_ukv;
    const float* osb_g; const float* omla_g; const float* w_o; const float* norm2_g; const float* w_pq;
    const float* keys1; const float* keys2; const float* u_tab; const float* v_tab; const float* fin_g;
    float* out; unsigned char* ws;
    int widx; int pad_;
};
template <class Tp> __device__ __forceinline__ Tp* WS(const Params& p, size_t off) { return (Tp*)(p.ws + off); }

__device__ __forceinline__ float bf2f(bf16_t v) { return __uint_as_float(((unsigned)v) << 16); }
__device__ __forceinline__ bf16_t f2bf(float f) { unsigned u = __float_as_uint(f); u += 0x7fffu + ((u >> 16) & 1u); return (bf16_t)(u >> 16); }
__device__ __forceinline__ unsigned pack2(float lo, float hi) { return (unsigned)f2bf(lo) | ((unsigned)f2bf(hi) << 16); }
__device__ __forceinline__ float lo_f(unsigned u) { return __uint_as_float(u << 16); }
__device__ __forceinline__ float hi_f(unsigned u) { return __uint_as_float(u & 0xffff0000u); }
__device__ __forceinline__ float dot8(uint4 a, uint4 b) {
    float s = lo_f(a.x) * lo_f(b.x); s += hi_f(a.x) * hi_f(b.x);
    s += lo_f(a.y) * lo_f(b.y); s += hi_f(a.y) * hi_f(b.y);
    s += lo_f(a.z) * lo_f(b.z); s += hi_f(a.z) * hi_f(b.z);
    s += lo_f(a.w) * lo_f(b.w); s += hi_f(a.w) * hi_f(b.w);
    return s;
}
__device__ __forceinline__ float wave_sum(float v) {
#pragma unroll
    for (int o = 32; o > 0; o >>= 1) v += __shfl_xor(v, o);
    return v;
}
__device__ __forceinline__ float gelu_exact(float x) { return 0.5f * x * (1.0f + erff(x * 0.70710678118654752f)); }

struct EpiInProj {
    static constexpr bool HAS_MID = false;
    bf16_t *qsb, *ksb, *vsb, *cq, *ckv, *kmla; const float *cosT, *sinT; float* rsp;
    __device__ __forceinline__ float row_scale(int) const { return 1.0f; }
    __device__ __forceinline__ float mid_scale(int) const { return 1.0f; }
    __device__ __forceinline__ void store8(int row, int col0, const float (&v)[8], float) const {
        if (col0 >= NIN) return;
        uint4 w;
        if (col0 < 3840) {
            float s = col0 < 1024 ? QS_SB : 1.0f;
            w.x = pack2(v[0] * s, v[1] * s); w.y = pack2(v[2] * s, v[3] * s); w.z = pack2(v[4] * s, v[5] * s); w.w = pack2(v[6] * s, v[7] * s);
            bf16_t* dst;
            if (col0 < 1024) dst = qsb + (size_t)row * 1024 + col0;
            else if (col0 < 2048) dst = ksb + (size_t)row * 1024 + (col0 - 1024);
            else if (col0 < 3072) dst = vsb + (size_t)row * 1024 + (col0 - 2048);
            else if (col0 < 3584) dst = cq + (size_t)row * 512 + (col0 - 3072);
            else dst = ckv + (size_t)row * 256 + (col0 - 3584);
            *(uint4*)dst = w;
            if (col0 >= 3072) {
                float ss = lo_f(w.x) * lo_f(w.x) + hi_f(w.x) * hi_f(w.x) + lo_f(w.y) * lo_f(w.y) + hi_f(w.y) * hi_f(w.y)
                         + lo_f(w.z) * lo_f(w.z) + hi_f(w.z) * hi_f(w.z) + lo_f(w.w) * lo_f(w.w) + hi_f(w.w) * hi_f(w.w);
                ss += __shfl_xor(ss, 16); ss += __shfl_xor(ss, 32);
                if ((tid_fresh(0) & 48) == 0) rsp[(size_t)row * 24 + ((col0 - 3072) >> 5)] = ss;
            }
        } else {
            const int e0 = col0 - 3840, i0 = e0 >> 1;
            float o[8];
#pragma unroll
            for (int j = 0; j < 4; ++j) {
                const float cs = cosT[(size_t)row * 32 + i0 + j], sn = sinT[(size_t)row * 32 + i0 + j];
                const float x1 = v[2 * j], x2 = v[2 * j + 1];
                o[2 * j] = x1 * cs - x2 * sn; o[2 * j + 1] = x2 * cs + x1 * sn;
            }
            w.x = pack2(o[0], o[1]); w.y = pack2(o[2], o[3]); w.z = pack2(o[4], o[5]); w.w = pack2(o[6], o[7]);
#pragma unroll
            for (int h = 0; h < 8; ++h) *(uint4*)(kmla + (size_t)row * 1536 + h * 192 + 128 + e0) = w;
        }
    }
};
struct EpiUq {
    static constexpr bool HAS_MID = false;
    bf16_t* qmla; const float *rsp, *cosT, *sinT;
    __device__ __forceinline__ float mid_scale(int) const { return 1.0f; }
    __device__ __forceinline__ float row_scale(int row) const { float s = 0.f;
#pragma unroll
        for (int i = 0; i < 16; ++i) s += rsp[(size_t)row * 24 + i];
        return rsqrtf(s * (1.0f / 512.0f) + EPS) * QS_MLA; }
    __device__ __forceinline__ void store8(int row, int col0, const float (&v)[8], float r) const {
        const int d0 = col0 % 192;
        float o[8];
        if (d0 < 128) {
#pragma unroll
            for (int j = 0; j < 8; ++j) o[j] = v[j] * r;
        } else {
            const int i0 = (d0 - 128) >> 1;
#pragma unroll
            for (int j = 0; j < 4; ++j) {
                const float cs = cosT[(size_t)row * 32 + i0 + j], sn = sinT[(size_t)row * 32 + i0 + j];
                const float x1 = v[2 * j], x2 = v[2 * j + 1];
                o[2 * j] = (x1 * cs - x2 * sn) * r; o[2 * j + 1] = (x2 * cs + x1 * sn) * r;
            }
        }
        uint4 w; w.x = pack2(o[0], o[1]); w.y = pack2(o[2], o[3]); w.z = pack2(o[4], o[5]); w.w = pack2(o[6], o[7]);
        *(uint4*)(qmla + (size_t)row * 1536 + col0) = w;
    }
};
struct EpiUkv {
    static constexpr bool HAS_MID = false;
    bf16_t *kmla, *vmla; const float* rsp;
    __device__ __forceinline__ float mid_scale(int) const { return 1.0f; }
    __device__ __forceinline__ float row_scale(int row) const { float s = 0.f;
#pragma unroll
        for (int i = 0; i < 8; ++i) s += rsp[(size_t)row * 24 + 16 + i];
        return rsqrtf(s * (1.0f / 256.0f) + EPS); }
    __device__ __forceinline__ void store8(int row, int col0, const float (&v)[8], float r) const {
        const int h = col0 >> 8, j0 = col0 & 255;
        uint4 w; w.x = pack2(v[0] * r, v[1] * r); w.y = pack2(v[2] * r, v[3] * r); w.z = pack2(v[4] * r, v[5] * r); w.w = pack2(v[6] * r, v[7] * r);
        bf16_t* dst = j0 < 128 ? kmla + (size_t)row * 1536 + h * 192 + j0 : vmla + (size_t)row * 1024 + h * 128 + (j0 - 128);
        *(uint4*)dst = w;
    }
};
struct EpiWo {
    static constexpr bool HAS_MID = true;
    const float* x; const float* mod; float* x1; const float* ssq;
    __device__ __forceinline__ void rstd2(int row, float& r0, float& r1) const { float s0 = 0.f, s1 = 0.f;
#pragma unroll
        for (int h = 0; h < 8; ++h) { s0 += ssq[(size_t)row * 16 + h]; s1 += ssq[(size_t)row * 16 + 8 + h]; }
        r0 = rsqrtf(s0 * (1.0f / 1024.0f) + EPS); r1 = rsqrtf(s1 * (1.0f / 1024.0f) + EPS); }
    __device__ __forceinline__ float mid_scale(int row) const { float r0, r1; rstd2(row, r0, r1); return r0 / r1; }
    __device__ __forceinline__ float row_scale(int row) const { float r0, r1; rstd2(row, r0, r1); return r1; }
    __device__ __forceinline__ void store8(int row, int col0, const float (&vin)[8], float rsc) const {
        float v[8];
#pragma unroll
        for (int i = 0; i < 8; ++i) v[i] = vin[i] * rsc;
        const int b = row >> 12;
        const float* g1 = mod + (size_t)b * 12288 + 2 * 2048 + col0;
        const float4 xa = *(const float4*)(x + (size_t)row * DM + col0), xb = *(const float4*)(x + (size_t)row * DM + col0 + 4);
        const float4 ga = *(const float4*)g1, gb = *(const float4*)(g1 + 4);
        float4 oa, ob;
        oa.x = xa.x + ga.x * v[0]; oa.y = xa.y + ga.y * v[1]; oa.z = xa.z + ga.z * v[2]; oa.w = xa.w + ga.w * v[3];
        ob.x = xb.x + gb.x * v[4]; ob.y = xb.y + gb.y * v[5]; ob.z = xb.z + gb.z * v[6]; ob.w = xb.w + gb.w * v[7];
        *(float4*)(x1 + (size_t)row * DM + col0) = oa; *(float4*)(x1 + (size_t)row * DM + col0 + 4) = ob;
    }
};
struct EpiQp {
    static constexpr bool HAS_MID = false;
    bf16_t* qp;
    __device__ __forceinline__ float row_scale(int) const { return 1.0f; }
    __device__ __forceinline__ float mid_scale(int) const { return 1.0f; }
    __device__ __forceinline__ void store8(int row, int col0, const float (&v)[8], float) const {
        uint4 w; w.x = pack2(v[0], v[1]); w.y = pack2(v[2], v[3]); w.z = pack2(v[4], v[5]); w.w = pack2(v[6], v[7]);
        *(uint4*)(qp + (size_t)row * DM + col0) = w;
    }
};

namespace pg8 {
#define PG8_LAS __attribute__((address_space(3)))
typedef unsigned short bf16_t;
typedef short bf16x8 __attribute__((ext_vector_type(8)));
typedef float f32x4 __attribute__((ext_vector_type(4)));
typedef unsigned u32x4 __attribute__((ext_vector_type(4)));
constexpr int BM = 256, BK = 64, HALF = 128, HTB = HALF * BK * 2  , STAGE_BYTES = 8 * HTB, NXCD = 8, WGM = 8;

__host__ __device__ __forceinline__ int lds_byte(int r, int c) { const int st = (r >> 4) * 2 + (c >> 5), rr = r & 15, cc = c & 31, ob = rr * 64 + cc * 2; return st * 1024 + (ob ^ (((ob >> 9) & 1) << 5)); }
__host__ __device__ __forceinline__ void stage_rc(int b, int& R, int& C) { const int st = b / 1024, sb = b % 1024, swz = sb ^ (((sb >> 9) & 1) << 5); R = (st >> 1) * 16 + swz / 64; C = (st & 1) * 32 + (swz % 64) / 2; }
__host__ __device__ __forceinline__ int perm32(int rho) { const int n = rho >> 4, i = rho & 15; return 8 * (i >> 2) + 4 * n + (i & 3); }

struct Unit { int pm, pn; };
struct Gemm { const bf16_t* A; const bf16_t* Bt; int M, N, K, widx; };

struct StaticOrder {
    int nM, nN, nwg, G, c;
    __host__ __device__ __forceinline__ void init(int M, int N, int G_, int c_) { nM = M / BM; nN = N / BM; nwg = nM * nN; G = G_; c = c_; }
    __host__ __device__ bool next(int i, Unit& u) const {
        const long L = (long)i * G + c; if (L >= nwg) return false;
        int wgid = (int)L; { const int q = nwg / NXCD, r = nwg % NXCD, xcd = wgid % NXCD, off = wgid / NXCD; wgid = (xcd < r ? xcd * (q + 1) : r * (q + 1) + (xcd - r) * q) + off; }
        const int nig = WGM * nN, gid = wgid / nig, fm = gid * WGM, gsz = (nM - fm) < WGM ? (nM - fm) : WGM;
        u.pm = fm + ((wgid % nig) % gsz); u.pn = (wgid % nig) / gsz; return true;
    }
    __device__ __forceinline__ void a_ready(const Unit&) const {}
    __device__ __forceinline__ void done(const Unit&) const {}
};

template <class Epi, class Sched, bool ALIGN_EPI = false, bool SP2 = false>
__device__ __forceinline__ void gemm_phase(PG8_LAS unsigned char* lds, const Gemm g, const Sched& S, const Epi& E) {
    const int tid = tid_fresh(g.widx), wid = __builtin_amdgcn_readfirstlane(tid >> 6), lane = tid & 63, wr = wid >> 2, wc = wid & 3, fr = lane & 15, fq = lane >> 4;
    const int K = g.K, nt = K / BK;
    unsigned voffA[2], voffB[2];
#pragma unroll
    for (int i = 0; i < 2; ++i) { int R, C; stage_rc(tid * 16 + i * 8192, R, C); const int Rb = Epi::PERM ? ((R & ~31) + perm32(R & 31)) : R;
        voffA[i] = (unsigned)(R * K + C) * 2u; voffB[i] = (unsigned)(Rb * K + C) * 2u; }
    const size_t kstep = (size_t)(BK * 2);
    const size_t hstep = (size_t)HALF * K * 2;
    const size_t tstep = 2 * hstep;
    const unsigned ldsw = (unsigned)wid * 1024u;
    const int aoff = lds_byte(wr * 64 + fr, fq * 8), boff = lds_byte(wc * 32 + fr, fq * 8);
#define PG8_SA(b, h) (((b) * 2 + (h)) * HTB)
#define PG8_SB(b, h) ((4 + (b) * 2 + (h)) * HTB)
#define PG8_STAGE(bufoff, gbase, voff) do { _Pragma("unroll") for (int _i = 0; _i < 2; ++_i) \
        __builtin_amdgcn_global_load_lds((const unsigned*)((const char*)(gbase) + (voff)[_i]), (PG8_LAS unsigned*)(lds + (bufoff) + ldsw + _i * 8192), 16, 0, 0); } while (0)
#define PG8_LDA(dst, b, h) do { _Pragma("unroll") for (int m = 0; m < 4; ++m) _Pragma("unroll") for (int k = 0; k < 2; ++k) dst[m][k] = *(const PG8_LAS bf16x8*)(lds + PG8_SA(b, h) + aoff + m * 2048 + k * 1024); } while (0)
#define PG8_LDB(dst, b, h) do { _Pragma("unroll") for (int n = 0; n < 2; ++n) _Pragma("unroll") for (int k = 0; k < 2; ++k) dst[n][k] = *(const PG8_LAS bf16x8*)(lds + PG8_SB(b, h) + boff + n * 2048 + k * 1024); } while (0)
#define PG8_MMA(ai, bj, At, Bt) do { __builtin_amdgcn_s_setprio(1); _Pragma("unroll") for (int m = 0; m < 4; ++m) _Pragma("unroll") for (int n = 0; n < 2; ++n) _Pragma("unroll") for (int k = 0; k < 2; ++k) \
        acc[ai][bj][m][n] = __builtin_amdgcn_mfma_f32_16x16x32_bf16(Bt[n][k], At[m][k], acc[ai][bj][m][n], 0, 0, 0); __builtin_amdgcn_s_setprio(0); } while (0)
#define PG8_WAIT_V(n) asm volatile("s_waitcnt vmcnt(" #n ")" ::: "memory")
#define PG8_WAIT_L(n) asm volatile("s_waitcnt lgkmcnt(" #n ")" ::: "memory")
#define PG8_BAR __builtin_amdgcn_s_barrier()
#define PG8_SCHED __builtin_amdgcn_sched_barrier(0)
    Unit cur, nxt; int ui = 0;
    if (!S.next(0, cur)) return;
    f32x4 acc[2][2][4][2];
#pragma unroll
    for (int a = 0; a < 2; ++a)
#pragma unroll
        for (int b = 0; b < 2; ++b)
#pragma unroll
            for (int m = 0; m < 4; ++m)
#pragma unroll
                for (int n = 0; n < 2; ++n) acc[a][b][m][n] = (f32x4){0.f, 0.f, 0.f, 0.f};
    bf16x8 At[4][2], B0[2][2], B1[2][2];
    const char* cA = (const char*)g.A + (size_t)cur.pm * tstep; const char* cB = (const char*)g.Bt + (size_t)cur.pn * tstep;
    S.a_ready(cur);
    if constexpr (SP2) {
        PG8_STAGE(PG8_SB(0, 0), cB, voffB); PG8_STAGE(PG8_SB(0, 1), cB + hstep, voffB); PG8_STAGE(PG8_SA(0, 0), cA, voffA); PG8_STAGE(PG8_SA(0, 1), cA + hstep, voffA);
        if (wr == 1) PG8_BAR;
        PG8_WAIT_V(2); PG8_BAR;
        PG8_STAGE(PG8_SB(1, 0), cB + kstep, voffB); PG8_STAGE(PG8_SA(1, 0), cA + kstep, voffA); PG8_STAGE(PG8_SB(1, 1), cB + hstep + kstep, voffB);
        PG8_WAIT_V(6); PG8_BAR;
    } else {
        PG8_STAGE(PG8_SB(0, 0), cB, voffB); PG8_STAGE(PG8_SA(0, 0), cA, voffA); PG8_STAGE(PG8_SB(0, 1), cB + hstep, voffB); PG8_STAGE(PG8_SA(0, 1), cA + hstep, voffA);
        if (wr == 1) PG8_BAR;
        PG8_WAIT_V(4); PG8_BAR;
        PG8_STAGE(PG8_SB(1, 0), cB + kstep, voffB); PG8_STAGE(PG8_SA(1, 0), cA + kstep, voffA); PG8_STAGE(PG8_SB(1, 1), cB + hstep + kstep, voffB);
        PG8_WAIT_V(6); PG8_BAR;
    }
    for (;;) {
        const bool has_next = S.next(ui + 1, nxt);
        const char* nA = has_next ? (const char*)g.A + (size_t)nxt.pm * tstep : cA; const char* nB = has_next ? (const char*)g.Bt + (size_t)nxt.pn * tstep : cB;
        for (int t = 0; t < nt; t += 2) {
            const bool last = (t == nt - 2);
            const char* a1 = cA + (size_t)(t + 1) * kstep;
            const char* a2 = last ? nA : cA + (size_t)(t + 2) * kstep; const char* b2 = last ? nB : cB + (size_t)(t + 2) * kstep;
            const char* a3 = a2 + kstep; const char* b3 = b2 + kstep;
            if (last && has_next) S.a_ready(nxt);
            if constexpr (Epi::HAS_MID) { if (t == (nt >> 1)) E.mid(acc, cur, wr, wc, fr, fq); }
            if constexpr (SP2) {
            PG8_LDB(B0, 0, 0); PG8_LDB(B1, 0, 1); PG8_SCHED; PG8_LDA(At, 0, 0); PG8_STAGE(PG8_SA(1, 1), a1 + hstep, voffA);
            PG8_WAIT_V(8); PG8_WAIT_L(0); PG8_BAR; PG8_MMA(0, 0, At, B0); PG8_MMA(0, 1, At, B1); PG8_BAR; PG8_SCHED;
            PG8_LDA(At, 0, 1); PG8_STAGE(PG8_SB(0, 0), b2, voffB); PG8_STAGE(PG8_SB(0, 1), b2 + hstep, voffB); PG8_STAGE(PG8_SA(0, 0), a2, voffA);
            PG8_WAIT_V(8); PG8_WAIT_L(0); PG8_BAR; PG8_MMA(1, 0, At, B0); PG8_MMA(1, 1, At, B1); PG8_BAR; PG8_SCHED;
            PG8_LDB(B0, 1, 0); PG8_LDB(B1, 1, 1); PG8_SCHED; PG8_LDA(At, 1, 0); PG8_STAGE(PG8_SA(0, 1), a2 + hstep, voffA);
            PG8_WAIT_V(8); PG8_WAIT_L(0); PG8_BAR; PG8_MMA(0, 0, At, B0); PG8_MMA(0, 1, At, B1); PG8_BAR; PG8_SCHED;
            PG8_LDA(At, 1, 1); PG8_STAGE(PG8_SB(1, 0), b3, voffB); PG8_STAGE(PG8_SB(1, 1), b3 + hstep, voffB); PG8_STAGE(PG8_SA(1, 0), a3, voffA);
            PG8_WAIT_V(8); PG8_WAIT_L(0); PG8_BAR; PG8_MMA(1, 0, At, B0); PG8_MMA(1, 1, At, B1); PG8_BAR; PG8_SCHED;
            } else {
            PG8_LDB(B0, 0, 0); PG8_SCHED; PG8_LDA(At, 0, 0); PG8_STAGE(PG8_SA(1, 1), a1 + hstep, voffA);
            PG8_WAIT_L(8); PG8_BAR; PG8_WAIT_L(0); PG8_MMA(0, 0, At, B0); PG8_BAR; PG8_SCHED;
            PG8_LDB(B1, 0, 1); PG8_STAGE(PG8_SB(0, 0), b2, voffB);
            PG8_BAR; PG8_WAIT_L(0); PG8_MMA(0, 1, At, B1); PG8_BAR;
            PG8_LDA(At, 0, 1); PG8_STAGE(PG8_SA(0, 0), a2, voffA);
            PG8_BAR; PG8_WAIT_L(0); PG8_MMA(1, 0, At, B0); PG8_BAR; PG8_SCHED;
            PG8_STAGE(PG8_SB(0, 1), b2 + hstep, voffB);
            PG8_WAIT_V(6); PG8_BAR; PG8_MMA(1, 1, At, B1); PG8_BAR;
            PG8_LDB(B0, 1, 0); PG8_SCHED; PG8_LDA(At, 1, 0); PG8_STAGE(PG8_SA(0, 1), a2 + hstep, voffA);
            PG8_WAIT_L(8); PG8_BAR; PG8_WAIT_L(0); PG8_MMA(0, 0, At, B0); PG8_BAR; PG8_SCHED;
            PG8_LDB(B1, 1, 1); PG8_STAGE(PG8_SB(1, 0), b3, voffB);
            PG8_BAR; PG8_WAIT_L(0); PG8_MMA(0, 1, At, B1); PG8_BAR;
            PG8_LDA(At, 1, 1); PG8_STAGE(PG8_SA(1, 0), a3, voffA);
            PG8_BAR; PG8_WAIT_L(0); PG8_MMA(1, 0, At, B0); PG8_BAR; PG8_SCHED;
            PG8_STAGE(PG8_SB(1, 1), b3 + hstep, voffB);
            PG8_WAIT_V(6); PG8_BAR; PG8_MMA(1, 1, At, B1); PG8_BAR;
            }
        }
        if constexpr (ALIGN_EPI) { if (wr == 0) PG8_BAR; }
        if constexpr (!Epi::AFTER_DRAIN) { E(acc, cur, wr, wc, fr, fq); S.done(cur); }
        if (!has_next) break;
#pragma unroll
        for (int a = 0; a < 2; ++a)
#pragma unroll
            for (int b = 0; b < 2; ++b)
#pragma unroll
                for (int m = 0; m < 4; ++m)
#pragma unroll
                    for (int n = 0; n < 2; ++n) acc[a][b][m][n] = (f32x4){0.f, 0.f, 0.f, 0.f};
        cur = nxt; cA = nA; cB = nB; ++ui;
        if constexpr (ALIGN_EPI) { if (wr == 1) PG8_BAR; }
    }
    PG8_WAIT_V(0);
    if constexpr (!ALIGN_EPI) { if (wr == 0) PG8_BAR; }
    PG8_BAR;
    if constexpr (Epi::AFTER_DRAIN) { E.fused(acc, cur, wr, wc, fr, fq, lds, wid, lane); S.done(cur); }
#undef PG8_SA
#undef PG8_SB
#undef PG8_STAGE
#undef PG8_LDA
#undef PG8_LDB
#undef PG8_MMA
#undef PG8_WAIT_V
#undef PG8_WAIT_L
#undef PG8_BAR
#undef PG8_SCHED
}
}

template <class C> struct EpiChunk {
    static constexpr bool PERM = true, AFTER_DRAIN = false, HAS_MID = C::HAS_MID;
    C c;
    __device__ __forceinline__ void mid(pg8::f32x4 (&acc)[2][2][4][2], const pg8::Unit& u, int wr, int wc, int fr, int fq) const {
#pragma unroll
        for (int ai = 0; ai < 2; ++ai)
#pragma unroll
            for (int m = 0; m < 4; ++m) { const float f = c.mid_scale(u.pm * 256 + ai * 128 + wr * 64 + m * 16 + fr);
#pragma unroll
                for (int bj = 0; bj < 2; ++bj)
#pragma unroll
                    for (int n = 0; n < 2; ++n) acc[ai][bj][m][n] = acc[ai][bj][m][n] * f; }
    }
    __device__ __forceinline__ void operator()(const pg8::f32x4 (&acc)[2][2][4][2], const pg8::Unit& u, int wr, int wc, int fr, int fq) const {
#pragma unroll
        for (int ai = 0; ai < 2; ++ai)
#pragma unroll
            for (int m = 0; m < 4; ++m) {
                const int row = u.pm * 256 + ai * 128 + wr * 64 + m * 16 + fr;
                const float rsc = c.row_scale(row);
#pragma unroll
                for (int bj = 0; bj < 2; ++bj) {
                    const int col0 = u.pn * 256 + bj * 128 + wc * 32 + 8 * fq;
                    const pg8::f32x4 a = acc[ai][bj][m][0], b = acc[ai][bj][m][1];
                    const float v[8] = {a[0], a[1], a[2], a[3], b[0], b[1], b[2], b[3]};
                    c.store8(row, col0, v, rsc);
                }
                asm volatile("" ::: "memory");
            }
    }
};
template <class C> __device__ __forceinline__ void gemm_mfma(const bf16_t* A, const bf16_t* Bt, int M, int N, int K, const C& c, int bid, int nblk, unsigned char* lds, int widx) {
    pg8::Gemm g; g.A = A; g.Bt = Bt; g.M = M; g.N = N; g.K = K; g.widx = widx;
    pg8::StaticOrder S; S.init(M, N, nblk, bid);
    EpiChunk<C> E{c};
    pg8::gemm_phase<EpiChunk<C>, pg8::StaticOrder, true, true>((PG8_LAS unsigned char*)lds, g, S, E);
}

template <class Epi>
__device__ __forceinline__ void gemm_ref(const bf16_t* A, int lda, const bf16_t* Bt, int ldb, int M, int N, int K, const Epi& E, int bid, int nblk) {
    const int tid = (int)threadIdx.x, tn = N / 64, ntile = (M / 64) * tn;
    for (int tile = bid; tile < ntile; tile += nblk) {
        const int row = (tile / tn) * 64 + (tid >> 3), col0 = (tile % tn) * 64 + (tid & 7) * 8;
        float acc[8];
#pragma unroll
        for (int j = 0; j < 8; ++j) acc[j] = 0.f;
        const bf16_t* ap = A + (size_t)row * lda; const bf16_t* bp = Bt + (size_t)col0 * ldb;
        for (int k0 = 0; k0 < K; k0 += 8) {
            const uint4 av = *(const uint4*)(ap + k0);
#pragma unroll
            for (int j = 0; j < 8; ++j) { const uint4 bv = *(const uint4*)(bp + (size_t)j * ldb + k0); acc[j] += dot8(av, bv); }
        }
        E.store8(row, col0, acc, E.row_scale(row));
    }
}

constexpr int J_ADA = 192, J_WIN = 64, J_WO = 32, J_WPQ = 32, J_WUQ = 24, J_WUKV = 32, J_KEYS = 16, J_ROPE = 16;
constexpr int J0_END = J_ADA, J1_END = J0_END + J_WIN, J2_END = J1_END + J_WO, J3_END = J2_END + J_WPQ, J4_END = J3_END + J_WUQ,
              J5_END = J4_END + J_WUKV, J6_END = J5_END + J_KEYS, J7_END = J6_END + J_ROPE, J8_END = J7_END + 1024;

__device__ __forceinline__ void job_ada(const Params& p, int it, float* lds) {
    const int tid = tid_fresh(p.widx);
    float* sc = lds;
    float* red = lds + 4096;
    for (int i = tid; i < 4096; i += 512) { const float v = p.c[i]; sc[i] = v / (1.0f + __expf(-v)); }
    __syncthreads();
    const int cg = tid & 15, rl = tid >> 4, c0 = it * 64 + cg * 4;
    float4 a0 = {0.f, 0.f, 0.f, 0.f}, a1 = {0.f, 0.f, 0.f, 0.f};
#pragma unroll 8
    for (int i = 0; i < 64; ++i) {
        const int k = rl + 32 * i;
        const float4 w = *(const float4*)(p.w_ada + (size_t)k * 12288 + c0);
        const float s0 = sc[k], s1 = sc[2048 + k];
        a0.x += s0 * w.x; a0.y += s0 * w.y; a0.z += s0 * w.z; a0.w += s0 * w.w;
        a1.x += s1 * w.x; a1.y += s1 * w.y; a1.z += s1 * w.z; a1.w += s1 * w.w;
    }
    float* r0 = red + rl * 128 + cg * 4;
    r0[0] = a0.x; r0[1] = a0.y; r0[2] = a0.z; r0[3] = a0.w; r0[64] = a1.x; r0[65] = a1.y; r0[66] = a1.z; r0[67] = a1.w;
    __syncthreads();
    if (tid < 128) {
        float s = 0.f;
        for (int r = 0; r < 32; ++r) s += red[r * 128 + tid];
        const int b = tid >> 6, col = it * 64 + (tid & 63);
        WS<float>(p, OFF_MOD)[(size_t)b * 12288 + col] = s + p.b_ada[col];
    }
    __syncthreads();
}

template <int W> __device__ __forceinline__ int tr_dst_row(int n) {
    if (W == 0) { if (n < 3840) return n; const int e = n - 3840; return 3840 + 2 * (e & 31) + (e >> 5); }
    if (W == 3) { const int h = n / 192, d = n % 192; if (d < 128) return n; const int e = d - 128; return h * 192 + 128 + 2 * (e & 31) + (e >> 5); }
    return n;
}
template <int W> __device__ __forceinline__ float tr_scale(const Params& p, int k) {
    if (W == 1) return k < 1024 ? p.osb_g[k] : p.omla_g[k - 1024];
    if (W == 3) return p.qn_g[k];
    if (W == 4) return p.kvn_g[k];
    return 1.0f;
}
template <int W> __device__ __forceinline__ void job_transpose(const Params& p, int it, float* tile) {
    constexpr int K = (W == 3) ? 512 : (W == 4) ? 256 : 2048;
    constexpr int NS = (W == 0) ? NIN : (W == 3) ? 1536 : 2048;
    constexpr int TS = 68;
    const float* src = (W == 0) ? p.w_in : (W == 1) ? p.w_o : (W == 2) ? p.w_pq : (W == 3) ? p.w_uq : p.w_ukv;
    bf16_t* dst = WS<bf16_t>(p, (W == 0) ? OFF_WIN_T : (W == 1) ? OFF_WO_T : (W == 2) ? OFF_WPQ_T : (W == 3) ? OFF_WUQ_T : OFF_WUKV_T);
    const int tid = tid_fresh(p.widx), n0 = it * 64;
    if (W == 0 && n0 >= NIN) {
        const uint4 z = {0u, 0u, 0u, 0u};
        for (int i = tid; i < 64 * K / 8; i += 512) *(uint4*)(dst + (size_t)n0 * K + (size_t)i * 8) = z;
        return;
    }
    const int lr = tid >> 4, lc = (tid & 15) * 4;
    const int sn = tid >> 3, skc = tid & 7;
    const size_t drow = (size_t)tr_dst_row<W>(n0 + sn) * K;
    for (int k0 = 0; k0 < K; k0 += 256) {
        float4 r[8];
#pragma unroll
        for (int i = 0; i < 8; ++i) r[i] = *(const float4*)(src + (size_t)(k0 + lr + 32 * i) * NS + n0 + lc);
#pragma unroll
        for (int i = 0; i < 8; ++i) *(float4*)(tile + (lr + 32 * i) * TS + lc) = r[i];
        __syncthreads();
#pragma unroll
        for (int q = 0; q < 4; ++q) {
            const int kk = skc * 32 + q * 8;
            float v[8];
#pragma unroll
            for (int j = 0; j < 8; ++j) v[j] = tile[(kk + j) * TS + sn] * tr_scale<W>(p, k0 + kk + j);
            uint4 w; w.x = pack2(v[0], v[1]); w.y = pack2(v[2], v[3]); w.z = pack2(v[4], v[5]); w.w = pack2(v[6], v[7]);
            *(uint4*)(dst + drow + k0 + kk) = w;
        }
        __syncthreads();
    }
}
__device__ __forceinline__ void job_keys(const Params& p, int slot) {
    const float* src = ((slot & 1) ? p.keys2 : p.keys1) + (size_t)(slot >> 1) * 16384;
    bf16_t* dst = WS<bf16_t>(p, OFF_KEYS) + (size_t)slot * 16384;
    for (int i = tid_fresh(p.widx); i < 16384; i += 512) dst[i] = f2bf(src[i]);
}
__device__ __forceinline__ void job_rope(const Params& p, int it) {
    float* cosT = WS<float>(p, OFF_COS); float* sinT = WS<float>(p, OFF_SIN);
    for (int j = 0; j < 32; ++j) {
        const int idx = tid_fresh(p.widx) + 512 * j, t = it * 512 + (idx >> 5), i = idx & 31;
        double inv = 1.0;
        for (int q = 0; q < i; ++q) inv *= 0.7498942093324559;
        const double ang = (double)p.pos[t] * inv;
        const double n = rint(ang * 0.15915494309189535);
        const double r = fma(-n, 6.283185307179586, ang) - n * 2.4492935982947064e-16;
        const float rf = (float)r;
        cosT[(size_t)t * 32 + i] = cosf(rf); sinT[(size_t)t * 32 + i] = sinf(rf);
    }
}
template <int EB> __device__ __forceinline__ void job_table(const Params& p, int it);
__device__ __forceinline__ void job_table6(const Params& p, int it);
__device__ __forceinline__ void phase0(const Params& p, int bid, int nblk, float* lds) {
    for (int it = bid; it < J7_END; it += nblk) {
        if (it < J0_END) job_ada(p, it, lds);
        else if (it < J1_END) job_transpose<0>(p, it - J0_END, lds);
        else if (it < J2_END) job_transpose<1>(p, it - J1_END, lds);
        else if (it < J3_END) job_transpose<2>(p, it - J2_END, lds);
        else if (it < J4_END) job_transpose<3>(p, it - J3_END, lds);
        else if (it < J5_END) job_transpose<4>(p, it - J4_END, lds);
        else if (it < J6_END) job_keys(p, it - J5_END);
        else if (it < J7_END) job_rope(p, it - J6_END);
        else if (TAB_EB == 6) job_table6(p, it - J7_END);
        else job_table<TAB_EB == 6 ? 1 : TAB_EB>(p, it - J7_END);
    }
}

__device__ __forceinline__ void phase_norm_mod(const Params& p, const float* src, const float* gain, int sh_idx, int sc_idx, bf16_t* dst, int bid, int nblk, float* lds) {
    const int tid = tid_fresh(p.widx), lane = tid & 63, wid = tid >> 6;
    const float* mod = WS<float>(p, OFF_MOD);
    float* av = lds;
    float* sv = lds + 4096;
    for (int i = tid; i < 4096; i += 512) { const int b = i >> 11, col = i & 2047;
        av[i] = gain[col] * (1.0f + mod[(size_t)b * 12288 + sc_idx * 2048 + col]); sv[i] = mod[(size_t)b * 12288 + sh_idx * 2048 + col]; }
    __syncthreads();
    for (int t = bid * 8 + wid; t < TOK; t += nblk * 8) {
        const int b = t >> 12;
        const float* xr = src + (size_t)t * DM;
        float4 v[8]; float ss = 0.f;
#pragma unroll
        for (int j = 0; j < 8; ++j) { v[j] = *(const float4*)(xr + (j * 64 + lane) * 4); ss += v[j].x * v[j].x + v[j].y * v[j].y + v[j].z * v[j].z + v[j].w * v[j].w; }
        ss = wave_sum(ss);
        const float rstd = rsqrtf(ss * (1.0f / DM) + EPS);
#pragma unroll
        for (int j = 0; j < 8; ++j) {
            const int col = (j * 64 + lane) * 4;
            const float4 a = *(const float4*)(av + b * 2048 + col), s = *(const float4*)(sv + b * 2048 + col);
            uint2 w; w.x = pack2(v[j].x * rstd * a.x + s.x, v[j].y * rstd * a.y + s.y); w.y = pack2(v[j].z * rstd * a.z + s.z, v[j].w * rstd * a.w + s.w);
            *(uint2*)(dst + (size_t)t * DM + col) = w;
        }
    }
    __syncthreads();
}

__device__ __forceinline__ void phase_rowstats(const Params& p, int bid, int nblk) {
    const int tidf = tid_fresh(p.widx), lane = tidf & 63, wid = tidf >> 6;
    const bf16_t* cq = WS<bf16_t>(p, OFF_CQ); const bf16_t* ckv = WS<bf16_t>(p, OFF_CKV);
    for (int t = bid * 8 + wid; t < TOK; t += nblk * 8) {
        const uint4 a = *(const uint4*)(cq + (size_t)t * 512 + lane * 8);
        float s1 = dot8(a, a), s2 = 0.f;
        if (lane < 32) { const uint4 b = *(const uint4*)(ckv + (size_t)t * 256 + lane * 8); s2 = dot8(b, b); }
        s1 = wave_sum(s1); s2 = wave_sum(s2);
        if (lane == 0) { WS<float>(p, OFF_RSQ)[t] = rsqrtf(s1 * (1.0f / 512.0f) + EPS); WS<float>(p, OFF_RSKV)[t] = rsqrtf(s2 * (1.0f / 256.0f) + EPS); }
    }
}

__device__ __forceinline__ void phase_attn_ref(const Params& p, int bid, int nblk) {
    const int tid = tid_fresh(p.widx), ql = tid >> 2, part = tid & 3;
    const bf16_t* qsb = WS<bf16_t>(p, OFF_QSB); const bf16_t* ksb = WS<bf16_t>(p, OFF_KSB); const bf16_t* vsb = WS<bf16_t>(p, OFF_VSB);
    const bf16_t* qml = WS<bf16_t>(p, OFF_QMLA); const bf16_t* kml = WS<bf16_t>(p, OFF_KMLA); const bf16_t* vml = WS<bf16_t>(p, OFF_VMLA);
    bf16_t* O = WS<bf16_t>(p, OFF_O); float* ssq = WS<float>(p, OFF_SSQ);
    for (int it = bid; it < 1024; it += nblk) {
        const int g = it >> 9, rem = it & 511, b = rem >> 8, h = (rem >> 5) & 7, qb = 31 - (rem & 31);
        const int t = qb * 128 + ql; const size_t tok = (size_t)b * SEQ + t;
        const int tmax = qb * 128 + (ql | 15);
        float o[32];
#pragma unroll
        for (int d = 0; d < 32; ++d) o[d] = 0.f;
        if (g == 0) {
            uint4 q[4];
#pragma unroll
            for (int j = 0; j < 4; ++j) q[j] = *(const uint4*)(qsb + tok * 1024 + h * 128 + part * 32 + j * 8);
            float between = 0.f;
            for (int s = tmax - 1; s >= 0; --s) {
                const size_t kt = (size_t)b * SEQ + s;
                float z2 = 0.f;
#pragma unroll
                for (int j = 0; j < 4; ++j) z2 += dot8(q[j], *(const uint4*)(ksb + kt * 1024 + h * 128 + part * 32 + j * 8));
                z2 += __shfl_xor(z2, 1); z2 += __shfl_xor(z2, 2);
                if (s < t) {
                    const float z = z2 * LN2;
                    const float l1p = log1pf(__expf(-fabsf(z)));
                    const float lsig = fminf(z, 0.f) - l1p, lsign = -fmaxf(z, 0.f) - l1p;
                    const float w = __expf(lsig + between);
                    between += lsign;
#pragma unroll
                    for (int j = 0; j < 4; ++j) { const uint4 vv = *(const uint4*)(vsb + kt * 1024 + h * 128 + part * 32 + j * 8);
                        o[j * 8 + 0] += w * lo_f(vv.x); o[j * 8 + 1] += w * hi_f(vv.x); o[j * 8 + 2] += w * lo_f(vv.y); o[j * 8 + 3] += w * hi_f(vv.y);
                        o[j * 8 + 4] += w * lo_f(vv.z); o[j * 8 + 5] += w * hi_f(vv.z); o[j * 8 + 6] += w * lo_f(vv.w); o[j * 8 + 7] += w * hi_f(vv.w); }
                }
            }
        } else {
            uint4 q[6];
#pragma unroll
            for (int j = 0; j < 6; ++j) q[j] = *(const uint4*)(qml + tok * 1536 + h * 192 + part * 48 + j * 8);
            float m = -1e30f, l = 0.f;
            for (int s = 0; s <= tmax; ++s) {
                const size_t kt = (size_t)b * SEQ + s;
                float sc = 0.f;
#pragma unroll
                for (int j = 0; j < 6; ++j) sc += dot8(q[j], *(const uint4*)(kml + kt * 1536 + h * 192 + part * 48 + j * 8));
                sc += __shfl_xor(sc, 1); sc += __shfl_xor(sc, 2);
                if (s <= t) {
                    const float mn = fmaxf(m, sc), alpha = exp2f(m - mn), pw = exp2f(sc - mn);
                    l = l * alpha + pw; m = mn;
#pragma unroll
                    for (int j = 0; j < 4; ++j) { const uint4 vv = *(const uint4*)(vml + kt * 1024 + h * 128 + part * 32 + j * 8);
                        o[j * 8 + 0] = o[j * 8 + 0] * alpha + pw * lo_f(vv.x); o[j * 8 + 1] = o[j * 8 + 1] * alpha + pw * hi_f(vv.x);
                        o[j * 8 + 2] = o[j * 8 + 2] * alpha + pw * lo_f(vv.y); o[j * 8 + 3] = o[j * 8 + 3] * alpha + pw * hi_f(vv.y);
                        o[j * 8 + 4] = o[j * 8 + 4] * alpha + pw * lo_f(vv.z); o[j * 8 + 5] = o[j * 8 + 5] * alpha + pw * hi_f(vv.z);
                        o[j * 8 + 6] = o[j * 8 + 6] * alpha + pw * lo_f(vv.w); o[j * 8 + 7] = o[j * 8 + 7] * alpha + pw * hi_f(vv.w); }
                }
            }
            const float inv = 1.0f / l;
#pragma unroll
            for (int d = 0; d < 32; ++d) o[d] *= inv;
        }
        float ss = 0.f;
#pragma unroll
        for (int d = 0; d < 32; ++d) ss += o[d] * o[d];
        ss += __shfl_xor(ss, 1); ss += __shfl_xor(ss, 2);
        if (part == 0) ssq[tok * 16 + g * 8 + h] = ss;
        bf16_t* op = O + tok * 2048 + g * 1024 + h * 128 + part * 32;
#pragma unroll
        for (int j = 0; j < 4; ++j) { uint4 w; w.x = pack2(o[j * 8], o[j * 8 + 1]); w.y = pack2(o[j * 8 + 2], o[j * 8 + 3]); w.z = pack2(o[j * 8 + 4], o[j * 8 + 5]); w.w = pack2(o[j * 8 + 6], o[j * 8 + 7]);
            *(uint4*)(op + j * 8) = w; }
    }
}


typedef short bf16x8_t __attribute__((ext_vector_type(8)));
typedef short s16x4_t __attribute__((ext_vector_type(4)));
typedef float f32x16_t __attribute__((ext_vector_type(16)));
typedef float f32x2_t __attribute__((ext_vector_type(2)));
typedef unsigned u32x4_t __attribute__((ext_vector_type(4)));
typedef __bf16 bf16x2_t __attribute__((ext_vector_type(2)));
__device__ __forceinline__ unsigned cvt_pk_bf16(float lo, float hi) { f32x2_t v = {lo, hi}; bf16x2_t b = __builtin_convertvector(v, bf16x2_t); return __builtin_bit_cast(unsigned, b); }
__device__ __forceinline__ void swap32(float a, float& lo, float& hi) {
    auto r = __builtin_amdgcn_permlane32_swap(__float_as_uint(a), __float_as_uint(a), false, false);
    lo = __uint_as_float(r[0]); hi = __uint_as_float(r[1]);
}
constexpr int ATT_VSTR = 320;
constexpr int ATT_STAGE_MAX = 64 * (192 * 2 + 16) + 64 * ATT_VSTR;
constexpr int ATT_BC_OFF = 2 * 64 * (192 * 2 + 16) + 3 * 64 * ATT_VSTR;
constexpr int ATT_HEAD_WORD = 3840;

template <int G>
__device__ __forceinline__ void attn_qk(const LAS unsigned char* kbuf, const bf16x8_t (&qf)[G ? 12 : 8], f32x16_t& s0, f32x16_t& s1, unsigned kread) {
    constexpr int DK = G ? 192 : 128, NKS = DK / 16, KSTR = DK * 2 + 16;
#pragma unroll
    for (int r = 0; r < 16; ++r) { s0[r] = 0.f; s1[r] = 0.f; }
    const LAS unsigned char* kp = kbuf + kread;
#pragma unroll
    for (int ks = 0; ks < NKS; ++ks) {
        const bf16x8_t a0 = *(const LAS bf16x8_t*)(kp + ks * 32), a1 = *(const LAS bf16x8_t*)(kp + 32 * KSTR + ks * 32);
        s0 = __builtin_amdgcn_mfma_f32_32x32x16_bf16(a0, qf[ks], s0, 0, 0, 0);
        s1 = __builtin_amdgcn_mfma_f32_32x32x16_bf16(a1, qf[ks], s1, 0, 0, 0);
    }
    __builtin_amdgcn_sched_group_barrier(0x100, 6, 0);
#pragma unroll
    for (int i = 0; i < 2 * NKS - 6; ++i) { __builtin_amdgcn_sched_group_barrier(0x8, 1, 0); __builtin_amdgcn_sched_group_barrier(0x100, 1, 0); }
#pragma unroll
    for (int i = 0; i < 6; ++i) __builtin_amdgcn_sched_group_barrier(0x8, 1, 0);
}
template <int G>
__device__ __forceinline__ void attn_sm(bool need_mask, f32x16_t& s0, f32x16_t& s1, unsigned (&pk)[2][8], f32x16_t (&o)[4], float& st0, float& st1, int lim, int hh) {
    if (need_mask) {
        asm volatile("" ::: "memory");
        const float neg = G ? -INFINITY : -100.0f;
#pragma unroll
        for (int r = 0; r < 16; ++r) { const int kr = (r & 3) + 8 * (r >> 2) + 4 * hh;
            s0[r] = (G ? (kr <= lim) : (kr < lim)) ? s0[r] : neg; s1[r] = (G ? (32 + kr <= lim) : (32 + kr < lim)) ? s1[r] : neg; }
    }
    if (G == 0) {
        float R = st0;
#pragma unroll
        for (int kb = 1; kb >= 0; --kb) {
#pragma unroll
            for (int g = 3; g >= 0; --g) {
                float sg[4], om[4];
#pragma unroll
                for (int rr = 0; rr < 4; ++rr) {
                    const float z2 = kb ? s1[4 * g + rr] : s0[4 * g + rr];
                    const float e = __builtin_amdgcn_exp2f(-z2);
                    const float sig = __builtin_amdgcn_rcpf(1.0f + e);
                    sg[rr] = sig; om[rr] = e * sig;
                }
                const float gown = (om[0] * om[1]) * (om[2] * om[3]);
                float glo, ghi; swap32(gown, glo, ghi);
                const float E = hh ? R : R * ghi;
                const float e2 = E * om[3], e1 = e2 * om[2], e0 = e1 * om[1];
                pk[kb][2 * g] = cvt_pk_bf16(sg[0] * e0, sg[1] * e1); pk[kb][2 * g + 1] = cvt_pk_bf16(sg[2] * e2, sg[3] * E);
                R = R * (glo * ghi);
            }
        }
        st0 = R;
    } else {
        float mx = fmaxf(s0[0], s1[0]);
#pragma unroll
        for (int r = 1; r < 16; ++r) mx = fmaxf(mx, fmaxf(s0[r], s1[r]));
        float mlo, mhi; swap32(mx, mlo, mhi);
        const float mn = fmaxf(st0, fmaxf(mlo, mhi)), alpha = __builtin_amdgcn_exp2f(st0 - mn);
        st0 = mn;
        float ls = 0.f;
#pragma unroll
        for (int g = 0; g < 4; ++g) {
            float a[4], bq[4];
#pragma unroll
            for (int rr = 0; rr < 4; ++rr) { a[rr] = __builtin_amdgcn_exp2f(s0[4 * g + rr] - mn); bq[rr] = __builtin_amdgcn_exp2f(s1[4 * g + rr] - mn); ls += a[rr] + bq[rr]; }
            pk[0][2 * g] = cvt_pk_bf16(a[0], a[1]); pk[0][2 * g + 1] = cvt_pk_bf16(a[2], a[3]);
            pk[1][2 * g] = cvt_pk_bf16(bq[0], bq[1]); pk[1][2 * g + 1] = cvt_pk_bf16(bq[2], bq[3]);
        }
        st1 = st1 * alpha + ls;
        if (__builtin_amdgcn_ballot_w64(alpha != 1.0f) != 0ull) {
#pragma unroll
            for (int d = 0; d < 4; ++d) o[d] = o[d] * alpha;
        }
    }
}
__device__ __forceinline__ void attn_pv(const LAS unsigned char* vbuf, const unsigned (&pk)[2][8], f32x16_t (&o)[4], unsigned vread) {
    constexpr int VSTR = ATT_VSTR;
    const LAS unsigned char* vp = vbuf + vread;
#pragma unroll
    for (int kb = 0; kb < 2; ++kb)
#pragma unroll
        for (int s = 0; s < 2; ++s) {
            bf16x8_t pf;
            { const unsigned w0 = pk[kb][4 * s], w1 = pk[kb][4 * s + 1], w2 = pk[kb][4 * s + 2], w3 = pk[kb][4 * s + 3];
              pf[0] = (short)(w0 & 0xffff); pf[1] = (short)(w0 >> 16); pf[2] = (short)(w1 & 0xffff); pf[3] = (short)(w1 >> 16);
              pf[4] = (short)(w2 & 0xffff); pf[5] = (short)(w2 >> 16); pf[6] = (short)(w3 & 0xffff); pf[7] = (short)(w3 >> 16); }
#pragma unroll
            for (int d = 0; d < 4; ++d) {
                const LAS unsigned char* vq = vp + (32 * kb + 16 * s) * VSTR + d * 64;
                const s16x4_t lo = __builtin_amdgcn_ds_read_tr16_b64_v4i16((LAS s16x4_t*)(vq));
                const s16x4_t hi = __builtin_amdgcn_ds_read_tr16_b64_v4i16((LAS s16x4_t*)(vq + 8 * VSTR));
                const bf16x8_t vf = {lo[0], lo[1], lo[2], lo[3], hi[0], hi[1], hi[2], hi[3]};
                o[d] = __builtin_amdgcn_mfma_f32_32x32x16_bf16(vf, pf, o[d], 0, 0, 0);
            }
        }
    __builtin_amdgcn_sched_group_barrier(0x100, 6, 0);
#pragma unroll
    for (int i = 0; i < 13; ++i) { __builtin_amdgcn_sched_group_barrier(0x8, 1, 0); __builtin_amdgcn_sched_group_barrier(0x100, 2, 0); }
#pragma unroll
    for (int i = 0; i < 3; ++i) __builtin_amdgcn_sched_group_barrier(0x8, 1, 0);
}

__device__ __forceinline__ void sb_half_math(const f32x16_t& s, unsigned (&pkh)[8], float& R, int hh) {
#pragma unroll
    for (int g = 3; g >= 0; --g) {
        float sg[4], om[4];
#pragma unroll
        for (int rr = 0; rr < 4; ++rr) { const float e = __builtin_amdgcn_exp2f(fminf(-s[4 * g + rr], 120.0f)); const float sig = __builtin_amdgcn_rcpf(1.0f + e); sg[rr] = sig; om[rr] = e * sig; }
        const float gown = (om[0] * om[1]) * (om[2] * om[3]);
        float glo, ghi; swap32(gown, glo, ghi);
        const float E = hh ? R : R * ghi;
        const float e2 = E * om[3], e1 = e2 * om[2], e0 = e1 * om[1];
        pkh[2 * g] = cvt_pk_bf16(sg[0] * e0, sg[1] * e1); pkh[2 * g + 1] = cvt_pk_bf16(sg[2] * e2, sg[3] * E);
        R = R * (glo * ghi);
    }
}
__device__ __forceinline__ void pv_half(const LAS unsigned char* vp, int kb, const unsigned (&pkh)[8], f32x16_t (&o)[4]) {
    constexpr int VSTR = ATT_VSTR;
#pragma unroll
    for (int s = 0; s < 2; ++s) {
        bf16x8_t pf;
        { const unsigned w0 = pkh[4 * s], w1 = pkh[4 * s + 1], w2 = pkh[4 * s + 2], w3 = pkh[4 * s + 3];
          pf[0] = (short)(w0 & 0xffff); pf[1] = (short)(w0 >> 16); pf[2] = (short)(w1 & 0xffff); pf[3] = (short)(w1 >> 16);
          pf[4] = (short)(w2 & 0xffff); pf[5] = (short)(w2 >> 16); pf[6] = (short)(w3 & 0xffff); pf[7] = (short)(w3 >> 16); }
#pragma unroll
        for (int d = 0; d < 4; ++d) {
            const LAS unsigned char* vq = vp + (32 * kb + 16 * s) * VSTR + d * 64;
            const s16x4_t lo = __builtin_amdgcn_ds_read_tr16_b64_v4i16((LAS s16x4_t*)(vq));
            const s16x4_t hi = __builtin_amdgcn_ds_read_tr16_b64_v4i16((LAS s16x4_t*)(vq + 8 * VSTR));
            const bf16x8_t vf = {lo[0], lo[1], lo[2], lo[3], hi[0], hi[1], hi[2], hi[3]};
            o[d] = __builtin_amdgcn_mfma_f32_32x32x16_bf16(vf, pf, o[d], 0, 0, 0);
        }
    }
}
__device__ __forceinline__ void attn_tile_sb(bool need_mask, const LAS unsigned char* base, const bf16x8_t (&qf)[8], f32x16_t (&o)[4], float& st0, int lim, unsigned kread, unsigned vread, int hh) {
    constexpr int KSTR = 128 * 2 + 16;
    const LAS unsigned char* kp = base + kread;
    f32x16_t s0, s1;
#pragma unroll
    for (int r = 0; r < 16; ++r) { s0[r] = 0.f; s1[r] = 0.f; }
#pragma unroll
    for (int ks = 0; ks < 8; ++ks) s1 = __builtin_amdgcn_mfma_f32_32x32x16_bf16(*(const LAS bf16x8_t*)(kp + 32 * KSTR + ks * 32), qf[ks], s1, 0, 0, 0);
#pragma unroll
    for (int ks = 0; ks < 8; ++ks) s0 = __builtin_amdgcn_mfma_f32_32x32x16_bf16(*(const LAS bf16x8_t*)(kp + ks * 32), qf[ks], s0, 0, 0, 0);
    if (need_mask) {
        asm volatile("" ::: "memory");
#pragma unroll
        for (int r = 0; r < 16; ++r) { const int kr = (r & 3) + 8 * (r >> 2) + 4 * hh; s0[r] = (kr < lim) ? s0[r] : -100.0f; s1[r] = (32 + kr < lim) ? s1[r] : -100.0f; }
    }
    unsigned pk1[8], pk0[8]; float R = st0;
    sb_half_math(s1, pk1, R, hh);
    pv_half(base + vread, 1, pk1, o);
    sb_half_math(s0, pk0, R, hh);
    pv_half(base + vread, 0, pk0, o);
    st0 = R;
}

__device__ __forceinline__ void attn_tile_mla(bool need_mask, const LAS unsigned char* base, const bf16x8_t (&qf)[12], f32x16_t (&o)[4], float& st0, float& st1, int lim, unsigned kread, unsigned vread, int hh) {
    f32x16_t s0, s1;
    attn_qk<1>(base, qf, s0, s1, kread);
    if (need_mask) {
        asm volatile("" ::: "memory");
#pragma unroll
        for (int r = 0; r < 16; ++r) { const int kr = (r & 3) + 8 * (r >> 2) + 4 * hh; s0[r] = (kr <= lim) ? s0[r] : -INFINITY; s1[r] = (32 + kr <= lim) ? s1[r] : -INFINITY; }
    }
    float mx = fmaxf(s0[0], s1[0]);
#pragma unroll
    for (int r = 1; r < 16; ++r) mx = fmaxf(mx, fmaxf(s0[r], s1[r]));
    float mlo, mhi; swap32(mx, mlo, mhi);
    const float mn = fmaxf(st0, fmaxf(mlo, mhi)), alpha = __builtin_amdgcn_exp2f(st0 - mn);
    st0 = mn;
    if (__builtin_amdgcn_ballot_w64(alpha != 1.0f) != 0ull) {
#pragma unroll
        for (int d = 0; d < 4; ++d) o[d] = o[d] * alpha;
    }
    unsigned pk1[8], pk0[8]; float ls = 0.f;
#pragma unroll
    for (int g = 0; g < 4; ++g) { float a[4];
#pragma unroll
        for (int rr = 0; rr < 4; ++rr) { a[rr] = __builtin_amdgcn_exp2f(s1[4 * g + rr] - mn); ls += a[rr]; }
        pk1[2 * g] = cvt_pk_bf16(a[0], a[1]); pk1[2 * g + 1] = cvt_pk_bf16(a[2], a[3]); }
    pv_half(base + vread, 1, pk1, o);
#pragma unroll
    for (int g = 0; g < 4; ++g) { float a[4];
#pragma unroll
        for (int rr = 0; rr < 4; ++rr) { a[rr] = __builtin_amdgcn_exp2f(s0[4 * g + rr] - mn); ls += a[rr]; }
        pk0[2 * g] = cvt_pk_bf16(a[0], a[1]); pk0[2 * g + 1] = cvt_pk_bf16(a[2], a[3]); }
    pv_half(base + vread, 0, pk0, o);
    st1 = st1 * alpha + ls;
}
template <int G>
__device__ __forceinline__ void attn_tile(bool need_mask, const LAS unsigned char* base, const bf16x8_t (&qf)[G ? 12 : 8], f32x16_t (&o)[4], float& st0, float& st1, int lim, unsigned kread, unsigned vread, int hh) {
    f32x16_t s0, s1; unsigned pk[2][8];
    attn_qk<G>(base, qf, s0, s1, kread);
    attn_sm<G>(need_mask, s0, s1, pk, o, st0, st1, lim, hh);
    attn_pv(base, pk, o, vread);
}
template <int G>
__device__ __forceinline__ void attn_unit2(const Params& p, int b, int h, int qb, LAS unsigned char* lds, int tid_in) {
    int tid = tid_in; asm volatile("" : "+v"(tid));
    constexpr int DK = G ? 192 : 128, NKS = DK / 16, KCH = DK / 8, KSTR = DK * 2 + 16, VSTR = ATT_VSTR;
    constexpr int KTILE = 64 * KSTR, VTILE = 64 * VSTR, NKL = KCH * 64 / 512, QP = G ? 1536 : 1024;
    const int lane = tid & 63, wid = __builtin_amdgcn_readfirstlane(tid >> 6), c = lane & 31, hh = lane >> 5, H = wid >> 2;
    const bf16_t* Qg = WS<bf16_t>(p, G ? OFF_QMLA : OFF_QSB); const bf16_t* Kg = WS<bf16_t>(p, G ? OFF_KMLA : OFF_KSB); const bf16_t* Vg = WS<bf16_t>(p, G ? OFF_VMLA : OFF_VSB);
    const size_t tok0 = (size_t)b * SEQ;
    const int trow = qb * 256 + wid * 32 + c;
    bf16x8_t qf[NKS];
    { const bf16_t* qp = Qg + (tok0 + trow) * QP + h * DK + hh * 8;
#pragma unroll
      for (int ks = 0; ks < NKS; ++ks) qf[ks] = *(const bf16x8_t*)(qp + ks * 16); }
    f32x16_t o[4];
#pragma unroll
    for (int d = 0; d < 4; ++d)
#pragma unroll
        for (int r = 0; r < 16; ++r) o[d][r] = 0.f;
    float st0 = G ? -1e30f : 1.0f, st1 = 0.f;
    const int srow = tid >> 3, sch = tid & 7;
    const bf16_t* Kb = Kg + tok0 * QP + (size_t)srow * QP + h * DK + sch * 8; const bf16_t* Vb = Vg + tok0 * 1024 + (size_t)srow * 1024 + h * 128 + sch * 8;
    const unsigned klds0 = (unsigned)(srow * KSTR + sch * 16), vlds0 = (unsigned)(2 * KTILE + srow * VSTR + sch * 16);
    const unsigned kread = (unsigned)(c * KSTR + hh * 16);
    const unsigned vread = (unsigned)(2 * KTILE + (4 * hh + ((lane & 15) >> 2)) * VSTR + (16 * ((lane >> 4) & 1) + 4 * (lane & 3)) * 2);
    const int jmax = 4 * qb + 3, T = jmax + 1, wb = wid >> 1;
    u32x4_t kreg[NKL], vreg[2];
#pragma unroll
    for (int i = 0; i < NKL; ++i) kreg[i] = *(const u32x4_t*)(Kb + (size_t)jmax * 64 * QP + i * 64);
#pragma unroll
    for (int i = 0; i < NKL; ++i) *(LAS u32x4_t*)(lds + klds0 + i * 128) = kreg[i];
#pragma unroll
    for (int i = 0; i < NKL; ++i) kreg[i] = *(const u32x4_t*)(Kb + (size_t)(jmax - 1) * 64 * QP + i * 64);
#pragma unroll
    for (int i = 0; i < 2; ++i) vreg[i] = *(const u32x4_t*)(Vb + (size_t)jmax * 64 * 1024 + i * 64);
    __syncthreads();
    f32x16_t s0, s1; unsigned pk[2][8];
#pragma unroll
    for (int r = 0; r < 16; ++r) { s0[r] = 0.f; s1[r] = 0.f; }
#pragma unroll
    for (int i = 0; i < 8; ++i) { pk[0][i] = 0u; pk[1][i] = 0u; }
#pragma unroll 1
    for (int slot = 0; slot < 2 * T + 2; ++slot) {
        if ((slot & 1) == 0) {
            const int s = slot >> 1;
            if (s + 1 < T) {
#pragma unroll
                for (int i = 0; i < NKL; ++i) *(LAS u32x4_t*)(lds + ((s + 1) & 1) * KTILE + klds0 + i * 128) = kreg[i];
            }
            if (s < T) {
#pragma unroll
                for (int i = 0; i < 2; ++i) *(LAS u32x4_t*)(lds + (s & 1) * VTILE + vlds0 + i * 128) = vreg[i];
            }
            if (s + 2 < T) {
#pragma unroll
                for (int i = 0; i < NKL; ++i) kreg[i] = *(const u32x4_t*)(Kb + (size_t)(jmax - s - 2) * 64 * QP + i * 64);
            }
            if (s + 1 < T) {
#pragma unroll
                for (int i = 0; i < 2; ++i) vreg[i] = *(const u32x4_t*)(Vb + (size_t)(jmax - s - 1) * 64 * 1024 + i * 64);
            }
        }
        if ((slot & 1) == H) {
            const int sm = (slot - H) >> 1;
            if (sm >= 1) { const int sp = sm - 1, jb = (jmax - sp) - 4 * qb; if (jb <= wb) attn_pv(lds + (sp & 1) * VTILE, pk, o, vread); }
            if (sm < T) { const int jb = (jmax - sm) - 4 * qb; if (jb <= wb) attn_qk<G>(lds + (sm & 1) * KTILE, qf, s0, s1, kread); }
        } else if (slot >= 1 + H) {
            const int sv = (slot - 1 - H) >> 1;
            if (sv < T) { const int j = jmax - sv, jb = j - 4 * qb; if (jb <= wb) attn_sm<G>(jb == wb, s0, s1, pk, o, st0, st1, trow - 64 * j, hh); }
        }
        __syncthreads();
    }
    if (G == 1) { float llo, lhi; swap32(st1, llo, lhi); const float inv = 1.0f / (llo + lhi);
#pragma unroll
        for (int d = 0; d < 4; ++d) o[d] = o[d] * inv; }
    float ss = 0.f;
    bf16_t* op = WS<bf16_t>(p, OFF_O) + (tok0 + trow) * 2048 + G * 1024 + h * 128 + 4 * hh;
#pragma unroll
    for (int d = 0; d < 4; ++d)
#pragma unroll
        for (int g = 0; g < 4; ++g) {
            const float v0 = o[d][4 * g], v1 = o[d][4 * g + 1], v2 = o[d][4 * g + 2], v3 = o[d][4 * g + 3];
            ss += v0 * v0 + v1 * v1 + v2 * v2 + v3 * v3;
            uint2 w; w.x = cvt_pk_bf16(v0, v1); w.y = cvt_pk_bf16(v2, v3);
            *(uint2*)(op + 32 * d + 8 * g) = w;
        }
    float slo, shi; swap32(ss, slo, shi);
    if (hh == 0) WS<float>(p, OFF_SSQ)[(tok0 + trow) * 16 + G * 8 + h] = slo + shi;
}

template <int G>
__device__ __forceinline__ void attn_unit(const Params& p, int b, int h, int qb, LAS unsigned char* lds, int tid_in) {
    int tid = tid_in; asm volatile("" : "+v"(tid));
    constexpr int DK = G ? 192 : 128, NKS = DK / 16, KCH = DK / 8, KSTR = DK * 2 + 16, VSTR = ATT_VSTR;
    constexpr int KTILE = 64 * KSTR, VTILE = 64 * VSTR, STAGE = KTILE + VTILE, NKL = KCH * 64 / 512, QP = G ? 1536 : 1024;
    const int lane = tid & 63, wid = __builtin_amdgcn_readfirstlane(tid >> 6), c = lane & 31, hh = lane >> 5;
    const bf16_t* Qg = WS<bf16_t>(p, G ? OFF_QMLA : OFF_QSB); const bf16_t* Kg = WS<bf16_t>(p, G ? OFF_KMLA : OFF_KSB); const bf16_t* Vg = WS<bf16_t>(p, G ? OFF_VMLA : OFF_VSB);
    const size_t tok0 = (size_t)b * SEQ;
    const int trow = qb * 256 + wid * 32 + c;
    bf16x8_t qf[NKS];
    { const bf16_t* qp = Qg + (tok0 + trow) * QP + h * DK + hh * 8;
#pragma unroll
      for (int ks = 0; ks < NKS; ++ks) qf[ks] = *(const bf16x8_t*)(qp + ks * 16); }
    f32x16_t o[4];
#pragma unroll
    for (int d = 0; d < 4; ++d)
#pragma unroll
        for (int r = 0; r < 16; ++r) o[d][r] = 0.f;
    float st0 = G ? -1e30f : 1.0f, st1 = 0.f;
    const int srow = tid >> 3, sch = tid & 7;
    const bf16_t* Kb = Kg + tok0 * QP + (size_t)srow * QP + h * DK + sch * 8; const bf16_t* Vb = Vg + tok0 * 1024 + (size_t)srow * 1024 + h * 128 + sch * 8;
    const unsigned klds0 = (unsigned)(srow * KSTR + sch * 16), vlds0 = (unsigned)(KTILE + srow * VSTR + sch * 16);
    u32x4_t kreg[NKL], vreg[2];
    const int jmax = 4 * qb + 3;
#pragma unroll
    for (int i = 0; i < NKL; ++i) kreg[i] = *(const u32x4_t*)(Kb + (size_t)jmax * 64 * QP + i * 64);
#pragma unroll
    for (int i = 0; i < 2; ++i) vreg[i] = *(const u32x4_t*)(Vb + (size_t)jmax * 64 * 1024 + i * 64);
    const unsigned kread = (unsigned)(c * KSTR + hh * 16);
    const unsigned vread = (unsigned)(KTILE + (4 * hh + ((lane & 15) >> 2)) * VSTR + (16 * ((lane >> 4) & 1) + 4 * (lane & 3)) * 2);
    LAS unsigned* aflag = (LAS unsigned*)(lds + ATT_BC_OFF + 16);
    if (G == 0) { if (tid < 3) aflag[tid] = 0u; }
    int f_cur = 0, f_prev = 2, f_next = 1;
    for (int j = jmax; j >= 0; --j) {
        LAS unsigned char* base = lds + ((jmax - j) & 1) * STAGE;
#pragma unroll
        for (int i = 0; i < NKL; ++i) *(LAS u32x4_t*)(base + klds0 + i * 128) = kreg[i];
#pragma unroll
        for (int i = 0; i < 2; ++i) *(LAS u32x4_t*)(base + vlds0 + i * 128) = vreg[i];
        __syncthreads();
        if (G == 0) {
            if (j < jmax) { const unsigned alive = (unsigned)__builtin_amdgcn_readfirstlane((int)aflag[f_prev]); if (alive == 0u) break; }
            if (tid == 0) aflag[f_next] = 0u;
        }
        if (j > 0) {
#pragma unroll
            for (int i = 0; i < NKL; ++i) kreg[i] = *(const u32x4_t*)(Kb + (size_t)(j - 1) * 64 * QP + i * 64);
#pragma unroll
            for (int i = 0; i < 2; ++i) vreg[i] = *(const u32x4_t*)(Vb + (size_t)(j - 1) * 64 * 1024 + i * 64);
        }
        const int jb = j - 4 * qb;
        if (jb <= (wid >> 1)) {
            const bool need_mask = (jb == (wid >> 1));
            const int lim = trow - 64 * j;
            if constexpr (G == 0) attn_tile_sb(need_mask, base, qf, o, st0, lim, kread, vread, hh); else attn_tile_mla(need_mask, base, qf, o, st0, st1, lim, kread, vread, hh);
        }
        if (G == 0) {
            if (__builtin_amdgcn_ballot_w64(st0 >= 9.094947e-13f) != 0ull) { if (lane == 0) aflag[f_cur] = 1u; }
            const int t_ = f_prev; f_prev = f_cur; f_cur = f_next; f_next = t_;
        }
    }
    if (G == 1) { float llo, lhi; swap32(st1, llo, lhi); const float inv = 1.0f / (llo + lhi);
#pragma unroll
        for (int d = 0; d < 4; ++d) o[d] = o[d] * inv; }
    float ss = 0.f;
    bf16_t* op = WS<bf16_t>(p, OFF_O) + (tok0 + trow) * 2048 + G * 1024 + h * 128 + 4 * hh;
#pragma unroll
    for (int d = 0; d < 4; ++d)
#pragma unroll
        for (int g = 0; g < 4; ++g) {
            const float v0 = o[d][4 * g], v1 = o[d][4 * g + 1], v2 = o[d][4 * g + 2], v3 = o[d][4 * g + 3];
            ss += v0 * v0 + v1 * v1 + v2 * v2 + v3 * v3;
            uint2 w; w.x = cvt_pk_bf16(v0, v1); w.y = cvt_pk_bf16(v2, v3);
            *(uint2*)(op + 32 * d + 8 * g) = w;
        }
    float slo, shi; swap32(ss, slo, shi);
    if (hh == 0) WS<float>(p, OFF_SSQ)[(tok0 + trow) * 16 + G * 8 + h] = slo + shi;
    __syncthreads();
}


template <int G, int NKL>
__device__ __forceinline__ void att3_step(int s, int T, int jmax, int s_first, int trow, int hh, LAS unsigned char* lds, int& vslot,
        u32x4_t (&kreg)[NKL], u32x4_t (&vreg)[2], const bf16_t* Kb, const bf16_t* Vb, unsigned klds0, unsigned vlds0, unsigned kread, unsigned vread,
        const bf16x8_t (&qf)[G ? 12 : 8], f32x16_t (&o)[4], float& st0, float& st1, f32x16_t& n0, f32x16_t& n1, f32x16_t& p0, f32x16_t& p1, unsigned (&pk)[2][8]) {
    constexpr int DK = G ? 192 : 128, KSTR = DK * 2 + 16, KTILE = 64 * KSTR, VTILE = 64 * ATT_VSTR, QP = G ? 1536 : 1024;
#pragma unroll
    for (int i = 0; i < NKL; ++i) *(LAS u32x4_t*)(lds + (s & 1) * KTILE + klds0 + i * 128) = kreg[i];
#pragma unroll
    for (int i = 0; i < 2; ++i) *(LAS u32x4_t*)(lds + vslot * VTILE + vlds0 + i * 128) = vreg[i];
    __syncthreads();
    if (s + 1 < T) {
#pragma unroll
        for (int i = 0; i < NKL; ++i) kreg[i] = *(const u32x4_t*)(Kb + (size_t)(jmax - s - 1) * 64 * QP + i * 64);
#pragma unroll
        for (int i = 0; i < 2; ++i) vreg[i] = *(const u32x4_t*)(Vb + (size_t)(jmax - s - 1) * 64 * 1024 + i * 64);
    }
    const int vprev = vslot == 0 ? 2 : vslot - 1;
    if (s > s_first + 1) {
        attn_qk<G>(lds + (s & 1) * KTILE, qf, n0, n1, kread);
        attn_sm<G>(false, p0, p1, pk, o, st0, st1, 0, hh);
        attn_pv(lds + vprev * VTILE, pk, o, vread);
    } else {
        if (s >= s_first) attn_qk<G>(lds + (s & 1) * KTILE, qf, n0, n1, kread);
        if (s - 1 >= s_first) { attn_sm<G>(s - 1 == s_first, p0, p1, pk, o, st0, st1, trow - 64 * (jmax - s + 1), hh); attn_pv(lds + vprev * VTILE, pk, o, vread); }
    }
    vslot = vslot == 2 ? 0 : vslot + 1;
}
template <int G>
__device__ __forceinline__ void attn_unit3(const Params& p, int b, int h, int qb, LAS unsigned char* lds, int tid_in) {
    int tid = tid_in; asm volatile("" : "+v"(tid));
    constexpr int DK = G ? 192 : 128, NKS = DK / 16, KCH = DK / 8, KSTR = DK * 2 + 16, VSTR = ATT_VSTR;
    constexpr int KTILE = 64 * KSTR, VTILE = 64 * VSTR, NKL = KCH * 64 / 512, QP = G ? 1536 : 1024;
    const int lane = tid & 63, wid = __builtin_amdgcn_readfirstlane(tid >> 6), c = lane & 31, hh = lane >> 5;
    const bf16_t* Qg = WS<bf16_t>(p, G ? OFF_QMLA : OFF_QSB); const bf16_t* Kg = WS<bf16_t>(p, G ? OFF_KMLA : OFF_KSB); const bf16_t* Vg = WS<bf16_t>(p, G ? OFF_VMLA : OFF_VSB);
    const size_t tok0 = (size_t)b * SEQ;
    const int trow = qb * 256 + wid * 32 + c;
    bf16x8_t qf[NKS];
    { const bf16_t* qp = Qg + (tok0 + trow) * QP + h * DK + hh * 8;
#pragma unroll
      for (int ks = 0; ks < NKS; ++ks) qf[ks] = *(const bf16x8_t*)(qp + ks * 16); }
    f32x16_t o[4];
#pragma unroll
    for (int d = 0; d < 4; ++d)
#pragma unroll
        for (int r = 0; r < 16; ++r) o[d][r] = 0.f;
    float st0 = G ? -1e30f : 1.0f, st1 = 0.f;
    const int srow = tid >> 3, sch = tid & 7;
    const bf16_t* Kb = Kg + tok0 * QP + (size_t)srow * QP + h * DK + sch * 8; const bf16_t* Vb = Vg + tok0 * 1024 + (size_t)srow * 1024 + h * 128 + sch * 8;
    const unsigned klds0 = (unsigned)(srow * KSTR + sch * 16), vlds0 = (unsigned)(2 * KTILE + srow * VSTR + sch * 16);
    const unsigned kread = (unsigned)(c * KSTR + hh * 16);
    const unsigned vread = (unsigned)(2 * KTILE + (4 * hh + ((lane & 15) >> 2)) * VSTR + (16 * ((lane >> 4) & 1) + 4 * (lane & 3)) * 2);
    const int jmax = 4 * qb + 3, T = jmax + 1, s_first = 3 - (wid >> 1);
    u32x4_t kreg[NKL], vreg[2];
#pragma unroll
    for (int i = 0; i < NKL; ++i) kreg[i] = *(const u32x4_t*)(Kb + (size_t)jmax * 64 * QP + i * 64);
#pragma unroll
    for (int i = 0; i < 2; ++i) vreg[i] = *(const u32x4_t*)(Vb + (size_t)jmax * 64 * 1024 + i * 64);
    f32x16_t sa0, sa1, sb0, sb1; unsigned pk[2][8];
#pragma unroll
    for (int r = 0; r < 16; ++r) { sa0[r] = 0.f; sa1[r] = 0.f; sb0[r] = 0.f; sb1[r] = 0.f; }
    int vslot = 0;
#pragma unroll 1
    for (int s = 0; s < T; s += 2) {
        att3_step<G, NKL>(s, T, jmax, s_first, trow, hh, lds, vslot, kreg, vreg, Kb, Vb, klds0, vlds0, kread, vread, qf, o, st0, st1, sa0, sa1, sb0, sb1, pk);
        att3_step<G, NKL>(s + 1, T, jmax, s_first, trow, hh, lds, vslot, kreg, vreg, Kb, Vb, klds0, vlds0, kread, vread, qf, o, st0, st1, sb0, sb1, sa0, sa1, pk);
    }
    { const int vprev = vslot == 0 ? 2 : vslot - 1;
      attn_sm<G>(T - 1 == s_first, sb0, sb1, pk, o, st0, st1, trow, hh);
      attn_pv(lds + vprev * VTILE, pk, o, vread); }
    if (G == 1) { float llo, lhi; swap32(st1, llo, lhi); const float inv = 1.0f / (llo + lhi);
#pragma unroll
        for (int d = 0; d < 4; ++d) o[d] = o[d] * inv; }
    float ss = 0.f;
    bf16_t* op = WS<bf16_t>(p, OFF_O) + (tok0 + trow) * 2048 + G * 1024 + h * 128 + 4 * hh;
#pragma unroll
    for (int d = 0; d < 4; ++d)
#pragma unroll
        for (int g = 0; g < 4; ++g) {
            const float v0 = o[d][4 * g], v1 = o[d][4 * g + 1], v2 = o[d][4 * g + 2], v3 = o[d][4 * g + 3];
            ss += v0 * v0 + v1 * v1 + v2 * v2 + v3 * v3;
            uint2 w; w.x = cvt_pk_bf16(v0, v1); w.y = cvt_pk_bf16(v2, v3);
            *(uint2*)(op + 32 * d + 8 * g) = w;
        }
    float slo, shi; swap32(ss, slo, shi);
    if (hh == 0) WS<float>(p, OFF_SSQ)[(tok0 + trow) * 16 + G * 8 + h] = slo + shi;
    __syncthreads();
}

__device__ __forceinline__ void phase_attn_mfma(const Params& p, float* ldsf, int headw = 0) {
    LAS unsigned char* lds = (LAS unsigned char*)ldsf;
    unsigned* head = WS<unsigned>(p, OFF_BAR) + ATT_HEAD_WORD + 64 * headw;
    for (;;) {
        const int tid = tid_fresh(p.widx);
        LAS unsigned* bc = (LAS unsigned*)(lds + ATT_BC_OFF);
        if (tid == 0) *bc = __hip_atomic_fetch_add(head, 1u, __ATOMIC_RELAXED, __HIP_MEMORY_SCOPE_AGENT);
        __syncthreads();
        const unsigned u = (unsigned)__builtin_amdgcn_readfirstlane((int)*bc);
        __syncthreads();
        if (u >= 1536u) break;
        const unsigned u3 = u / 3u, um = u - 3u * u3;
        if (headw != 0 && (um != 0u || (int)(u3 & 1u) != (PROBE_ATTN_G))) continue;
        if (um != 0u) { if (TAB_EB == 6) job_table6(p, (int)(2u * u3 + um - 1u)); else job_table<TAB_EB == 6 ? 1 : TAB_EB>(p, (int)(2u * u3 + um - 1u)); continue; }
        const int qb = 15 - (int)(u3 >> 5), rest = (int)(u3 & 31u), g = rest & 1, b = (rest >> 1) & 1, h = rest >> 2;
#if ATT_ANTIPHASE
        if (g == 0) attn_unit<0>(p, b, h, qb, lds, tid); else attn_unit<1>(p, b, h, qb, lds, tid);
#else
        if (g == 0) attn_unit<0>(p, b, h, qb, lds, tid); else attn_unit<1>(p, b, h, qb, lds, tid);
#endif
    }
}

__device__ __forceinline__ void phase_onorm(const Params& p, int bid, int nblk) {
    const int tidf = tid_fresh(p.widx), lane = tidf & 63, wid = tidf >> 6;
    bf16_t* O = WS<bf16_t>(p, OFF_O); const float* ssq = WS<float>(p, OFF_SSQ);
    for (int t = bid * 8 + wid; t < TOK; t += nblk * 8) {
        float s0 = 0.f, s1 = 0.f;
#pragma unroll
        for (int h = 0; h < 8; ++h) { s0 += ssq[(size_t)t * 16 + h]; s1 += ssq[(size_t)t * 16 + 8 + h]; }
        const float r0 = rsqrtf(s0 * (1.0f / 1024.0f) + EPS), r1 = rsqrtf(s1 * (1.0f / 1024.0f) + EPS);
#pragma unroll
        for (int j = 0; j < 4; ++j) {
            const int off = (j * 64 + lane) * 8; const float r = off < 1024 ? r0 : r1;
            uint4 v = *(uint4*)(O + (size_t)t * 2048 + off);
            v.x = pack2(lo_f(v.x) * r, hi_f(v.x) * r); v.y = pack2(lo_f(v.y) * r, hi_f(v.y) * r); v.z = pack2(lo_f(v.z) * r, hi_f(v.z) * r); v.w = pack2(lo_f(v.w) * r, hi_f(v.w) * r);
            *(uint4*)(O + (size_t)t * 2048 + off) = v;
        }
    }
}

__device__ __forceinline__ void wave_argmax(float& v, int& i) {
#pragma unroll
    for (int o = 32; o > 0; o >>= 1) { const float ov = __shfl_xor(v, o); const int oi = __shfl_xor(i, o); if (ov > v || (ov == v && oi < i)) { v = ov; i = oi; } }
}
__device__ __forceinline__ void phase_route_ref(const Params& p, int bid, int nblk) {
    const int tidf = tid_fresh(p.widx), lane = tidf & 63, wid = tidf >> 6;
    const bf16_t* qp = WS<bf16_t>(p, OFF_QP); const bf16_t* keys = WS<bf16_t>(p, OFF_KEYS);
    int* ridx = WS<int>(p, OFF_RIDX); float* rgate = WS<float>(p, OFF_RGATE);
    for (int it = bid * 8 + wid; it < TOK * 8; it += nblk * 8) {
        const int t = it >> 3, h = it & 7;
        float tv[2]; int ti[2];
#pragma unroll
        for (int half = 0; half < 2; ++half) {
            const bf16_t* q = qp + (size_t)t * 2048 + h * 256 + half * 128;
            const bf16_t* kb = keys + (size_t)(h * 2 + half) * 16384;
            float s0 = 0.f, s1 = 0.f;
            for (int d = 0; d < 128; d += 8) { const uint4 qv = *(const uint4*)(q + d);
                s0 += dot8(qv, *(const uint4*)(kb + (size_t)lane * 128 + d)); s1 += dot8(qv, *(const uint4*)(kb + (size_t)(lane + 64) * 128 + d)); }
            float mv = 0.f; int mi = 0;
            for (int r = 0; r < 16; ++r) {
                float v; int i;
                if (s0 >= s1) { v = s0; i = lane; } else { v = s1; i = lane + 64; }
                wave_argmax(v, i);
                if (i == lane) s0 = -INFINITY;
                if (i == lane + 64) s1 = -INFINITY;
                if (lane == r) { mv = v; mi = i; }
            }
            tv[half] = mv; ti[half] = mi;
        }
        float cv[4];
#pragma unroll
        for (int j = 0; j < 4; ++j) { const int c = lane * 4 + j; cv[j] = __shfl(tv[0], c >> 4) + __shfl(tv[1], c & 15); }
        float bv = 0.f; int bc = 0;
        for (int r = 0; r < 16; ++r) {
            float v = cv[0]; int i = lane * 4;
#pragma unroll
            for (int j = 1; j < 4; ++j) if (cv[j] > v) { v = cv[j]; i = lane * 4 + j; }
            wave_argmax(v, i);
#pragma unroll
            for (int j = 0; j < 4; ++j) if (i == lane * 4 + j) cv[j] = -INFINITY;
            if (lane == r) { bv = v; bc = i; }
        }
        const float mx = __shfl(bv, 0);
        float e = lane < 16 ? __expf(bv - mx) : 0.f;
        const float sum = wave_sum(e);
        const int i1 = __shfl(ti[0], bc >> 4), i2 = __shfl(ti[1], bc & 15);
        if (lane < 16) { ridx[(size_t)t * 128 + h * 16 + lane] = i1 * 128 + i2; rgate[(size_t)t * 128 + h * 16 + lane] = e / sum; }
    }
}


__device__ __forceinline__ unsigned f2key(float f) { const unsigned u = __float_as_uint(f); return (u & 0x80000000u) ? ~u : (u | 0x80000000u); }
__device__ __forceinline__ float key2f(unsigned k) { return __uint_as_float((k & 0x80000000u) ? (k & 0x7fffffffu) : ~k); }
#define RT_CE(a, b) do { const unsigned _h = max((a), (b)), _l = min((a), (b)); (a) = _h; (b) = _l; } while (0)
__device__ __forceinline__ void sort16_desc(unsigned* a) {
#pragma unroll
    for (int k = 2; k <= 16; k <<= 1)
#pragma unroll
        for (int j = k >> 1; j > 0; j >>= 1)
#pragma unroll
            for (int i = 0; i < 16; ++i) { const int l = i ^ j; if (l > i) { if ((i & k) == 0) RT_CE(a[i], a[l]); else RT_CE(a[l], a[i]); } }
}
__device__ __forceinline__ void merge16_desc(unsigned* a, const unsigned* b) {
#pragma unroll
    for (int i = 0; i < 16; ++i) a[i] = max(a[i], b[15 - i]);
#pragma unroll
    for (int j = 8; j > 0; j >>= 1)
#pragma unroll
        for (int i = 0; i < 16; ++i) { const int l = i ^ j; if (l > i) RT_CE(a[i], a[l]); }
}
__device__ __forceinline__ void top16_of_64(unsigned* v) {
    sort16_desc(v); sort16_desc(v + 16); sort16_desc(v + 32); sort16_desc(v + 48);
    merge16_desc(v, v + 16); merge16_desc(v + 32, v + 48); merge16_desc(v, v + 32);
}
constexpr int rt_cand_pos(int i, int j) { int n = 0; for (int a = 0; a < 16; ++a) for (int b = 0; b < 16; ++b) { if (a == i && b == j) return n; if ((a + 1) * (b + 1) <= 16) ++n; } return n; }
static_assert(rt_cand_pos(15, 1) == 50, "50 staircase candidates");

__device__ __forceinline__ void phase_route_mfma(const Params& p, int bid, int nblk, float* ldsf) {
    const int tidf = tid_fresh(p.widx), lane = tidf & 63, wid = __builtin_amdgcn_readfirstlane(tidf >> 6), c = lane & 31, hh = lane >> 5;
    const bf16_t* qp = WS<bf16_t>(p, OFF_QP); const bf16_t* keys = WS<bf16_t>(p, OFF_KEYS);
    int* ridx = WS<int>(p, OFF_RIDX); float* rgate = WS<float>(p, OFF_RGATE);
    LAS unsigned* tbl = (LAS unsigned*)ldsf + wid * 2048;
    for (int it = bid * 8 + wid; it < 2048; it += nblk * 8) {
        const int tile = it >> 3, h = it & 7, t = tile * 32 + c;
#pragma unroll 1
        for (int half = 0; half < 2; ++half) {
            const bf16_t* kb = keys + (size_t)(h * 2 + half) * 16384 + (size_t)c * 128 + hh * 8;
            const bf16_t* qq = qp + (size_t)t * 2048 + h * 256 + half * 128 + hh * 8;
            bf16x8_t qf[8];
#pragma unroll
            for (int ks = 0; ks < 8; ++ks) qf[ks] = *(const bf16x8_t*)(qq + ks * 16);
            unsigned v[64];
#pragma unroll
            for (int blk = 0; blk < 4; ++blk) {
                f32x16_t s;
#pragma unroll
                for (int r = 0; r < 16; ++r) s[r] = 0.f;
#pragma unroll
                for (int ks = 0; ks < 8; ++ks) { const bf16x8_t a = *(const bf16x8_t*)(kb + (size_t)blk * 32 * 128 + ks * 16); s = __builtin_amdgcn_mfma_f32_32x32x16_bf16(a, qf[ks], s, 0, 0, 0); }
#pragma unroll
                for (int r = 0; r < 16; ++r) { const int n = 32 * blk + (r & 3) + 8 * (r >> 2) + 4 * hh; v[blk * 16 + r] = (f2key(s[r]) & ~127u) | (unsigned)(127 - n); }
                asm volatile("" ::: "memory");
            }
            top16_of_64(v);
            unsigned o[16];
#pragma unroll
            for (int i = 0; i < 16; ++i) { auto r2 = __builtin_amdgcn_permlane32_swap(v[i], v[i], false, false); o[i] = hh ? r2[0] : r2[1]; }
            merge16_desc(v, o);
#pragma unroll
            for (int i = 0; i < 16; ++i) tbl[(half * 16 + i) * 64 + lane] = v[i];
        }
        float f1[16], f2[16];
#pragma unroll
        for (int i = 0; i < 16; ++i) { f1[i] = key2f(tbl[i * 64 + lane] & ~127u); f2[i] = key2f(tbl[(16 + i) * 64 + lane] & ~127u); }
        unsigned cd[64];
#pragma unroll
        for (int i = 0; i < 64; ++i) cd[i] = 0u;
#pragma unroll
        for (int i = 0; i < 16; ++i)
#pragma unroll
            for (int j = 0; j < 16; ++j)
                if ((i + 1) * (j + 1) <= 16) cd[rt_cand_pos(i, j)] = (f2key(f1[i] + f2[j]) & ~255u) | (unsigned)(255 - (i * 16 + j));
        top16_of_64(cd);
        float e[16], sum = 0.f; const float mx = key2f(cd[0] & ~255u);
#pragma unroll
        for (int k = 0; k < 16; ++k) { e[k] = __expf(key2f(cd[k] & ~255u) - mx); sum += e[k]; }
        const float inv = 1.0f / sum;
        if (hh == 0) {
#pragma unroll
            for (int k = 0; k < 16; ++k) {
                const int pid = 255 - (int)(cd[k] & 255u), i = pid >> 4, j = pid & 15;
                const int n1 = 127 - (int)(tbl[i * 64 + lane] & 127u), n2 = 127 - (int)(tbl[(16 + j) * 64 + lane] & 127u);
                ridx[(size_t)t * 128 + h * 16 + k] = n1 * 128 + n2; rgate[(size_t)t * 128 + h * 16 + k] = e[k] * inv;
            }
        }
    }
}

__device__ __forceinline__ void phase_peer_ref(const Params& p, int bid, int nblk) {
    const int tidf = tid_fresh(p.widx), lane = tidf & 63, wid = tidf >> 6;
    const bf16_t* h2 = WS<bf16_t>(p, OFF_H); const float* x1 = WS<float>(p, OFF_X1); const float* mod = WS<float>(p, OFF_MOD);
    const int* ridx = WS<int>(p, OFF_RIDX); const float* rgate = WS<float>(p, OFF_RGATE);
    for (int t = bid * 8 + wid; t < TOK; t += nblk * 8) {
        const int b = t >> 12;
        float4 hv[8], y[8];
#pragma unroll
        for (int j = 0; j < 8; ++j) { const uint2 w = *(const uint2*)(h2 + (size_t)t * DM + (j * 64 + lane) * 4);
            hv[j].x = lo_f(w.x); hv[j].y = hi_f(w.x); hv[j].z = lo_f(w.y); hv[j].w = hi_f(w.y); y[j] = (float4){0.f, 0.f, 0.f, 0.f}; }
        for (int e = 0; e < 128; ++e) {
            const int ex = ridx[(size_t)t * 128 + e]; const float gt = rgate[(size_t)t * 128 + e];
            const float* ur = p.u_tab + (size_t)ex * DM; const float* vr = p.v_tab + (size_t)ex * DM;
            float d = 0.f;
#pragma unroll
            for (int j = 0; j < 8; ++j) { const float4 u = *(const float4*)(ur + (j * 64 + lane) * 4); d += u.x * hv[j].x + u.y * hv[j].y + u.z * hv[j].z + u.w * hv[j].w; }
            d = wave_sum(d);
            const float cf = gt * gelu_exact(d);
#pragma unroll
            for (int j = 0; j < 8; ++j) { const float4 v = *(const float4*)(vr + (j * 64 + lane) * 4); y[j].x += cf * v.x; y[j].y += cf * v.y; y[j].z += cf * v.z; y[j].w += cf * v.w; }
        }
        float ss = 0.f;
#pragma unroll
        for (int j = 0; j < 8; ++j) { const int col = (j * 64 + lane) * 4;
            const float4 xv = *(const float4*)(x1 + (size_t)t * DM + col); const float4 g2 = *(const float4*)(mod + (size_t)b * 12288 + 5 * 2048 + col);
            y[j].x = xv.x + g2.x * y[j].x; y[j].y = xv.y + g2.y * y[j].y; y[j].z = xv.z + g2.z * y[j].z; y[j].w = xv.w + g2.w * y[j].w;
            ss += y[j].x * y[j].x + y[j].y * y[j].y + y[j].z * y[j].z + y[j].w * y[j].w; }
        ss = wave_sum(ss);
        const float rstd = rsqrtf(ss * (1.0f / DM) + EPS);
#pragma unroll
        for (int j = 0; j < 8; ++j) { const int col = (j * 64 + lane) * 4; const float4 fg = *(const float4*)(p.fin_g + col);
            float4 o; o.x = y[j].x * rstd * fg.x; o.y = y[j].y * rstd * fg.y; o.z = y[j].z * rstd * fg.z; o.w = y[j].w * rstd * fg.w;
            *(float4*)(p.out + (size_t)t * DM + col) = o; }
    }
}


template <int EB> __device__ __forceinline__ void job_table(const Params& p, int it) {
    const int tidf = tid_fresh(p.widx), lane = tidf & 63, wid = tidf >> 6;
    const int tab = it >> 9, r0 = (it & 511) * 32;
    const float* src = tab ? p.v_tab : p.u_tab;
    unsigned char* dst = p.ws + (tab ? OFF_VTAB : OFF_UTAB);
    float* scl = WS<float>(p, tab ? OFF_VSC : OFF_USC);
#pragma unroll 1
    for (int rr = 0; rr < 4; ++rr) {
        const int row = r0 + wid * 4 + rr;
        float4 v[8]; float am = 0.f;
#pragma unroll
        for (int j = 0; j < 8; ++j) { v[j] = *(const float4*)(src + (size_t)row * DM + (j * 64 + lane) * 4);
            am = fmaxf(am, fmaxf(fmaxf(fabsf(v[j].x), fabsf(v[j].y)), fmaxf(fabsf(v[j].z), fabsf(v[j].w)))); }
#pragma unroll
        for (int o = 32; o > 0; o >>= 1) am = fmaxf(am, __shfl_xor(am, o));
        if (EB == 1) {
            const int e = (int)((__float_as_uint(am) >> 23) & 255u) - 127;
            const float sc = am > 0.f ? __uint_as_float((unsigned)(127 + 7 - e) << 23) : 1.0f;
            if (lane == 0) scl[row] = am > 0.f ? __uint_as_float((unsigned)(127 - 7 + e) << 23) : 1.0f;
#pragma unroll
            for (int j = 0; j < 8; ++j) {
                int w = __builtin_amdgcn_cvt_pk_fp8_f32(v[j].x * sc, v[j].y * sc, 0, false);
                w = __builtin_amdgcn_cvt_pk_fp8_f32(v[j].z * sc, v[j].w * sc, w, true);
                *(int*)(dst + (size_t)row * 2048 + (j * 64 + lane) * 4) = w;
            }
        } else {
            if (lane == 0) scl[row] = 1.0f;
#pragma unroll
            for (int j = 0; j < 8; ++j) { uint2 w; w.x = pack2(v[j].x, v[j].y); w.y = pack2(v[j].z, v[j].w);
                *(uint2*)(dst + (size_t)row * 4096 + (j * 64 + lane) * 8) = w; }
        }
    }
}

template <int EB> __device__ __forceinline__ void dec_chunk(const u32x4_t r, float* f) {
    if (EB == 1) {
#pragma unroll
        for (int w = 0; w < 4; ++w) { const f32x2_t a = __builtin_amdgcn_cvt_pk_f32_fp8((int)r[w], false), b = __builtin_amdgcn_cvt_pk_f32_fp8((int)r[w], true);
            f[4 * w] = a[0]; f[4 * w + 1] = a[1]; f[4 * w + 2] = b[0]; f[4 * w + 3] = b[1]; }
    } else {
#pragma unroll
        for (int w = 0; w < 4; ++w) { f[2 * w] = lo_f(r[w]); f[2 * w + 1] = hi_f(r[w]); }
    }
}

template <int EB> __device__ __forceinline__ void phase_peer_gather(const Params& p, int bid, int nblk) {
    constexpr int EPC = 16 / EB, NCH = 32 / EPC, ROWB = 2048 * EB;
    const int tidf = tid_fresh(p.widx), lane = tidf & 63, wid = tidf >> 6;
    const unsigned char* utab = p.ws + OFF_UTAB; const unsigned char* vtab = p.ws + OFF_VTAB;
    const float* usc = WS<float>(p, OFF_USC); const float* vsc = WS<float>(p, OFF_VSC);
    const bf16_t* h2 = WS<bf16_t>(p, OFF_H); const float* x1 = WS<float>(p, OFF_X1); const float* mod = WS<float>(p, OFF_MOD);
    const int* ridx = WS<int>(p, OFF_RIDX); const float* rgate = WS<float>(p, OFF_RGATE);
    for (int t = bid * 8 + wid; t < TOK; t += nblk * 8) {
        const int b = t >> 12;
        float hv[32];
#pragma unroll
        for (int j = 0; j < NCH; ++j) {
            const bf16_t* hp = h2 + (size_t)t * DM + (j * 64 + lane) * EPC;
#pragma unroll
            for (int q8 = 0; q8 < EPC / 8; ++q8) { const uint4 w = *(const uint4*)(hp + q8 * 8);
                float* f = hv + j * EPC + q8 * 8;
                f[0] = lo_f(w.x); f[1] = hi_f(w.x); f[2] = lo_f(w.y); f[3] = hi_f(w.y); f[4] = lo_f(w.z); f[5] = hi_f(w.z); f[6] = lo_f(w.w); f[7] = hi_f(w.w); }
        }
        const int myi0 = ridx[(size_t)t * 128 + lane], myi1 = ridx[(size_t)t * 128 + 64 + lane];
        const float myg0 = rgate[(size_t)t * 128 + lane], myg1 = rgate[(size_t)t * 128 + 64 + lane];
        float dots0 = 0.f, dots1 = 0.f;
#pragma unroll 1
        for (int eb = 0; eb < 128; eb += 8) {
            const int idxv = eb < 64 ? myi0 : myi1;
            u32x4_t r[8][NCH];
#pragma unroll
            for (int k = 0; k < 8; ++k) {
                const int idx = __builtin_amdgcn_readlane(idxv, (eb & 63) + k);
                const unsigned char* row = utab + (size_t)idx * ROWB + lane * 16;
#pragma unroll
                for (int j = 0; j < NCH; ++j) r[k][j] = *(const u32x4_t*)(row + j * 1024);
            }
            float d[8];
#pragma unroll
            for (int k = 0; k < 8; ++k) {
                float s = 0.f;
#pragma unroll
                for (int j = 0; j < NCH; ++j) { float f[EPC]; dec_chunk<EB>(r[k][j], f);
#pragma unroll
                    for (int q = 0; q < EPC; ++q) s += f[q] * hv[j * EPC + q]; }
                asm volatile("" : "+v"(s));
                d[k] = s;
                __builtin_amdgcn_sched_barrier(0);
            }
            float n4[4], n2[2];
#pragma unroll
            for (int i = 0; i < 4; ++i) { const bool hi = lane & 1; const float send = hi ? d[2 * i] : d[2 * i + 1], keep = hi ? d[2 * i + 1] : d[2 * i]; n4[i] = keep + __shfl_xor(send, 1); }
#pragma unroll
            for (int i = 0; i < 2; ++i) { const bool hi = lane & 2; const float send = hi ? n4[2 * i] : n4[2 * i + 1], keep = hi ? n4[2 * i + 1] : n4[2 * i]; n2[i] = keep + __shfl_xor(send, 2); }
            float tot;
            { const bool hi = lane & 4; const float send = hi ? n2[0] : n2[1], keep = hi ? n2[1] : n2[0]; tot = keep + __shfl_xor(send, 4); }
            tot += __shfl_xor(tot, 8); tot += __shfl_xor(tot, 16); tot += __shfl_xor(tot, 32);
            const bool mine = (lane >> 3) == ((eb & 63) >> 3);
            if (eb < 64) dots0 = mine ? tot : dots0; else dots1 = mine ? tot : dots1;
        }
        const float cf0 = myg0 * gelu_exact(dots0 * usc[myi0]) * vsc[myi0], cf1 = myg1 * gelu_exact(dots1 * usc[myi1]) * vsc[myi1];
        float y[32];
#pragma unroll
        for (int q = 0; q < 32; ++q) y[q] = 0.f;
#pragma unroll 1
        for (int eb = 0; eb < 128; eb += 8) {
            const int idxv = eb < 64 ? myi0 : myi1; const float cfv = eb < 64 ? cf0 : cf1;
            u32x4_t r[8][NCH];
#pragma unroll
            for (int k = 0; k < 8; ++k) {
                const int idx = __builtin_amdgcn_readlane(idxv, (eb & 63) + k);
                const unsigned char* row = vtab + (size_t)idx * ROWB + lane * 16;
#pragma unroll
                for (int j = 0; j < NCH; ++j) r[k][j] = *(const u32x4_t*)(row + j * 1024);
            }
#pragma unroll
            for (int k = 0; k < 8; ++k) {
                const float cf = __uint_as_float((unsigned)__builtin_amdgcn_readlane((int)__float_as_uint(cfv), (eb & 63) + k));
#pragma unroll
                for (int j = 0; j < NCH; ++j) { float f[EPC]; dec_chunk<EB>(r[k][j], f);
#pragma unroll
                    for (int q = 0; q < EPC; ++q) y[j * EPC + q] += cf * f[q]; }
                asm volatile("" : "+v"(y[0]), "+v"(y[1]), "+v"(y[2]), "+v"(y[3]), "+v"(y[4]), "+v"(y[5]), "+v"(y[6]), "+v"(y[7]), "+v"(y[8]), "+v"(y[9]), "+v"(y[10]), "+v"(y[11]), "+v"(y[12]), "+v"(y[13]), "+v"(y[14]), "+v"(y[15]));
                asm volatile("" : "+v"(y[16]), "+v"(y[17]), "+v"(y[18]), "+v"(y[19]), "+v"(y[20]), "+v"(y[21]), "+v"(y[22]), "+v"(y[23]), "+v"(y[24]), "+v"(y[25]), "+v"(y[26]), "+v"(y[27]), "+v"(y[28]), "+v"(y[29]), "+v"(y[30]), "+v"(y[31]));
                __builtin_amdgcn_sched_barrier(0);
            }
        }
        float ss = 0.f;
#pragma unroll
        for (int j = 0; j < NCH; ++j)
#pragma unroll
            for (int q4 = 0; q4 < EPC / 4; ++q4) {
                const int col = (j * 64 + lane) * EPC + q4 * 4;
                const float4 xv = *(const float4*)(x1 + (size_t)t * DM + col); const float4 g2 = *(const float4*)(mod + (size_t)b * 12288 + 5 * 2048 + col);
                float* yy = y + j * EPC + q4 * 4;
                yy[0] = xv.x + g2.x * yy[0]; yy[1] = xv.y + g2.y * yy[1]; yy[2] = xv.z + g2.z * yy[2]; yy[3] = xv.w + g2.w * yy[3];
                ss += yy[0] * yy[0] + yy[1] * yy[1] + yy[2] * yy[2] + yy[3] * yy[3];
                if (q4 & 1) __builtin_amdgcn_sched_barrier(0);
            }
        ss = wave_sum(ss);
        const float rstd = rsqrtf(ss * (1.0f / DM) + EPS);
#pragma unroll
        for (int j = 0; j < NCH; ++j)
#pragma unroll
            for (int q4 = 0; q4 < EPC / 4; ++q4) {
                const int col = (j * 64 + lane) * EPC + q4 * 4; const float4 fg = *(const float4*)(p.fin_g + col);
                const float* yy = y + j * EPC + q4 * 4;
                float4 o; o.x = yy[0] * rstd * fg.x; o.y = yy[1] * rstd * fg.y; o.z = yy[2] * rstd * fg.z; o.w = yy[3] * rstd * fg.w;
                *(float4*)(p.out + (size_t)t * DM + col) = o;
                if (q4 & 1) __builtin_amdgcn_sched_barrier(0);
            }
    }
}


typedef float v32f_t __attribute__((ext_vector_type(32)));
typedef float v16f_t __attribute__((ext_vector_type(16)));
typedef unsigned v6u_t __attribute__((ext_vector_type(6)));
typedef _Float16 v32h_t __attribute__((ext_vector_type(32)));
typedef _Float16 h2_t __attribute__((ext_vector_type(2)));
typedef unsigned u32x2_t __attribute__((ext_vector_type(2)));
__device__ __forceinline__ float wave_max_noaddr(float v) {
    v = fmaxf(v, __int_as_float(__builtin_amdgcn_ds_swizzle(__float_as_int(v), (1 << 10) | 0x1f)));
    v = fmaxf(v, __int_as_float(__builtin_amdgcn_ds_swizzle(__float_as_int(v), (2 << 10) | 0x1f)));
    v = fmaxf(v, __int_as_float(__builtin_amdgcn_ds_swizzle(__float_as_int(v), (4 << 10) | 0x1f)));
    v = fmaxf(v, __int_as_float(__builtin_amdgcn_ds_swizzle(__float_as_int(v), (8 << 10) | 0x1f)));
    v = fmaxf(v, __int_as_float(__builtin_amdgcn_ds_swizzle(__float_as_int(v), (16 << 10) | 0x1f)));
    auto r = __builtin_amdgcn_permlane32_swap(__float_as_uint(v), __float_as_uint(v), false, false);
    return fmaxf(__uint_as_float(r[0]), __uint_as_float(r[1]));
}
__device__ __forceinline__ void job_table6(const Params& p, int it) {
    const int tidf = tid_fresh(p.widx), lane = tidf & 63, wid = tidf >> 6;
    const int tab = it >> 9, r0 = (it & 511) * 32;
    const float* src = tab ? p.v_tab : p.u_tab;
    unsigned char* dst = p.ws + (tab ? OFF_VTAB : OFF_UTAB);
    float* scl = WS<float>(p, tab ? OFF_VSC : OFF_USC);
    typedef float f32x4v __attribute__((ext_vector_type(4)));
    f32x4v v[4][8];
#pragma unroll
    for (int rr = 0; rr < 4; ++rr)
#pragma unroll
        for (int j = 0; j < 8; ++j) v[rr][j] = __builtin_nontemporal_load((const f32x4v*)(src + (size_t)(r0 + wid * 4 + rr) * DM + (j * 64 + lane) * 4));
#pragma unroll
    for (int rr = 0; rr < 4; ++rr) {
        const int row = r0 + wid * 4 + rr;
        v16f_t a, b; float am = 0.f;
#pragma unroll
        for (int j = 0; j < 8; ++j) { const f32x4v w = v[rr][j];
            a[2 * j] = w.x; b[2 * j] = w.y; a[2 * j + 1] = w.z; b[2 * j + 1] = w.w; am = fmaxf(am, fmaxf(fmaxf(fabsf(w.x), fabsf(w.y)), fmaxf(fabsf(w.z), fabsf(w.w)))); }
        am = wave_max_noaddr(am);
        const int e = (int)((__float_as_uint(am) >> 23) & 255u) - 127;
        const float sc = am > 0.f ? __uint_as_float((unsigned)(127 + 2 - e) << 23) : 1.0f;
        if (lane == 0) scl[row] = am > 0.f ? __uint_as_float((unsigned)(127 - 2 + e) << 23) : 1.0f;
        a = a * sc; b = b * sc;
        const v6u_t pk = __builtin_amdgcn_cvt_scalef32_2xpk16_fp6_f32(a, b, 1.0f);
#if PEER_SLICED
        { unsigned char* d6 = dst + ((size_t)(lane >> 3) * NEXP + row) * 192;
          u32x4_t w0 = {pk[0], pk[1], pk[2], pk[3]}; u32x2_t w1 = {pk[4], pk[5]};
          *(u32x4_t*)(d6 + (lane & 7) * 16) = w0; *(u32x2_t*)(d6 + 128 + (lane & 7) * 8) = w1; }
#else
        u32x4_t w0 = {pk[0], pk[1], pk[2], pk[3]}; u32x2_t w1 = {pk[4], pk[5]};
        *(u32x4_t*)(dst + (size_t)row * 1536 + lane * 16) = w0;
        *(u32x2_t*)(dst + (size_t)row * 1536 + 1024 + lane * 8) = w1;
#endif
    }
}

#define PG6_LOAD(RA, RB, tab, iv, e0) do { _Pragma("unroll") for (int k = 0; k < 8; ++k) { \
        const int idx_ = __builtin_amdgcn_readlane((iv), (e0) + k); const unsigned char* row_ = (tab) + (size_t)idx_ * 1536; \
        RA[k] = *(const u32x4_t*)(row_ + lane * 16); RB[k] = *(const u32x2_t*)(row_ + 1024 + lane * 8); } } while (0)
#define PG6_CU(RA, RB, eb) do { float d[8]; \
        _Pragma("unroll") for (int k = 0; k < 8; ++k) { \
            const v6u_t pk_ = {RA[k][0], RA[k][1], RA[k][2], RA[k][3], RB[k][0], RB[k][1]}; \
            const v32h_t f_ = __builtin_amdgcn_cvt_scalef32_pk32_f16_fp6(pk_, 1.0f); float s0_ = 0.f, s1_ = 0.f, s2_ = 0.f, s3_ = 0.f; \
            _Pragma("unroll") for (int q = 0; q < 16; q += 4) { \
                s0_ = __builtin_amdgcn_fdot2((h2_t){f_[2 * q], f_[2 * q + 1]}, hvh[q], s0_, false); s1_ = __builtin_amdgcn_fdot2((h2_t){f_[2 * q + 2], f_[2 * q + 3]}, hvh[q + 1], s1_, false); \
                s2_ = __builtin_amdgcn_fdot2((h2_t){f_[2 * q + 4], f_[2 * q + 5]}, hvh[q + 2], s2_, false); s3_ = __builtin_amdgcn_fdot2((h2_t){f_[2 * q + 6], f_[2 * q + 7]}, hvh[q + 3], s3_, false); } \
            float s_ = (s0_ + s1_) + (s2_ + s3_);             \
            asm volatile("" : "+v"(s_)); d[k] = s_; __builtin_amdgcn_sched_barrier(0); } \
        float n4[4], n2[2], tot; \
        _Pragma("unroll") for (int i_ = 0; i_ < 4; ++i_) { const bool hi_ = lane & 1; const float send = hi_ ? d[2 * i_] : d[2 * i_ + 1], keep = hi_ ? d[2 * i_ + 1] : d[2 * i_]; n4[i_] = keep + __shfl_xor(send, 1); } \
        _Pragma("unroll") for (int i_ = 0; i_ < 2; ++i_) { const bool hi_ = lane & 2; const float send = hi_ ? n4[2 * i_] : n4[2 * i_ + 1], keep = hi_ ? n4[2 * i_ + 1] : n4[2 * i_]; n2[i_] = keep + __shfl_xor(send, 2); } \
        { const bool hi_ = lane & 4; const float send = hi_ ? n2[0] : n2[1], keep = hi_ ? n2[1] : n2[0]; tot = keep + __shfl_xor(send, 4); } \
        tot += __shfl_xor(tot, 8); tot += __shfl_xor(tot, 16); tot += __shfl_xor(tot, 32); \
        const bool mine_ = (lane >> 3) == (((eb) & 63) >> 3); \
        if ((eb) < 64) dots0 = mine_ ? tot : dots0; else dots1 = mine_ ? tot : dots1; } while (0)
#define PG6_CV(RA, RB, eb) do { const float cfv_ = (eb) < 64 ? cf0 : cf1; \
        _Pragma("unroll") for (int k = 0; k < 8; ++k) { \
            const _Float16 ch_ = (_Float16)__uint_as_float((unsigned)__builtin_amdgcn_readlane((int)__float_as_uint(cfv_), ((eb) & 63) + k)); const h2_t c2_ = {ch_, ch_}; \
            const v6u_t pk_ = {RA[k][0], RA[k][1], RA[k][2], RA[k][3], RB[k][0], RB[k][1]}; \
            const v32h_t f_ = __builtin_amdgcn_cvt_scalef32_pk32_f16_fp6(pk_, 1.0f); \
            _Pragma("unroll") for (int q = 0; q < 16; ++q) yh[q] = (h2_t){f_[2 * q], f_[2 * q + 1]} * c2_ + yh[q]; \
            asm volatile("" : "+v"(yh[0]), "+v"(yh[1]), "+v"(yh[2]), "+v"(yh[3]), "+v"(yh[4]), "+v"(yh[5]), "+v"(yh[6]), "+v"(yh[7]), "+v"(yh[8]), "+v"(yh[9]), "+v"(yh[10]), "+v"(yh[11]), "+v"(yh[12]), "+v"(yh[13]), "+v"(yh[14]), "+v"(yh[15])); \
            __builtin_amdgcn_sched_barrier(0); } } while (0)
__device__ __forceinline__ void phase_peer_gather6(const Params& p, int bid, int nblk) {
    const int tidf = tid_fresh(p.widx), lane = tidf & 63, wid = tidf >> 6;
    const unsigned char* utab = p.ws + OFF_UTAB; const unsigned char* vtab = p.ws + OFF_VTAB;
    const float* usc = WS<float>(p, OFF_USC); const float* vsc = WS<float>(p, OFF_VSC);
    const bf16_t* h2 = WS<bf16_t>(p, OFF_H); const float* x1 = WS<float>(p, OFF_X1); const float* mod = WS<float>(p, OFF_MOD);
    const int* ridx = WS<int>(p, OFF_RIDX); const float* rgate = WS<float>(p, OFF_RGATE);
    const int tstep = nblk * 8;
    int t = bid * 8 + wid;
    if (t >= TOK) return;
    int myi0 = ridx[(size_t)t * 128 + lane], myi1 = ridx[(size_t)t * 128 + 64 + lane];
    u32x4_t a4[8], b4[8]; u32x2_t a2[8], b2[8];
    PG6_LOAD(a4, a2, utab, myi0, 0);
    for (; t < TOK; t += tstep) {
        const int b = t >> 12;
        const int tn = t + tstep; const bool more = tn < TOK;
        const int ni0 = more ? ridx[(size_t)tn * 128 + lane] : 0, ni1 = more ? ridx[(size_t)tn * 128 + 64 + lane] : 0;
        const float myg0 = rgate[(size_t)t * 128 + lane], myg1 = rgate[(size_t)t * 128 + 64 + lane];
        float hv[32];
        { const bf16_t* hp = h2 + (size_t)t * DM + lane * 4;
#pragma unroll
          for (int j = 0; j < 8; ++j) { const uint2 w = *(const uint2*)(hp + j * 256); float* f = hv + j * 4;
              f[0] = lo_f(w.x); f[1] = hi_f(w.x); f[2] = lo_f(w.y); f[3] = hi_f(w.y); } }
        h2_t hvh[16];
#pragma unroll
        for (int q = 0; q < 16; ++q) hvh[q] = (h2_t){(_Float16)hv[2 * q], (_Float16)hv[2 * q + 1]};
        float dots0 = 0.f, dots1 = 0.f;
#pragma unroll 1
        for (int eb = 0; eb < 128; eb += 16) {
            { const int e1 = eb + 8; PG6_LOAD(b4, b2, utab, (e1 < 64 ? myi0 : myi1), (e1 & 63)); }
            PG6_CU(a4, a2, eb);
            if (eb + 16 < 128) { const int e2 = eb + 16; PG6_LOAD(a4, a2, utab, (e2 < 64 ? myi0 : myi1), (e2 & 63)); }
            else PG6_LOAD(a4, a2, vtab, myi0, 0);
            PG6_CU(b4, b2, eb + 8);
        }
        const float cf0 = myg0 * gelu_exact(dots0 * usc[myi0]) * vsc[myi0], cf1 = myg1 * gelu_exact(dots1 * usc[myi1]) * vsc[myi1];
        h2_t yh[16];
#pragma unroll
        for (int q = 0; q < 16; ++q) yh[q] = (h2_t){(_Float16)0.f, (_Float16)0.f};
#pragma unroll 1
        for (int eb = 0; eb < 128; eb += 16) {
            { const int e1 = eb + 8; PG6_LOAD(b4, b2, vtab, (e1 < 64 ? myi0 : myi1), (e1 & 63)); }
            PG6_CV(a4, a2, eb);
            if (eb + 16 < 128) { const int e2 = eb + 16; PG6_LOAD(a4, a2, vtab, (e2 < 64 ? myi0 : myi1), (e2 & 63)); }
            else if (more) PG6_LOAD(a4, a2, utab, ni0, 0);
            PG6_CV(b4, b2, eb + 8);
        }
        myi0 = ni0; myi1 = ni1;
        float y[32];
#pragma unroll
        for (int q = 0; q < 16; ++q) { y[2 * q] = (float)yh[q][0]; y[2 * q + 1] = (float)yh[q][1]; }
        float ss = 0.f;
#pragma unroll
        for (int q4 = 0; q4 < 8; ++q4) {
            const int col = (q4 * 64 + lane) * 4;
            const float4 xv = *(const float4*)(x1 + (size_t)t * DM + col); const float4 g2 = *(const float4*)(mod + (size_t)b * 12288 + 5 * 2048 + col);
            float* yy = y + q4 * 4;
            yy[0] = xv.x + g2.x * yy[0]; yy[1] = xv.y + g2.y * yy[1]; yy[2] = xv.z + g2.z * yy[2]; yy[3] = xv.w + g2.w * yy[3];
            ss += yy[0] * yy[0] + yy[1] * yy[1] + yy[2] * yy[2] + yy[3] * yy[3];
            if (q4 & 1) __builtin_amdgcn_sched_barrier(0);
        }
        ss = wave_sum(ss);
        const float rstd = rsqrtf(ss * (1.0f / DM) + EPS);
#pragma unroll
        for (int q4 = 0; q4 < 8; ++q4) {
            const int col = (q4 * 64 + lane) * 4; const float4 fg = *(const float4*)(p.fin_g + col);
            const float* yy = y + q4 * 4;
            float4 o; o.x = yy[0] * rstd * fg.x; o.y = yy[1] * rstd * fg.y; o.z = yy[2] * rstd * fg.z; o.w = yy[3] * rstd * fg.w;
            *(float4*)(p.out + (size_t)t * DM + col) = o;
            if (q4 & 1) __builtin_amdgcn_sched_barrier(0);
        }
    }
}


__device__ __forceinline__ void phase_peer_u6(const Params& p, int bid, int nblk) {
    const int tidf = tid_fresh(p.widx), lane = tidf & 63, wid = tidf >> 6;
    const unsigned char* utab = p.ws + OFF_UTAB;
    const float* usc = WS<float>(p, OFF_USC); const float* vsc = WS<float>(p, OFF_VSC);
    const bf16_t* h2 = WS<bf16_t>(p, OFF_H); const int* ridx = WS<int>(p, OFF_RIDX); const float* rgate = WS<float>(p, OFF_RGATE); float* cfo = WS<float>(p, OFF_PD);
    const int tstep = nblk * 8;
    int t = bid * 8 + wid;
    if (t >= TOK) return;
    int myi0 = ridx[(size_t)t * 128 + lane], myi1 = ridx[(size_t)t * 128 + 64 + lane];
    u32x4_t a4[8], b4[8]; u32x2_t a2[8], b2[8];
    PG6_LOAD(a4, a2, utab, myi0, 0);
    for (; t < TOK; t += tstep) {
        const int tn = t + tstep; const bool more = tn < TOK;
        const int ni0 = more ? ridx[(size_t)tn * 128 + lane] : 0, ni1 = more ? ridx[(size_t)tn * 128 + 64 + lane] : 0;
        const float myg0 = rgate[(size_t)t * 128 + lane], myg1 = rgate[(size_t)t * 128 + 64 + lane];
        h2_t hvh[16];
        { const bf16_t* hp = h2 + (size_t)t * DM + lane * 4;
#pragma unroll
          for (int j = 0; j < 8; ++j) { const uint2 w = *(const uint2*)(hp + j * 256);
              hvh[2 * j] = (h2_t){(_Float16)lo_f(w.x), (_Float16)hi_f(w.x)}; hvh[2 * j + 1] = (h2_t){(_Float16)lo_f(w.y), (_Float16)hi_f(w.y)}; } }
        float dots0 = 0.f, dots1 = 0.f;
#pragma unroll 1
        for (int eb = 0; eb < 128; eb += 16) {
            { const int e1 = eb + 8; PG6_LOAD(b4, b2, utab, (e1 < 64 ? myi0 : myi1), (e1 & 63)); }
            PG6_CU(a4, a2, eb);
            if (eb + 16 < 128) { const int e2 = eb + 16; PG6_LOAD(a4, a2, utab, (e2 < 64 ? myi0 : myi1), (e2 & 63)); }
            else if (more) PG6_LOAD(a4, a2, utab, ni0, 0);
            PG6_CU(b4, b2, eb + 8);
        }
        cfo[(size_t)t * 128 + lane] = myg0 * gelu_exact(dots0 * usc[myi0]) * vsc[myi0];
        cfo[(size_t)t * 128 + 64 + lane] = myg1 * gelu_exact(dots1 * usc[myi1]) * vsc[myi1];
        myi0 = ni0; myi1 = ni1;
    }
}
__device__ __forceinline__ void phase_peer_v6(const Params& p, int bid, int nblk) {
    const int tidf = tid_fresh(p.widx), lane = tidf & 63, wid = tidf >> 6;
    const unsigned char* vtab = p.ws + OFF_VTAB;
    const float* x1 = WS<float>(p, OFF_X1); const float* mod = WS<float>(p, OFF_MOD);
    const int* ridx = WS<int>(p, OFF_RIDX); const float* cfi = WS<float>(p, OFF_PD);
    const int tstep = nblk * 8;
    int t = bid * 8 + wid;
    if (t >= TOK) return;
    int myi0 = ridx[(size_t)t * 128 + lane], myi1 = ridx[(size_t)t * 128 + 64 + lane];
    float cf0 = cfi[(size_t)t * 128 + lane], cf1 = cfi[(size_t)t * 128 + 64 + lane];
    u32x4_t a4[8], b4[8]; u32x2_t a2[8], b2[8];
    PG6_LOAD(a4, a2, vtab, myi0, 0);
    for (; t < TOK; t += tstep) {
        const int b = t >> 12;
        const int tn = t + tstep; const bool more = tn < TOK;
        const int ni0 = more ? ridx[(size_t)tn * 128 + lane] : 0, ni1 = more ? ridx[(size_t)tn * 128 + 64 + lane] : 0;
        const float nc0 = more ? cfi[(size_t)tn * 128 + lane] : 0.f, nc1 = more ? cfi[(size_t)tn * 128 + 64 + lane] : 0.f;
        h2_t yh[16];
#pragma unroll
        for (int q = 0; q < 16; ++q) yh[q] = (h2_t){(_Float16)0.f, (_Float16)0.f};
#pragma unroll 1
        for (int eb = 0; eb < 128; eb += 16) {
            { const int e1 = eb + 8; PG6_LOAD(b4, b2, vtab, (e1 < 64 ? myi0 : myi1), (e1 & 63)); }
            PG6_CV(a4, a2, eb);
            if (eb + 16 < 128) { const int e2 = eb + 16; PG6_LOAD(a4, a2, vtab, (e2 < 64 ? myi0 : myi1), (e2 & 63)); }
            else if (more) PG6_LOAD(a4, a2, vtab, ni0, 0);
            PG6_CV(b4, b2, eb + 8);
        }
        myi0 = ni0; myi1 = ni1; cf0 = nc0; cf1 = nc1;
        float y[32];
#pragma unroll
        for (int q = 0; q < 16; ++q) { y[2 * q] = (float)yh[q][0]; y[2 * q + 1] = (float)yh[q][1]; }
        float ss = 0.f;
#pragma unroll
        for (int q4 = 0; q4 < 8; ++q4) {
            const int col = (q4 * 64 + lane) * 4;
            const float4 xv = *(const float4*)(x1 + (size_t)t * DM + col); const float4 g2 = *(const float4*)(mod + (size_t)b * 12288 + 5 * 2048 + col);
            float* yy = y + q4 * 4;
            yy[0] = xv.x + g2.x * yy[0]; yy[1] = xv.y + g2.y * yy[1]; yy[2] = xv.z + g2.z * yy[2]; yy[3] = xv.w + g2.w * yy[3];
            ss += yy[0] * yy[0] + yy[1] * yy[1] + yy[2] * yy[2] + yy[3] * yy[3];
            if (q4 & 1) __builtin_amdgcn_sched_barrier(0);
        }
        ss = wave_sum(ss);
        const float rstd = rsqrtf(ss * (1.0f / DM) + EPS);
#pragma unroll
        for (int q4 = 0; q4 < 8; ++q4) {
            const int col = (q4 * 64 + lane) * 4; const float4 fg = *(const float4*)(p.fin_g + col);
            const float* yy = y + q4 * 4;
            float4 o; o.x = yy[0] * rstd * fg.x; o.y = yy[1] * rstd * fg.y; o.z = yy[2] * rstd * fg.z; o.w = yy[3] * rstd * fg.w;
            *(float4*)(p.out + (size_t)t * DM + col) = o;
            if (q4 & 1) __builtin_amdgcn_sched_barrier(0);
        }
    }
}

#define XB_TMO      128
#define XB_XCNT(j)  (256  + 64 * (j))
#define XB_XSUB(j)  (1280 + 64 * (j))
#define XB_XGEN(j)  (2304 + 64 * (j))
#define XB_TOP      3328
#define XB_TOPGEN   3392
#define XCD_BAR_WORDS 3456
#define XB_SPIN_CAP (1u << 18)

__device__ __forceinline__ unsigned xb_ld(unsigned* p)              { return __hip_atomic_load(p, __ATOMIC_RELAXED, __HIP_MEMORY_SCOPE_AGENT); }
__device__ __forceinline__ unsigned xb_add(unsigned* p, unsigned v) { return __hip_atomic_fetch_add(p, v, __ATOMIC_RELAXED, __HIP_MEMORY_SCOPE_AGENT); }
__device__ __forceinline__ unsigned xb_xcc_id() { return (unsigned)__builtin_amdgcn_s_getreg((3 << 11) | 20) & 0xFu; }
#define XB_SPIN(cond, bar) do { unsigned _sp = 0; while (cond) { __builtin_amdgcn_s_sleep(1); \
    if ((++_sp & 255u) == 0u) { if (xb_ld(&(bar)[XB_TMO])) break; if (_sp > XB_SPIN_CAP) { atomicAdd(&(bar)[XB_TMO], 1u); break; } } } } while (0)

struct XcdBarrier {
    int widx;
    unsigned* bar; unsigned x;
    volatile LAS unsigned* st;
};

__device__ __forceinline__ bool xb_thread0(int widx) { unsigned m = ~0u; asm volatile("" : "+s"(m)); return widx == 0 && __builtin_amdgcn_mbcnt_hi(m, __builtin_amdgcn_mbcnt_lo(m, 0u)) == 0u; }
__device__ __forceinline__ XcdBarrier xcd_barrier_post(unsigned* bar, volatile LAS unsigned* st, int widx) {
    XcdBarrier b; b.widx = widx; b.bar = bar; b.x = xb_xcc_id(); b.st = st;
    if (xb_thread0(widx)) (void)xb_add(&bar[XB_XCNT(b.x)], 1u);
    return b;
}
__device__ __forceinline__ void xcd_barrier_complete(unsigned* bar, unsigned x, unsigned& nloc, unsigned& nx) {
    const unsigned G = gridDim.x * gridDim.y * gridDim.z;
    unsigned sum, cnt, mine, sp = 0u;
    for (;;) {
        sum = 0u; cnt = 0u; mine = 0u;
#pragma unroll
        for (unsigned j = 0; j < 16; ++j) { const unsigned c = xb_ld(&bar[XB_XCNT(j)]); sum += c; cnt += (c > 0u) ? 1u : 0u; mine = (j == x) ? c : mine; }
        if (sum == G) break;
        __builtin_amdgcn_s_sleep(1);
        if ((++sp & 255u) == 0u) { if (xb_ld(&bar[XB_TMO])) break; if (sp > XB_SPIN_CAP) { atomicAdd(&bar[XB_TMO], 1u); break; } }
    }
    nloc = mine > 0u ? mine : 1u; nx = cnt > 0u ? cnt : 1u;
}

__device__ __forceinline__ void xcd_barrier(const XcdBarrier& b) {
    asm volatile("s_waitcnt vmcnt(0)" ::: "memory");
    __syncthreads();
    if (xb_thread0(b.widx)) {
        unsigned* bar = b.bar;
        __builtin_amdgcn_s_waitcnt(0);
        unsigned nloc = b.st[0], nx = b.st[1];
        if (nloc == 0u) { xcd_barrier_complete(bar, b.x, nloc, nx); b.st[0] = nloc; b.st[1] = nx; }
        const unsigned old = xb_add(&bar[XB_XSUB(b.x)], 1u);
        const unsigned gen = old / nloc;
        if (old + 1u == (gen + 1u) * nloc) {
            __builtin_amdgcn_fence(__ATOMIC_RELEASE, "agent");
            asm volatile("s_waitcnt vmcnt(0)" ::: "memory");
            const unsigned og = xb_add(&bar[XB_TOP], 1u);
            const unsigned tg = og / nx;
            if (og + 1u == (tg + 1u) * nx) xb_add(&bar[XB_TOPGEN], 1u);
            else XB_SPIN(xb_ld(&bar[XB_TOPGEN]) == tg, bar);
            __builtin_amdgcn_fence(__ATOMIC_ACQUIRE, "agent");
            xb_add(&bar[XB_XGEN(b.x)], 1u);
            asm volatile("s_waitcnt vmcnt(0)" ::: "memory");
        } else {
            XB_SPIN(xb_ld(&bar[XB_XGEN(b.x)]) == gen, bar);
            __builtin_amdgcn_fence(__ATOMIC_ACQUIRE, "agent");
            asm volatile("s_waitcnt vmcnt(0)" ::: "memory");
        }
    }
    __syncthreads();
}


constexpr int PS_Q_WORD = 3968;
__device__ __forceinline__ unsigned ps_next(unsigned* q, LAS unsigned* bc, int tid) {
    if (tid == 0) *bc = __hip_atomic_fetch_add(q, 1u, __ATOMIC_RELAXED, __HIP_MEMORY_SCOPE_AGENT);
    __syncthreads();
    const unsigned u = (unsigned)__builtin_amdgcn_readfirstlane((int)*bc);
    __syncthreads();
    return u;
}
#define PS_LOADH(RA, RB, tb, idv) do { _Pragma("unroll") for (int bt = 0; bt < 8; ++bt) { const int idx_ = __shfl((idv), bt * 8 + g); const unsigned char* rp_ = (tb) + (size_t)idx_ * 192; \
        RA[bt] = *(const u32x4_t*)(rp_ + j * 16); RB[bt] = *(const u32x2_t*)(rp_ + 128 + j * 8); } } while (0)
#define PS_CU(RA, RB, outp) do { float mine_ = 0.f; \
        _Pragma("unroll") for (int bt = 0; bt < 8; ++bt) { \
            const v6u_t pk_ = {RA[bt][0], RA[bt][1], RA[bt][2], RA[bt][3], RB[bt][0], RB[bt][1]}; \
            const v32f_t f_ = __builtin_amdgcn_cvt_scalef32_pk32_f32_fp6(pk_, 1.0f); float sd_ = 0.f; \
            _Pragma("unroll") for (int qq = 0; qq < 32; ++qq) sd_ += f_[qq] * hv[qq]; \
            sd_ += __shfl_xor(sd_, 1); sd_ += __shfl_xor(sd_, 2); sd_ += __shfl_xor(sd_, 4); \
            mine_ = (j == bt) ? sd_ : mine_; __builtin_amdgcn_sched_barrier(0); } \
        __builtin_nontemporal_store(mine_, (outp) + j * 8 + g); } while (0)
#define PS_CV(RA, RB, cfv) do { \
        _Pragma("unroll") for (int bt = 0; bt < 8; ++bt) { const float cf_ = __shfl((cfv), bt * 8 + g); \
            const v6u_t pk_ = {RA[bt][0], RA[bt][1], RA[bt][2], RA[bt][3], RB[bt][0], RB[bt][1]}; \
            const v32f_t f_ = __builtin_amdgcn_cvt_scalef32_pk32_f32_fp6(pk_, 1.0f); \
            _Pragma("unroll") for (int qq = 0; qq < 32; ++qq) y[qq] += cf_ * f_[qq]; \
            asm volatile("" : "+v"(y[0]), "+v"(y[1]), "+v"(y[2]), "+v"(y[3]), "+v"(y[4]), "+v"(y[5]), "+v"(y[6]), "+v"(y[7]), "+v"(y[8]), "+v"(y[9]), "+v"(y[10]), "+v"(y[11]), "+v"(y[12]), "+v"(y[13]), "+v"(y[14]), "+v"(y[15])); \
            asm volatile("" : "+v"(y[16]), "+v"(y[17]), "+v"(y[18]), "+v"(y[19]), "+v"(y[20]), "+v"(y[21]), "+v"(y[22]), "+v"(y[23]), "+v"(y[24]), "+v"(y[25]), "+v"(y[26]), "+v"(y[27]), "+v"(y[28]), "+v"(y[29]), "+v"(y[30]), "+v"(y[31])); \
            __builtin_amdgcn_sched_barrier(0); } } while (0)
constexpr int PS_CHUNK = 64;
__device__ __forceinline__ void phase_peer_u_sliced(const Params& p, float* ldsf) {
    const int tid = tid_fresh(p.widx), lane = tid & 63, wid = tid >> 6, g = lane >> 3, j = lane & 7;
    LAS unsigned* bc = (LAS unsigned*)ldsf;
    const unsigned char* utab = p.ws + OFF_UTAB;
    const bf16_t* h2 = WS<bf16_t>(p, OFF_H); const int* ridx = WS<int>(p, OFF_RIDX); float* pd = WS<float>(p, OFF_PD);
    const int x0 = (int)(xb_xcc_id() & 7u);
#pragma unroll 1
    for (int so = 0; so < 8; ++so) {
        const int s = (x0 + so) & 7;
        unsigned* q = WS<unsigned>(p, OFF_BAR) + PS_Q_WORD + 8 * s;
        const unsigned char* tb = utab + (size_t)s * NEXP * 192;
        const bf16_t* hb = h2 + s * 256 + j * 32;
#pragma unroll 1
        for (;;) {
            const unsigned ch = ps_next(q, bc, tid);
            if (ch >= TOK / PS_CHUNK) break;
            int t = (int)ch * PS_CHUNK + wid;
            int i0 = __builtin_nontemporal_load(ridx + (size_t)t * 128 + lane), i1 = __builtin_nontemporal_load(ridx + (size_t)t * 128 + 64 + lane);
            uint4 hp[4];
#pragma unroll
            for (int q8 = 0; q8 < 4; ++q8) hp[q8] = *(const uint4*)(hb + (size_t)t * DM + q8 * 8);
            u32x4_t a4[8], b4[8]; u32x2_t a2[8], b2[8];
            PS_LOADH(a4, a2, tb, i0);
#pragma unroll 1
            for (int k = 0; k < PS_CHUNK / 8; ++k, t += 8) {
                float hv[32];
#pragma unroll
                for (int q8 = 0; q8 < 4; ++q8) { const uint4 w = hp[q8]; float* f = hv + q8 * 8;
                    f[0] = lo_f(w.x); f[1] = hi_f(w.x); f[2] = lo_f(w.y); f[3] = hi_f(w.y); f[4] = lo_f(w.z); f[5] = hi_f(w.z); f[6] = lo_f(w.w); f[7] = hi_f(w.w); }
                const bool more = k + 1 < PS_CHUNK / 8; const int tn = more ? t + 8 : t;
                const int n0 = __builtin_nontemporal_load(ridx + (size_t)tn * 128 + lane), n1 = __builtin_nontemporal_load(ridx + (size_t)tn * 128 + 64 + lane);
#pragma unroll
                for (int q8 = 0; q8 < 4; ++q8) hp[q8] = *(const uint4*)(hb + (size_t)tn * DM + q8 * 8);
                PS_LOADH(b4, b2, tb, i1);
                PS_CU(a4, a2, pd + ((size_t)s * TOK + t) * 128);
                if (more) PS_LOADH(a4, a2, tb, n0);
                PS_CU(b4, b2, pd + ((size_t)s * TOK + t) * 128 + 64);
                i0 = n0; i1 = n1;
            }
        }
    }
}
__device__ __forceinline__ void phase_peer_v_sliced(const Params& p, float* ldsf) {
    const int tid = tid_fresh(p.widx), lane = tid & 63, wid = tid >> 6, g = lane >> 3, j = lane & 7;
    LAS unsigned* bc = (LAS unsigned*)ldsf;
    const unsigned char* vtab = p.ws + OFF_VTAB;
    const float* usc = WS<float>(p, OFF_USC); const float* vsc = WS<float>(p, OFF_VSC);
    const int* ridx = WS<int>(p, OFF_RIDX); const float* rgate = WS<float>(p, OFF_RGATE); const float* pd = WS<float>(p, OFF_PD);
    float* x1 = WS<float>(p, OFF_X1); const float* mod = WS<float>(p, OFF_MOD); float* ssqp = WS<float>(p, OFF_SSQP);
    const int x0 = (int)(xb_xcc_id() & 7u);
    const int cofs = j * 32 + 16 * (g & 1) + 8 * ((g >> 1) & 1) + 4 * (g >> 2);
#pragma unroll 1
    for (int so = 0; so < 8; ++so) {
        const int s = (x0 + so) & 7;
        unsigned* q = WS<unsigned>(p, OFF_BAR) + PS_Q_WORD + 64 + 8 * s;
        const unsigned char* tb = vtab + (size_t)s * NEXP * 192;
#pragma unroll 1
        for (;;) {
            const unsigned ch = ps_next(q, bc, tid);
            if (ch >= TOK / PS_CHUNK) break;
            int t = (int)ch * PS_CHUNK + wid;
            int i0 = __builtin_nontemporal_load(ridx + (size_t)t * 128 + lane), i1 = __builtin_nontemporal_load(ridx + (size_t)t * 128 + 64 + lane);
            float d0 = 0.f, d1 = 0.f;
#pragma unroll
            for (int x = 0; x < 8; ++x) { d0 += __builtin_nontemporal_load(pd + ((size_t)x * TOK + t) * 128 + lane); d1 += __builtin_nontemporal_load(pd + ((size_t)x * TOK + t) * 128 + 64 + lane); }
            float g0 = __builtin_nontemporal_load(rgate + (size_t)t * 128 + lane), g1 = __builtin_nontemporal_load(rgate + (size_t)t * 128 + 64 + lane);
            u32x4_t a4[8], b4[8]; u32x2_t a2[8], b2[8];
            PS_LOADH(a4, a2, tb, i0);
#pragma unroll 1
            for (int k = 0; k < PS_CHUNK / 8; ++k, t += 8) {
                const int b = t >> 12, col = s * 256 + cofs;
                const float cf0 = g0 * gelu_exact(d0 * usc[i0]) * vsc[i0], cf1 = g1 * gelu_exact(d1 * usc[i1]) * vsc[i1];
                const float4 xv = *(const float4*)(x1 + (size_t)t * DM + col); const float4 gg = *(const float4*)(mod + (size_t)b * 12288 + 5 * 2048 + col);
                const bool more = k + 1 < PS_CHUNK / 8; const int tn = more ? t + 8 : t;
                const int n0 = __builtin_nontemporal_load(ridx + (size_t)tn * 128 + lane), n1 = __builtin_nontemporal_load(ridx + (size_t)tn * 128 + 64 + lane);
                float e0 = 0.f, e1 = 0.f;
#pragma unroll
                for (int x = 0; x < 8; ++x) { e0 += __builtin_nontemporal_load(pd + ((size_t)x * TOK + tn) * 128 + lane); e1 += __builtin_nontemporal_load(pd + ((size_t)x * TOK + tn) * 128 + 64 + lane); }
                const float ng0 = __builtin_nontemporal_load(rgate + (size_t)tn * 128 + lane), ng1 = __builtin_nontemporal_load(rgate + (size_t)tn * 128 + 64 + lane);
                float y[32];
#pragma unroll
                for (int qq = 0; qq < 32; ++qq) y[qq] = 0.f;
                PS_LOADH(b4, b2, tb, i1);
                PS_CV(a4, a2, cf0);
                if (more) PS_LOADH(a4, a2, tb, n0);
                PS_CV(b4, b2, cf1);
                float w16[16], w8[8], w4[4];
                { const bool hi = (g & 1) != 0;
#pragma unroll
                  for (int i = 0; i < 16; ++i) { const float send = hi ? y[i] : y[16 + i], keep = hi ? y[16 + i] : y[i]; w16[i] = keep + __shfl_xor(send, 8); } }
                { const bool hi = (g & 2) != 0;
#pragma unroll
                  for (int i = 0; i < 8; ++i) { const float send = hi ? w16[i] : w16[8 + i], keep = hi ? w16[8 + i] : w16[i]; w8[i] = keep + __shfl_xor(send, 16); } }
                { const bool hi = (g & 4) != 0;
#pragma unroll
                  for (int i = 0; i < 4; ++i) { const float send = hi ? w8[i] : w8[4 + i], keep = hi ? w8[4 + i] : w8[i]; w4[i] = keep + __shfl_xor(send, 32); } }
                float4 o; o.x = xv.x + gg.x * w4[0]; o.y = xv.y + gg.y * w4[1]; o.z = xv.z + gg.z * w4[2]; o.w = xv.w + gg.w * w4[3];
                *(float4*)(x1 + (size_t)t * DM + col) = o;
                const float ss = wave_sum(o.x * o.x + o.y * o.y + o.z * o.z + o.w * o.w);
                if (lane == 0) ssqp[(size_t)s * TOK + t] = ss;
                i0 = n0; i1 = n1; d0 = e0; d1 = e1; g0 = ng0; g1 = ng1;
            }
        }
    }
}
__device__ __forceinline__ void phase_peer_final(const Params& p, int bid, int nblk) {
    const int tidf = tid_fresh(p.widx), lane = tidf & 63, wid = tidf >> 6;
    const float* x2 = WS<float>(p, OFF_X1); const float* ssqp = WS<float>(p, OFF_SSQP);
    for (int t = bid * 8 + wid; t < TOK; t += nblk * 8) {
        float ss = 0.f;
#pragma unroll
        for (int s = 0; s < 8; ++s) ss += ssqp[(size_t)s * TOK + t];
        const float rstd = rsqrtf(ss * (1.0f / DM) + EPS);
#pragma unroll
        for (int jj = 0; jj < 8; ++jj) { const int col = (jj * 64 + lane) * 4;
            const float4 v = *(const float4*)(x2 + (size_t)t * DM + col), fg = *(const float4*)(p.fin_g + col);
            float4 o; o.x = v.x * rstd * fg.x; o.y = v.y * rstd * fg.y; o.z = v.z * rstd * fg.z; o.w = v.w * rstd * fg.w;
            *(float4*)(p.out + (size_t)t * DM + col) = o; }
    }
}

constexpr int NPHASE = 12;
#ifndef USE_FAST_ROUTE
#define USE_FAST_ROUTE 1
#endif
#ifndef USE_FAST_PEER
#define USE_FAST_PEER 1
#endif
#ifndef USE_MFMA_ATTN
#define USE_MFMA_ATTN 1
#endif
#ifndef USE_MFMA_GEMM
#define USE_MFMA_GEMM 1
#endif
#if USE_MFMA_GEMM
#define GEMM(A, Bt, M, N, K, E) gemm_mfma(A, Bt, M, N, K, E, bid, nblk, (unsigned char*)lds, p.widx)
#else
#define GEMM(A, Bt, M, N, K, E) gemm_ref(A, K, Bt, K, M, N, K, E, bid, nblk)
#endif
template <int PH, int RERUN = 0> __device__ __forceinline__ void run_phase(const Params& p, int bid, int nblk, float* lds) {
    if (PH == 0) phase0(p, bid, nblk, lds);
    if (PH == 1) phase_norm_mod(p, p.x, p.norm1_g, 0, 1, WS<bf16_t>(p, OFF_H), bid, nblk, lds);
    if (PH == 2) { EpiInProj E{WS<bf16_t>(p, OFF_QSB), WS<bf16_t>(p, OFF_KSB), WS<bf16_t>(p, OFF_VSB), WS<bf16_t>(p, OFF_CQ), WS<bf16_t>(p, OFF_CKV), WS<bf16_t>(p, OFF_KMLA),
                                WS<float>(p, OFF_COS), WS<float>(p, OFF_SIN), WS<float>(p, OFF_RSP)};
        GEMM(WS<bf16_t>(p, OFF_H), WS<bf16_t>(p, OFF_WIN_T), TOK, NINP, DM, E); }
    if (PH == 3) phase_rowstats(p, bid, nblk);
    if (PH == 4) { EpiUq E1{WS<bf16_t>(p, OFF_QMLA), WS<float>(p, OFF_RSP), WS<float>(p, OFF_COS), WS<float>(p, OFF_SIN)};
        GEMM(WS<bf16_t>(p, OFF_CQ), WS<bf16_t>(p, OFF_WUQ_T), TOK, 1536, 512, E1);
        EpiUkv E2{WS<bf16_t>(p, OFF_KMLA), WS<bf16_t>(p, OFF_VMLA), WS<float>(p, OFF_RSP)};
        GEMM(WS<bf16_t>(p, OFF_CKV), WS<bf16_t>(p, OFF_WUKV_T), TOK, 2048, 256, E2); }
#if USE_MFMA_ATTN
    if (PH == 5) phase_attn_mfma(p, lds, RERUN);
#else
    if (PH == 5) phase_attn_ref(p, bid, nblk);
#endif
    if (PH == 6) phase_onorm(p, bid, nblk);
    if (PH == 7) { EpiWo E{p.x, WS<float>(p, OFF_MOD), WS<float>(p, OFF_X1), WS<float>(p, OFF_SSQ)};
        GEMM(WS<bf16_t>(p, OFF_O), WS<bf16_t>(p, OFF_WO_T), TOK, DM, DM, E); }
    if (PH == 8) phase_norm_mod(p, WS<float>(p, OFF_X1), p.norm2_g, 3, 4, WS<bf16_t>(p, OFF_H), bid, nblk, lds);
    if (PH == 9) { EpiQp E{WS<bf16_t>(p, OFF_QP)};
        GEMM(WS<bf16_t>(p, OFF_H), WS<bf16_t>(p, OFF_WPQ_T), TOK, DM, DM, E); }
#if USE_FAST_ROUTE
    if (PH == 10) phase_route_mfma(p, bid, nblk, lds);
#else
    if (PH == 10) phase_route_ref(p, bid, nblk);
#endif
#if USE_FAST_PEER && PEER_SLICED
    if (PH == 11) phase_peer_u_sliced(p, lds);
    if (PH == 12) phase_peer_v_sliced(p, lds);
    if (PH == 13) phase_peer_final(p, bid, nblk);
#elif USE_FAST_PEER && PEER_SPLIT && TAB_EB == 6
    if (PH == 11) phase_peer_u6(p, bid, nblk);
    if (PH == 12) phase_peer_v6(p, bid, nblk);
#elif USE_FAST_PEER
    if (PH == 11) { if (TAB_EB == 6) phase_peer_gather6(p, bid, nblk); else phase_peer_gather<TAB_EB == 6 ? 1 : TAB_EB>(p, bid, nblk); }
#else
    if (PH == 11) phase_peer_ref(p, bid, nblk);
#endif
}

extern __shared__ __attribute__((aligned(16))) unsigned char dynlds[];
constexpr int LDS_MAIN = 131072;
constexpr int LDS_BYTES = LDS_MAIN + 16;

template <int PH> __global__ void __launch_bounds__(512, 2) k_phase(Params pin) {
    Params p = pin; p.widx = __builtin_amdgcn_readfirstlane((int)(threadIdx.x >> 6));
    run_phase<PH>(p, blockIdx.x, gridDim.x, (float*)dynlds);
}

__global__ void __launch_bounds__(512, 2) k_fused(Params pin) {
    Params p = pin; p.widx = __builtin_amdgcn_readfirstlane((int)(threadIdx.x >> 6));
    float* lds = (float*)dynlds;
    volatile LAS unsigned* xbw = (volatile LAS unsigned*)(dynlds + LDS_MAIN);
    if (xb_thread0(p.widx)) { xbw[0] = 0u; xbw[1] = 0u; xbw[2] = 0u; xbw[3] = 0u; }
    __syncthreads();
    XcdBarrier bar = xcd_barrier_post(WS<unsigned>(p, OFF_BAR), xbw, p.widx);
    const int bid = blockIdx.x, nblk = gridDim.x;
    run_phase<0>(p, bid, nblk, lds); if (PROBE_DOUBLE & (1 << 0)) run_phase<0, 1>(p, bid, nblk, lds); xcd_barrier(bar);
    run_phase<1>(p, bid, nblk, lds); if (PROBE_DOUBLE & (1 << 1)) run_phase<1, 1>(p, bid, nblk, lds); xcd_barrier(bar);
    run_phase<2>(p, bid, nblk, lds); if (PROBE_DOUBLE & (1 << 2)) run_phase<2, 1>(p, bid, nblk, lds); xcd_barrier(bar);
    run_phase<4>(p, bid, nblk, lds); if (PROBE_DOUBLE & (1 << 4)) run_phase<4, 1>(p, bid, nblk, lds); xcd_barrier(bar);
    run_phase<5>(p, bid, nblk, lds); if (PROBE_DOUBLE & (1 << 5)) run_phase<5, 1>(p, bid, nblk, lds); xcd_barrier(bar);
    run_phase<7>(p, bid, nblk, lds); if (PROBE_DOUBLE & (1 << 7)) run_phase<7, 1>(p, bid, nblk, lds); xcd_barrier(bar);
    run_phase<8>(p, bid, nblk, lds); if (PROBE_DOUBLE & (1 << 8)) run_phase<8, 1>(p, bid, nblk, lds); xcd_barrier(bar);
    run_phase<9>(p, bid, nblk, lds); if (PROBE_DOUBLE & (1 << 9)) run_phase<9, 1>(p, bid, nblk, lds); xcd_barrier(bar);
    run_phase<10>(p, bid, nblk, lds); if (PROBE_DOUBLE & (1 << 10)) run_phase<10, 1>(p, bid, nblk, lds); xcd_barrier(bar);
    run_phase<11>(p, bid, nblk, lds); if (PROBE_DOUBLE & (1 << 11)) run_phase<11, 1>(p, bid, nblk, lds);
#if USE_FAST_PEER && PEER_SLICED
    xcd_barrier(bar); run_phase<12>(p, bid, nblk, lds);
    xcd_barrier(bar); run_phase<13>(p, bid, nblk, lds);
#elif USE_FAST_PEER && PEER_SPLIT && TAB_EB == 6
    xcd_barrier(bar); run_phase<12>(p, bid, nblk, lds);
#endif
}

template <int PH> static void launch_phase(const Params& p, int grid, hipStream_t st) {
    hipLaunchKernelGGL((k_phase<PH>), dim3(grid), dim3(512), LDS_BYTES, st, p);
}

extern "C" void kernel_launch(void* const* d_in, const int* in_sizes, int n_in, void* d_out, int out_size, void* d_ws, size_t ws_size, hipStream_t stream) {
    Params p{};
    p.x = (const float*)d_in[0]; p.c = (const float*)d_in[1]; p.pos = (const int*)d_in[2]; p.w_ada = (const float*)d_in[3]; p.b_ada = (const float*)d_in[4];
    p.norm1_g = (const float*)d_in[5]; p.w_in = (const float*)d_in[6]; p.qn_g = (const float*)d_in[7]; p.w_uq = (const float*)d_in[8]; p.kvn_g = (const float*)d_in[9];
    p.w_ukv = (const float*)d_in[10]; p.osb_g = (const float*)d_in[11]; p.omla_g = (const float*)d_in[12]; p.w_o = (const float*)d_in[13]; p.norm2_g = (const float*)d_in[14];
    p.w_pq = (const float*)d_in[15]; p.keys1 = (const float*)d_in[16]; p.keys2 = (const float*)d_in[17]; p.u_tab = (const float*)d_in[18]; p.v_tab = (const float*)d_in[19];
    p.fin_g = (const float*)d_in[20]; p.out = (float*)d_out; p.ws = (unsigned char*)d_ws;
#if FUSED
    static int grid = 0;
    if (!grid) {
        int dev = 0, cus = 0, per_cu = 0;
        hipGetDevice(&dev);
        hipDeviceGetAttribute(&cus, hipDeviceAttributeMultiprocessorCount, dev);
        hipFuncSetAttribute((const void*)k_fused, hipFuncAttributeMaxDynamicSharedMemorySize, LDS_BYTES);
        hipOccupancyMaxActiveBlocksPerMultiprocessor(&per_cu, k_fused, 512, LDS_BYTES);
        grid = per_cu >= 1 ? cus : 0;
    }
    hipMemsetAsync((unsigned char*)d_ws + OFF_BAR, 0, 16384, stream);
    if (grid) hipLaunchKernelGGL(k_fused, dim3(grid), dim3(512), LDS_BYTES, stream, p);
#else
    const int G = 1024;
    launch_phase<0>(p, G, stream); launch_phase<1>(p, G, stream); launch_phase<2>(p, G, stream); launch_phase<3>(p, G, stream);
    launch_phase<4>(p, G, stream); launch_phase<5>(p, G, stream); launch_phase<6>(p, G, stream); launch_phase<7>(p, G, stream);
    launch_phase<8>(p, G, stream); launch_phase<9>(p, G, stream); launch_phase<10>(p, G, stream); launch_phase<11>(p, G, stream);
#endif
}
```

```cpp
#include <hip/hip_runtime.h>
#include <stdint.h>

#ifndef TAB_EB
#define TAB_EB 6
#endif
#ifndef ATT_ANTIPHASE
#define ATT_ANTIPHASE 1
#endif
#ifndef PEER_SPLIT
#define PEER_SPLIT 1
#endif
#ifndef PEER_SLICED
#define PEER_SLICED 0
#endif
#ifndef PROBE_ATTN_G
#define PROBE_ATTN_G 0
#endif
#ifndef PROBE_DOUBLE
#define PROBE_DOUBLE 0
#endif
#ifndef FUSED
#define FUSED 1
#endif

typedef unsigned short bf16_t;
#define LAS __attribute__((address_space(3)))
__device__ __forceinline__ int tid_fresh(int widx) { unsigned m = ~0u; asm volatile("" : "+s"(m)); int t = (widx << 6) | (int)__builtin_amdgcn_mbcnt_hi(m, __builtin_amdgcn_mbcnt_lo(m, 0u)); asm volatile("" : "+v"(t)); return t; }

constexpr int TOK = 8192, DM = 2048, SEQ = 4096, NB = 2;
constexpr int NIN = 3904, NINP = 4096;
constexpr int NEXP = 16384;
constexpr float EPS = 1e-6f;
constexpr float LOG2E = 1.4426950408889634f, LN2 = 0.6931471805599453f;
constexpr float QS_SB = 0.12751743082459868f;
constexpr float QS_MLA = 0.10411754627697264f;

constexpr size_t MiB = 1ull << 20;
constexpr size_t OFF_BAR = 0;
constexpr size_t OFF_MOD = 16384;
constexpr size_t OFF_COS = OFF_MOD + 98304;
constexpr size_t OFF_SIN = OFF_COS + MiB;
constexpr size_t OFF_RSQ = OFF_SIN + MiB;
constexpr size_t OFF_RSKV = OFF_RSQ + 32768;
constexpr size_t OFF_SSQ = OFF_RSKV + 32768;
constexpr size_t OFF_KEYS = OFF_SSQ + 524288;
constexpr size_t OFF_USC = OFF_KEYS + 524288;
constexpr size_t OFF_VSC = OFF_USC + 65536;
static_assert(OFF_VSC + 65536 <= 4 * MiB, "ws map");
constexpr size_t OFF_WIN_T = 4 * MiB;
constexpr size_t OFF_WUQ_T = OFF_WIN_T + 16 * MiB;
constexpr size_t OFF_WUKV_T = OFF_WUQ_T + 2 * MiB;
constexpr size_t OFF_WO_T = OFF_WUKV_T + 1 * MiB;
constexpr size_t OFF_WPQ_T = OFF_WO_T + 8 * MiB;
constexpr size_t OFF_H = OFF_WPQ_T + 8 * MiB;
constexpr size_t OFF_QSB = OFF_H + 32 * MiB;
constexpr size_t OFF_KSB = OFF_QSB + 16 * MiB;
constexpr size_t OFF_VSB = OFF_KSB + 16 * MiB;
constexpr size_t OFF_CQ = OFF_VSB + 16 * MiB;
constexpr size_t OFF_CKV = OFF_CQ + 8 * MiB;
constexpr size_t OFF_QMLA = OFF_CKV + 4 * MiB;
constexpr size_t OFF_KMLA = OFF_QMLA + 24 * MiB;
constexpr size_t OFF_VMLA = OFF_KMLA + 24 * MiB;
constexpr size_t OFF_O = OFF_VMLA + 16 * MiB;
constexpr size_t OFF_X1 = OFF_O + 32 * MiB;
constexpr size_t OFF_QP = OFF_X1 + 64 * MiB;
constexpr size_t OFF_RIDX = OFF_QP + 32 * MiB;
constexpr size_t OFF_RGATE = OFF_RIDX + 4 * MiB;
constexpr size_t OFF_UTAB = OFF_RGATE + 4 * MiB;
constexpr size_t OFF_VTAB = OFF_UTAB + 64 * MiB;
constexpr size_t OFF_PD = OFF_VTAB + 64 * MiB;
constexpr size_t OFF_SSQP = OFF_PD + 32 * MiB;
constexpr size_t OFF_RSP = OFF_SSQP + 1 * MiB;
constexpr size_t WS_END = OFF_RSP + 1 * MiB;

struct Params {
    const float* x; const float* c; const int* pos; const float* w_ada; const float* b_ada; const float* norm1_g;
    const float* w_in; const float* qn_g; const float* w_uq; const float* kvn_g; const float* w_ukv;
    const float* osb_g; const float* omla_g; const float* w_o; const float* norm2_g; const float* w_pq;
    const float* keys1; const float* keys2; const float* u_tab; const float* v_tab; const float* fin_g;
    float* out; unsigned char* ws;
    int widx; int pad_;
};
template <class Tp> __device__ __forceinline__ Tp* WS(const Params& p, size_t off) { return (Tp*)(p.ws + off); }

__device__ __forceinline__ float bf2f(bf16_t v) { return __uint_as_float(((unsigned)v) << 16); }
__device__ __forceinline__ bf16_t f2bf(float f) { unsigned u = __float_as_uint(f); u += 0x7fffu + ((u >> 16) & 1u); return (bf16_t)(u >> 16); }
__device__ __forceinline__ unsigned pack2(float lo, float hi) { return (unsigned)f2bf(lo) | ((unsigned)f2bf(hi) << 16); }
__device__ __forceinline__ float lo_f(unsigned u) { return __uint_as_float(u << 16); }
__device__ __forceinline__ float hi_f(unsigned u) { return __uint_as_float(u & 0xffff0000u); }
__device__ __forceinline__ float dot8(uint4 a, uint4 b) {
    float s = lo_f(a.x) * lo_f(b.x); s += hi_f(a.x) * hi_f(b.x);
    s += lo_f(a.y) * lo_f(b.y); s += hi_f(a.y) * hi_f(b.y);
    s += lo_f(a.z) * lo_f(b.z); s += hi_f(a.z) * hi_f(b.z);
    s += lo_f(a.w) * lo_f(b.w); s += hi_f(a.w) * hi_f(b.w);
    return s;
}
__device__ __forceinline__ float wave_sum(float v) {
#pragma unroll
    for (int o = 32; o > 0; o >>= 1) v += __shfl_xor(v, o);
    return v;
}
__device__ __forceinline__ float gelu_exact(float x) { return 0.5f * x * (1.0f + erff(x * 0.70710678118654752f)); }

struct EpiInProj {
    static constexpr bool HAS_MID = false;
    bf16_t *qsb, *ksb, *vsb, *cq, *ckv, *kmla; const float *cosT, *sinT; float* rsp;
    __device__ __forceinline__ float row_scale(int) const { return 1.0f; }
    __device__ __forceinline__ float mid_scale(int) const { return 1.0f; }
    __device__ __forceinline__ void store8(int row, int col0, const float (&v)[8], float) const {
        if (col0 >= NIN) return;
        uint4 w;
        if (col0 < 3840) {
            float s = col0 < 1024 ? QS_SB : 1.0f;
            w.x = pack2(v[0] * s, v[1] * s); w.y = pack2(v[2] * s, v[3] * s); w.z = pack2(v[4] * s, v[5] * s); w.w = pack2(v[6] * s, v[7] * s);
            bf16_t* dst;
            if (col0 < 1024) dst = qsb + (size_t)row * 1024 + col0;
            else if (col0 < 2048) dst = ksb + (size_t)row * 1024 + (col0 - 1024);
            else if (col0 < 3072) dst = vsb + (size_t)row * 1024 + (col0 - 2048);
            else if (col0 < 3584) dst = cq + (size_t)row * 512 + (col0 - 3072);
            else dst = ckv + (size_t)row * 256 + (col0 - 3584);
            *(uint4*)dst = w;
            if (col0 >= 3072) {
                float ss = lo_f(w.x) * lo_f(w.x) + hi_f(w.x) * hi_f(w.x) + lo_f(w.y) * lo_f(w.y) + hi_f(w.y) * hi_f(w.y)
                         + lo_f(w.z) * lo_f(w.z) + hi_f(w.z) * hi_f(w.z) + lo_f(w.w) * lo_f(w.w) + hi_f(w.w) * hi_f(w.w);
                ss += __shfl_xor(ss, 16); ss += __shfl_xor(ss, 32);
                if ((tid_fresh(0) & 48) == 0) rsp[(size_t)row * 24 + ((col0 - 3072) >> 5)] = ss;
            }
        } else {
            const int e0 = col0 - 3840, i0 = e0 >> 1;
            float o[8];
#pragma unroll
            for (int j = 0; j < 4; ++j) {
                const float cs = cosT[(size_t)row * 32 + i0 + j], sn = sinT[(size_t)row * 32 + i0 + j];
                const float x1 = v[2 * j], x2 = v[2 * j + 1];
                o[2 * j] = x1 * cs - x2 * sn; o[2 * j + 1] = x2 * cs + x1 * sn;
            }
            w.x = pack2(o[0], o[1]); w.y = pack2(o[2], o[3]); w.z = pack2(o[4], o[5]); w.w = pack2(o[6], o[7]);
#pragma unroll
            for (int h = 0; h < 8; ++h) *(uint4*)(kmla + (size_t)row * 1536 + h * 192 + 128 + e0) = w;
        }
    }
};
struct EpiUq {
    static constexpr bool HAS_MID = false;
    bf16_t* qmla; const float *rsp, *cosT, *sinT; const LAS float* tab; int tab_pm;
    __device__ __forceinline__ float mid_scale(int) const { return 1.0f; }
    __device__ __forceinline__ float slow_scale(int row) const { float s = 0.f;
#pragma unroll
        for (int i = 0; i < 16; ++i) s += rsp[(size_t)row * 24 + i];
        return rsqrtf(s * (1.0f / 512.0f) + EPS) * QS_MLA; }
    __device__ __forceinline__ float row_scale(int row) const { return (row >> 8) == tab_pm ? tab[row & 255] : slow_scale(row); }
    __device__ __forceinline__ void store8(int row, int col0, const float (&v)[8], float r) const {
        const int d0 = col0 % 192;
        float o[8];
        if (d0 < 128) {
#pragma unroll
            for (int j = 0; j < 8; ++j) o[j] = v[j] * r;
        } else {
            const int i0 = (d0 - 128) >> 1;
#pragma unroll
            for (int j = 0; j < 4; ++j) {
                const float cs = cosT[(size_t)row * 32 + i0 + j], sn = sinT[(size_t)row * 32 + i0 + j];
                const float x1 = v[2 * j], x2 = v[2 * j + 1];
                o[2 * j] = (x1 * cs - x2 * sn) * r; o[2 * j + 1] = (x2 * cs + x1 * sn) * r;
            }
        }
        uint4 w; w.x = pack2(o[0], o[1]); w.y = pack2(o[2], o[3]); w.z = pack2(o[4], o[5]); w.w = pack2(o[6], o[7]);
        *(uint4*)(qmla + (size_t)row * 1536 + col0) = w;
    }
};
struct EpiUkv {
    static constexpr bool HAS_MID = false;
    bf16_t *kmla, *vmla; const float* rsp; const LAS float* tab; int tab_pm;
    __device__ __forceinline__ float mid_scale(int) const { return 1.0f; }
    __device__ __forceinline__ float slow_scale(int row) const { float s = 0.f;
#pragma unroll
        for (int i = 0; i < 8; ++i) s += rsp[(size_t)row * 24 + 16 + i];
        return rsqrtf(s * (1.0f / 256.0f) + EPS); }
    __device__ __forceinline__ float row_scale(int row) const { return (row >> 8) == tab_pm ? tab[row & 255] : slow_scale(row); }
    __device__ __forceinline__ void store8(int row, int col0, const float (&v)[8], float r) const {
        const int h = col0 >> 8, j0 = col0 & 255;
        uint4 w; w.x = pack2(v[0] * r, v[1] * r); w.y = pack2(v[2] * r, v[3] * r); w.z = pack2(v[4] * r, v[5] * r); w.w = pack2(v[6] * r, v[7] * r);
        bf16_t* dst = j0 < 128 ? kmla + (size_t)row * 1536 + h * 192 + j0 : vmla + (size_t)row * 1024 + h * 128 + (j0 - 128);
        *(uint4*)dst = w;
    }
};
struct EpiWo {
    static constexpr bool HAS_MID = true;
    const float* x; const float* mod; bf16_t* x1; const float* ssq; const LAS float* tab; int tab_pm;
    __device__ __forceinline__ void rstd2(int row, float& r0, float& r1) const { float s0 = 0.f, s1 = 0.f;
#pragma unroll
        for (int h = 0; h < 8; ++h) { s0 += ssq[(size_t)row * 16 + h]; s1 += ssq[(size_t)row * 16 + 8 + h]; }
        r0 = rsqrtf(s0 * (1.0f / 1024.0f) + EPS); r1 = rsqrtf(s1 * (1.0f / 1024.0f) + EPS); }
    __device__ __forceinline__ float mid_scale(int row) const { if ((row >> 8) == tab_pm) return tab[2 * (row & 255)]; float r0, r1; rstd2(row, r0, r1); return r0 / r1; }
    __device__ __forceinline__ float row_scale(int row) const { if ((row >> 8) == tab_pm) return tab[2 * (row & 255) + 1]; float r0, r1; rstd2(row, r0, r1); return r1; }
    __device__ __forceinline__ void store8(int row, int col0, const float (&vin)[8], float rsc) const {
        float v[8];
#pragma unroll
        for (int i = 0; i < 8; ++i) v[i] = vin[i] * rsc;
        const int b = row >> 12;
        const float* g1 = mod + (size_t)b * 12288 + 2 * 2048 + col0;
        const float4 xa = *(const float4*)(x + (size_t)row * DM + col0), xb = *(const float4*)(x + (size_t)row * DM + col0 + 4);
        const float4 ga = *(const float4*)g1, gb = *(const float4*)(g1 + 4);
        float4 oa, ob;
        oa.x = xa.x + ga.x * v[0]; oa.y = xa.y + ga.y * v[1]; oa.z = xa.z + ga.z * v[2]; oa.w = xa.w + ga.w * v[3];
        ob.x = xb.x + gb.x * v[4]; ob.y = xb.y + gb.y * v[5]; ob.z = xb.z + gb.z * v[6]; ob.w = xb.w + gb.w * v[7];
        uint4 w; w.x = pack2(oa.x, oa.y); w.y = pack2(oa.z, oa.w); w.z = pack2(ob.x, ob.y); w.w = pack2(ob.z, ob.w);
        *(uint4*)(x1 + (size_t)row * DM + col0) = w;
    }
};
struct EpiQp {
    static constexpr bool HAS_MID = false;
    bf16_t* qp;
    __device__ __forceinline__ float row_scale(int) const { return 1.0f; }
    __device__ __forceinline__ float mid_scale(int) const { return 1.0f; }
    __device__ __forceinline__ void store8(int row, int col0, const float (&v)[8], float) const {
        uint4 w; w.x = pack2(v[0], v[1]); w.y = pack2(v[2], v[3]); w.z = pack2(v[4], v[5]); w.w = pack2(v[6], v[7]);
        *(uint4*)(qp + (size_t)row * DM + col0) = w;
    }
};

namespace pg8 {
#define PG8_LAS __attribute__((address_space(3)))
typedef unsigned short bf16_t;
typedef short bf16x8 __attribute__((ext_vector_type(8)));
typedef float f32x4 __attribute__((ext_vector_type(4)));
typedef unsigned u32x4 __attribute__((ext_vector_type(4)));
constexpr int BM = 256, BK = 64, HALF = 128, HTB = HALF * BK * 2  , STAGE_BYTES = 8 * HTB, NXCD = 8, WGM = 8;

__host__ __device__ __forceinline__ int lds_byte(int r, int c) { const int st = (r >> 4) * 2 + (c >> 5), rr = r & 15, cc = c & 31, ob = rr * 64 + cc * 2; return st * 1024 + (ob ^ (((ob >> 9) & 1) << 5)); }
__host__ __device__ __forceinline__ void stage_rc(int b, int& R, int& C) { const int st = b / 1024, sb = b % 1024, swz = sb ^ (((sb >> 9) & 1) << 5); R = (st >> 1) * 16 + swz / 64; C = (st & 1) * 32 + (swz % 64) / 2; }
__host__ __device__ __forceinline__ int perm32(int rho) { const int n = rho >> 4, i = rho & 15; return 8 * (i >> 2) + 4 * n + (i & 3); }

struct Unit { int pm, pn; };
struct Gemm { const bf16_t* A; const bf16_t* Bt; int M, N, K, widx; };

struct StaticOrder {
    int nM, nN, nwg, G, c;
    __host__ __device__ __forceinline__ void init(int M, int N, int G_, int c_) { nM = M / BM; nN = N / BM; nwg = nM * nN; G = G_; c = c_; }
    __host__ __device__ bool next(int i, Unit& u) const {
        const long L = (long)i * G + c; if (L >= nwg) return false;
        int wgid = (int)L; { const int q = nwg / NXCD, r = nwg % NXCD, xcd = wgid % NXCD, off = wgid / NXCD; wgid = (xcd < r ? xcd * (q + 1) : r * (q + 1) + (xcd - r) * q) + off; }
        const int nig = WGM * nN, gid = wgid / nig, fm = gid * WGM, gsz = (nM - fm) < WGM ? (nM - fm) : WGM;
        u.pm = fm + ((wgid % nig) % gsz); u.pn = (wgid % nig) / gsz; return true;
    }
    __device__ __forceinline__ void a_ready(const Unit&) const {}
    __device__ __forceinline__ void done(const Unit&) const {}
};

template <class Epi, class Sched, bool ALIGN_EPI = false, bool SP2 = false>
__device__ __forceinline__ void gemm_phase(PG8_LAS unsigned char* lds, const Gemm g, const Sched& S, const Epi& E) {
    const int tid = tid_fresh(g.widx), wid = __builtin_amdgcn_readfirstlane(tid >> 6), lane = tid & 63, wr = wid >> 2, wc = wid & 3, fr = lane & 15, fq = lane >> 4;
    const int K = g.K, nt = K / BK;
    unsigned voffA[2], voffB[2];
#pragma unroll
    for (int i = 0; i < 2; ++i) { int R, C; stage_rc(tid * 16 + i * 8192, R, C); const int Rb = Epi::PERM ? ((R & ~31) + perm32(R & 31)) : R;
        voffA[i] = (unsigned)(R * K + C) * 2u; voffB[i] = (unsigned)(Rb * K + C) * 2u; }
    const size_t kstep = (size_t)(BK * 2);
    const size_t hstep = (size_t)HALF * K * 2;
    const size_t tstep = 2 * hstep;
    const unsigned ldsw = (unsigned)wid * 1024u;
    const int aoff = lds_byte(wr * 64 + fr, fq * 8), boff = lds_byte(wc * 32 + fr, fq * 8);
#define PG8_SA(b, h) (((b) * 2 + (h)) * HTB)
#define PG8_SB(b, h) ((4 + (b) * 2 + (h)) * HTB)
#define PG8_STAGE(bufoff, gbase, voff) do { _Pragma("unroll") for (int _i = 0; _i < 2; ++_i) \
        __builtin_amdgcn_global_load_lds((const unsigned*)((const char*)(gbase) + (voff)[_i]), (PG8_LAS unsigned*)(lds + (bufoff) + ldsw + _i * 8192), 16, 0, 0); } while (0)
#define PG8_LDA(dst, b, h) do { _Pragma("unroll") for (int m = 0; m < 4; ++m) _Pragma("unroll") for (int k = 0; k < 2; ++k) dst[m][k] = *(const PG8_LAS bf16x8*)(lds + PG8_SA(b, h) + aoff + m * 2048 + k * 1024); } while (0)
#define PG8_LDB(dst, b, h) do { _Pragma("unroll") for (int n = 0; n < 2; ++n) _Pragma("unroll") for (int k = 0; k < 2; ++k) dst[n][k] = *(const PG8_LAS bf16x8*)(lds + PG8_SB(b, h) + boff + n * 2048 + k * 1024); } while (0)
#define PG8_MMA(ai, bj, At, Bt) do { __builtin_amdgcn_s_setprio(1); _Pragma("unroll") for (int m = 0; m < 4; ++m) _Pragma("unroll") for (int n = 0; n < 2; ++n) _Pragma("unroll") for (int k = 0; k < 2; ++k) \
        acc[ai][bj][m][n] = __builtin_amdgcn_mfma_f32_16x16x32_bf16(Bt[n][k], At[m][k], acc[ai][bj][m][n], 0, 0, 0); __builtin_amdgcn_s_setprio(0); } while (0)
#define PG8_WAIT_V(n) asm volatile("s_waitcnt vmcnt(" #n ")" ::: "memory")
#define PG8_WAIT_L(n) asm volatile("s_waitcnt lgkmcnt(" #n ")" ::: "memory")
#define PG8_BAR __builtin_amdgcn_s_barrier()
#define PG8_SCHED __builtin_amdgcn_sched_barrier(0)
    Unit cur, nxt; int ui = 0;
    if (!S.next(0, cur)) return;
    f32x4 acc[2][2][4][2];
#pragma unroll
    for (int a = 0; a < 2; ++a)
#pragma unroll
        for (int b = 0; b < 2; ++b)
#pragma unroll
            for (int m = 0; m < 4; ++m)
#pragma unroll
                for (int n = 0; n < 2; ++n) acc[a][b][m][n] = (f32x4){0.f, 0.f, 0.f, 0.f};
    bf16x8 At[4][2], B0[2][2], B1[2][2];
    const char* cA = (const char*)g.A + (size_t)cur.pm * tstep; const char* cB = (const char*)g.Bt + (size_t)cur.pn * tstep;
    S.a_ready(cur);
    if constexpr (SP2) {
        PG8_STAGE(PG8_SB(0, 0), cB, voffB); PG8_STAGE(PG8_SB(0, 1), cB + hstep, voffB); PG8_STAGE(PG8_SA(0, 0), cA, voffA); PG8_STAGE(PG8_SA(0, 1), cA + hstep, voffA);
        if (wr == 1) PG8_BAR;
        PG8_WAIT_V(2); PG8_BAR;
        PG8_STAGE(PG8_SB(1, 0), cB + kstep, voffB); PG8_STAGE(PG8_SA(1, 0), cA + kstep, voffA); PG8_STAGE(PG8_SB(1, 1), cB + hstep + kstep, voffB);
        PG8_WAIT_V(6); PG8_BAR;
    } else {
        PG8_STAGE(PG8_SB(0, 0), cB, voffB); PG8_STAGE(PG8_SA(0, 0), cA, voffA); PG8_STAGE(PG8_SB(0, 1), cB + hstep, voffB); PG8_STAGE(PG8_SA(0, 1), cA + hstep, voffA);
        if (wr == 1) PG8_BAR;
        PG8_WAIT_V(4); PG8_BAR;
        PG8_STAGE(PG8_SB(1, 0), cB + kstep, voffB); PG8_STAGE(PG8_SA(1, 0), cA + kstep, voffA); PG8_STAGE(PG8_SB(1, 1), cB + hstep + kstep, voffB);
        PG8_WAIT_V(6); PG8_BAR;
    }
    for (;;) {
        const bool has_next = S.next(ui + 1, nxt);
        const char* nA = has_next ? (const char*)g.A + (size_t)nxt.pm * tstep : cA; const char* nB = has_next ? (const char*)g.Bt + (size_t)nxt.pn * tstep : cB;
        for (int t = 0; t < nt; t += 2) {
            const bool last = (t == nt - 2);
            const char* a1 = cA + (size_t)(t + 1) * kstep;
            const char* a2 = last ? nA : cA + (size_t)(t + 2) * kstep; const char* b2 = last ? nB : cB + (size_t)(t + 2) * kstep;
            const char* a3 = a2 + kstep; const char* b3 = b2 + kstep;
            if (last && has_next) S.a_ready(nxt);
            if constexpr (Epi::HAS_MID) { if (t == (nt >> 1)) E.mid(acc, cur, wr, wc, fr, fq); }
            if constexpr (SP2) {
            PG8_LDB(B0, 0, 0); PG8_LDB(B1, 0, 1); PG8_SCHED; PG8_LDA(At, 0, 0); PG8_STAGE(PG8_SA(1, 1), a1 + hstep, voffA);
            PG8_WAIT_V(8); PG8_WAIT_L(0); PG8_BAR; PG8_MMA(0, 0, At, B0); PG8_MMA(0, 1, At, B1); PG8_BAR; PG8_SCHED;
            PG8_LDA(At, 0, 1); PG8_STAGE(PG8_SB(0, 0), b2, voffB); PG8_STAGE(PG8_SB(0, 1), b2 + hstep, voffB); PG8_STAGE(PG8_SA(0, 0), a2, voffA);
            PG8_WAIT_V(8); PG8_WAIT_L(0); PG8_BAR; PG8_MMA(1, 0, At, B0); PG8_MMA(1, 1, At, B1); PG8_BAR; PG8_SCHED;
            PG8_LDB(B0, 1, 0); PG8_LDB(B1, 1, 1); PG8_SCHED; PG8_LDA(At, 1, 0); PG8_STAGE(PG8_SA(0, 1), a2 + hstep, voffA);
            PG8_WAIT_V(8); PG8_WAIT_L(0); PG8_BAR; PG8_MMA(0, 0, At, B0); PG8_MMA(0, 1, At, B1); PG8_BAR; PG8_SCHED;
            PG8_LDA(At, 1, 1); PG8_STAGE(PG8_SB(1, 0), b3, voffB); PG8_STAGE(PG8_SB(1, 1), b3 + hstep, voffB); PG8_STAGE(PG8_SA(1, 0), a3, voffA);
            PG8_WAIT_V(8); PG8_WAIT_L(0); PG8_BAR; PG8_MMA(1, 0, At, B0); PG8_MMA(1, 1, At, B1); PG8_BAR; PG8_SCHED;
            } else {
            PG8_LDB(B0, 0, 0); PG8_SCHED; PG8_LDA(At, 0, 0); PG8_STAGE(PG8_SA(1, 1), a1 + hstep, voffA);
            PG8_WAIT_L(8); PG8_BAR; PG8_WAIT_L(0); PG8_MMA(0, 0, At, B0); PG8_BAR; PG8_SCHED;
            PG8_LDB(B1, 0, 1); PG8_STAGE(PG8_SB(0, 0), b2, voffB);
            PG8_BAR; PG8_WAIT_L(0); PG8_MMA(0, 1, At, B1); PG8_BAR;
            PG8_LDA(At, 0, 1); PG8_STAGE(PG8_SA(0, 0), a2, voffA);
            PG8_BAR; PG8_WAIT_L(0); PG8_MMA(1, 0, At, B0); PG8_BAR; PG8_SCHED;
            PG8_STAGE(PG8_SB(0, 1), b2 + hstep, voffB);
            PG8_WAIT_V(6); PG8_BAR; PG8_MMA(1, 1, At, B1); PG8_BAR;
            PG8_LDB(B0, 1, 0); PG8_SCHED; PG8_LDA(At, 1, 0); PG8_STAGE(PG8_SA(0, 1), a2 + hstep, voffA);
            PG8_WAIT_L(8); PG8_BAR; PG8_WAIT_L(0); PG8_MMA(0, 0, At, B0); PG8_BAR; PG8_SCHED;
            PG8_LDB(B1, 1, 1); PG8_STAGE(PG8_SB(1, 0), b3, voffB);
            PG8_BAR; PG8_WAIT_L(0); PG8_MMA(0, 1, At, B1); PG8_BAR;
            PG8_LDA(At, 1, 1); PG8_STAGE(PG8_SA(1, 0), a3, voffA);
            PG8_BAR; PG8_WAIT_L(0); PG8_MMA(1, 0, At, B0); PG8_BAR; PG8_SCHED;
            PG8_STAGE(PG8_SB(1, 1), b3 + hstep, voffB);
            PG8_WAIT_V(6); PG8_BAR; PG8_MMA(1, 1, At, B1); PG8_BAR;
            }
        }
        if constexpr (ALIGN_EPI) { if (wr == 0) PG8_BAR; }
        if constexpr (!Epi::AFTER_DRAIN) { E(acc, cur, wr, wc, fr, fq); S.done(cur); }
        if (!has_next) break;
#pragma unroll
        for (int a = 0; a < 2; ++a)
#pragma unroll
            for (int b = 0; b < 2; ++b)
#pragma unroll
                for (int m = 0; m < 4; ++m)
#pragma unroll
                    for (int n = 0; n < 2; ++n) acc[a][b][m][n] = (f32x4){0.f, 0.f, 0.f, 0.f};
        cur = nxt; cA = nA; cB = nB; ++ui;
        if constexpr (ALIGN_EPI) { if (wr == 1) PG8_BAR; }
    }
    PG8_WAIT_V(0);
    if constexpr (!ALIGN_EPI) { if (wr == 0) PG8_BAR; }
    PG8_BAR;
    if constexpr (Epi::AFTER_DRAIN) { E.fused(acc, cur, wr, wc, fr, fq, lds, wid, lane); S.done(cur); }
#undef PG8_SA
#undef PG8_SB
#undef PG8_STAGE
#undef PG8_LDA
#undef PG8_LDB
#undef PG8_MMA
#undef PG8_WAIT_V
#undef PG8_WAIT_L
#undef PG8_BAR
#undef PG8_SCHED
}
}

template <class C> struct EpiChunk {
    static constexpr bool PERM = true, AFTER_DRAIN = false, HAS_MID = C::HAS_MID;
    C c;
    __device__ __forceinline__ void mid(pg8::f32x4 (&acc)[2][2][4][2], const pg8::Unit& u, int wr, int wc, int fr, int fq) const {
#pragma unroll
        for (int ai = 0; ai < 2; ++ai)
#pragma unroll
            for (int m = 0; m < 4; ++m) { const float f = c.mid_scale(u.pm * 256 + ai * 128 + wr * 64 + m * 16 + fr);
#pragma unroll
                for (int bj = 0; bj < 2; ++bj)
#pragma unroll
                    for (int n = 0; n < 2; ++n) acc[ai][bj][m][n] = acc[ai][bj][m][n] * f; }
    }
    __device__ __forceinline__ void operator()(const pg8::f32x4 (&acc)[2][2][4][2], const pg8::Unit& u, int wr, int wc, int fr_in, int fq_in) const {
        int fr = fr_in, fq = fq_in; asm volatile("" : "+v"(fr), "+v"(fq));
#pragma unroll
        for (int ai = 0; ai < 2; ++ai)
#pragma unroll
            for (int m = 0; m < 4; ++m) {
                const int row = u.pm * 256 + ai * 128 + wr * 64 + m * 16 + fr;
                const float rsc = c.row_scale(row);
#pragma unroll
                for (int bj = 0; bj < 2; ++bj) {
                    const int col0 = u.pn * 256 + bj * 128 + wc * 32 + 8 * fq;
                    const pg8::f32x4 a = acc[ai][bj][m][0], b = acc[ai][bj][m][1];
                    const float v[8] = {a[0], a[1], a[2], a[3], b[0], b[1], b[2], b[3]};
                    c.store8(row, col0, v, rsc);
                }
                asm volatile("" ::: "memory");
            }
    }
};
template <class C> __device__ __forceinline__ void gemm_mfma(const bf16_t* A, const bf16_t* Bt, int M, int N, int K, const C& c, int bid, int nblk, unsigned char* lds, int widx) {
    pg8::Gemm g; g.A = A; g.Bt = Bt; g.M = M; g.N = N; g.K = K; g.widx = widx;
    pg8::StaticOrder S; S.init(M, N, nblk, bid);
    EpiChunk<C> E{c};
    pg8::gemm_phase<EpiChunk<C>, pg8::StaticOrder, true, true>((PG8_LAS unsigned char*)lds, g, S, E);
}

template <class Epi>
__device__ __forceinline__ void gemm_ref(const bf16_t* A, int lda, const bf16_t* Bt, int ldb, int M, int N, int K, const Epi& E, int bid, int nblk) {
    const int tid = (int)threadIdx.x, tn = N / 64, ntile = (M / 64) * tn;
    for (int tile = bid; tile < ntile; tile += nblk) {
        const int row = (tile / tn) * 64 + (tid >> 3), col0 = (tile % tn) * 64 + (tid & 7) * 8;
        float acc[8];
#pragma unroll
        for (int j = 0; j < 8; ++j) acc[j] = 0.f;
        const bf16_t* ap = A + (size_t)row * lda; const bf16_t* bp = Bt + (size_t)col0 * ldb;
        for (int k0 = 0; k0 < K; k0 += 8) {
            const uint4 av = *(const uint4*)(ap + k0);
#pragma unroll
            for (int j = 0; j < 8; ++j) { const uint4 bv = *(const uint4*)(bp + (size_t)j * ldb + k0); acc[j] += dot8(av, bv); }
        }
        E.store8(row, col0, acc, E.row_scale(row));
    }
}

constexpr int J_ADA = 192, J_WIN = 64, J_WO = 32, J_WPQ = 32, J_WUQ = 24, J_WUKV = 32, J_KEYS = 16, J_ROPE = 16;
constexpr int J0_END = J_ADA, J1_END = J0_END + J_WIN, J2_END = J1_END + J_WO, J3_END = J2_END + J_WPQ, J4_END = J3_END + J_WUQ,
              J5_END = J4_END + J_WUKV, J6_END = J5_END + J_KEYS, J7_END = J6_END + J_ROPE, J8_END = J7_END + 1024;

__device__ __forceinline__ void job_ada(const Params& p, int it, float* lds) {
    const int tid = tid_fresh(p.widx);
    float* sc = lds;
    float* red = lds + 4096;
    for (int i = tid; i < 4096; i += 512) { const float v = p.c[i]; sc[i] = v / (1.0f + __expf(-v)); }
    __syncthreads();
    const int cg = tid & 15, rl = tid >> 4, c0 = it * 64 + cg * 4;
    float4 a0 = {0.f, 0.f, 0.f, 0.f}, a1 = {0.f, 0.f, 0.f, 0.f};
#pragma unroll 8
    for (int i = 0; i < 64; ++i) {
        const int k = rl + 32 * i;
        const float4 w = *(const float4*)(p.w_ada + (size_t)k * 12288 + c0);
        const float s0 = sc[k], s1 = sc[2048 + k];
        a0.x += s0 * w.x; a0.y += s0 * w.y; a0.z += s0 * w.z; a0.w += s0 * w.w;
        a1.x += s1 * w.x; a1.y += s1 * w.y; a1.z += s1 * w.z; a1.w += s1 * w.w;
    }
    float* r0 = red + rl * 128 + cg * 4;
    r0[0] = a0.x; r0[1] = a0.y; r0[2] = a0.z; r0[3] = a0.w; r0[64] = a1.x; r0[65] = a1.y; r0[66] = a1.z; r0[67] = a1.w;
    __syncthreads();
    if (tid < 128) {
        float s = 0.f;
        for (int r = 0; r < 32; ++r) s += red[r * 128 + tid];
        const int b = tid >> 6, col = it * 64 + (tid & 63);
        WS<float>(p, OFF_MOD)[(size_t)b * 12288 + col] = s + p.b_ada[col];
    }
    __syncthreads();
}

template <int W> __device__ __forceinline__ int tr_dst_row(int n) {
    if (W == 0) { if (n < 3840) return n; const int e = n - 3840; return 3840 + 2 * (e & 31) + (e >> 5); }
    if (W == 3) { const int h = n / 192, d = n % 192; if (d < 128) return n; const int e = d - 128; return h * 192 + 128 + 2 * (e & 31) + (e >> 5); }
    return n;
}
template <int W> __device__ __forceinline__ float tr_scale(const Params& p, int k) {
    if (W == 1) return k < 1024 ? p.osb_g[k] : p.omla_g[k - 1024];
    if (W == 3) return p.qn_g[k];
    if (W == 4) return p.kvn_g[k];
    return 1.0f;
}
template <int W> __device__ __forceinline__ void job_transpose(const Params& p, int it, float* tile) {
    constexpr int K = (W == 3) ? 512 : (W == 4) ? 256 : 2048;
    constexpr int NS = (W == 0) ? NIN : (W == 3) ? 1536 : 2048;
    constexpr int TS = 68;
    const float* src = (W == 0) ? p.w_in : (W == 1) ? p.w_o : (W == 2) ? p.w_pq : (W == 3) ? p.w_uq : p.w_ukv;
    bf16_t* dst = WS<bf16_t>(p, (W == 0) ? OFF_WIN_T : (W == 1) ? OFF_WO_T : (W == 2) ? OFF_WPQ_T : (W == 3) ? OFF_WUQ_T : OFF_WUKV_T);
    const int tid = tid_fresh(p.widx), n0 = it * 64;
    if (W == 0 && n0 >= NIN) {
        const uint4 z = {0u, 0u, 0u, 0u};
        for (int i = tid; i < 64 * K / 8; i += 512) *(uint4*)(dst + (size_t)n0 * K + (size_t)i * 8) = z;
        return;
    }
    const int lr = tid >> 4, lc = (tid & 15) * 4;
    const int sn = tid >> 3, skc = tid & 7;
    const size_t drow = (size_t)tr_dst_row<W>(n0 + sn) * K;
    for (int k0 = 0; k0 < K; k0 += 256) {
        float4 r[8];
#pragma unroll
        for (int i = 0; i < 8; ++i) r[i] = *(const float4*)(src + (size_t)(k0 + lr + 32 * i) * NS + n0 + lc);
#pragma unroll
        for (int i = 0; i < 8; ++i) *(float4*)(tile + (lr + 32 * i) * TS + lc) = r[i];
        __syncthreads();
#pragma unroll
        for (int q = 0; q < 4; ++q) {
            const int kk = skc * 32 + q * 8;
            float v[8];
#pragma unroll
            for (int j = 0; j < 8; ++j) v[j] = tile[(kk + j) * TS + sn] * tr_scale<W>(p, k0 + kk + j);
            uint4 w; w.x = pack2(v[0], v[1]); w.y = pack2(v[2], v[3]); w.z = pack2(v[4], v[5]); w.w = pack2(v[6], v[7]);
            *(uint4*)(dst + drow + k0 + kk) = w;
        }
        __syncthreads();
    }
}
__device__ __forceinline__ void job_keys(const Params& p, int slot) {
    const float* src = ((slot & 1) ? p.keys2 : p.keys1) + (size_t)(slot >> 1) * 16384;
    bf16_t* dst = WS<bf16_t>(p, OFF_KEYS) + (size_t)slot * 16384;
    for (int i = tid_fresh(p.widx); i < 16384; i += 512) dst[i] = f2bf(src[i]);
}
__device__ __forceinline__ void job_rope(const Params& p, int it) {
    float* cosT = WS<float>(p, OFF_COS); float* sinT = WS<float>(p, OFF_SIN);
    for (int j = 0; j < 32; ++j) {
        const int idx = tid_fresh(p.widx) + 512 * j, t = it * 512 + (idx >> 5), i = idx & 31;
        double inv = 1.0;
        for (int q = 0; q < i; ++q) inv *= 0.7498942093324559;
        const double ang = (double)p.pos[t] * inv;
        const double n = rint(ang * 0.15915494309189535);
        const double r = fma(-n, 6.283185307179586, ang) - n * 2.4492935982947064e-16;
        const float rf = (float)r;
        cosT[(size_t)t * 32 + i] = cosf(rf); sinT[(size_t)t * 32 + i] = sinf(rf);
    }
}
template <int EB> __device__ __forceinline__ void job_table(const Params& p, int it);
__device__ __forceinline__ void job_table6(const Params& p, int it);
__device__ __forceinline__ void phase0(const Params& p, int bid, int nblk, float* lds) {
    for (int it = bid; it < J7_END; it += nblk) {
        if (it < J0_END) job_ada(p, it, lds);
        else if (it < J1_END) job_transpose<0>(p, it - J0_END, lds);
        else if (it < J2_END) job_transpose<1>(p, it - J1_END, lds);
        else if (it < J3_END) job_transpose<2>(p, it - J2_END, lds);
        else if (it < J4_END) job_transpose<3>(p, it - J3_END, lds);
        else if (it < J5_END) job_transpose<4>(p, it - J4_END, lds);
        else if (it < J6_END) job_keys(p, it - J5_END);
        else if (it < J7_END) job_rope(p, it - J6_END);
        else if (TAB_EB == 6) job_table6(p, it - J7_END);
        else job_table<TAB_EB == 6 ? 1 : TAB_EB>(p, it - J7_END);
    }
}

template <class TS> __device__ __forceinline__ void phase_norm_mod(const Params& p, const TS* src, const float* gain, int sh_idx, int sc_idx, bf16_t* dst, int bid, int nblk, float* lds) {
    const int tid = tid_fresh(p.widx), lane = tid & 63, wid = tid >> 6;
    const float* mod = WS<float>(p, OFF_MOD);
    float* av = lds;
    float* sv = lds + 4096;
    for (int i = tid; i < 4096; i += 512) { const int b = i >> 11, col = i & 2047;
        av[i] = gain[col] * (1.0f + mod[(size_t)b * 12288 + sc_idx * 2048 + col]); sv[i] = mod[(size_t)b * 12288 + sh_idx * 2048 + col]; }
    __syncthreads();
    for (int t = bid * 8 + wid; t < TOK; t += nblk * 8) {
        const int b = t >> 12;
        const TS* xr = src + (size_t)t * DM;
        float4 v[8]; float ss = 0.f;
#pragma unroll
        for (int j = 0; j < 8; ++j) {
            if constexpr (sizeof(TS) == 4) v[j] = *(const float4*)(xr + (j * 64 + lane) * 4);
            else { const uint2 w = *(const uint2*)(xr + (j * 64 + lane) * 4); v[j].x = lo_f(w.x); v[j].y = hi_f(w.x); v[j].z = lo_f(w.y); v[j].w = hi_f(w.y); }
            ss += v[j].x * v[j].x + v[j].y * v[j].y + v[j].z * v[j].z + v[j].w * v[j].w; }
        ss = wave_sum(ss);
        const float rstd = rsqrtf(ss * (1.0f / DM) + EPS);
#pragma unroll
        for (int j = 0; j < 8; ++j) {
            const int col = (j * 64 + lane) * 4;
            const float4 a = *(const float4*)(av + b * 2048 + col), s = *(const float4*)(sv + b * 2048 + col);
            uint2 w; w.x = pack2(v[j].x * rstd * a.x + s.x, v[j].y * rstd * a.y + s.y); w.y = pack2(v[j].z * rstd * a.z + s.z, v[j].w * rstd * a.w + s.w);
            *(uint2*)(dst + (size_t)t * DM + col) = w;
        }
    }
    __syncthreads();
}

__device__ __forceinline__ void phase_rowstats(const Params& p, int bid, int nblk) {
    const int tidf = tid_fresh(p.widx), lane = tidf & 63, wid = tidf >> 6;
    const bf16_t* cq = WS<bf16_t>(p, OFF_CQ); const bf16_t* ckv = WS<bf16_t>(p, OFF_CKV);
    for (int t = bid * 8 + wid; t < TOK; t += nblk * 8) {
        const uint4 a = *(const uint4*)(cq + (size_t)t * 512 + lane * 8);
        float s1 = dot8(a, a), s2 = 0.f;
        if (lane < 32) { const uint4 b = *(const uint4*)(ckv + (size_t)t * 256 + lane * 8); s2 = dot8(b, b); }
        s1 = wave_sum(s1); s2 = wave_sum(s2);
        if (lane == 0) { WS<float>(p, OFF_RSQ)[t] = rsqrtf(s1 * (1.0f / 512.0f) + EPS); WS<float>(p, OFF_RSKV)[t] = rsqrtf(s2 * (1.0f / 256.0f) + EPS); }
    }
}

__device__ __forceinline__ void phase_attn_ref(const Params& p, int bid, int nblk) {
    const int tid = tid_fresh(p.widx), ql = tid >> 2, part = tid & 3;
    const bf16_t* qsb = WS<bf16_t>(p, OFF_QSB); const bf16_t* ksb = WS<bf16_t>(p, OFF_KSB); const bf16_t* vsb = WS<bf16_t>(p, OFF_VSB);
    const bf16_t* qml = WS<bf16_t>(p, OFF_QMLA); const bf16_t* kml = WS<bf16_t>(p, OFF_KMLA); const bf16_t* vml = WS<bf16_t>(p, OFF_VMLA);
    bf16_t* O = WS<bf16_t>(p, OFF_O); float* ssq = WS<float>(p, OFF_SSQ);
    for (int it = bid; it < 1024; it += nblk) {
        const int g = it >> 9, rem = it & 511, b = rem >> 8, h = (rem >> 5) & 7, qb = 31 - (rem & 31);
        const int t = qb * 128 + ql; const size_t tok = (size_t)b * SEQ + t;
        const int tmax = qb * 128 + (ql | 15);
        float o[32];
#pragma unroll
        for (int d = 0; d < 32; ++d) o[d] = 0.f;
        if (g == 0) {
            uint4 q[4];
#pragma unroll
            for (int j = 0; j < 4; ++j) q[j] = *(const uint4*)(qsb + tok * 1024 + h * 128 + part * 32 + j * 8);
            float between = 0.f;
            for (int s = tmax - 1; s >= 0; --s) {
                const size_t kt = (size_t)b * SEQ + s;
                float z2 = 0.f;
#pragma unroll
                for (int j = 0; j < 4; ++j) z2 += dot8(q[j], *(const uint4*)(ksb + kt * 1024 + h * 128 + part * 32 + j * 8));
                z2 += __shfl_xor(z2, 1); z2 += __shfl_xor(z2, 2);
                if (s < t) {
                    const float z = z2 * LN2;
                    const float l1p = log1pf(__expf(-fabsf(z)));
                    const float lsig = fminf(z, 0.f) - l1p, lsign = -fmaxf(z, 0.f) - l1p;
                    const float w = __expf(lsig + between);
                    between += lsign;
#pragma unroll
                    for (int j = 0; j < 4; ++j) { const uint4 vv = *(const uint4*)(vsb + kt * 1024 + h * 128 + part * 32 + j * 8);
                        o[j * 8 + 0] += w * lo_f(vv.x); o[j * 8 + 1] += w * hi_f(vv.x); o[j * 8 + 2] += w * lo_f(vv.y); o[j * 8 + 3] += w * hi_f(vv.y);
                        o[j * 8 + 4] += w * lo_f(vv.z); o[j * 8 + 5] += w * hi_f(vv.z); o[j * 8 + 6] += w * lo_f(vv.w); o[j * 8 + 7] += w * hi_f(vv.w); }
                }
            }
        } else {
            uint4 q[6];
#pragma unroll
            for (int j = 0; j < 6; ++j) q[j] = *(const uint4*)(qml + tok * 1536 + h * 192 + part * 48 + j * 8);
            float m = -1e30f, l = 0.f;
            for (int s = 0; s <= tmax; ++s) {
                const size_t kt = (size_t)b * SEQ + s;
                float sc = 0.f;
#pragma unroll
                for (int j = 0; j < 6; ++j) sc += dot8(q[j], *(const uint4*)(kml + kt * 1536 + h * 192 + part * 48 + j * 8));
                sc += __shfl_xor(sc, 1); sc += __shfl_xor(sc, 2);
                if (s <= t) {
                    const float mn = fmaxf(m, sc), alpha = exp2f(m - mn), pw = exp2f(sc - mn);
                    l = l * alpha + pw; m = mn;
#pragma unroll
                    for (int j = 0; j < 4; ++j) { const uint4 vv = *(const uint4*)(vml + kt * 1024 + h * 128 + part * 32 + j * 8);
                        o[j * 8 + 0] = o[j * 8 + 0] * alpha + pw * lo_f(vv.x); o[j * 8 + 1] = o[j * 8 + 1] * alpha + pw * hi_f(vv.x);
                        o[j * 8 + 2] = o[j * 8 + 2] * alpha + pw * lo_f(vv.y); o[j * 8 + 3] = o[j * 8 + 3] * alpha + pw * hi_f(vv.y);
                        o[j * 8 + 4] = o[j * 8 + 4] * alpha + pw * lo_f(vv.z); o[j * 8 + 5] = o[j * 8 + 5] * alpha + pw * hi_f(vv.z);
                        o[j * 8 + 6] = o[j * 8 + 6] * alpha + pw * lo_f(vv.w); o[j * 8 + 7] = o[j * 8 + 7] * alpha + pw * hi_f(vv.w); }
                }
            }
            const float inv = 1.0f / l;
#pragma unroll
            for (int d = 0; d < 32; ++d) o[d] *= inv;
        }
        float ss = 0.f;
#pragma unroll
        for (int d = 0; d < 32; ++d) ss += o[d] * o[d];
        ss += __shfl_xor(ss, 1); ss += __shfl_xor(ss, 2);
        if (part == 0) ssq[tok * 16 + g * 8 + h] = ss;
        bf16_t* op = O + tok * 2048 + g * 1024 + h * 128 + part * 32;
#pragma unroll
        for (int j = 0; j < 4; ++j) { uint4 w; w.x = pack2(o[j * 8], o[j * 8 + 1]); w.y = pack2(o[j * 8 + 2], o[j * 8 + 3]); w.z = pack2(o[j * 8 + 4], o[j * 8 + 5]); w.w = pack2(o[j * 8 + 6], o[j * 8 + 7]);
            *(uint4*)(op + j * 8) = w; }
    }
}


typedef short bf16x8_t __attribute__((ext_vector_type(8)));
typedef short s16x4_t __attribute__((ext_vector_type(4)));
typedef float f32x16_t __attribute__((ext_vector_type(16)));
typedef float f32x2_t __attribute__((ext_vector_type(2)));
typedef unsigned u32x4_t __attribute__((ext_vector_type(4)));
typedef __bf16 bf16x2_t __attribute__((ext_vector_type(2)));
__device__ __forceinline__ unsigned cvt_pk_bf16(float lo, float hi) { f32x2_t v = {lo, hi}; bf16x2_t b = __builtin_convertvector(v, bf16x2_t); return __builtin_bit_cast(unsigned, b); }
__device__ __forceinline__ void swap32(float a, float& lo, float& hi) {
    auto r = __builtin_amdgcn_permlane32_swap(__float_as_uint(a), __float_as_uint(a), false, false);
    lo = __uint_as_float(r[0]); hi = __uint_as_float(r[1]);
}
constexpr int LDS_TAB_OFF = 131072 + 16;
constexpr int ATT_VSTR = 320;
constexpr int ATT_STAGE_MAX = 64 * (192 * 2 + 16) + 64 * ATT_VSTR;
constexpr int ATT_BC_OFF = 2 * 64 * (192 * 2 + 16) + 3 * 64 * ATT_VSTR;
constexpr int ATT_HEAD_WORD = 3840;

template <int G>
__device__ __forceinline__ void attn_qk(const LAS unsigned char* kbuf, const bf16x8_t (&qf)[G ? 12 : 8], f32x16_t& s0, f32x16_t& s1, unsigned kread) {
    constexpr int DK = G ? 192 : 128, NKS = DK / 16, KSTR = DK * 2 + 16;
#pragma unroll
    for (int r = 0; r < 16; ++r) { s0[r] = 0.f; s1[r] = 0.f; }
    const LAS unsigned char* kp = kbuf + kread;
#pragma unroll
    for (int ks = 0; ks < NKS; ++ks) {
        const bf16x8_t a0 = *(const LAS bf16x8_t*)(kp + ks * 32), a1 = *(const LAS bf16x8_t*)(kp + 32 * KSTR + ks * 32);
        s0 = __builtin_amdgcn_mfma_f32_32x32x16_bf16(a0, qf[ks], s0, 0, 0, 0);
        s1 = __builtin_amdgcn_mfma_f32_32x32x16_bf16(a1, qf[ks], s1, 0, 0, 0);
    }
    __builtin_amdgcn_sched_group_barrier(0x100, 6, 0);
#pragma unroll
    for (int i = 0; i < 2 * NKS - 6; ++i) { __builtin_amdgcn_sched_group_barrier(0x8, 1, 0); __builtin_amdgcn_sched_group_barrier(0x100, 1, 0); }
#pragma unroll
    for (int i = 0; i < 6; ++i) __builtin_amdgcn_sched_group_barrier(0x8, 1, 0);
}
template <int G>
__device__ __forceinline__ void attn_sm(bool need_mask, f32x16_t& s0, f32x16_t& s1, unsigned (&pk)[2][8], f32x16_t (&o)[4], float& st0, float& st1, int lim, int hh) {
    if (need_mask) {
        asm volatile("" ::: "memory");
        const float neg = G ? -INFINITY : -100.0f;
#pragma unroll
        for (int r = 0; r < 16; ++r) { const int kr = (r & 3) + 8 * (r >> 2) + 4 * hh;
            s0[r] = (G ? (kr <= lim) : (kr < lim)) ? s0[r] : neg; s1[r] = (G ? (32 + kr <= lim) : (32 + kr < lim)) ? s1[r] : neg; }
    }
    if (G == 0) {
        float R = st0;
#pragma unroll
        for (int kb = 1; kb >= 0; --kb) {
#pragma unroll
            for (int g = 3; g >= 0; --g) {
                float sg[4], om[4];
#pragma unroll
                for (int rr = 0; rr < 4; ++rr) {
                    const float z2 = kb ? s1[4 * g + rr] : s0[4 * g + rr];
                    const float e = __builtin_amdgcn_exp2f(-z2);
                    const float sig = __builtin_amdgcn_rcpf(1.0f + e);
                    sg[rr] = sig; om[rr] = e * sig;
                }
                const float gown = (om[0] * om[1]) * (om[2] * om[3]);
                float glo, ghi; swap32(gown, glo, ghi);
                const float E = hh ? R : R * ghi;
                const float e2 = E * om[3], e1 = e2 * om[2], e0 = e1 * om[1];
                pk[kb][2 * g] = cvt_pk_bf16(sg[0] * e0, sg[1] * e1); pk[kb][2 * g + 1] = cvt_pk_bf16(sg[2] * e2, sg[3] * E);
                R = R * (glo * ghi);
            }
        }
        st0 = R;
    } else {
        float mx = fmaxf(s0[0], s1[0]);
#pragma unroll
        for (int r = 1; r < 16; ++r) mx = fmaxf(mx, fmaxf(s0[r], s1[r]));
        float mlo, mhi; swap32(mx, mlo, mhi);
        const float mn = fmaxf(st0, fmaxf(mlo, mhi)), alpha = __builtin_amdgcn_exp2f(st0 - mn);
        st0 = mn;
        float ls = 0.f;
#pragma unroll
        for (int g = 0; g < 4; ++g) {
            float a[4], bq[4];
#pragma unroll
            for (int rr = 0; rr < 4; ++rr) { a[rr] = __builtin_amdgcn_exp2f(s0[4 * g + rr] - mn); bq[rr] = __builtin_amdgcn_exp2f(s1[4 * g + rr] - mn); ls += a[rr] + bq[rr]; }
            pk[0][2 * g] = cvt_pk_bf16(a[0], a[1]); pk[0][2 * g + 1] = cvt_pk_bf16(a[2], a[3]);
            pk[1][2 * g] = cvt_pk_bf16(bq[0], bq[1]); pk[1][2 * g + 1] = cvt_pk_bf16(bq[2], bq[3]);
        }
        st1 = st1 * alpha + ls;
        if (__builtin_amdgcn_ballot_w64(alpha != 1.0f) != 0ull) {
#pragma unroll
            for (int d = 0; d < 4; ++d) o[d] = o[d] * alpha;
        }
    }
}
__device__ __forceinline__ void attn_pv(const LAS unsigned char* vbuf, const unsigned (&pk)[2][8], f32x16_t (&o)[4], unsigned vread) {
    constexpr int VSTR = ATT_VSTR;
    const LAS unsigned char* vp = vbuf + vread;
#pragma unroll
    for (int kb = 0; kb < 2; ++kb)
#pragma unroll
        for (int s = 0; s < 2; ++s) {
            bf16x8_t pf;
            { const unsigned w0 = pk[kb][4 * s], w1 = pk[kb][4 * s + 1], w2 = pk[kb][4 * s + 2], w3 = pk[kb][4 * s + 3];
              pf[0] = (short)(w0 & 0xffff); pf[1] = (short)(w0 >> 16); pf[2] = (short)(w1 & 0xffff); pf[3] = (short)(w1 >> 16);
              pf[4] = (short)(w2 & 0xffff); pf[5] = (short)(w2 >> 16); pf[6] = (short)(w3 & 0xffff); pf[7] = (short)(w3 >> 16); }
#pragma unroll
            for (int d = 0; d < 4; ++d) {
                const LAS unsigned char* vq = vp + (32 * kb + 16 * s) * VSTR + d * 64;
                const s16x4_t lo = __builtin_amdgcn_ds_read_tr16_b64_v4i16((LAS s16x4_t*)(vq));
                const s16x4_t hi = __builtin_amdgcn_ds_read_tr16_b64_v4i16((LAS s16x4_t*)(vq + 8 * VSTR));
                const bf16x8_t vf = {lo[0], lo[1], lo[2], lo[3], hi[0], hi[1], hi[2], hi[3]};
                o[d] = __builtin_amdgcn_mfma_f32_32x32x16_bf16(vf, pf, o[d], 0, 0, 0);
            }
        }
    __builtin_amdgcn_sched_group_barrier(0x100, 6, 0);
#pragma unroll
    for (int i = 0; i < 13; ++i) { __builtin_amdgcn_sched_group_barrier(0x8, 1, 0); __builtin_amdgcn_sched_group_barrier(0x100, 2, 0); }
#pragma unroll
    for (int i = 0; i < 3; ++i) __builtin_amdgcn_sched_group_barrier(0x8, 1, 0);
}

__device__ __forceinline__ void sb_half_math(const f32x16_t& s, unsigned (&pkh)[8], float& R, int hh) {
#pragma unroll
    for (int g = 3; g >= 0; --g) {
        float sg[4], om[4];
#pragma unroll
        for (int rr = 0; rr < 4; ++rr) { const float e = __builtin_amdgcn_exp2f(fminf(-s[4 * g + rr], 120.0f)); const float sig = __builtin_amdgcn_rcpf(1.0f + e); sg[rr] = sig; om[rr] = e * sig; }
        const float gown = (om[0] * om[1]) * (om[2] * om[3]);
        float glo, ghi; swap32(gown, glo, ghi);
        const float E = hh ? R : R * ghi;
        const float e2 = E * om[3], e1 = e2 * om[2], e0 = e1 * om[1];
        pkh[2 * g] = cvt_pk_bf16(sg[0] * e0, sg[1] * e1); pkh[2 * g + 1] = cvt_pk_bf16(sg[2] * e2, sg[3] * E);
        R = R * (glo * ghi);
    }
}
__device__ __forceinline__ void pv_half(const LAS unsigned char* vp, int kb, const unsigned (&pkh)[8], f32x16_t (&o)[4]) {
    constexpr int VSTR = ATT_VSTR;
#pragma unroll
    for (int s = 0; s < 2; ++s) {
        bf16x8_t pf;
        { const unsigned w0 = pkh[4 * s], w1 = pkh[4 * s + 1], w2 = pkh[4 * s + 2], w3 = pkh[4 * s + 3];
          pf[0] = (short)(w0 & 0xffff); pf[1] = (short)(w0 >> 16); pf[2] = (short)(w1 & 0xffff); pf[3] = (short)(w1 >> 16);
          pf[4] = (short)(w2 & 0xffff); pf[5] = (short)(w2 >> 16); pf[6] = (short)(w3 & 0xffff); pf[7] = (short)(w3 >> 16); }
#pragma unroll
        for (int d = 0; d < 4; ++d) {
            const LAS unsigned char* vq = vp + (32 * kb + 16 * s) * VSTR + d * 64;
            const s16x4_t lo = __builtin_amdgcn_ds_read_tr16_b64_v4i16((LAS s16x4_t*)(vq));
            const s16x4_t hi = __builtin_amdgcn_ds_read_tr16_b64_v4i16((LAS s16x4_t*)(vq + 8 * VSTR));
            const bf16x8_t vf = {lo[0], lo[1], lo[2], lo[3], hi[0], hi[1], hi[2], hi[3]};
            o[d] = __builtin_amdgcn_mfma_f32_32x32x16_bf16(vf, pf, o[d], 0, 0, 0);
        }
    }
}
__device__ __forceinline__ void attn_tile_sb(bool need_mask, const LAS unsigned char* base, const bf16x8_t (&qf)[8], f32x16_t (&o)[4], float& st0, int lim, unsigned kread, unsigned vread, int hh) {
    constexpr int KSTR = 128 * 2 + 16;
    const LAS unsigned char* kp = base + kread;
    f32x16_t s0, s1;
#pragma unroll
    for (int r = 0; r < 16; ++r) { s0[r] = 0.f; s1[r] = 0.f; }
#pragma unroll
    for (int ks = 0; ks < 8; ++ks) s1 = __builtin_amdgcn_mfma_f32_32x32x16_bf16(*(const LAS bf16x8_t*)(kp + 32 * KSTR + ks * 32), qf[ks], s1, 0, 0, 0);
#pragma unroll
    for (int ks = 0; ks < 8; ++ks) s0 = __builtin_amdgcn_mfma_f32_32x32x16_bf16(*(const LAS bf16x8_t*)(kp + ks * 32), qf[ks], s0, 0, 0, 0);
    if (need_mask) {
        asm volatile("" ::: "memory");
#pragma unroll
        for (int r = 0; r < 16; ++r) { const int kr = (r & 3) + 8 * (r >> 2) + 4 * hh; s0[r] = (kr < lim) ? s0[r] : -100.0f; s1[r] = (32 + kr < lim) ? s1[r] : -100.0f; }
    }
    unsigned pk1[8], pk0[8]; float R = st0;
    sb_half_math(s1, pk1, R, hh);
    pv_half(base + vread, 1, pk1, o);
    sb_half_math(s0, pk0, R, hh);
    pv_half(base + vread, 0, pk0, o);
    st0 = R;
}

__device__ __forceinline__ void attn_tile_mla(bool need_mask, const LAS unsigned char* base, const bf16x8_t (&qf)[12], f32x16_t (&o)[4], float& st0, float& st1, int lim, unsigned kread, unsigned vread, int hh) {
    f32x16_t s0, s1;
    attn_qk<1>(base, qf, s0, s1, kread);
    if (need_mask) {
        asm volatile("" ::: "memory");
#pragma unroll
        for (int r = 0; r < 16; ++r) { const int kr = (r & 3) + 8 * (r >> 2) + 4 * hh; s0[r] = (kr <= lim) ? s0[r] : -INFINITY; s1[r] = (32 + kr <= lim) ? s1[r] : -INFINITY; }
    }
    float mx = fmaxf(s0[0], s1[0]);
#pragma unroll
    for (int r = 1; r < 16; ++r) mx = fmaxf(mx, fmaxf(s0[r], s1[r]));
    float mlo, mhi; swap32(mx, mlo, mhi);
    const float mn = fmaxf(st0, fmaxf(mlo, mhi)), alpha = __builtin_amdgcn_exp2f(st0 - mn);
    st0 = mn;
    if (__builtin_amdgcn_ballot_w64(alpha != 1.0f) != 0ull) {
#pragma unroll
        for (int d = 0; d < 4; ++d) o[d] = o[d] * alpha;
    }
    unsigned pk1[8], pk0[8]; float ls = 0.f;
#pragma unroll
    for (int g = 0; g < 4; ++g) { float a[4];
#pragma unroll
        for (int rr = 0; rr < 4; ++rr) { a[rr] = __builtin_amdgcn_exp2f(s1[4 * g + rr] - mn); ls += a[rr]; }
        pk1[2 * g] = cvt_pk_bf16(a[0], a[1]); pk1[2 * g + 1] = cvt_pk_bf16(a[2], a[3]); }
    pv_half(base + vread, 1, pk1, o);
#pragma unroll
    for (int g = 0; g < 4; ++g) { float a[4];
#pragma unroll
        for (int rr = 0; rr < 4; ++rr) { a[rr] = __builtin_amdgcn_exp2f(s0[4 * g + rr] - mn); ls += a[rr]; }
        pk0[2 * g] = cvt_pk_bf16(a[0], a[1]); pk0[2 * g + 1] = cvt_pk_bf16(a[2], a[3]); }
    pv_half(base + vread, 0, pk0, o);
    st1 = st1 * alpha + ls;
}
template <int G>
__device__ __forceinline__ void attn_tile(bool need_mask, const LAS unsigned char* base, const bf16x8_t (&qf)[G ? 12 : 8], f32x16_t (&o)[4], float& st0, float& st1, int lim, unsigned kread, unsigned vread, int hh) {
    f32x16_t s0, s1; unsigned pk[2][8];
    attn_qk<G>(base, qf, s0, s1, kread);
    attn_sm<G>(need_mask, s0, s1, pk, o, st0, st1, lim, hh);
    attn_pv(base, pk, o, vread);
}
template <int G>
__device__ __forceinline__ void attn_unit2(const Params& p, int b, int h, int qb, LAS unsigned char* lds, int tid_in) {
    int tid = tid_in; asm volatile("" : "+v"(tid));
    constexpr int DK = G ? 192 : 128, NKS = DK / 16, KCH = DK / 8, KSTR = DK * 2 + 16, VSTR = ATT_VSTR;
    constexpr int KTILE = 64 * KSTR, VTILE = 64 * VSTR, NKL = KCH * 64 / 512, QP = G ? 1536 : 1024;
    const int lane = tid & 63, wid = __builtin_amdgcn_readfirstlane(tid >> 6), c = lane & 31, hh = lane >> 5, H = wid >> 2;
    const bf16_t* Qg = WS<bf16_t>(p, G ? OFF_QMLA : OFF_QSB); const bf16_t* Kg = WS<bf16_t>(p, G ? OFF_KMLA : OFF_KSB); const bf16_t* Vg = WS<bf16_t>(p, G ? OFF_VMLA : OFF_VSB);
    const size_t tok0 = (size_t)b * SEQ;
    const int trow = qb * 256 + wid * 32 + c;
    bf16x8_t qf[NKS];
    { const bf16_t* qp = Qg + (tok0 + trow) * QP + h * DK + hh * 8;
#pragma unroll
      for (int ks = 0; ks < NKS; ++ks) qf[ks] = *(const bf16x8_t*)(qp + ks * 16); }
    f32x16_t o[4];
#pragma unroll
    for (int d = 0; d < 4; ++d)
#pragma unroll
        for (int r = 0; r < 16; ++r) o[d][r] = 0.f;
    float st0 = G ? -1e30f : 1.0f, st1 = 0.f;
    const int srow = tid >> 3, sch = tid & 7;
    const bf16_t* Kb = Kg + tok0 * QP + (size_t)srow * QP + h * DK + sch * 8; const bf16_t* Vb = Vg + tok0 * 1024 + (size_t)srow * 1024 + h * 128 + sch * 8;
    const unsigned klds0 = (unsigned)(srow * KSTR + sch * 16), vlds0 = (unsigned)(2 * KTILE + srow * VSTR + sch * 16);
    const unsigned kread = (unsigned)(c * KSTR + hh * 16);
    const unsigned vread = (unsigned)(2 * KTILE + (4 * hh + ((lane & 15) >> 2)) * VSTR + (16 * ((lane >> 4) & 1) + 4 * (lane & 3)) * 2);
    const int jmax = 4 * qb + 3, T = jmax + 1, wb = wid >> 1;
    u32x4_t kreg[NKL], vreg[2];
#pragma unroll
    for (int i = 0; i < NKL; ++i) kreg[i] = *(const u32x4_t*)(Kb + (size_t)jmax * 64 * QP + i * 64);
#pragma unroll
    for (int i = 0; i < NKL; ++i) *(LAS u32x4_t*)(lds + klds0 + i * 128) = kreg[i];
#pragma unroll
    for (int i = 0; i < NKL; ++i) kreg[i] = *(const u32x4_t*)(Kb + (size_t)(jmax - 1) * 64 * QP + i * 64);
#pragma unroll
    for (int i = 0; i < 2; ++i) vreg[i] = *(const u32x4_t*)(Vb + (size_t)jmax * 64 * 1024 + i * 64);
    __syncthreads();
    f32x16_t s0, s1; unsigned pk[2][8];
#pragma unroll
    for (int r = 0; r < 16; ++r) { s0[r] = 0.f; s1[r] = 0.f; }
#pragma unroll
    for (int i = 0; i < 8; ++i) { pk[0][i] = 0u; pk[1][i] = 0u; }
#pragma unroll 1
    for (int slot = 0; slot < 2 * T + 2; ++slot) {
        if ((slot & 1) == 0) {
            const int s = slot >> 1;
            if (s + 1 < T) {
#pragma unroll
                for (int i = 0; i < NKL; ++i) *(LAS u32x4_t*)(lds + ((s + 1) & 1) * KTILE + klds0 + i * 128) = kreg[i];
            }
            if (s < T) {
#pragma unroll
                for (int i = 0; i < 2; ++i) *(LAS u32x4_t*)(lds + (s & 1) * VTILE + vlds0 + i * 128) = vreg[i];
            }
            if (s + 2 < T) {
#pragma unroll
                for (int i = 0; i < NKL; ++i) kreg[i] = *(const u32x4_t*)(Kb + (size_t)(jmax - s - 2) * 64 * QP + i * 64);
            }
            if (s + 1 < T) {
#pragma unroll
                for (int i = 0; i < 2; ++i) vreg[i] = *(const u32x4_t*)(Vb + (size_t)(jmax - s - 1) * 64 * 1024 + i * 64);
            }
        }
        if ((slot & 1) == H) {
            const int sm = (slot - H) >> 1;
            if (sm >= 1) { const int sp = sm - 1, jb = (jmax - sp) - 4 * qb; if (jb <= wb) attn_pv(lds + (sp & 1) * VTILE, pk, o, vread); }
            if (sm < T) { const int jb = (jmax - sm) - 4 * qb; if (jb <= wb) attn_qk<G>(lds + (sm & 1) * KTILE, qf, s0, s1, kread); }
        } else if (slot >= 1 + H) {
            const int sv = (slot - 1 - H) >> 1;
            if (sv < T) { const int j = jmax - sv, jb = j - 4 * qb; if (jb <= wb) attn_sm<G>(jb == wb, s0, s1, pk, o, st0, st1, trow - 64 * j, hh); }
        }
        __syncthreads();
    }
    if (G == 1) { float llo, lhi; swap32(st1, llo, lhi); const float inv = 1.0f / (llo + lhi);
#pragma unroll
        for (int d = 0; d < 4; ++d) o[d] = o[d] * inv; }
    float ss = 0.f;
    bf16_t* op = WS<bf16_t>(p, OFF_O) + (tok0 + trow) * 2048 + G * 1024 + h * 128 + 4 * hh;
#pragma unroll
    for (int d = 0; d < 4; ++d)
#pragma unroll
        for (int g = 0; g < 4; ++g) {
            const float v0 = o[d][4 * g], v1 = o[d][4 * g + 1], v2 = o[d][4 * g + 2], v3 = o[d][4 * g + 3];
            ss += v0 * v0 + v1 * v1 + v2 * v2 + v3 * v3;
            uint2 w; w.x = cvt_pk_bf16(v0, v1); w.y = cvt_pk_bf16(v2, v3);
            *(uint2*)(op + 32 * d + 8 * g) = w;
        }
    float slo, shi; swap32(ss, slo, shi);
    if (hh == 0) WS<float>(p, OFF_SSQ)[(tok0 + trow) * 16 + G * 8 + h] = slo + shi;
}

template <int G>
__device__ __forceinline__ void attn_unit(const Params& p, int b, int h, int qb, LAS unsigned char* lds, int tid_in) {
    int tid = tid_in; asm volatile("" : "+v"(tid));
    constexpr int DK = G ? 192 : 128, NKS = DK / 16, KCH = DK / 8, KSTR = DK * 2 + 16, VSTR = ATT_VSTR;
    constexpr int KTILE = 64 * KSTR, VTILE = 64 * VSTR, STAGE = KTILE + VTILE, NKL = KCH * 64 / 512, QP = G ? 1536 : 1024;
    const int lane = tid & 63, wid = __builtin_amdgcn_readfirstlane(tid >> 6), c = lane & 31, hh = lane >> 5;
    const bf16_t* Qg = WS<bf16_t>(p, G ? OFF_QMLA : OFF_QSB); const bf16_t* Kg = WS<bf16_t>(p, G ? OFF_KMLA : OFF_KSB); const bf16_t* Vg = WS<bf16_t>(p, G ? OFF_VMLA : OFF_VSB);
    const size_t tok0 = (size_t)b * SEQ;
    const int trow = qb * 256 + wid * 32 + c;
    bf16x8_t qf[NKS];
    { const bf16_t* qp = Qg + (tok0 + trow) * QP + h * DK + hh * 8;
#pragma unroll
      for (int ks = 0; ks < NKS; ++ks) qf[ks] = *(const bf16x8_t*)(qp + ks * 16); }
    f32x16_t o[4];
#pragma unroll
    for (int d = 0; d < 4; ++d)
#pragma unroll
        for (int r = 0; r < 16; ++r) o[d][r] = 0.f;
    float st0 = G ? -1e30f : 1.0f, st1 = 0.f;
    const int srow = tid >> 3, sch = tid & 7;
    const bf16_t* Kb = Kg + tok0 * QP + (size_t)srow * QP + h * DK + sch * 8; const bf16_t* Vb = Vg + tok0 * 1024 + (size_t)srow * 1024 + h * 128 + sch * 8;
    const unsigned klds0 = (unsigned)(srow * KSTR + sch * 16), vlds0 = (unsigned)(KTILE + srow * VSTR + sch * 16);
    u32x4_t kreg[NKL], vreg[2];
    const int jmax = 4 * qb + 3;
#pragma unroll
    for (int i = 0; i < NKL; ++i) kreg[i] = *(const u32x4_t*)(Kb + (size_t)jmax * 64 * QP + i * 64);
#pragma unroll
    for (int i = 0; i < 2; ++i) vreg[i] = *(const u32x4_t*)(Vb + (size_t)jmax * 64 * 1024 + i * 64);
    const unsigned kread = (unsigned)(c * KSTR + hh * 16);
    const unsigned vread = (unsigned)(KTILE + (4 * hh + ((lane & 15) >> 2)) * VSTR + (16 * ((lane >> 4) & 1) + 4 * (lane & 3)) * 2);
    LAS unsigned* aflag = (LAS unsigned*)(lds + ATT_BC_OFF + 16);
    if (G == 0) { if (tid < 3) aflag[tid] = 0u; }
    int f_cur = 0, f_prev = 2, f_next = 1;
    for (int j = jmax; j >= 0; --j) {
        LAS unsigned char* base = lds + ((jmax - j) & 1) * STAGE;
#pragma unroll
        for (int i = 0; i < NKL; ++i) *(LAS u32x4_t*)(base + klds0 + i * 128) = kreg[i];
#pragma unroll
        for (int i = 0; i < 2; ++i) *(LAS u32x4_t*)(base + vlds0 + i * 128) = vreg[i];
        __syncthreads();
        if (G == 0) {
            if (j < jmax) { const unsigned alive = (unsigned)__builtin_amdgcn_readfirstlane((int)aflag[f_prev]); if (alive == 0u) break; }
            if (tid == 0) aflag[f_next] = 0u;
        }
        if (j > 0) {
#pragma unroll
            for (int i = 0; i < NKL; ++i) kreg[i] = *(const u32x4_t*)(Kb + (size_t)(j - 1) * 64 * QP + i * 64);
#pragma unroll
            for (int i = 0; i < 2; ++i) vreg[i] = *(const u32x4_t*)(Vb + (size_t)(j - 1) * 64 * 1024 + i * 64);
        }
        const int jb = j - 4 * qb;
        if (jb <= (wid >> 1)) {
            const bool need_mask = (jb == (wid >> 1));
            const int lim = trow - 64 * j;
            if constexpr (G == 0) attn_tile_sb(need_mask, base, qf, o, st0, lim, kread, vread, hh); else attn_tile_mla(need_mask, base, qf, o, st0, st1, lim, kread, vread, hh);
        }
        if (G == 0) {
            if (__builtin_amdgcn_ballot_w64(st0 >= 9.094947e-13f) != 0ull) { if (lane == 0) aflag[f_cur] = 1u; }
            const int t_ = f_prev; f_prev = f_cur; f_cur = f_next; f_next = t_;
        }
    }
    if (G == 1) { float llo, lhi; swap32(st1, llo, lhi); const float inv = 1.0f / (llo + lhi);
#pragma unroll
        for (int d = 0; d < 4; ++d) o[d] = o[d] * inv; }
    float ss = 0.f;
    bf16_t* op = WS<bf16_t>(p, OFF_O) + (tok0 + trow) * 2048 + G * 1024 + h * 128 + 4 * hh;
#pragma unroll
    for (int d = 0; d < 4; ++d)
#pragma unroll
        for (int g = 0; g < 4; ++g) {
            const float v0 = o[d][4 * g], v1 = o[d][4 * g + 1], v2 = o[d][4 * g + 2], v3 = o[d][4 * g + 3];
            ss += v0 * v0 + v1 * v1 + v2 * v2 + v3 * v3;
            uint2 w; w.x = cvt_pk_bf16(v0, v1); w.y = cvt_pk_bf16(v2, v3);
            *(uint2*)(op + 32 * d + 8 * g) = w;
        }
    float slo, shi; swap32(ss, slo, shi);
    if (hh == 0) WS<float>(p, OFF_SSQ)[(tok0 + trow) * 16 + G * 8 + h] = slo + shi;
    __syncthreads();
}


__device__ __forceinline__ void attn_unit_mla_mid(const Params& p, int b, int h, int qb, LAS unsigned char* lds, int tid_in) {
    int tid = tid_in; asm volatile("" : "+v"(tid));
    constexpr int DK = 192, NKS = 12, KSTR = DK * 2 + 16, VSTR = ATT_VSTR, KTILE = 64 * KSTR, VTILE = 64 * VSTR, STAGE = KTILE + VTILE, NKL = 3, QP = 1536;
    const int lane = tid & 63, wid = __builtin_amdgcn_readfirstlane(tid >> 6), c = lane & 31, hh = lane >> 5;
    const bf16_t* Qg = WS<bf16_t>(p, OFF_QMLA); const bf16_t* Kg = WS<bf16_t>(p, OFF_KMLA); const bf16_t* Vg = WS<bf16_t>(p, OFF_VMLA);
    const size_t tok0 = (size_t)b * SEQ;
    const int trow = qb * 256 + wid * 32 + c;
    bf16x8_t qf[NKS];
    { const bf16_t* qp = Qg + (tok0 + trow) * QP + h * DK + hh * 8;
#pragma unroll
      for (int ks = 0; ks < NKS; ++ks) qf[ks] = *(const bf16x8_t*)(qp + ks * 16); }
    f32x16_t o[4];
#pragma unroll
    for (int d = 0; d < 4; ++d)
#pragma unroll
        for (int r = 0; r < 16; ++r) o[d][r] = 0.f;
    float st0 = -1e30f, st1 = 0.f;
    const int srow = tid >> 3, sch = tid & 7;
    const bf16_t* Kb = Kg + tok0 * QP + (size_t)srow * QP + h * DK + sch * 8; const bf16_t* Vb = Vg + tok0 * 1024 + (size_t)srow * 1024 + h * 128 + sch * 8;
    const unsigned klds0 = (unsigned)(srow * KSTR + sch * 16), vlds0 = (unsigned)(KTILE + srow * VSTR + sch * 16);
    u32x4_t kreg[NKL], vreg[2];
    const int jmax = 4 * qb + 3;
#pragma unroll
    for (int i = 0; i < NKL; ++i) kreg[i] = *(const u32x4_t*)(Kb + (size_t)jmax * 64 * QP + i * 64);
#pragma unroll
    for (int i = 0; i < 2; ++i) vreg[i] = *(const u32x4_t*)(Vb + (size_t)jmax * 64 * 1024 + i * 64);
#pragma unroll
    for (int i = 0; i < NKL; ++i) *(LAS u32x4_t*)(lds + klds0 + i * 128) = kreg[i];
#pragma unroll
    for (int i = 0; i < 2; ++i) *(LAS u32x4_t*)(lds + vlds0 + i * 128) = vreg[i];
#pragma unroll
    for (int i = 0; i < NKL; ++i) kreg[i] = *(const u32x4_t*)(Kb + (size_t)(jmax - 1) * 64 * QP + i * 64);
#pragma unroll
    for (int i = 0; i < 2; ++i) vreg[i] = *(const u32x4_t*)(Vb + (size_t)(jmax - 1) * 64 * 1024 + i * 64);
    const unsigned kread = (unsigned)(c * KSTR + hh * 16);
    const unsigned vread = (unsigned)(KTILE + (4 * hh + ((lane & 15) >> 2)) * VSTR + (16 * ((lane >> 4) & 1) + 4 * (lane & 3)) * 2);
    for (int j = jmax; j >= 0; --j) {
        LAS unsigned char* base = lds + ((jmax - j) & 1) * STAGE;
        LAS unsigned char* nbase = lds + ((jmax - j + 1) & 1) * STAGE;
        __syncthreads();
        const int jb = j - 4 * qb;
        const bool act = jb <= (wid >> 1);
        f32x16_t s0, s1; unsigned pk1[8], pk0[8]; float ls = 0.f, alpha = 1.0f, mn = st0;
        if (act) {
            attn_qk<1>(base, qf, s0, s1, kread);
            if (jb == (wid >> 1)) {
                asm volatile("" ::: "memory");
                const int lim = trow - 64 * j;
#pragma unroll
                for (int r = 0; r < 16; ++r) { const int kr = (r & 3) + 8 * (r >> 2) + 4 * hh; s0[r] = (kr <= lim) ? s0[r] : -INFINITY; s1[r] = (32 + kr <= lim) ? s1[r] : -INFINITY; }
            }
            float mx = fmaxf(s0[0], s1[0]);
#pragma unroll
            for (int r = 1; r < 16; ++r) mx = fmaxf(mx, fmaxf(s0[r], s1[r]));
            float mlo, mhi; swap32(mx, mlo, mhi);
            mn = fmaxf(st0, fmaxf(mlo, mhi)); alpha = __builtin_amdgcn_exp2f(st0 - mn);
            st0 = mn;
            if (__builtin_amdgcn_ballot_w64(alpha != 1.0f) != 0ull) {
#pragma unroll
                for (int d = 0; d < 4; ++d) o[d] = o[d] * alpha;
            }
#pragma unroll
            for (int g = 0; g < 4; ++g) { float a[4];
#pragma unroll
                for (int rr = 0; rr < 4; ++rr) { a[rr] = __builtin_amdgcn_exp2f(s1[4 * g + rr] - mn); ls += a[rr]; }
                pk1[2 * g] = cvt_pk_bf16(a[0], a[1]); pk1[2 * g + 1] = cvt_pk_bf16(a[2], a[3]); }
        }
        if (j > 0) {
#pragma unroll
            for (int i = 0; i < NKL; ++i) *(LAS u32x4_t*)(nbase + klds0 + i * 128) = kreg[i];
#pragma unroll
            for (int i = 0; i < 2; ++i) *(LAS u32x4_t*)(nbase + vlds0 + i * 128) = vreg[i];
            if (j > 1) {
#pragma unroll
                for (int i = 0; i < NKL; ++i) kreg[i] = *(const u32x4_t*)(Kb + (size_t)(j - 2) * 64 * QP + i * 64);
#pragma unroll
                for (int i = 0; i < 2; ++i) vreg[i] = *(const u32x4_t*)(Vb + (size_t)(j - 2) * 64 * 1024 + i * 64);
            }
        }
        if (act) {
            pv_half(base + vread, 1, pk1, o);
#pragma unroll
            for (int g = 0; g < 4; ++g) { float a[4];
#pragma unroll
                for (int rr = 0; rr < 4; ++rr) { a[rr] = __builtin_amdgcn_exp2f(s0[4 * g + rr] - mn); ls += a[rr]; }
                pk0[2 * g] = cvt_pk_bf16(a[0], a[1]); pk0[2 * g + 1] = cvt_pk_bf16(a[2], a[3]); }
            pv_half(base + vread, 0, pk0, o);
            st1 = st1 * alpha + ls;
        }
    }
    { float llo, lhi; swap32(st1, llo, lhi); const float inv = 1.0f / (llo + lhi);
#pragma unroll
      for (int d = 0; d < 4; ++d) o[d] = o[d] * inv; }
    float ss = 0.f;
    bf16_t* op = WS<bf16_t>(p, OFF_O) + (tok0 + trow) * 2048 + 1024 + h * 128 + 4 * hh;
#pragma unroll
    for (int d = 0; d < 4; ++d)
#pragma unroll
        for (int g = 0; g < 4; ++g) {
            const float v0 = o[d][4 * g], v1 = o[d][4 * g + 1], v2 = o[d][4 * g + 2], v3 = o[d][4 * g + 3];
            ss += v0 * v0 + v1 * v1 + v2 * v2 + v3 * v3;
            uint2 w; w.x = cvt_pk_bf16(v0, v1); w.y = cvt_pk_bf16(v2, v3);
            *(uint2*)(op + 32 * d + 8 * g) = w;
        }
    float slo, shi; swap32(ss, slo, shi);
    if (hh == 0) WS<float>(p, OFF_SSQ)[(tok0 + trow) * 16 + 8 + h] = slo + shi;
    __syncthreads();
}

template <int G, int NKL>
__device__ __forceinline__ void att3_step(int s, int T, int jmax, int s_first, int trow, int hh, LAS unsigned char* lds, int& vslot,
        u32x4_t (&kreg)[NKL], u32x4_t (&vreg)[2], const bf16_t* Kb, const bf16_t* Vb, unsigned klds0, unsigned vlds0, unsigned kread, unsigned vread,
        const bf16x8_t (&qf)[G ? 12 : 8], f32x16_t (&o)[4], float& st0, float& st1, f32x16_t& n0, f32x16_t& n1, f32x16_t& p0, f32x16_t& p1, unsigned (&pk)[2][8]) {
    constexpr int DK = G ? 192 : 128, KSTR = DK * 2 + 16, KTILE = 64 * KSTR, VTILE = 64 * ATT_VSTR, QP = G ? 1536 : 1024;
#pragma unroll
    for (int i = 0; i < NKL; ++i) *(LAS u32x4_t*)(lds + (s & 1) * KTILE + klds0 + i * 128) = kreg[i];
#pragma unroll
    for (int i = 0; i < 2; ++i) *(LAS u32x4_t*)(lds + vslot * VTILE + vlds0 + i * 128) = vreg[i];
    __syncthreads();
    if (s + 1 < T) {
#pragma unroll
        for (int i = 0; i < NKL; ++i) kreg[i] = *(const u32x4_t*)(Kb + (size_t)(jmax - s - 1) * 64 * QP + i * 64);
#pragma unroll
        for (int i = 0; i < 2; ++i) vreg[i] = *(const u32x4_t*)(Vb + (size_t)(jmax - s - 1) * 64 * 1024 + i * 64);
    }
    const int vprev = vslot == 0 ? 2 : vslot - 1;
    if (s > s_first + 1) {
        attn_qk<G>(lds + (s & 1) * KTILE, qf, n0, n1, kread);
        attn_sm<G>(false, p0, p1, pk, o, st0, st1, 0, hh);
        attn_pv(lds + vprev * VTILE, pk, o, vread);
    } else {
        if (s >= s_first) attn_qk<G>(lds + (s & 1) * KTILE, qf, n0, n1, kread);
        if (s - 1 >= s_first) { attn_sm<G>(s - 1 == s_first, p0, p1, pk, o, st0, st1, trow - 64 * (jmax - s + 1), hh); attn_pv(lds + vprev * VTILE, pk, o, vread); }
    }
    vslot = vslot == 2 ? 0 : vslot + 1;
}
template <int G>
__device__ __forceinline__ void attn_unit3(const Params& p, int b, int h, int qb, LAS unsigned char* lds, int tid_in) {
    int tid = tid_in; asm volatile("" : "+v"(tid));
    constexpr int DK = G ? 192 : 128, NKS = DK / 16, KCH = DK / 8, KSTR = DK * 2 + 16, VSTR = ATT_VSTR;
    constexpr int KTILE = 64 * KSTR, VTILE = 64 * VSTR, NKL = KCH * 64 / 512, QP = G ? 1536 : 1024;
    const int lane = tid & 63, wid = __builtin_amdgcn_readfirstlane(tid >> 6), c = lane & 31, hh = lane >> 5;
    const bf16_t* Qg = WS<bf16_t>(p, G ? OFF_QMLA : OFF_QSB); const bf16_t* Kg = WS<bf16_t>(p, G ? OFF_KMLA : OFF_KSB); const bf16_t* Vg = WS<bf16_t>(p, G ? OFF_VMLA : OFF_VSB);
    const size_t tok0 = (size_t)b * SEQ;
    const int trow = qb * 256 + wid * 32 + c;
    bf16x8_t qf[NKS];
    { const bf16_t* qp = Qg + (tok0 + trow) * QP + h * DK + hh * 8;
#pragma unroll
      for (int ks = 0; ks < NKS; ++ks) qf[ks] = *(const bf16x8_t*)(qp + ks * 16); }
    f32x16_t o[4];
#pragma unroll
    for (int d = 0; d < 4; ++d)
#pragma unroll
        for (int r = 0; r < 16; ++r) o[d][r] = 0.f;
    float st0 = G ? -1e30f : 1.0f, st1 = 0.f;
    const int srow = tid >> 3, sch = tid & 7;
    const bf16_t* Kb = Kg + tok0 * QP + (size_t)srow * QP + h * DK + sch * 8; const bf16_t* Vb = Vg + tok0 * 1024 + (size_t)srow * 1024 + h * 128 + sch * 8;
    const unsigned klds0 = (unsigned)(srow * KSTR + sch * 16), vlds0 = (unsigned)(2 * KTILE + srow * VSTR + sch * 16);
    const unsigned kread = (unsigned)(c * KSTR + hh * 16);
    const unsigned vread = (unsigned)(2 * KTILE + (4 * hh + ((lane & 15) >> 2)) * VSTR + (16 * ((lane >> 4) & 1) + 4 * (lane & 3)) * 2);
    const int jmax = 4 * qb + 3, T = jmax + 1, s_first = 3 - (wid >> 1);
    u32x4_t kreg[NKL], vreg[2];
#pragma unroll
    for (int i = 0; i < NKL; ++i) kreg[i] = *(const u32x4_t*)(Kb + (size_t)jmax * 64 * QP + i * 64);
#pragma unroll
    for (int i = 0; i < 2; ++i) vreg[i] = *(const u32x4_t*)(Vb + (size_t)jmax * 64 * 1024 + i * 64);
    f32x16_t sa0, sa1, sb0, sb1; unsigned pk[2][8];
#pragma unroll
    for (int r = 0; r < 16; ++r) { sa0[r] = 0.f; sa1[r] = 0.f; sb0[r] = 0.f; sb1[r] = 0.f; }
    int vslot = 0;
#pragma unroll 1
    for (int s = 0; s < T; s += 2) {
        att3_step<G, NKL>(s, T, jmax, s_first, trow, hh, lds, vslot, kreg, vreg, Kb, Vb, klds0, vlds0, kread, vread, qf, o, st0, st1, sa0, sa1, sb0, sb1, pk);
        att3_step<G, NKL>(s + 1, T, jmax, s_first, trow, hh, lds, vslot, kreg, vreg, Kb, Vb, klds0, vlds0, kread, vread, qf, o, st0, st1, sb0, sb1, sa0, sa1, pk);
    }
    { const int vprev = vslot == 0 ? 2 : vslot - 1;
      attn_sm<G>(T - 1 == s_first, sb0, sb1, pk, o, st0, st1, trow, hh);
      attn_pv(lds + vprev * VTILE, pk, o, vread); }
    if (G == 1) { float llo, lhi; swap32(st1, llo, lhi); const float inv = 1.0f / (llo + lhi);
#pragma unroll
        for (int d = 0; d < 4; ++d) o[d] = o[d] * inv; }
    float ss = 0.f;
    bf16_t* op = WS<bf16_t>(p, OFF_O) + (tok0 + trow) * 2048 + G * 1024 + h * 128 + 4 * hh;
#pragma unroll
    for (int d = 0; d < 4; ++d)
#pragma unroll
        for (int g = 0; g < 4; ++g) {
            const float v0 = o[d][4 * g], v1 = o[d][4 * g + 1], v2 = o[d][4 * g + 2], v3 = o[d][4 * g + 3];
            ss += v0 * v0 + v1 * v1 + v2 * v2 + v3 * v3;
            uint2 w; w.x = cvt_pk_bf16(v0, v1); w.y = cvt_pk_bf16(v2, v3);
            *(uint2*)(op + 32 * d + 8 * g) = w;
        }
    float slo, shi; swap32(ss, slo, shi);
    if (hh == 0) WS<float>(p, OFF_SSQ)[(tok0 + trow) * 16 + G * 8 + h] = slo + shi;
    __syncthreads();
}

__device__ __forceinline__ void phase_attn_mfma(const Params& p, float* ldsf, int headw = 0) {
    LAS unsigned char* lds = (LAS unsigned char*)ldsf;
    unsigned* head = WS<unsigned>(p, OFF_BAR) + ATT_HEAD_WORD + 64 * headw;
    for (;;) {
        const int tid = tid_fresh(p.widx);
        LAS unsigned* bc = (LAS unsigned*)(lds + ATT_BC_OFF);
        if (tid == 0) *bc = __hip_atomic_fetch_add(head, 1u, __ATOMIC_RELAXED, __HIP_MEMORY_SCOPE_AGENT);
        __syncthreads();
        const unsigned u = (unsigned)__builtin_amdgcn_readfirstlane((int)*bc);
        __syncthreads();
        if (u >= 1536u) break;
        const unsigned u3 = u / 3u, um = u - 3u * u3;
        if (headw != 0 && (um != 0u || (int)(u3 & 1u) != (PROBE_ATTN_G))) continue;
        if (um != 0u) { if (TAB_EB == 6) job_table6(p, (int)(2u * u3 + um - 1u)); else job_table<TAB_EB == 6 ? 1 : TAB_EB>(p, (int)(2u * u3 + um - 1u)); continue; }
        const int qb = 15 - (int)(u3 >> 5), rest = (int)(u3 & 31u), g = rest & 1, b = (rest >> 1) & 1, h = rest >> 2;
#if ATT_ANTIPHASE
        if (g == 0) attn_unit<0>(p, b, h, qb, lds, tid); else attn_unit_mla_mid(p, b, h, qb, lds, tid);
#else
        if (g == 0) attn_unit<0>(p, b, h, qb, lds, tid); else attn_unit<1>(p, b, h, qb, lds, tid);
#endif
    }
}

__device__ __forceinline__ void phase_onorm(const Params& p, int bid, int nblk) {
    const int tidf = tid_fresh(p.widx), lane = tidf & 63, wid = tidf >> 6;
    bf16_t* O = WS<bf16_t>(p, OFF_O); const float* ssq = WS<float>(p, OFF_SSQ);
    for (int t = bid * 8 + wid; t < TOK; t += nblk * 8) {
        float s0 = 0.f, s1 = 0.f;
#pragma unroll
        for (int h = 0; h < 8; ++h) { s0 += ssq[(size_t)t * 16 + h]; s1 += ssq[(size_t)t * 16 + 8 + h]; }
        const float r0 = rsqrtf(s0 * (1.0f / 1024.0f) + EPS), r1 = rsqrtf(s1 * (1.0f / 1024.0f) + EPS);
#pragma unroll
        for (int j = 0; j < 4; ++j) {
            const int off = (j * 64 + lane) * 8; const float r = off < 1024 ? r0 : r1;
            uint4 v = *(uint4*)(O + (size_t)t * 2048 + off);
            v.x = pack2(lo_f(v.x) * r, hi_f(v.x) * r); v.y = pack2(lo_f(v.y) * r, hi_f(v.y) * r); v.z = pack2(lo_f(v.z) * r, hi_f(v.z) * r); v.w = pack2(lo_f(v.w) * r, hi_f(v.w) * r);
            *(uint4*)(O + (size_t)t * 2048 + off) = v;
        }
    }
}

__device__ __forceinline__ void wave_argmax(float& v, int& i) {
#pragma unroll
    for (int o = 32; o > 0; o >>= 1) { const float ov = __shfl_xor(v, o); const int oi = __shfl_xor(i, o); if (ov > v || (ov == v && oi < i)) { v = ov; i = oi; } }
}
__device__ __forceinline__ void phase_route_ref(const Params& p, int bid, int nblk) {
    const int tidf = tid_fresh(p.widx), lane = tidf & 63, wid = tidf >> 6;
    const bf16_t* qp = WS<bf16_t>(p, OFF_QP); const bf16_t* keys = WS<bf16_t>(p, OFF_KEYS);
    int* ridx = WS<int>(p, OFF_RIDX); float* rgate = WS<float>(p, OFF_RGATE);
    for (int it = bid * 8 + wid; it < TOK * 8; it += nblk * 8) {
        const int t = it >> 3, h = it & 7;
        float tv[2]; int ti[2];
#pragma unroll
        for (int half = 0; half < 2; ++half) {
            const bf16_t* q = qp + (size_t)t * 2048 + h * 256 + half * 128;
            const bf16_t* kb = keys + (size_t)(h * 2 + half) * 16384;
            float s0 = 0.f, s1 = 0.f;
            for (int d = 0; d < 128; d += 8) { const uint4 qv = *(const uint4*)(q + d);
                s0 += dot8(qv, *(const uint4*)(kb + (size_t)lane * 128 + d)); s1 += dot8(qv, *(const uint4*)(kb + (size_t)(lane + 64) * 128 + d)); }
            float mv = 0.f; int mi = 0;
            for (int r = 0; r < 16; ++r) {
                float v; int i;
                if (s0 >= s1) { v = s0; i = lane; } else { v = s1; i = lane + 64; }
                wave_argmax(v, i);
                if (i == lane) s0 = -INFINITY;
                if (i == lane + 64) s1 = -INFINITY;
                if (lane == r) { mv = v; mi = i; }
            }
            tv[half] = mv; ti[half] = mi;
        }
        float cv[4];
#pragma unroll
        for (int j = 0; j < 4; ++j) { const int c = lane * 4 + j; cv[j] = __shfl(tv[0], c >> 4) + __shfl(tv[1], c & 15); }
        float bv = 0.f; int bc = 0;
        for (int r = 0; r < 16; ++r) {
            float v = cv[0]; int i = lane * 4;
#pragma unroll
            for (int j = 1; j < 4; ++j) if (cv[j] > v) { v = cv[j]; i = lane * 4 + j; }
            wave_argmax(v, i);
#pragma unroll
            for (int j = 0; j < 4; ++j) if (i == lane * 4 + j) cv[j] = -INFINITY;
            if (lane == r) { bv = v; bc = i; }
        }
        const float mx = __shfl(bv, 0);
        float e = lane < 16 ? __expf(bv - mx) : 0.f;
        const float sum = wave_sum(e);
        const int i1 = __shfl(ti[0], bc >> 4), i2 = __shfl(ti[1], bc & 15);
        if (lane < 16) { ridx[(size_t)t * 128 + h * 16 + lane] = i1 * 128 + i2; rgate[(size_t)t * 128 + h * 16 + lane] = e / sum; }
    }
}


__device__ __forceinline__ unsigned f2key(float f) { const unsigned u = __float_as_uint(f); return (u & 0x80000000u) ? ~u : (u | 0x80000000u); }
__device__ __forceinline__ float key2f(unsigned k) { return __uint_as_float((k & 0x80000000u) ? (k & 0x7fffffffu) : ~k); }
#define RT_CE(a, b) do { const unsigned _h = max((a), (b)), _l = min((a), (b)); (a) = _h; (b) = _l; } while (0)
__device__ __forceinline__ void sort16_desc(unsigned* a) {
#pragma unroll
    for (int k = 2; k <= 16; k <<= 1)
#pragma unroll
        for (int j = k >> 1; j > 0; j >>= 1)
#pragma unroll
            for (int i = 0; i < 16; ++i) { const int l = i ^ j; if (l > i) { if ((i & k) == 0) RT_CE(a[i], a[l]); else RT_CE(a[l], a[i]); } }
}
__device__ __forceinline__ void merge16_desc(unsigned* a, const unsigned* b) {
#pragma unroll
    for (int i = 0; i < 16; ++i) a[i] = max(a[i], b[15 - i]);
#pragma unroll
    for (int j = 8; j > 0; j >>= 1)
#pragma unroll
        for (int i = 0; i < 16; ++i) { const int l = i ^ j; if (l > i) RT_CE(a[i], a[l]); }
}
__device__ __forceinline__ void top16_of_64(unsigned* v) {
    sort16_desc(v); sort16_desc(v + 16); sort16_desc(v + 32); sort16_desc(v + 48);
    merge16_desc(v, v + 16); merge16_desc(v + 32, v + 48); merge16_desc(v, v + 32);
}
constexpr int rt_cand_pos(int i, int j) { int n = 0; for (int a = 0; a < 16; ++a) for (int b = 0; b < 16; ++b) { if (a == i && b == j) return n; if ((a + 1) * (b + 1) <= 16) ++n; } return n; }
static_assert(rt_cand_pos(15, 1) == 50, "50 staircase candidates");

__device__ __forceinline__ void phase_route_mfma(const Params& p, int bid, int nblk, float* ldsf) {
    const int tidf = tid_fresh(p.widx), lane = tidf & 63, wid = __builtin_amdgcn_readfirstlane(tidf >> 6), c = lane & 31, hh = lane >> 5;
    const bf16_t* qp = WS<bf16_t>(p, OFF_QP); const bf16_t* keys = WS<bf16_t>(p, OFF_KEYS);
    int* ridx = WS<int>(p, OFF_RIDX); float* rgate = WS<float>(p, OFF_RGATE);
    LAS unsigned* tbl = (LAS unsigned*)ldsf + wid * 2048;
    for (int it = bid * 8 + wid; it < 2048; it += nblk * 8) {
        const int tile = it >> 3, h = it & 7, t = (nblk * 32 == TOK) ? tile * 8 + (c & 7) + (c >> 3) * (TOK / 4) : tile * 32 + c;
#pragma unroll 1
        for (int half = 0; half < 2; ++half) {
            const bf16_t* kb = keys + (size_t)(h * 2 + half) * 16384 + (size_t)c * 128 + hh * 8;
            const bf16_t* qq = qp + (size_t)t * 2048 + h * 256 + half * 128 + hh * 8;
            bf16x8_t qf[8];
#pragma unroll
            for (int ks = 0; ks < 8; ++ks) qf[ks] = *(const bf16x8_t*)(qq + ks * 16);
            unsigned v[64];
#pragma unroll
            for (int blk = 0; blk < 4; ++blk) {
                f32x16_t s;
#pragma unroll
                for (int r = 0; r < 16; ++r) s[r] = 0.f;
#pragma unroll
                for (int ks = 0; ks < 8; ++ks) { const bf16x8_t a = *(const bf16x8_t*)(kb + (size_t)blk * 32 * 128 + ks * 16); s = __builtin_amdgcn_mfma_f32_32x32x16_bf16(a, qf[ks], s, 0, 0, 0); }
#pragma unroll
                for (int r = 0; r < 16; ++r) { const int n = 32 * blk + (r & 3) + 8 * (r >> 2) + 4 * hh; v[blk * 16 + r] = (f2key(s[r]) & ~127u) | (unsigned)(127 - n); }
            }
            top16_of_64(v);
            unsigned o[16];
#pragma unroll
            for (int i = 0; i < 16; ++i) { auto r2 = __builtin_amdgcn_permlane32_swap(v[i], v[i], false, false); o[i] = hh ? r2[0] : r2[1]; }
            merge16_desc(v, o);
#pragma unroll
            for (int i = 0; i < 16; ++i) tbl[(half * 16 + i) * 64 + lane] = v[i];
        }
        float f1[16], f2[16];
#pragma unroll
        for (int i = 0; i < 16; ++i) { f1[i] = key2f(tbl[i * 64 + lane] & ~127u); f2[i] = key2f(tbl[(16 + i) * 64 + lane] & ~127u); }
        unsigned cd[64];
#pragma unroll
        for (int i = 0; i < 64; ++i) cd[i] = 0u;
#pragma unroll
        for (int i = 0; i < 16; ++i)
#pragma unroll
            for (int j = 0; j < 16; ++j)
                if ((i + 1) * (j + 1) <= 16) cd[rt_cand_pos(i, j)] = (f2key(f1[i] + f2[j]) & ~255u) | (unsigned)(255 - (i * 16 + j));
        top16_of_64(cd);
        float e[16], sum = 0.f; const float mx = key2f(cd[0] & ~255u);
#pragma unroll
        for (int k = 0; k < 16; ++k) { e[k] = __expf(key2f(cd[k] & ~255u) - mx); sum += e[k]; }
        const float inv = 1.0f / sum;
        if (hh == 0) {
#pragma unroll
            for (int k = 0; k < 16; ++k) {
                const int pid = 255 - (int)(cd[k] & 255u), i = pid >> 4, j = pid & 15;
                const int n1 = 127 - (int)(tbl[i * 64 + lane] & 127u), n2 = 127 - (int)(tbl[(16 + j) * 64 + lane] & 127u);
                ridx[(size_t)t * 128 + h * 16 + k] = n1 * 128 + n2; rgate[(size_t)t * 128 + h * 16 + k] = e[k] * inv;
            }
        }
    }
}

__device__ __forceinline__ void phase_peer_ref(const Params& p, int bid, int nblk) {
    const int tidf = tid_fresh(p.widx), lane = tidf & 63, wid = tidf >> 6;
    const bf16_t* h2 = WS<bf16_t>(p, OFF_H); const float* x1 = WS<float>(p, OFF_X1); const float* mod = WS<float>(p, OFF_MOD);
    const int* ridx = WS<int>(p, OFF_RIDX); const float* rgate = WS<float>(p, OFF_RGATE);
    for (int t = bid * 8 + wid; t < TOK; t += nblk * 8) {
        const int b = t >> 12;
        float4 hv[8], y[8];
#pragma unroll
        for (int j = 0; j < 8; ++j) { const uint2 w = *(const uint2*)(h2 + (size_t)t * DM + (j * 64 + lane) * 4);
            hv[j].x = lo_f(w.x); hv[j].y = hi_f(w.x); hv[j].z = lo_f(w.y); hv[j].w = hi_f(w.y); y[j] = (float4){0.f, 0.f, 0.f, 0.f}; }
        for (int e = 0; e < 128; ++e) {
            const int ex = ridx[(size_t)t * 128 + e]; const float gt = rgate[(size_t)t * 128 + e];
            const float* ur = p.u_tab + (size_t)ex * DM; const float* vr = p.v_tab + (size_t)ex * DM;
            float d = 0.f;
#pragma unroll
            for (int j = 0; j < 8; ++j) { const float4 u = *(const float4*)(ur + (j * 64 + lane) * 4); d += u.x * hv[j].x + u.y * hv[j].y + u.z * hv[j].z + u.w * hv[j].w; }
            d = wave_sum(d);
            const float cf = gt * gelu_exact(d);
#pragma unroll
            for (int j = 0; j < 8; ++j) { const float4 v = *(const float4*)(vr + (j * 64 + lane) * 4); y[j].x += cf * v.x; y[j].y += cf * v.y; y[j].z += cf * v.z; y[j].w += cf * v.w; }
        }
        float ss = 0.f;
#pragma unroll
        for (int j = 0; j < 8; ++j) { const int col = (j * 64 + lane) * 4;
            const float4 xv = *(const float4*)(x1 + (size_t)t * DM + col); const float4 g2 = *(const float4*)(mod + (size_t)b * 12288 + 5 * 2048 + col);
            y[j].x = xv.x + g2.x * y[j].x; y[j].y = xv.y + g2.y * y[j].y; y[j].z = xv.z + g2.z * y[j].z; y[j].w = xv.w + g2.w * y[j].w;
            ss += y[j].x * y[j].x + y[j].y * y[j].y + y[j].z * y[j].z + y[j].w * y[j].w; }
        ss = wave_sum(ss);
        const float rstd = rsqrtf(ss * (1.0f / DM) + EPS);
#pragma unroll
        for (int j = 0; j < 8; ++j) { const int col = (j * 64 + lane) * 4; const float4 fg = *(const float4*)(p.fin_g + col);
            float4 o; o.x = y[j].x * rstd * fg.x; o.y = y[j].y * rstd * fg.y; o.z = y[j].z * rstd * fg.z; o.w = y[j].w * rstd * fg.w;
            *(float4*)(p.out + (size_t)t * DM + col) = o; }
    }
}


template <int EB> __device__ __forceinline__ void job_table(const Params& p, int it) {
    const int tidf = tid_fresh(p.widx), lane = tidf & 63, wid = tidf >> 6;
    const int tab = it >> 9, r0 = (it & 511) * 32;
    const float* src = tab ? p.v_tab : p.u_tab;
    unsigned char* dst = p.ws + (tab ? OFF_VTAB : OFF_UTAB);
    float* scl = WS<float>(p, tab ? OFF_VSC : OFF_USC);
#pragma unroll 1
    for (int rr = 0; rr < 4; ++rr) {
        const int row = r0 + wid * 4 + rr;
        float4 v[8]; float am = 0.f;
#pragma unroll
        for (int j = 0; j < 8; ++j) { v[j] = *(const float4*)(src + (size_t)row * DM + (j * 64 + lane) * 4);
            am = fmaxf(am, fmaxf(fmaxf(fabsf(v[j].x), fabsf(v[j].y)), fmaxf(fabsf(v[j].z), fabsf(v[j].w)))); }
#pragma unroll
        for (int o = 32; o > 0; o >>= 1) am = fmaxf(am, __shfl_xor(am, o));
        if (EB == 1) {
            const int e = (int)((__float_as_uint(am) >> 23) & 255u) - 127;
            const float sc = am > 0.f ? __uint_as_float((unsigned)(127 + 7 - e) << 23) : 1.0f;
            if (lane == 0) scl[row] = am > 0.f ? __uint_as_float((unsigned)(127 - 7 + e) << 23) : 1.0f;
#pragma unroll
            for (int j = 0; j < 8; ++j) {
                int w = __builtin_amdgcn_cvt_pk_fp8_f32(v[j].x * sc, v[j].y * sc, 0, false);
                w = __builtin_amdgcn_cvt_pk_fp8_f32(v[j].z * sc, v[j].w * sc, w, true);
                *(int*)(dst + (size_t)row * 2048 + (j * 64 + lane) * 4) = w;
            }
        } else {
            if (lane == 0) scl[row] = 1.0f;
#pragma unroll
            for (int j = 0; j < 8; ++j) { uint2 w; w.x = pack2(v[j].x, v[j].y); w.y = pack2(v[j].z, v[j].w);
                *(uint2*)(dst + (size_t)row * 4096 + (j * 64 + lane) * 8) = w; }
        }
    }
}

template <int EB> __device__ __forceinline__ void dec_chunk(const u32x4_t r, float* f) {
    if (EB == 1) {
#pragma unroll
        for (int w = 0; w < 4; ++w) { const f32x2_t a = __builtin_amdgcn_cvt_pk_f32_fp8((int)r[w], false), b = __builtin_amdgcn_cvt_pk_f32_fp8((int)r[w], true);
            f[4 * w] = a[0]; f[4 * w + 1] = a[1]; f[4 * w + 2] = b[0]; f[4 * w + 3] = b[1]; }
    } else {
#pragma unroll
        for (int w = 0; w < 4; ++w) { f[2 * w] = lo_f(r[w]); f[2 * w + 1] = hi_f(r[w]); }
    }
}

template <int EB> __device__ __forceinline__ void phase_peer_gather(const Params& p, int bid, int nblk) {
    constexpr int EPC = 16 / EB, NCH = 32 / EPC, ROWB = 2048 * EB;
    const int tidf = tid_fresh(p.widx), lane = tidf & 63, wid = tidf >> 6;
    const unsigned char* utab = p.ws + OFF_UTAB; const unsigned char* vtab = p.ws + OFF_VTAB;
    const float* usc = WS<float>(p, OFF_USC); const float* vsc = WS<float>(p, OFF_VSC);
    const bf16_t* h2 = WS<bf16_t>(p, OFF_H); const float* x1 = WS<float>(p, OFF_X1); const float* mod = WS<float>(p, OFF_MOD);
    const int* ridx = WS<int>(p, OFF_RIDX); const float* rgate = WS<float>(p, OFF_RGATE);
    for (int t = bid * 8 + wid; t < TOK; t += nblk * 8) {
        const int b = t >> 12;
        float hv[32];
#pragma unroll
        for (int j = 0; j < NCH; ++j) {
            const bf16_t* hp = h2 + (size_t)t * DM + (j * 64 + lane) * EPC;
#pragma unroll
            for (int q8 = 0; q8 < EPC / 8; ++q8) { const uint4 w = *(const uint4*)(hp + q8 * 8);
                float* f = hv + j * EPC + q8 * 8;
                f[0] = lo_f(w.x); f[1] = hi_f(w.x); f[2] = lo_f(w.y); f[3] = hi_f(w.y); f[4] = lo_f(w.z); f[5] = hi_f(w.z); f[6] = lo_f(w.w); f[7] = hi_f(w.w); }
        }
        const int myi0 = ridx[(size_t)t * 128 + lane], myi1 = ridx[(size_t)t * 128 + 64 + lane];
        const float myg0 = rgate[(size_t)t * 128 + lane], myg1 = rgate[(size_t)t * 128 + 64 + lane];
        float dots0 = 0.f, dots1 = 0.f;
#pragma unroll 1
        for (int eb = 0; eb < 128; eb += 8) {
            const int idxv = eb < 64 ? myi0 : myi1;
            u32x4_t r[8][NCH];
#pragma unroll
            for (int k = 0; k < 8; ++k) {
                const int idx = __builtin_amdgcn_readlane(idxv, (eb & 63) + k);
                const unsigned char* row = utab + (size_t)idx * ROWB + lane * 16;
#pragma unroll
                for (int j = 0; j < NCH; ++j) r[k][j] = *(const u32x4_t*)(row + j * 1024);
            }
            float d[8];
#pragma unroll
            for (int k = 0; k < 8; ++k) {
                float s = 0.f;
#pragma unroll
                for (int j = 0; j < NCH; ++j) { float f[EPC]; dec_chunk<EB>(r[k][j], f);
#pragma unroll
                    for (int q = 0; q < EPC; ++q) s += f[q] * hv[j * EPC + q]; }
                asm volatile("" : "+v"(s));
                d[k] = s;
                __builtin_amdgcn_sched_barrier(0);
            }
            float n4[4], n2[2];
#pragma unroll
            for (int i = 0; i < 4; ++i) { const bool hi = lane & 1; const float send = hi ? d[2 * i] : d[2 * i + 1], keep = hi ? d[2 * i + 1] : d[2 * i]; n4[i] = keep + __shfl_xor(send, 1); }
#pragma unroll
            for (int i = 0; i < 2; ++i) { const bool hi = lane & 2; const float send = hi ? n4[2 * i] : n4[2 * i + 1], keep = hi ? n4[2 * i + 1] : n4[2 * i]; n2[i] = keep + __shfl_xor(send, 2); }
            float tot;
            { const bool hi = lane & 4; const float send = hi ? n2[0] : n2[1], keep = hi ? n2[1] : n2[0]; tot = keep + __shfl_xor(send, 4); }
            tot += __shfl_xor(tot, 8); tot += __shfl_xor(tot, 16); tot += __shfl_xor(tot, 32);
            const bool mine = (lane >> 3) == ((eb & 63) >> 3);
            if (eb < 64) dots0 = mine ? tot : dots0; else dots1 = mine ? tot : dots1;
        }
        const float cf0 = myg0 * gelu_exact(dots0 * usc[myi0]) * vsc[myi0], cf1 = myg1 * gelu_exact(dots1 * usc[myi1]) * vsc[myi1];
        float y[32];
#pragma unroll
        for (int q = 0; q < 32; ++q) y[q] = 0.f;
#pragma unroll 1
        for (int eb = 0; eb < 128; eb += 8) {
            const int idxv = eb < 64 ? myi0 : myi1; const float cfv = eb < 64 ? cf0 : cf1;
            u32x4_t r[8][NCH];
#pragma unroll
            for (int k = 0; k < 8; ++k) {
                const int idx = __builtin_amdgcn_readlane(idxv, (eb & 63) + k);
                const unsigned char* row = vtab + (size_t)idx * ROWB + lane * 16;
#pragma unroll
                for (int j = 0; j < NCH; ++j) r[k][j] = *(const u32x4_t*)(row + j * 1024);
            }
#pragma unroll
            for (int k = 0; k < 8; ++k) {
                const float cf = __uint_as_float((unsigned)__builtin_amdgcn_readlane((int)__float_as_uint(cfv), (eb & 63) + k));
#pragma unroll
                for (int j = 0; j < NCH; ++j) { float f[EPC]; dec_chunk<EB>(r[k][j], f);
#pragma unroll
                    for (int q = 0; q < EPC; ++q) y[j * EPC + q] += cf * f[q]; }
                asm volatile("" : "+v"(y[0]), "+v"(y[1]), "+v"(y[2]), "+v"(y[3]), "+v"(y[4]), "+v"(y[5]), "+v"(y[6]), "+v"(y[7]), "+v"(y[8]), "+v"(y[9]), "+v"(y[10]), "+v"(y[11]), "+v"(y[12]), "+v"(y[13]), "+v"(y[14]), "+v"(y[15]));
                asm volatile("" : "+v"(y[16]), "+v"(y[17]), "+v"(y[18]), "+v"(y[19]), "+v"(y[20]), "+v"(y[21]), "+v"(y[22]), "+v"(y[23]), "+v"(y[24]), "+v"(y[25]), "+v"(y[26]), "+v"(y[27]), "+v"(y[28]), "+v"(y[29]), "+v"(y[30]), "+v"(y[31]));
                __builtin_amdgcn_sched_barrier(0);
            }
        }
        float ss = 0.f;
#pragma unroll
        for (int j = 0; j < NCH; ++j)
#pragma unroll
            for (int q4 = 0; q4 < EPC / 4; ++q4) {
                const int col = (j * 64 + lane) * EPC + q4 * 4;
                const float4 xv = *(const float4*)(x1 + (size_t)t * DM + col); const float4 g2 = *(const float4*)(mod + (size_t)b * 12288 + 5 * 2048 + col);
                float* yy = y + j * EPC + q4 * 4;
                yy[0] = xv.x + g2.x * yy[0]; yy[1] = xv.y + g2.y * yy[1]; yy[2] = xv.z + g2.z * yy[2]; yy[3] = xv.w + g2.w * yy[3];
                ss += yy[0] * yy[0] + yy[1] * yy[1] + yy[2] * yy[2] + yy[3] * yy[3];
                if (q4 & 1) __builtin_amdgcn_sched_barrier(0);
            }
        ss = wave_sum(ss);
        const float rstd = rsqrtf(ss * (1.0f / DM) + EPS);
#pragma unroll
        for (int j = 0; j < NCH; ++j)
#pragma unroll
            for (int q4 = 0; q4 < EPC / 4; ++q4) {
                const int col = (j * 64 + lane) * EPC + q4 * 4; const float4 fg = *(const float4*)(p.fin_g + col);
                const float* yy = y + j * EPC + q4 * 4;
                float4 o; o.x = yy[0] * rstd * fg.x; o.y = yy[1] * rstd * fg.y; o.z = yy[2] * rstd * fg.z; o.w = yy[3] * rstd * fg.w;
                *(float4*)(p.out + (size_t)t * DM + col) = o;
                if (q4 & 1) __builtin_amdgcn_sched_barrier(0);
            }
    }
}


typedef float v32f_t __attribute__((ext_vector_type(32)));
typedef float v16f_t __attribute__((ext_vector_type(16)));
typedef unsigned v6u_t __attribute__((ext_vector_type(6)));
typedef _Float16 v32h_t __attribute__((ext_vector_type(32)));
typedef _Float16 h2_t __attribute__((ext_vector_type(2)));
typedef _Float16 h4_t __attribute__((ext_vector_type(4)));
typedef float f32x4v_t __attribute__((ext_vector_type(4)));
typedef unsigned u32x2_t __attribute__((ext_vector_type(2)));
__device__ __forceinline__ float wave_max_noaddr(float v) {
    v = fmaxf(v, __int_as_float(__builtin_amdgcn_ds_swizzle(__float_as_int(v), (1 << 10) | 0x1f)));
    v = fmaxf(v, __int_as_float(__builtin_amdgcn_ds_swizzle(__float_as_int(v), (2 << 10) | 0x1f)));
    v = fmaxf(v, __int_as_float(__builtin_amdgcn_ds_swizzle(__float_as_int(v), (4 << 10) | 0x1f)));
    v = fmaxf(v, __int_as_float(__builtin_amdgcn_ds_swizzle(__float_as_int(v), (8 << 10) | 0x1f)));
    v = fmaxf(v, __int_as_float(__builtin_amdgcn_ds_swizzle(__float_as_int(v), (16 << 10) | 0x1f)));
    auto r = __builtin_amdgcn_permlane32_swap(__float_as_uint(v), __float_as_uint(v), false, false);
    return fmaxf(__uint_as_float(r[0]), __uint_as_float(r[1]));
}
__device__ __forceinline__ void job_table6(const Params& p, int it) {
    const int tidf = tid_fresh(p.widx), lane = tidf & 63, wid = tidf >> 6;
    const int tab = it >> 9, r0 = (it & 511) * 32;
    const float* src = tab ? p.v_tab : p.u_tab;
    unsigned char* dst = p.ws + (tab ? OFF_VTAB : OFF_UTAB);
    float* scl = WS<float>(p, tab ? OFF_VSC : OFF_USC);
    typedef float f32x4v __attribute__((ext_vector_type(4)));
    f32x4v v[4][8];
#pragma unroll
    for (int rr = 0; rr < 4; ++rr)
#pragma unroll
        for (int j = 0; j < 8; ++j) v[rr][j] = __builtin_nontemporal_load((const f32x4v*)(src + (size_t)(r0 + wid * 4 + rr) * DM + (j * 64 + lane) * 4));
#pragma unroll
    for (int rr = 0; rr < 4; ++rr) {
        const int row = r0 + wid * 4 + rr;
        v16f_t a, b; float am = 0.f;
#pragma unroll
        for (int j = 0; j < 8; ++j) { const f32x4v w = v[rr][j];
            a[2 * j] = w.x; b[2 * j] = w.y; a[2 * j + 1] = w.z; b[2 * j + 1] = w.w; am = fmaxf(am, fmaxf(fmaxf(fabsf(w.x), fabsf(w.y)), fmaxf(fabsf(w.z), fabsf(w.w)))); }
        am = wave_max_noaddr(am);
        const int e = (int)((__float_as_uint(am) >> 23) & 255u) - 127;
        const float sc = am > 0.f ? __uint_as_float((unsigned)(127 + 2 - e) << 23) : 1.0f;
        if (lane == 0) scl[row] = am > 0.f ? __uint_as_float((unsigned)(127 - 2 + e) << 23) : 1.0f;
        a = a * sc; b = b * sc;
        const v6u_t pk = __builtin_amdgcn_cvt_scalef32_2xpk16_fp6_f32(a, b, 1.0f);
#if PEER_SLICED
        { unsigned char* d6 = dst + ((size_t)(lane >> 3) * NEXP + row) * 192;
          u32x4_t w0 = {pk[0], pk[1], pk[2], pk[3]}; u32x2_t w1 = {pk[4], pk[5]};
          *(u32x4_t*)(d6 + (lane & 7) * 16) = w0; *(u32x2_t*)(d6 + 128 + (lane & 7) * 8) = w1; }
#else
        u32x4_t w0 = {pk[0], pk[1], pk[2], pk[3]}; u32x2_t w1 = {pk[4], pk[5]};
        *(u32x4_t*)(dst + (size_t)row * 1536 + lane * 16) = w0;
        *(u32x2_t*)(dst + (size_t)row * 1536 + 1024 + lane * 8) = w1;
#endif
    }
}

#define PG6_LOAD(RA, RB, tab, iv, e0) do { _Pragma("unroll") for (int k = 0; k < 8; ++k) { \
        const unsigned idx_ = (unsigned)__builtin_amdgcn_readlane((iv), (e0) + k); const unsigned char* row_ = (tab) + (size_t)idx_ * 1536u;     \
        RA[k] = *(const u32x4_t*)(row_ + lane16); RB[k] = *(const u32x2_t*)(row_ + 1024u + lane8); } } while (0)
#define PG6_CU(RA, RB, eb) do { float d[8]; \
        _Pragma("unroll") for (int k = 0; k < 8; ++k) { \
            const v6u_t pk_ = {RA[k][0], RA[k][1], RA[k][2], RA[k][3], RB[k][0], RB[k][1]}; \
            const v32h_t f_ = __builtin_amdgcn_cvt_scalef32_pk32_f16_fp6(pk_, 1.0f); float s0_ = 0.f, s1_ = 0.f, s2_ = 0.f, s3_ = 0.f; \
            _Pragma("unroll") for (int q = 0; q < 16; q += 4) { \
                s0_ = __builtin_amdgcn_fdot2((h2_t){f_[2 * q], f_[2 * q + 1]}, hvh[q], s0_, false); s1_ = __builtin_amdgcn_fdot2((h2_t){f_[2 * q + 2], f_[2 * q + 3]}, hvh[q + 1], s1_, false); \
                s2_ = __builtin_amdgcn_fdot2((h2_t){f_[2 * q + 4], f_[2 * q + 5]}, hvh[q + 2], s2_, false); s3_ = __builtin_amdgcn_fdot2((h2_t){f_[2 * q + 6], f_[2 * q + 7]}, hvh[q + 3], s3_, false); } \
            float s_ = (s0_ + s1_) + (s2_ + s3_);             \
            asm volatile("" : "+v"(s_)); d[k] = s_; __builtin_amdgcn_sched_barrier(0); } \
        float n4[4], n2[2], tot; \
        _Pragma("unroll") for (int i_ = 0; i_ < 4; ++i_) { const bool hi_ = lane & 1; const float send = hi_ ? d[2 * i_] : d[2 * i_ + 1], keep = hi_ ? d[2 * i_ + 1] : d[2 * i_]; n4[i_] = keep + __shfl_xor(send, 1); } \
        _Pragma("unroll") for (int i_ = 0; i_ < 2; ++i_) { const bool hi_ = lane & 2; const float send = hi_ ? n4[2 * i_] : n4[2 * i_ + 1], keep = hi_ ? n4[2 * i_ + 1] : n4[2 * i_]; n2[i_] = keep + __shfl_xor(send, 2); } \
        { const bool hi_ = lane & 4; const float send = hi_ ? n2[0] : n2[1], keep = hi_ ? n2[1] : n2[0]; tot = keep + __shfl_xor(send, 4); } \
        tot += __shfl_xor(tot, 8); tot += __shfl_xor(tot, 16); tot += __shfl_xor(tot, 32); \
        const bool mine_ = (lane >> 3) == (((eb) & 63) >> 3); \
        if ((eb) < 64) dots0 = mine_ ? tot : dots0; else dots1 = mine_ ? tot : dots1; } while (0)
#define PG6_CU4(RA, RB, eb) do { float d[8]; \
        _Pragma("unroll") for (int k = 0; k < 8; k += 2) { \
            const v6u_t pka_ = {RA[k][0], RA[k][1], RA[k][2], RA[k][3], RB[k][0], RB[k][1]}; const v6u_t pkb_ = {RA[k + 1][0], RA[k + 1][1], RA[k + 1][2], RA[k + 1][3], RB[k + 1][0], RB[k + 1][1]}; \
            const v32h_t fa_ = __builtin_amdgcn_cvt_scalef32_pk32_f16_fp6(pka_, 1.0f), fb_ = __builtin_amdgcn_cvt_scalef32_pk32_f16_fp6(pkb_, 1.0f); \
            f32x4v_t ca_ = {0.f, 0.f, 0.f, 0.f}, cb_ = {0.f, 0.f, 0.f, 0.f}; \
            _Pragma("unroll") for (int q = 0; q < 8; ++q) { \
                ca_ = __builtin_amdgcn_mfma_f32_4x4x4f16((h4_t){fa_[4 * q], fa_[4 * q + 1], fa_[4 * q + 2], fa_[4 * q + 3]}, hv4[q], ca_, 0, 0, 0); \
                cb_ = __builtin_amdgcn_mfma_f32_4x4x4f16((h4_t){fb_[4 * q], fb_[4 * q + 1], fb_[4 * q + 2], fb_[4 * q + 3]}, hv4[q], cb_, 0, 0, 0); } \
            float sa_ = l3b1 ? (l3b0 ? ca_[3] : ca_[2]) : (l3b0 ? ca_[1] : ca_[0]), sb_ = l3b1 ? (l3b0 ? cb_[3] : cb_[2]) : (l3b0 ? cb_[1] : cb_[0]); \
            asm volatile("" : "+v"(sa_), "+v"(sb_)); d[k] = sa_; d[k + 1] = sb_; __builtin_amdgcn_sched_barrier(0); } \
        float n4[4], n2[2], tot; \
        _Pragma("unroll") for (int i_ = 0; i_ < 4; ++i_) { const bool hi_ = lane & 1; const float send = hi_ ? d[2 * i_] : d[2 * i_ + 1], keep = hi_ ? d[2 * i_ + 1] : d[2 * i_]; n4[i_] = keep + __shfl_xor(send, 1); } \
        _Pragma("unroll") for (int i_ = 0; i_ < 2; ++i_) { const bool hi_ = lane & 2; const float send = hi_ ? n4[2 * i_] : n4[2 * i_ + 1], keep = hi_ ? n4[2 * i_ + 1] : n4[2 * i_]; n2[i_] = keep + __shfl_xor(send, 2); } \
        { const bool hi_ = lane & 4; const float send = hi_ ? n2[0] : n2[1], keep = hi_ ? n2[1] : n2[0]; tot = keep + __shfl_xor(send, 4); } \
        tot += __shfl_xor(tot, 8); tot += __shfl_xor(tot, 16); tot += __shfl_xor(tot, 32); \
        const bool mine_ = (lane >> 3) == (((eb) & 63) >> 3); \
        if ((eb) < 64) dots0 = mine_ ? tot : dots0; else dots1 = mine_ ? tot : dots1; } while (0)
#define PG6_CV(RA, RB, eb) do { const float cfv_ = (eb) < 64 ? cf0 : cf1; \
        _Pragma("unroll") for (int k = 0; k < 8; ++k) { \
            const _Float16 ch_ = (_Float16)__uint_as_float((unsigned)__builtin_amdgcn_readlane((int)__float_as_uint(cfv_), ((eb) & 63) + k)); const h2_t c2_ = {ch_, ch_}; \
            const v6u_t pk_ = {RA[k][0], RA[k][1], RA[k][2], RA[k][3], RB[k][0], RB[k][1]}; \
            const v32h_t f_ = __builtin_amdgcn_cvt_scalef32_pk32_f16_fp6(pk_, 1.0f); \
            _Pragma("unroll") for (int q = 0; q < 16; ++q) yh[q] = (h2_t){f_[2 * q], f_[2 * q + 1]} * c2_ + yh[q]; \
            asm volatile("" : "+v"(yh[0]), "+v"(yh[1]), "+v"(yh[2]), "+v"(yh[3]), "+v"(yh[4]), "+v"(yh[5]), "+v"(yh[6]), "+v"(yh[7]), "+v"(yh[8]), "+v"(yh[9]), "+v"(yh[10]), "+v"(yh[11]), "+v"(yh[12]), "+v"(yh[13]), "+v"(yh[14]), "+v"(yh[15])); \
            __builtin_amdgcn_sched_barrier(0); } } while (0)
#define PG6_CV4(RA, RB, eb) do { const unsigned ccv_ = (eb) < 64 ? cc0 : cc1; \
        _Pragma("unroll") for (int k = 0; k < 8; ++k) { \
            const unsigned cs_ = (unsigned)__builtin_amdgcn_readlane((int)ccv_, ((eb) & 63) + k); \
            union { unsigned u[2]; h4_t h; } am_; am_.u[0] = cs_ & am0; am_.u[1] = cs_ & am1; \
            const v6u_t pk_ = {RA[k][0], RA[k][1], RA[k][2], RA[k][3], RB[k][0], RB[k][1]}; \
            const v32h_t f_ = __builtin_amdgcn_cvt_scalef32_pk32_f16_fp6(pk_, 1.0f); \
            _Pragma("unroll") for (int q = 0; q < 8; ++q) ya[q] = __builtin_amdgcn_mfma_f32_4x4x4f16(am_.h, (h4_t){f_[4 * q], f_[4 * q + 1], f_[4 * q + 2], f_[4 * q + 3]}, ya[q], 0, 0, 0); \
            if (k & 1) __builtin_amdgcn_sched_barrier(0); } } while (0)
__device__ __forceinline__ void phase_peer_gather6(const Params& p, int bid, int nblk) {
    const int tidf = tid_fresh(p.widx), lane = tidf & 63, wid = tidf >> 6;
    const unsigned lane16 = (unsigned)lane * 16u, lane8 = (unsigned)lane * 8u;
    const unsigned char* utab = p.ws + OFF_UTAB; const unsigned char* vtab = p.ws + OFF_VTAB;
    const float* usc = WS<float>(p, OFF_USC); const float* vsc = WS<float>(p, OFF_VSC);
    const bf16_t* h2 = WS<bf16_t>(p, OFF_H); const float* x1 = WS<float>(p, OFF_X1); const float* mod = WS<float>(p, OFF_MOD);
    const int* ridx = WS<int>(p, OFF_RIDX); const float* rgate = WS<float>(p, OFF_RGATE);
    const int tstep = nblk * 8;
    int t = bid * 8 + wid;
    if (t >= TOK) return;
    int myi0 = ridx[(size_t)t * 128 + lane], myi1 = ridx[(size_t)t * 128 + 64 + lane];
    u32x4_t a4[8], b4[8]; u32x2_t a2[8], b2[8];
    PG6_LOAD(a4, a2, utab, myi0, 0);
    for (; t < TOK; t += tstep) {
        const int b = t >> 12;
        const int tn = t + tstep; const bool more = tn < TOK;
        const int ni0 = more ? ridx[(size_t)tn * 128 + lane] : 0, ni1 = more ? ridx[(size_t)tn * 128 + 64 + lane] : 0;
        const float myg0 = rgate[(size_t)t * 128 + lane], myg1 = rgate[(size_t)t * 128 + 64 + lane];
        float hv[32];
        { const bf16_t* hp = h2 + (size_t)t * DM + lane * 4;
#pragma unroll
          for (int j = 0; j < 8; ++j) { const uint2 w = *(const uint2*)(hp + j * 256); float* f = hv + j * 4;
              f[0] = lo_f(w.x); f[1] = hi_f(w.x); f[2] = lo_f(w.y); f[3] = hi_f(w.y); } }
        h2_t hvh[16];
#pragma unroll
        for (int q = 0; q < 16; ++q) hvh[q] = (h2_t){(_Float16)hv[2 * q], (_Float16)hv[2 * q + 1]};
        float dots0 = 0.f, dots1 = 0.f;
#pragma unroll 1
        for (int eb = 0; eb < 128; eb += 16) {
            { const int e1 = eb + 8; PG6_LOAD(b4, b2, utab, (e1 < 64 ? myi0 : myi1), (e1 & 63)); }
            PG6_CU(a4, a2, eb);
            if (eb + 16 < 128) { const int e2 = eb + 16; PG6_LOAD(a4, a2, utab, (e2 < 64 ? myi0 : myi1), (e2 & 63)); }
            else PG6_LOAD(a4, a2, vtab, myi0, 0);
            PG6_CU(b4, b2, eb + 8);
        }
        const float cf0 = myg0 * gelu_exact(dots0 * usc[myi0]) * vsc[myi0], cf1 = myg1 * gelu_exact(dots1 * usc[myi1]) * vsc[myi1];
        h2_t yh[16];
#pragma unroll
        for (int q = 0; q < 16; ++q) yh[q] = (h2_t){(_Float16)0.f, (_Float16)0.f};
#pragma unroll 1
        for (int eb = 0; eb < 128; eb += 16) {
            { const int e1 = eb + 8; PG6_LOAD(b4, b2, vtab, (e1 < 64 ? myi0 : myi1), (e1 & 63)); }
            PG6_CV(a4, a2, eb);
            if (eb + 16 < 128) { const int e2 = eb + 16; PG6_LOAD(a4, a2, vtab, (e2 < 64 ? myi0 : myi1), (e2 & 63)); }
            else if (more) PG6_LOAD(a4, a2, utab, ni0, 0);
            PG6_CV(b4, b2, eb + 8);
        }
        myi0 = ni0; myi1 = ni1;
        float y[32];
#pragma unroll
        for (int q = 0; q < 16; ++q) { y[2 * q] = (float)yh[q][0]; y[2 * q + 1] = (float)yh[q][1]; }
        float ss = 0.f;
#pragma unroll
        for (int q4 = 0; q4 < 8; ++q4) {
            const int col = (q4 * 64 + lane) * 4;
            const float4 xv = *(const float4*)(x1 + (size_t)t * DM + col); const float4 g2 = *(const float4*)(mod + (size_t)b * 12288 + 5 * 2048 + col);
            float* yy = y + q4 * 4;
            yy[0] = xv.x + g2.x * yy[0]; yy[1] = xv.y + g2.y * yy[1]; yy[2] = xv.z + g2.z * yy[2]; yy[3] = xv.w + g2.w * yy[3];
            ss += yy[0] * yy[0] + yy[1] * yy[1] + yy[2] * yy[2] + yy[3] * yy[3];
            if (q4 & 1) __builtin_amdgcn_sched_barrier(0);
        }
        ss = wave_sum(ss);
        const float rstd = rsqrtf(ss * (1.0f / DM) + EPS);
#pragma unroll
        for (int q4 = 0; q4 < 8; ++q4) {
            const int col = (q4 * 64 + lane) * 4; const float4 fg = *(const float4*)(p.fin_g + col);
            const float* yy = y + q4 * 4;
            float4 o; o.x = yy[0] * rstd * fg.x; o.y = yy[1] * rstd * fg.y; o.z = yy[2] * rstd * fg.z; o.w = yy[3] * rstd * fg.w;
            *(float4*)(p.out + (size_t)t * DM + col) = o;
            if (q4 & 1) __builtin_amdgcn_sched_barrier(0);
        }
    }
}


__device__ __forceinline__ int ld_agent(const int* q) { return __hip_atomic_load(q, __ATOMIC_RELAXED, __HIP_MEMORY_SCOPE_AGENT); }
__device__ __forceinline__ float ld_agent(const float* q) { return __hip_atomic_load(q, __ATOMIC_RELAXED, __HIP_MEMORY_SCOPE_AGENT); }
__device__ __forceinline__ void phase_peer_u6(const Params& p, int bid, int nblk) {
    const int tidf = tid_fresh(p.widx), lane = tidf & 63, wid = tidf >> 6;
    const unsigned lane16 = (unsigned)lane * 16u, lane8 = (unsigned)lane * 8u;
    const unsigned char* utab = p.ws + OFF_UTAB;
    const float* usc = WS<float>(p, OFF_USC); const float* vsc = WS<float>(p, OFF_VSC);
    const bf16_t* h2 = WS<bf16_t>(p, OFF_H); const int* ridx = WS<int>(p, OFF_RIDX); const float* rgate = WS<float>(p, OFF_RGATE); float* cfo = WS<float>(p, OFF_PD);
    const int tstep = nblk * 8;
    const bool l3b0 = (lane & 1) != 0, l3b1 = (lane & 2) != 0;
    int t = bid * 8 + wid;
    if (t >= TOK) return;
    int myi0 = ld_agent(ridx + (size_t)t * 128 + lane), myi1 = ld_agent(ridx + (size_t)t * 128 + 64 + lane);
    u32x4_t a4[8], b4[8]; u32x2_t a2[8], b2[8];
    PG6_LOAD(a4, a2, utab, myi0, 0);
    for (; t < TOK; t += tstep) {
        const int tn = t + tstep; const bool more = tn < TOK;
        const int ni0 = more ? ld_agent(ridx + (size_t)tn * 128 + lane) : 0, ni1 = more ? ld_agent(ridx + (size_t)tn * 128 + 64 + lane) : 0;
        const float myg0 = ld_agent(rgate + (size_t)t * 128 + lane), myg1 = ld_agent(rgate + (size_t)t * 128 + 64 + lane);
        const float us0 = usc[myi0], us1 = usc[myi1], vs0 = vsc[myi0], vs1 = vsc[myi1];
        h4_t hv4[8];
        { const bf16_t* hp = h2 + (size_t)t * DM + lane * 4;
#pragma unroll
          for (int j = 0; j < 8; ++j) { const uint2 w = *(const uint2*)(hp + j * 256);
              hv4[j] = (h4_t){(_Float16)lo_f(w.x), (_Float16)hi_f(w.x), (_Float16)lo_f(w.y), (_Float16)hi_f(w.y)}; } }
        float dots0 = 0.f, dots1 = 0.f;
#pragma unroll 1
        for (int eb = 0; eb < 128; eb += 16) {
            { const int e1 = eb + 8; PG6_LOAD(b4, b2, utab, (e1 < 64 ? myi0 : myi1), (e1 & 63)); }
            PG6_CU4(a4, a2, eb);
            if (eb + 16 < 128) { const int e2 = eb + 16; PG6_LOAD(a4, a2, utab, (e2 < 64 ? myi0 : myi1), (e2 & 63)); }
            else if (more) PG6_LOAD(a4, a2, utab, ni0, 0);
            PG6_CU4(b4, b2, eb + 8);
        }
        cfo[(size_t)t * 128 + lane] = myg0 * gelu_exact(dots0 * us0) * vs0;
        cfo[(size_t)t * 128 + 64 + lane] = myg1 * gelu_exact(dots1 * us1) * vs1;
        myi0 = ni0; myi1 = ni1;
    }
}
__device__ __forceinline__ void phase_peer_v6(const Params& p, int bid, int nblk) {
    const int tidf = tid_fresh(p.widx), lane = tidf & 63, wid = tidf >> 6;
    const unsigned lane16 = (unsigned)lane * 16u, lane8 = (unsigned)lane * 8u;
    const unsigned char* vtab = p.ws + OFF_VTAB;
    const bf16_t* x1 = WS<bf16_t>(p, OFF_X1); const float* mod = WS<float>(p, OFF_MOD);
    const int* ridx = WS<int>(p, OFF_RIDX); const float* cfi = WS<float>(p, OFF_PD);
    const int tstep = nblk * 8;
    int t = bid * 8 + wid;
    if (t >= TOK) return;
    int myi0 = ld_agent(ridx + (size_t)t * 128 + lane), myi1 = ld_agent(ridx + (size_t)t * 128 + 64 + lane);
    const unsigned am0 = (lane & 3) == 0 ? 0x0000ffffu : ((lane & 3) == 1 ? 0xffff0000u : 0u), am1 = (lane & 3) == 2 ? 0x0000ffffu : ((lane & 3) == 3 ? 0xffff0000u : 0u);
    float cf0 = __hip_atomic_load(cfi + (size_t)t * 128 + lane, __ATOMIC_RELAXED, __HIP_MEMORY_SCOPE_AGENT), cf1 = __hip_atomic_load(cfi + (size_t)t * 128 + 64 + lane, __ATOMIC_RELAXED, __HIP_MEMORY_SCOPE_AGENT);
    u32x4_t a4[8], b4[8]; u32x2_t a2[8], b2[8];
    PG6_LOAD(a4, a2, vtab, myi0, 0);
    for (; t < TOK; t += tstep) {
        const int b = t >> 12;
        const int tn = t + tstep; const bool more = tn < TOK;
        const int ni0 = more ? ld_agent(ridx + (size_t)tn * 128 + lane) : 0, ni1 = more ? ld_agent(ridx + (size_t)tn * 128 + 64 + lane) : 0;
        const float nc0 = more ? __hip_atomic_load(cfi + (size_t)tn * 128 + lane, __ATOMIC_RELAXED, __HIP_MEMORY_SCOPE_AGENT) : 0.f, nc1 = more ? __hip_atomic_load(cfi + (size_t)tn * 128 + 64 + lane, __ATOMIC_RELAXED, __HIP_MEMORY_SCOPE_AGENT) : 0.f;
        uint2 xr[8];
#pragma unroll
        for (int q4 = 0; q4 < 8; ++q4) xr[q4] = *(const uint2*)(x1 + (size_t)t * DM + (q4 * 64 + lane) * 4);
        f32x4v_t ya[8];
#pragma unroll
        for (int q = 0; q < 8; ++q) ya[q] = (f32x4v_t){0.f, 0.f, 0.f, 0.f};
        unsigned cc0, cc1;
        { union { h2_t h; unsigned u; } c_; c_.h = (h2_t){(_Float16)cf0, (_Float16)cf0}; cc0 = c_.u; c_.h = (h2_t){(_Float16)cf1, (_Float16)cf1}; cc1 = c_.u; }
#pragma unroll 1
        for (int eb = 0; eb < 128; eb += 16) {
            { const int e1 = eb + 8; PG6_LOAD(b4, b2, vtab, (e1 < 64 ? myi0 : myi1), (e1 & 63)); }
            PG6_CV4(a4, a2, eb);
            if (eb + 16 < 128) { const int e2 = eb + 16; PG6_LOAD(a4, a2, vtab, (e2 < 64 ? myi0 : myi1), (e2 & 63)); }
            else if (more) PG6_LOAD(a4, a2, vtab, ni0, 0);
            PG6_CV4(b4, b2, eb + 8);
        }
        myi0 = ni0; myi1 = ni1; cf0 = nc0; cf1 = nc1;
        float y[32];
#pragma unroll
        for (int q = 0; q < 8; ++q) { y[4 * q] = ya[q][0]; y[4 * q + 1] = ya[q][1]; y[4 * q + 2] = ya[q][2]; y[4 * q + 3] = ya[q][3]; }
        float ss = 0.f;
#pragma unroll
        for (int q4 = 0; q4 < 8; ++q4) {
            const int col = (q4 * 64 + lane) * 4;
            const uint2 xw = xr[q4]; const float4 g2 = *(const float4*)(mod + (size_t)b * 12288 + 5 * 2048 + col);
            float4 xv; xv.x = lo_f(xw.x); xv.y = hi_f(xw.x); xv.z = lo_f(xw.y); xv.w = hi_f(xw.y);
            float* yy = y + q4 * 4;
            yy[0] = xv.x + g2.x * yy[0]; yy[1] = xv.y + g2.y * yy[1]; yy[2] = xv.z + g2.z * yy[2]; yy[3] = xv.w + g2.w * yy[3];
            ss += yy[0] * yy[0] + yy[1] * yy[1] + yy[2] * yy[2] + yy[3] * yy[3];
            if (q4 & 1) __builtin_amdgcn_sched_barrier(0);
        }
        ss = wave_sum(ss);
        const float rstd = rsqrtf(ss * (1.0f / DM) + EPS);
#pragma unroll
        for (int q4 = 0; q4 < 8; ++q4) {
            const int col = (q4 * 64 + lane) * 4; const float4 fg = *(const float4*)(p.fin_g + col);
            const float* yy = y + q4 * 4;
            float4 o; o.x = yy[0] * rstd * fg.x; o.y = yy[1] * rstd * fg.y; o.z = yy[2] * rstd * fg.z; o.w = yy[3] * rstd * fg.w;
            *(float4*)(p.out + (size_t)t * DM + col) = o;
            if (q4 & 1) __builtin_amdgcn_sched_barrier(0);
        }
    }
}

#define XB_TMO      128
#define XB_XCNT(j)  (256  + 64 * (j))
#define XB_XSUB(j)  (1280 + 64 * (j))
#define XB_XGEN(j)  (2304 + 64 * (j))
#define XB_TOP      3328
#define XB_TOPGEN   3392
#define XCD_BAR_WORDS 3456
#define XB_SPIN_CAP (1u << 18)

__device__ __forceinline__ unsigned xb_ld(unsigned* p)              { return __hip_atomic_load(p, __ATOMIC_RELAXED, __HIP_MEMORY_SCOPE_AGENT); }
__device__ __forceinline__ unsigned xb_add(unsigned* p, unsigned v) { return __hip_atomic_fetch_add(p, v, __ATOMIC_RELAXED, __HIP_MEMORY_SCOPE_AGENT); }
__device__ __forceinline__ unsigned xb_xcc_id() { return (unsigned)__builtin_amdgcn_s_getreg((3 << 11) | 20) & 0xFu; }
#define XB_SPIN(cond, bar) do { unsigned _sp = 0; while (cond) { __builtin_amdgcn_s_sleep(1); \
    if ((++_sp & 255u) == 0u) { if (xb_ld(&(bar)[XB_TMO])) break; if (_sp > XB_SPIN_CAP) { atomicAdd(&(bar)[XB_TMO], 1u); break; } } } } while (0)

struct XcdBarrier {
    int widx;
    unsigned* bar; unsigned x;
    volatile LAS unsigned* st;
};

__device__ __forceinline__ bool xb_thread0(int widx) { unsigned m = ~0u; asm volatile("" : "+s"(m)); return widx == 0 && __builtin_amdgcn_mbcnt_hi(m, __builtin_amdgcn_mbcnt_lo(m, 0u)) == 0u; }
__device__ __forceinline__ XcdBarrier xcd_barrier_post(unsigned* bar, volatile LAS unsigned* st, int widx) {
    XcdBarrier b; b.widx = widx; b.bar = bar; b.x = xb_xcc_id(); b.st = st;
    if (xb_thread0(widx)) (void)xb_add(&bar[XB_XCNT(b.x)], 1u);
    return b;
}
__device__ __forceinline__ void xcd_barrier_complete(unsigned* bar, unsigned x, unsigned& nloc, unsigned& nx) {
    const unsigned G = gridDim.x * gridDim.y * gridDim.z;
    unsigned sum, cnt, mine, sp = 0u;
    for (;;) {
        sum = 0u; cnt = 0u; mine = 0u;
#pragma unroll
        for (unsigned j = 0; j < 16; ++j) { const unsigned c = xb_ld(&bar[XB_XCNT(j)]); sum += c; cnt += (c > 0u) ? 1u : 0u; mine = (j == x) ? c : mine; }
        if (sum == G) break;
        __builtin_amdgcn_s_sleep(1);
        if ((++sp & 255u) == 0u) { if (xb_ld(&bar[XB_TMO])) break; if (sp > XB_SPIN_CAP) { atomicAdd(&bar[XB_TMO], 1u); break; } }
    }
    nloc = mine > 0u ? mine : 1u; nx = cnt > 0u ? cnt : 1u;
}

__device__ __forceinline__ void xcd_barrier(const XcdBarrier& b) {
    asm volatile("s_waitcnt vmcnt(0)" ::: "memory");
    __syncthreads();
    if (xb_thread0(b.widx)) {
        unsigned* bar = b.bar;
        __builtin_amdgcn_s_waitcnt(0);
        unsigned nloc = b.st[0], nx = b.st[1];
        if (nloc == 0u) { xcd_barrier_complete(bar, b.x, nloc, nx); b.st[0] = nloc; b.st[1] = nx; }
        const unsigned old = xb_add(&bar[XB_XSUB(b.x)], 1u);
        const unsigned gen = old / nloc;
        if (old + 1u == (gen + 1u) * nloc) {
            __builtin_amdgcn_fence(__ATOMIC_RELEASE, "agent");
            asm volatile("s_waitcnt vmcnt(0)" ::: "memory");
            const unsigned og = xb_add(&bar[XB_TOP], 1u);
            const unsigned tg = og / nx;
            if (og + 1u == (tg + 1u) * nx) xb_add(&bar[XB_TOPGEN], 1u);
            else XB_SPIN(xb_ld(&bar[XB_TOPGEN]) == tg, bar);
            __builtin_amdgcn_fence(__ATOMIC_ACQUIRE, "agent");
            xb_add(&bar[XB_XGEN(b.x)], 1u);
            asm volatile("s_waitcnt vmcnt(0)" ::: "memory");
        } else {
            XB_SPIN(xb_ld(&bar[XB_XGEN(b.x)]) == gen, bar);
            __builtin_amdgcn_fence(__ATOMIC_ACQUIRE, "agent");
            asm volatile("s_waitcnt vmcnt(0)" ::: "memory");
        }
    }
    __syncthreads();
}


constexpr int PS_Q_WORD = 3968;
__device__ __forceinline__ unsigned ps_next(unsigned* q, LAS unsigned* bc, int tid) {
    if (tid == 0) *bc = __hip_atomic_fetch_add(q, 1u, __ATOMIC_RELAXED, __HIP_MEMORY_SCOPE_AGENT);
    __syncthreads();
    const unsigned u = (unsigned)__builtin_amdgcn_readfirstlane((int)*bc);
    __syncthreads();
    return u;
}
#define PS_LOADH(RA, RB, tb, idv) do { _Pragma("unroll") for (int bt = 0; bt < 8; ++bt) { const int idx_ = __shfl((idv), bt * 8 + g); const unsigned char* rp_ = (tb) + (size_t)idx_ * 192; \
        RA[bt] = *(const u32x4_t*)(rp_ + j * 16); RB[bt] = *(const u32x2_t*)(rp_ + 128 + j * 8); } } while (0)
#define PS_CU(RA, RB, outp) do { float mine_ = 0.f; \
        _Pragma("unroll") for (int bt = 0; bt < 8; ++bt) { \
            const v6u_t pk_ = {RA[bt][0], RA[bt][1], RA[bt][2], RA[bt][3], RB[bt][0], RB[bt][1]}; \
            const v32f_t f_ = __builtin_amdgcn_cvt_scalef32_pk32_f32_fp6(pk_, 1.0f); float sd_ = 0.f; \
            _Pragma("unroll") for (int qq = 0; qq < 32; ++qq) sd_ += f_[qq] * hv[qq]; \
            sd_ += __shfl_xor(sd_, 1); sd_ += __shfl_xor(sd_, 2); sd_ += __shfl_xor(sd_, 4); \
            mine_ = (j == bt) ? sd_ : mine_; __builtin_amdgcn_sched_barrier(0); } \
        __builtin_nontemporal_store(mine_, (outp) + j * 8 + g); } while (0)
#define PS_CV(RA, RB, cfv) do { \
        _Pragma("unroll") for (int bt = 0; bt < 8; ++bt) { const float cf_ = __shfl((cfv), bt * 8 + g); \
            const v6u_t pk_ = {RA[bt][0], RA[bt][1], RA[bt][2], RA[bt][3], RB[bt][0], RB[bt][1]}; \
            const v32f_t f_ = __builtin_amdgcn_cvt_scalef32_pk32_f32_fp6(pk_, 1.0f); \
            _Pragma("unroll") for (int qq = 0; qq < 32; ++qq) y[qq] += cf_ * f_[qq]; \
            asm volatile("" : "+v"(y[0]), "+v"(y[1]), "+v"(y[2]), "+v"(y[3]), "+v"(y[4]), "+v"(y[5]), "+v"(y[6]), "+v"(y[7]), "+v"(y[8]), "+v"(y[9]), "+v"(y[10]), "+v"(y[11]), "+v"(y[12]), "+v"(y[13]), "+v"(y[14]), "+v"(y[15])); \
            asm volatile("" : "+v"(y[16]), "+v"(y[17]), "+v"(y[18]), "+v"(y[19]), "+v"(y[20]), "+v"(y[21]), "+v"(y[22]), "+v"(y[23]), "+v"(y[24]), "+v"(y[25]), "+v"(y[26]), "+v"(y[27]), "+v"(y[28]), "+v"(y[29]), "+v"(y[30]), "+v"(y[31])); \
            __builtin_amdgcn_sched_barrier(0); } } while (0)
constexpr int PS_CHUNK = 64;
__device__ __forceinline__ void phase_peer_u_sliced(const Params& p, float* ldsf) {
    const int tid = tid_fresh(p.widx), lane = tid & 63, wid = tid >> 6, g = lane >> 3, j = lane & 7;
    LAS unsigned* bc = (LAS unsigned*)ldsf;
    const unsigned char* utab = p.ws + OFF_UTAB;
    const bf16_t* h2 = WS<bf16_t>(p, OFF_H); const int* ridx = WS<int>(p, OFF_RIDX); float* pd = WS<float>(p, OFF_PD);
    const int x0 = (int)(xb_xcc_id() & 7u);
#pragma unroll 1
    for (int so = 0; so < 8; ++so) {
        const int s = (x0 + so) & 7;
        unsigned* q = WS<unsigned>(p, OFF_BAR) + PS_Q_WORD + 8 * s;
        const unsigned char* tb = utab + (size_t)s * NEXP * 192;
        const bf16_t* hb = h2 + s * 256 + j * 32;
#pragma unroll 1
        for (;;) {
            const unsigned ch = ps_next(q, bc, tid);
            if (ch >= TOK / PS_CHUNK) break;
            int t = (int)ch * PS_CHUNK + wid;
            int i0 = __builtin_nontemporal_load(ridx + (size_t)t * 128 + lane), i1 = __builtin_nontemporal_load(ridx + (size_t)t * 128 + 64 + lane);
            uint4 hp[4];
#pragma unroll
            for (int q8 = 0; q8 < 4; ++q8) hp[q8] = *(const uint4*)(hb + (size_t)t * DM + q8 * 8);
            u32x4_t a4[8], b4[8]; u32x2_t a2[8], b2[8];
            PS_LOADH(a4, a2, tb, i0);
#pragma unroll 1
            for (int k = 0; k < PS_CHUNK / 8; ++k, t += 8) {
                float hv[32];
#pragma unroll
                for (int q8 = 0; q8 < 4; ++q8) { const uint4 w = hp[q8]; float* f = hv + q8 * 8;
                    f[0] = lo_f(w.x); f[1] = hi_f(w.x); f[2] = lo_f(w.y); f[3] = hi_f(w.y); f[4] = lo_f(w.z); f[5] = hi_f(w.z); f[6] = lo_f(w.w); f[7] = hi_f(w.w); }
                const bool more = k + 1 < PS_CHUNK / 8; const int tn = more ? t + 8 : t;
                const int n0 = __builtin_nontemporal_load(ridx + (size_t)tn * 128 + lane), n1 = __builtin_nontemporal_load(ridx + (size_t)tn * 128 + 64 + lane);
#pragma unroll
                for (int q8 = 0; q8 < 4; ++q8) hp[q8] = *(const uint4*)(hb + (size_t)tn * DM + q8 * 8);
                PS_LOADH(b4, b2, tb, i1);
                PS_CU(a4, a2, pd + ((size_t)s * TOK + t) * 128);
                if (more) PS_LOADH(a4, a2, tb, n0);
                PS_CU(b4, b2, pd + ((size_t)s * TOK + t) * 128 + 64);
                i0 = n0; i1 = n1;
            }
        }
    }
}
__device__ __forceinline__ void phase_peer_v_sliced(const Params& p, float* ldsf) {
    const int tid = tid_fresh(p.widx), lane = tid & 63, wid = tid >> 6, g = lane >> 3, j = lane & 7;
    LAS unsigned* bc = (LAS unsigned*)ldsf;
    const unsigned char* vtab = p.ws + OFF_VTAB;
    const float* usc = WS<float>(p, OFF_USC); const float* vsc = WS<float>(p, OFF_VSC);
    const int* ridx = WS<int>(p, OFF_RIDX); const float* rgate = WS<float>(p, OFF_RGATE); const float* pd = WS<float>(p, OFF_PD);
    float* x1 = WS<float>(p, OFF_X1); const float* mod = WS<float>(p, OFF_MOD); float* ssqp = WS<float>(p, OFF_SSQP);
    const int x0 = (int)(xb_xcc_id() & 7u);
    const int cofs = j * 32 + 16 * (g & 1) + 8 * ((g >> 1) & 1) + 4 * (g >> 2);
#pragma unroll 1
    for (int so = 0; so < 8; ++so) {
        const int s = (x0 + so) & 7;
        unsigned* q = WS<unsigned>(p, OFF_BAR) + PS_Q_WORD + 64 + 8 * s;
        const unsigned char* tb = vtab + (size_t)s * NEXP * 192;
#pragma unroll 1
        for (;;) {
            const unsigned ch = ps_next(q, bc, tid);
            if (ch >= TOK / PS_CHUNK) break;
            int t = (int)ch * PS_CHUNK + wid;
            int i0 = __builtin_nontemporal_load(ridx + (size_t)t * 128 + lane), i1 = __builtin_nontemporal_load(ridx + (size_t)t * 128 + 64 + lane);
            float d0 = 0.f, d1 = 0.f;
#pragma unroll
            for (int x = 0; x < 8; ++x) { d0 += __builtin_nontemporal_load(pd + ((size_t)x * TOK + t) * 128 + lane); d1 += __builtin_nontemporal_load(pd + ((size_t)x * TOK + t) * 128 + 64 + lane); }
            float g0 = __builtin_nontemporal_load(rgate + (size_t)t * 128 + lane), g1 = __builtin_nontemporal_load(rgate + (size_t)t * 128 + 64 + lane);
            u32x4_t a4[8], b4[8]; u32x2_t a2[8], b2[8];
            PS_LOADH(a4, a2, tb, i0);
#pragma unroll 1
            for (int k = 0; k < PS_CHUNK / 8; ++k, t += 8) {
                const int b = t >> 12, col = s * 256 + cofs;
                const float cf0 = g0 * gelu_exact(d0 * usc[i0]) * vsc[i0], cf1 = g1 * gelu_exact(d1 * usc[i1]) * vsc[i1];
                const float4 xv = *(const float4*)(x1 + (size_t)t * DM + col); const float4 gg = *(const float4*)(mod + (size_t)b * 12288 + 5 * 2048 + col);
                const bool more = k + 1 < PS_CHUNK / 8; const int tn = more ? t + 8 : t;
                const int n0 = __builtin_nontemporal_load(ridx + (size_t)tn * 128 + lane), n1 = __builtin_nontemporal_load(ridx + (size_t)tn * 128 + 64 + lane);
                float e0 = 0.f, e1 = 0.f;
#pragma unroll
                for (int x = 0; x < 8; ++x) { e0 += __builtin_nontemporal_load(pd + ((size_t)x * TOK + tn) * 128 + lane); e1 += __builtin_nontemporal_load(pd + ((size_t)x * TOK + tn) * 128 + 64 + lane); }
                const float ng0 = __builtin_nontemporal_load(rgate + (size_t)tn * 128 + lane), ng1 = __builtin_nontemporal_load(rgate + (size_t)tn * 128 + 64 + lane);
                float y[32];
#pragma unroll
                for (int qq = 0; qq < 32; ++qq) y[qq] = 0.f;
                PS_LOADH(b4, b2, tb, i1);
                PS_CV(a4, a2, cf0);
                if (more) PS_LOADH(a4, a2, tb, n0);
                PS_CV(b4, b2, cf1);
                float w16[16], w8[8], w4[4];
                { const bool hi = (g & 1) != 0;
#pragma unroll
                  for (int i = 0; i < 16; ++i) { const float send = hi ? y[i] : y[16 + i], keep = hi ? y[16 + i] : y[i]; w16[i] = keep + __shfl_xor(send, 8); } }
                { const bool hi = (g & 2) != 0;
#pragma unroll
                  for (int i = 0; i < 8; ++i) { const float send = hi ? w16[i] : w16[8 + i], keep = hi ? w16[8 + i] : w16[i]; w8[i] = keep + __shfl_xor(send, 16); } }
                { const bool hi = (g & 4) != 0;
#pragma unroll
                  for (int i = 0; i < 4; ++i) { const float send = hi ? w8[i] : w8[4 + i], keep = hi ? w8[4 + i] : w8[i]; w4[i] = keep + __shfl_xor(send, 32); } }
                float4 o; o.x = xv.x + gg.x * w4[0]; o.y = xv.y + gg.y * w4[1]; o.z = xv.z + gg.z * w4[2]; o.w = xv.w + gg.w * w4[3];
                *(float4*)(x1 + (size_t)t * DM + col) = o;
                const float ss = wave_sum(o.x * o.x + o.y * o.y + o.z * o.z + o.w * o.w);
                if (lane == 0) ssqp[(size_t)s * TOK + t] = ss;
                i0 = n0; i1 = n1; d0 = e0; d1 = e1; g0 = ng0; g1 = ng1;
            }
        }
    }
}
__device__ __forceinline__ void phase_peer_final(const Params& p, int bid, int nblk) {
    const int tidf = tid_fresh(p.widx), lane = tidf & 63, wid = tidf >> 6;
    const float* x2 = WS<float>(p, OFF_X1); const float* ssqp = WS<float>(p, OFF_SSQP);
    for (int t = bid * 8 + wid; t < TOK; t += nblk * 8) {
        float ss = 0.f;
#pragma unroll
        for (int s = 0; s < 8; ++s) ss += ssqp[(size_t)s * TOK + t];
        const float rstd = rsqrtf(ss * (1.0f / DM) + EPS);
#pragma unroll
        for (int jj = 0; jj < 8; ++jj) { const int col = (jj * 64 + lane) * 4;
            const float4 v = *(const float4*)(x2 + (size_t)t * DM + col), fg = *(const float4*)(p.fin_g + col);
            float4 o; o.x = v.x * rstd * fg.x; o.y = v.y * rstd * fg.y; o.z = v.z * rstd * fg.z; o.w = v.w * rstd * fg.w;
            *(float4*)(p.out + (size_t)t * DM + col) = o; }
    }
}

constexpr int NPHASE = 12;
#ifndef USE_FAST_ROUTE
#define USE_FAST_ROUTE 1
#endif
#ifndef USE_FAST_PEER
#define USE_FAST_PEER 1
#endif
#ifndef USE_MFMA_ATTN
#define USE_MFMA_ATTN 1
#endif
#ifndef USE_MFMA_GEMM
#define USE_MFMA_GEMM 1
#endif
#if !(FUSED && USE_FAST_PEER && PEER_SPLIT && TAB_EB == 6 && !PEER_SLICED)
#error "x1 is kept in bf16: only the default (live) path reads it that way"
#endif
#if USE_MFMA_GEMM
#define GEMM(A, Bt, M, N, K, E) gemm_mfma(A, Bt, M, N, K, E, bid, nblk, (unsigned char*)lds, p.widx)
#else
#define GEMM(A, Bt, M, N, K, E) gemm_ref(A, K, Bt, K, M, N, K, E, bid, nblk)
#endif
template <int PH, int RERUN = 0> __device__ __forceinline__ void run_phase(const Params& p, int bid, int nblk, float* lds) {
    if (PH == 0) phase0(p, bid, nblk, lds);
    if (PH == 1) phase_norm_mod(p, p.x, p.norm1_g, 0, 1, WS<bf16_t>(p, OFF_H), bid, nblk, lds);
    if (PH == 2) { EpiInProj E{WS<bf16_t>(p, OFF_QSB), WS<bf16_t>(p, OFF_KSB), WS<bf16_t>(p, OFF_VSB), WS<bf16_t>(p, OFF_CQ), WS<bf16_t>(p, OFF_CKV), WS<bf16_t>(p, OFF_KMLA),
                                WS<float>(p, OFF_COS), WS<float>(p, OFF_SIN), WS<float>(p, OFF_RSP)};
        GEMM(WS<bf16_t>(p, OFF_H), WS<bf16_t>(p, OFF_WIN_T), TOK, NINP, DM, E); }
    if (PH == 3) phase_rowstats(p, bid, nblk);
    if (PH == 4) {
        LAS float* tab = (LAS float*)((LAS unsigned char*)lds + LDS_TAB_OFF); const int tid = tid_fresh(p.widx);
        { pg8::StaticOrder S; S.init(TOK, 1536, nblk, bid); pg8::Unit u0; const int pm0 = S.next(0, u0) ? u0.pm : -1;
          EpiUq E1{WS<bf16_t>(p, OFF_QMLA), WS<float>(p, OFF_RSP), WS<float>(p, OFF_COS), WS<float>(p, OFF_SIN), tab, pm0};
          if (pm0 >= 0 && tid < 256) tab[tid] = E1.slow_scale(pm0 * 256 + tid);
          __syncthreads();
          GEMM(WS<bf16_t>(p, OFF_CQ), WS<bf16_t>(p, OFF_WUQ_T), TOK, 1536, 512, E1); }
        __syncthreads();
        { pg8::StaticOrder S; S.init(TOK, 2048, nblk, bid); pg8::Unit u0; const int pm0 = S.next(0, u0) ? u0.pm : -1;
          EpiUkv E2{WS<bf16_t>(p, OFF_KMLA), WS<bf16_t>(p, OFF_VMLA), WS<float>(p, OFF_RSP), tab, pm0};
          if (pm0 >= 0 && tid < 256) tab[tid] = E2.slow_scale(pm0 * 256 + tid);
          __syncthreads();
          GEMM(WS<bf16_t>(p, OFF_CKV), WS<bf16_t>(p, OFF_WUKV_T), TOK, 2048, 256, E2); } }
#if USE_MFMA_ATTN
    if (PH == 5) phase_attn_mfma(p, lds, RERUN);
#else
    if (PH == 5) phase_attn_ref(p, bid, nblk);
#endif
    if (PH == 6) phase_onorm(p, bid, nblk);
    if (PH == 7) { LAS float* tab = (LAS float*)((LAS unsigned char*)lds + LDS_TAB_OFF); const int tid = tid_fresh(p.widx);
        pg8::StaticOrder S; S.init(TOK, DM, nblk, bid); pg8::Unit u0; const int pm0 = S.next(0, u0) ? u0.pm : -1;
        EpiWo E{p.x, WS<float>(p, OFF_MOD), WS<bf16_t>(p, OFF_X1), WS<float>(p, OFF_SSQ), tab, pm0};
        if (pm0 >= 0 && tid < 256) { float r0, r1; E.rstd2(pm0 * 256 + tid, r0, r1); tab[2 * tid] = r0 / r1; tab[2 * tid + 1] = r1; }
        __syncthreads();
        GEMM(WS<bf16_t>(p, OFF_O), WS<bf16_t>(p, OFF_WO_T), TOK, DM, DM, E); }
    if (PH == 8) phase_norm_mod(p, WS<bf16_t>(p, OFF_X1), p.norm2_g, 3, 4, WS<bf16_t>(p, OFF_H), bid, nblk, lds);
    if (PH == 9) { EpiQp E{WS<bf16_t>(p, OFF_QP)};
        GEMM(WS<bf16_t>(p, OFF_H), WS<bf16_t>(p, OFF_WPQ_T), TOK, DM, DM, E); }
#if USE_FAST_ROUTE
    if (PH == 10) phase_route_mfma(p, bid, nblk, lds);
#else
    if (PH == 10) phase_route_ref(p, bid, nblk);
#endif
#if USE_FAST_PEER && PEER_SLICED
    if (PH == 11) phase_peer_u_sliced(p, lds);
    if (PH == 12) phase_peer_v_sliced(p, lds);
    if (PH == 13) phase_peer_final(p, bid, nblk);
#elif USE_FAST_PEER && PEER_SPLIT && TAB_EB == 6
    if (PH == 11) phase_peer_u6(p, bid, nblk);
    if (PH == 12) phase_peer_v6(p, bid, nblk);
#elif USE_FAST_PEER
    if (PH == 11) { if (TAB_EB == 6) phase_peer_gather6(p, bid, nblk); else phase_peer_gather<TAB_EB == 6 ? 1 : TAB_EB>(p, bid, nblk); }
#else
    if (PH == 11) phase_peer_ref(p, bid, nblk);
#endif
}

extern __shared__ __attribute__((aligned(16))) unsigned char dynlds[];
constexpr int LDS_MAIN = 131072;
constexpr int LDS_BYTES = LDS_MAIN + 16 + 2048;

template <int PH> __global__ void __launch_bounds__(512, 2) k_phase(Params pin) {
    Params p = pin; p.widx = __builtin_amdgcn_readfirstlane((int)(threadIdx.x >> 6));
    run_phase<PH>(p, blockIdx.x, gridDim.x, (float*)dynlds);
}

__global__ void __launch_bounds__(512, 2) k_fused(Params pin) {
    Params p = pin; p.widx = __builtin_amdgcn_readfirstlane((int)(threadIdx.x >> 6));
    float* lds = (float*)dynlds;
    volatile LAS unsigned* xbw = (volatile LAS unsigned*)(dynlds + LDS_MAIN);
    if (xb_thread0(p.widx)) { xbw[0] = 0u; xbw[1] = 0u; xbw[2] = 0u; xbw[3] = 0u; }
    __syncthreads();
    XcdBarrier bar = xcd_barrier_post(WS<unsigned>(p, OFF_BAR), xbw, p.widx);
    const int bid = blockIdx.x, nblk = gridDim.x;
    run_phase<0>(p, bid, nblk, lds); if (PROBE_DOUBLE & (1 << 0)) run_phase<0, 1>(p, bid, nblk, lds); xcd_barrier(bar);
    run_phase<1>(p, bid, nblk, lds); if (PROBE_DOUBLE & (1 << 1)) run_phase<1, 1>(p, bid, nblk, lds); xcd_barrier(bar);
    run_phase<2>(p, bid, nblk, lds); if (PROBE_DOUBLE & (1 << 2)) run_phase<2, 1>(p, bid, nblk, lds); xcd_barrier(bar);
    run_phase<4>(p, bid, nblk, lds); if (PROBE_DOUBLE & (1 << 4)) run_phase<4, 1>(p, bid, nblk, lds); xcd_barrier(bar);
    run_phase<5>(p, bid, nblk, lds); if (PROBE_DOUBLE & (1 << 5)) run_phase<5, 1>(p, bid, nblk, lds); xcd_barrier(bar);
    run_phase<7>(p, bid, nblk, lds); if (PROBE_DOUBLE & (1 << 7)) run_phase<7, 1>(p, bid, nblk, lds); xcd_barrier(bar);
    run_phase<8>(p, bid, nblk, lds); if (PROBE_DOUBLE & (1 << 8)) run_phase<8, 1>(p, bid, nblk, lds); xcd_barrier(bar);
    run_phase<9>(p, bid, nblk, lds); if (PROBE_DOUBLE & (1 << 9)) run_phase<9, 1>(p, bid, nblk, lds); xcd_barrier(bar);
    run_phase<10>(p, bid, nblk, lds); if (PROBE_DOUBLE & (1 << 10)) run_phase<10, 1>(p, bid, nblk, lds);
#if USE_FAST_ROUTE && USE_FAST_PEER && PEER_SPLIT && TAB_EB == 6 && !PEER_SLICED
    if (nblk * 32 == TOK) { asm volatile("s_waitcnt vmcnt(0)" ::: "memory"); __syncthreads(); }
    else xcd_barrier(bar);
#else
    xcd_barrier(bar);
#endif
    run_phase<11>(p, bid, nblk, lds); if (PROBE_DOUBLE & (1 << 11)) run_phase<11, 1>(p, bid, nblk, lds);
#if USE_FAST_PEER && PEER_SLICED
    xcd_barrier(bar); run_phase<12>(p, bid, nblk, lds);
    xcd_barrier(bar); run_phase<13>(p, bid, nblk, lds);
#elif USE_FAST_PEER && PEER_SPLIT && TAB_EB == 6
    asm volatile("s_waitcnt vmcnt(0)" ::: "memory");
    run_phase<12>(p, bid, nblk, lds);
#endif
}

template <int PH> static void launch_phase(const Params& p, int grid, hipStream_t st) {
    hipLaunchKernelGGL((k_phase<PH>), dim3(grid), dim3(512), LDS_BYTES, st, p);
}

extern "C" void kernel_launch(void* const* d_in, const int* in_sizes, int n_in, void* d_out, int out_size, void* d_ws, size_t ws_size, hipStream_t stream) {
    Params p{};
    p.x = (const float*)d_in[0]; p.c = (const float*)d_in[1]; p.pos = (const int*)d_in[2]; p.w_ada = (const float*)d_in[3]; p.b_ada = (const float*)d_in[4];
    p.norm1_g = (const float*)d_in[5]; p.w_in = (const float*)d_in[6]; p.qn_g = (const float*)d_in[7]; p.w_uq = (const float*)d_in[8]; p.kvn_g = (const float*)d_in[9];
    p.w_ukv = (const float*)d_in[10]; p.osb_g = (const float*)d_in[11]; p.omla_g = (const float*)d_in[12]; p.w_o = (const float*)d_in[13]; p.norm2_g = (const float*)d_in[14];
    p.w_pq = (const float*)d_in[15]; p.keys1 = (const float*)d_in[16]; p.keys2 = (const float*)d_in[17]; p.u_tab = (const float*)d_in[18]; p.v_tab = (const float*)d_in[19];
    p.fin_g = (const float*)d_in[20]; p.out = (float*)d_out; p.ws = (unsigned char*)d_ws;
#if FUSED
    static int grid = 0;
    if (!grid) {
        int dev = 0, cus = 0, per_cu = 0;
        hipGetDevice(&dev);
        hipDeviceGetAttribute(&cus, hipDeviceAttributeMultiprocessorCount, dev);
        hipFuncSetAttribute((const void*)k_fused, hipFuncAttributeMaxDynamicSharedMemorySize, LDS_BYTES);
        hipOccupancyMaxActiveBlocksPerMultiprocessor(&per_cu, k_fused, 512, LDS_BYTES);
        grid = per_cu >= 1 ? cus : 0;
    }
    hipMemsetAsync((unsigned char*)d_ws + OFF_BAR, 0, 16384, stream);
    if (grid) hipLaunchKernelGGL(k_fused, dim3(grid), dim3(512), LDS_BYTES, stream, p);
#else
    const int G = 1024;
    launch_phase<0>(p, G, stream); launch_phase<1>(p, G, stream); launch_phase<2>(p, G, stream); launch_phase<3>(p, G, stream);
    launch_phase<4>(p, G, stream); launch_phase<5>(p, G, stream); launch_phase<6>(p, G, stream); launch_phase<7>(p, G, stream);
    launch_phase<8>(p, G, stream); launch_phase<9>(p, G, stream); launch_phase<10>(p, G, stream); launch_phase<11>(p, G, stream);
#endif
}
```

```cpp
#include <hip/hip_runtime.h>
#include <stdint.h>

#ifndef TAB_EB
#define TAB_EB 6
#endif
#ifndef ATT_ANTIPHASE
#define ATT_ANTIPHASE 1
#endif
#ifndef PEER_SPLIT
#define PEER_SPLIT 1
#endif
#ifndef PEER_SLICED
#define PEER_SLICED 0
#endif
#ifndef PROBE_ATTN_G
#define PROBE_ATTN_G 0
#endif
#ifndef PROBE_DOUBLE
#define PROBE_DOUBLE 0
#endif
#ifndef FUSED
#define FUSED 1
#endif

typedef unsigned short bf16_t;
#define LAS __attribute__((address_space(3)))
__device__ __forceinline__ int tid_fresh(int widx) { unsigned m = ~0u; asm volatile("" : "+s"(m)); int t = (widx << 6) | (int)__builtin_amdgcn_mbcnt_hi(m, __builtin_amdgcn_mbcnt_lo(m, 0u)); asm volatile("" : "+v"(t)); return t; }

constexpr int TOK = 8192, DM = 2048, SEQ = 4096, NB = 2;
constexpr int NIN = 3904, NINP = 4096;
constexpr int NEXP = 16384;
constexpr float EPS = 1e-6f;
constexpr float LOG2E = 1.4426950408889634f, LN2 = 0.6931471805599453f;
constexpr float QS_SB = 0.12751743082459868f;
constexpr float QS_MLA = 0.10411754627697264f;

constexpr size_t MiB = 1ull << 20;
constexpr size_t OFF_BAR = 0;
constexpr size_t OFF_MOD = 16384;
constexpr size_t OFF_COS = OFF_MOD + 98304;
constexpr size_t OFF_SIN = OFF_COS + MiB;
constexpr size_t OFF_RSQ = OFF_SIN + MiB;
constexpr size_t OFF_RSKV = OFF_RSQ + 32768;
constexpr size_t OFF_SSQ = OFF_RSKV + 32768;
constexpr size_t OFF_KEYS = OFF_SSQ + 524288;
constexpr size_t OFF_USC = OFF_KEYS + 524288;
constexpr size_t OFF_VSC = OFF_USC + 65536;
static_assert(OFF_VSC + 65536 <= 4 * MiB, "ws map");
constexpr size_t OFF_WIN_T = 4 * MiB;
constexpr size_t OFF_WUQ_T = OFF_WIN_T + 16 * MiB;
constexpr size_t OFF_WUKV_T = OFF_WUQ_T + 2 * MiB;
constexpr size_t OFF_WO_T = OFF_WUKV_T + 1 * MiB;
constexpr size_t OFF_WPQ_T = OFF_WO_T + 8 * MiB;
constexpr size_t OFF_H = OFF_WPQ_T + 8 * MiB;
constexpr size_t OFF_QSB = OFF_H + 32 * MiB;
constexpr size_t OFF_KSB = OFF_QSB + 16 * MiB;
constexpr size_t OFF_VSB = OFF_KSB + 16 * MiB;
constexpr size_t OFF_CQ = OFF_VSB + 16 * MiB;
constexpr size_t OFF_CKV = OFF_CQ + 8 * MiB;
constexpr size_t OFF_QMLA = OFF_CKV + 4 * MiB;
constexpr size_t OFF_KMLA = OFF_QMLA + 24 * MiB;
constexpr size_t OFF_VMLA = OFF_KMLA + 24 * MiB;
constexpr size_t OFF_O = OFF_VMLA + 16 * MiB;
constexpr size_t OFF_X1 = OFF_O + 32 * MiB;
constexpr size_t OFF_QP = OFF_X1 + 64 * MiB;
constexpr size_t OFF_RIDX = OFF_QP + 32 * MiB;
constexpr size_t OFF_RGATE = OFF_RIDX + 4 * MiB;
constexpr size_t OFF_UTAB = OFF_RGATE + 4 * MiB;
constexpr size_t OFF_VTAB = OFF_UTAB + 64 * MiB;
constexpr size_t OFF_PD = OFF_VTAB + 64 * MiB;
constexpr size_t OFF_SSQP = OFF_PD + 32 * MiB;
constexpr size_t OFF_RSP = OFF_SSQP + 1 * MiB;
constexpr size_t WS_END = OFF_RSP + 1 * MiB;

struct Params {
    const float* x; const float* c; const int* pos; const float* w_ada; const float* b_ada; const float* norm1_g;
    const float* w_in; const float* qn_g; const float* w_uq; const float* kvn_g; const float* w_ukv;
    const float* osb_g; const float* omla_g; const float* w_o; const float* norm2_g; const float* w_pq;
    const float* keys1; const float* keys2; const float* u_tab; const float* v_tab; const float* fin_g;
    float* out; unsigned char* ws;
    int widx; int pad_;
};
template <class Tp> __device__ __forceinline__ Tp* WS(const Params& p, size_t off) { return (Tp*)(p.ws + off); }

__device__ __forceinline__ float bf2f(bf16_t v) { return __uint_as_float(((unsigned)v) << 16); }
__device__ __forceinline__ bf16_t f2bf(float f) { unsigned u = __float_as_uint(f); u += 0x7fffu + ((u >> 16) & 1u); return (bf16_t)(u >> 16); }
__device__ __forceinline__ unsigned pack2(float lo, float hi) { return (unsigned)f2bf(lo) | ((unsigned)f2bf(hi) << 16); }
__device__ __forceinline__ float lo_f(unsigned u) { return __uint_as_float(u << 16); }
__device__ __forceinline__ float hi_f(unsigned u) { return __uint_as_float(u & 0xffff0000u); }
__device__ __forceinline__ float dot8(uint4 a, uint4 b) {
    float s = lo_f(a.x) * lo_f(b.x); s += hi_f(a.x) * hi_f(b.x);
    s += lo_f(a.y) * lo_f(b.y); s += hi_f(a.y) * hi_f(b.y);
    s += lo_f(a.z) * lo_f(b.z); s += hi_f(a.z) * hi_f(b.z);
    s += lo_f(a.w) * lo_f(b.w); s += hi_f(a.w) * hi_f(b.w);
    return s;
}
__device__ __forceinline__ float wave_sum(float v) {
#pragma unroll
    for (int o = 32; o > 0; o >>= 1) v += __shfl_xor(v, o);
    return v;
}
__device__ __forceinline__ float gelu_exact(float x) { return 0.5f * x * (1.0f + erff(x * 0.70710678118654752f)); }

struct EpiInProj {
    static constexpr bool HAS_MID = false;
    bf16_t *qsb, *ksb, *vsb, *cq, *ckv, *kmla; const float *cosT, *sinT; float* rsp;
    __device__ __forceinline__ float row_scale(int) const { return 1.0f; }
    __device__ __forceinline__ float mid_scale(int) const { return 1.0f; }
    __device__ __forceinline__ void store8(int row, int col0, const float (&v)[8], float) const {
        if (col0 >= NIN) return;
        uint4 w;
        if (col0 < 3840) {
            float s = col0 < 1024 ? QS_SB : 1.0f;
            w.x = pack2(v[0] * s, v[1] * s); w.y = pack2(v[2] * s, v[3] * s); w.z = pack2(v[4] * s, v[5] * s); w.w = pack2(v[6] * s, v[7] * s);
            bf16_t* dst;
            if (col0 < 1024) dst = qsb + (size_t)row * 1024 + col0;
            else if (col0 < 2048) dst = ksb + (size_t)row * 1024 + (col0 - 1024);
            else if (col0 < 3072) dst = vsb + (size_t)row * 1024 + (col0 - 2048);
            else if (col0 < 3584) dst = cq + (size_t)row * 512 + (col0 - 3072);
            else dst = ckv + (size_t)row * 256 + (col0 - 3584);
            *(uint4*)dst = w;
            if (col0 >= 3072) {
                float ss = lo_f(w.x) * lo_f(w.x) + hi_f(w.x) * hi_f(w.x) + lo_f(w.y) * lo_f(w.y) + hi_f(w.y) * hi_f(w.y)
                         + lo_f(w.z) * lo_f(w.z) + hi_f(w.z) * hi_f(w.z) + lo_f(w.w) * lo_f(w.w) + hi_f(w.w) * hi_f(w.w);
                ss += __shfl_xor(ss, 16); ss += __shfl_xor(ss, 32);
                if ((tid_fresh(0) & 48) == 0) rsp[(size_t)row * 24 + ((col0 - 3072) >> 5)] = ss;
            }
        } else {
            const int e0 = col0 - 3840, i0 = e0 >> 1;
            float o[8];
#pragma unroll
            for (int j = 0; j < 4; ++j) {
                const float cs = cosT[(size_t)row * 32 + i0 + j], sn = sinT[(size_t)row * 32 + i0 + j];
                const float x1 = v[2 * j], x2 = v[2 * j + 1];
                o[2 * j] = x1 * cs - x2 * sn; o[2 * j + 1] = x2 * cs + x1 * sn;
            }
            w.x = pack2(o[0], o[1]); w.y = pack2(o[2], o[3]); w.z = pack2(o[4], o[5]); w.w = pack2(o[6], o[7]);
#pragma unroll
            for (int h = 0; h < 8; ++h) *(uint4*)(kmla + (size_t)row * 1536 + h * 192 + 128 + e0) = w;
        }
    }
};
struct EpiUq {
    static constexpr bool HAS_MID = false;
    bf16_t* qmla; const float *rsp, *cosT, *sinT; const LAS float* tab; int tab_pm;
    __device__ __forceinline__ float mid_scale(int) const { return 1.0f; }
    __device__ __forceinline__ float slow_scale(int row) const { float s = 0.f;
#pragma unroll
        for (int i = 0; i < 16; ++i) s += rsp[(size_t)row * 24 + i];
        return rsqrtf(s * (1.0f / 512.0f) + EPS) * QS_MLA; }
    __device__ __forceinline__ float row_scale(int row) const { return (row >> 8) == tab_pm ? tab[row & 255] : slow_scale(row); }
    __device__ __forceinline__ void store8(int row, int col0, const float (&v)[8], float r) const {
        const int d0 = col0 % 192;
        float o[8];
        if (d0 < 128) {
#pragma unroll
            for (int j = 0; j < 8; ++j) o[j] = v[j] * r;
        } else {
            const int i0 = (d0 - 128) >> 1;
#pragma unroll
            for (int j = 0; j < 4; ++j) {
                const float cs = cosT[(size_t)row * 32 + i0 + j], sn = sinT[(size_t)row * 32 + i0 + j];
                const float x1 = v[2 * j], x2 = v[2 * j + 1];
                o[2 * j] = (x1 * cs - x2 * sn) * r; o[2 * j + 1] = (x2 * cs + x1 * sn) * r;
            }
        }
        uint4 w; w.x = pack2(o[0], o[1]); w.y = pack2(o[2], o[3]); w.z = pack2(o[4], o[5]); w.w = pack2(o[6], o[7]);
        *(uint4*)(qmla + (size_t)row * 1536 + col0) = w;
    }
};
struct EpiUkv {
    static constexpr bool HAS_MID = false;
    bf16_t *kmla, *vmla; const float* rsp; const LAS float* tab; int tab_pm;
    __device__ __forceinline__ float mid_scale(int) const { return 1.0f; }
    __device__ __forceinline__ float slow_scale(int row) const { float s = 0.f;
#pragma unroll
        for (int i = 0; i < 8; ++i) s += rsp[(size_t)row * 24 + 16 + i];
        return rsqrtf(s * (1.0f / 256.0f) + EPS); }
    __device__ __forceinline__ float row_scale(int row) const { return (row >> 8) == tab_pm ? tab[row & 255] : slow_scale(row); }
    __device__ __forceinline__ void store8(int row, int col0, const float (&v)[8], float r) const {
        const int h = col0 >> 8, j0 = col0 & 255;
        uint4 w; w.x = pack2(v[0] * r, v[1] * r); w.y = pack2(v[2] * r, v[3] * r); w.z = pack2(v[4] * r, v[5] * r); w.w = pack2(v[6] * r, v[7] * r);
        bf16_t* dst = j0 < 128 ? kmla + (size_t)row * 1536 + h * 192 + j0 : vmla + (size_t)row * 1024 + h * 128 + (j0 - 128);
        *(uint4*)dst = w;
    }
};
struct EpiWo {
    static constexpr bool HAS_MID = true;
    const float* x; const float* mod; bf16_t* x1; const float* ssq; const LAS float* tab; int tab_pm;
    __device__ __forceinline__ void rstd2(int row, float& r0, float& r1) const { float s0 = 0.f, s1 = 0.f;
#pragma unroll
        for (int h = 0; h < 8; ++h) { s0 += ssq[(size_t)row * 16 + h]; s1 += ssq[(size_t)row * 16 + 8 + h]; }
        r0 = rsqrtf(s0 * (1.0f / 1024.0f) + EPS); r1 = rsqrtf(s1 * (1.0f / 1024.0f) + EPS); }
    __device__ __forceinline__ float mid_scale(int row) const { if ((row >> 8) == tab_pm) return tab[2 * (row & 255)]; float r0, r1; rstd2(row, r0, r1); return r0 / r1; }
    __device__ __forceinline__ float row_scale(int row) const { if ((row >> 8) == tab_pm) return tab[2 * (row & 255) + 1]; float r0, r1; rstd2(row, r0, r1); return r1; }
    __device__ __forceinline__ void store8(int row, int col0, const float (&vin)[8], float rsc) const {
        float v[8];
#pragma unroll
        for (int i = 0; i < 8; ++i) v[i] = vin[i] * rsc;
        const int b = row >> 12;
        const float* g1 = mod + (size_t)b * 12288 + 2 * 2048 + col0;
        const float4 xa = *(const float4*)(x + (size_t)row * DM + col0), xb = *(const float4*)(x + (size_t)row * DM + col0 + 4);
        const float4 ga = *(const float4*)g1, gb = *(const float4*)(g1 + 4);
        float4 oa, ob;
        oa.x = xa.x + ga.x * v[0]; oa.y = xa.y + ga.y * v[1]; oa.z = xa.z + ga.z * v[2]; oa.w = xa.w + ga.w * v[3];
        ob.x = xb.x + gb.x * v[4]; ob.y = xb.y + gb.y * v[5]; ob.z = xb.z + gb.z * v[6]; ob.w = xb.w + gb.w * v[7];
        uint4 w; w.x = pack2(oa.x, oa.y); w.y = pack2(oa.z, oa.w); w.z = pack2(ob.x, ob.y); w.w = pack2(ob.z, ob.w);
        *(uint4*)(x1 + (size_t)row * DM + col0) = w;
    }
};
struct EpiQp {
    static constexpr bool HAS_MID = false;
    bf16_t* qp;
    __device__ __forceinline__ float row_scale(int) const { return 1.0f; }
    __device__ __forceinline__ float mid_scale(int) const { return 1.0f; }
    __device__ __forceinline__ void store8(int row, int col0, const float (&v)[8], float) const {
        uint4 w; w.x = pack2(v[0], v[1]); w.y = pack2(v[2], v[3]); w.z = pack2(v[4], v[5]); w.w = pack2(v[6], v[7]);
        *(uint4*)(qp + (size_t)row * DM + col0) = w;
    }
};

namespace pg8 {
#define PG8_LAS __attribute__((address_space(3)))
typedef unsigned short bf16_t;
typedef short bf16x8 __attribute__((ext_vector_type(8)));
typedef float f32x4 __attribute__((ext_vector_type(4)));
typedef unsigned u32x4 __attribute__((ext_vector_type(4)));
constexpr int BM = 256, BK = 64, HALF = 128, HTB = HALF * BK * 2  , STAGE_BYTES = 8 * HTB, NXCD = 8, WGM = 8;

__host__ __device__ __forceinline__ int lds_byte(int r, int c) { const int st = (r >> 4) * 2 + (c >> 5), rr = r & 15, cc = c & 31, ob = rr * 64 + cc * 2; return st * 1024 + (ob ^ (((ob >> 9) & 1) << 5)); }
__host__ __device__ __forceinline__ void stage_rc(int b, int& R, int& C) { const int st = b / 1024, sb = b % 1024, swz = sb ^ (((sb >> 9) & 1) << 5); R = (st >> 1) * 16 + swz / 64; C = (st & 1) * 32 + (swz % 64) / 2; }
__host__ __device__ __forceinline__ int perm32(int rho) { const int n = rho >> 4, i = rho & 15; return 8 * (i >> 2) + 4 * n + (i & 3); }

struct Unit { int pm, pn; };
struct Gemm { const bf16_t* A; const bf16_t* Bt; int M, N, K, widx; };

struct StaticOrder {
    int nM, nN, nwg, G, c;
    __host__ __device__ __forceinline__ void init(int M, int N, int G_, int c_) { nM = M / BM; nN = N / BM; nwg = nM * nN; G = G_; c = c_; }
    __host__ __device__ bool next(int i, Unit& u) const {
        const long L = (long)i * G + c; if (L >= nwg) return false;
        int wgid = (int)L; { const int q = nwg / NXCD, r = nwg % NXCD, xcd = wgid % NXCD, off = wgid / NXCD; wgid = (xcd < r ? xcd * (q + 1) : r * (q + 1) + (xcd - r) * q) + off; }
        const int nig = WGM * nN, gid = wgid / nig, fm = gid * WGM, gsz = (nM - fm) < WGM ? (nM - fm) : WGM;
        u.pm = fm + ((wgid % nig) % gsz); u.pn = (wgid % nig) / gsz; return true;
    }
    __device__ __forceinline__ void a_ready(const Unit&) const {}
    __device__ __forceinline__ void done(const Unit&) const {}
};

template <class Epi, class Sched, bool ALIGN_EPI = false, bool SP2 = false>
__device__ __forceinline__ void gemm_phase(PG8_LAS unsigned char* lds, const Gemm g, const Sched& S, const Epi& E) {
    const int tid = tid_fresh(g.widx), wid = __builtin_amdgcn_readfirstlane(tid >> 6), lane = tid & 63, wr = wid >> 2, wc = wid & 3, fr = lane & 15, fq = lane >> 4;
    const int K = g.K, nt = K / BK;
    unsigned voffA[2], voffB[2];
#pragma unroll
    for (int i = 0; i < 2; ++i) { int R, C; stage_rc(tid * 16 + i * 8192, R, C); const int Rb = Epi::PERM ? ((R & ~31) + perm32(R & 31)) : R;
        voffA[i] = (unsigned)(R * K + C) * 2u; voffB[i] = (unsigned)(Rb * K + C) * 2u; }
    const size_t kstep = (size_t)(BK * 2);
    const size_t hstep = (size_t)HALF * K * 2;
    const size_t tstep = 2 * hstep;
    const unsigned ldsw = (unsigned)wid * 1024u;
    const int aoff = lds_byte(wr * 64 + fr, fq * 8), boff = lds_byte(wc * 32 + fr, fq * 8);
#define PG8_SA(b, h) (((b) * 2 + (h)) * HTB)
#define PG8_SB(b, h) ((4 + (b) * 2 + (h)) * HTB)
#define PG8_STAGE(bufoff, gbase, voff) do { _Pragma("unroll") for (int _i = 0; _i < 2; ++_i) \
        __builtin_amdgcn_global_load_lds((const unsigned*)((const char*)(gbase) + (voff)[_i]), (PG8_LAS unsigned*)(lds + (bufoff) + ldsw + _i * 8192), 16, 0, 0); } while (0)
#define PG8_LDA(dst, b, h) do { _Pragma("unroll") for (int m = 0; m < 4; ++m) _Pragma("unroll") for (int k = 0; k < 2; ++k) dst[m][k] = *(const PG8_LAS bf16x8*)(lds + PG8_SA(b, h) + aoff + m * 2048 + k * 1024); } while (0)
#define PG8_LDB(dst, b, h) do { _Pragma("unroll") for (int n = 0; n < 2; ++n) _Pragma("unroll") for (int k = 0; k < 2; ++k) dst[n][k] = *(const PG8_LAS bf16x8*)(lds + PG8_SB(b, h) + boff + n * 2048 + k * 1024); } while (0)
#define PG8_MMA(ai, bj, At, Bt) do { __builtin_amdgcn_s_setprio(1); _Pragma("unroll") for (int m = 0; m < 4; ++m) _Pragma("unroll") for (int n = 0; n < 2; ++n) _Pragma("unroll") for (int k = 0; k < 2; ++k) \
        acc[ai][bj][m][n] = __builtin_amdgcn_mfma_f32_16x16x32_bf16(Bt[n][k], At[m][k], acc[ai][bj][m][n], 0, 0, 0); __builtin_amdgcn_s_setprio(0); } while (0)
#define PG8_WAIT_V(n) asm volatile("s_waitcnt vmcnt(" #n ")" ::: "memory")
#define PG8_WAIT_L(n) asm volatile("s_waitcnt lgkmcnt(" #n ")" ::: "memory")
#define PG8_BAR __builtin_amdgcn_s_barrier()
#define PG8_SCHED __builtin_amdgcn_sched_barrier(0)
    Unit cur, nxt; int ui = 0;
    if (!S.next(0, cur)) return;
    f32x4 acc[2][2][4][2];
#pragma unroll
    for (int a = 0; a < 2; ++a)
#pragma unroll
        for (int b = 0; b < 2; ++b)
#pragma unroll
            for (int m = 0; m < 4; ++m)
#pragma unroll
                for (int n = 0; n < 2; ++n) acc[a][b][m][n] = (f32x4){0.f, 0.f, 0.f, 0.f};
    bf16x8 At[4][2], B0[2][2], B1[2][2];
    const char* cA = (const char*)g.A + (size_t)cur.pm * tstep; const char* cB = (const char*)g.Bt + (size_t)cur.pn * tstep;
    S.a_ready(cur);
    if constexpr (SP2) {
        PG8_STAGE(PG8_SB(0, 0), cB, voffB); PG8_STAGE(PG8_SB(0, 1), cB + hstep, voffB); PG8_STAGE(PG8_SA(0, 0), cA, voffA); PG8_STAGE(PG8_SA(0, 1), cA + hstep, voffA);
        if (wr == 1) PG8_BAR;
        PG8_WAIT_V(2); PG8_BAR;
        PG8_STAGE(PG8_SB(1, 0), cB + kstep, voffB); PG8_STAGE(PG8_SA(1, 0), cA + kstep, voffA); PG8_STAGE(PG8_SB(1, 1), cB + hstep + kstep, voffB);
        PG8_WAIT_V(6); PG8_BAR;
    } else {
        PG8_STAGE(PG8_SB(0, 0), cB, voffB); PG8_STAGE(PG8_SA(0, 0), cA, voffA); PG8_STAGE(PG8_SB(0, 1), cB + hstep, voffB); PG8_STAGE(PG8_SA(0, 1), cA + hstep, voffA);
        if (wr == 1) PG8_BAR;
        PG8_WAIT_V(4); PG8_BAR;
        PG8_STAGE(PG8_SB(1, 0), cB + kstep, voffB); PG8_STAGE(PG8_SA(1, 0), cA + kstep, voffA); PG8_STAGE(PG8_SB(1, 1), cB + hstep + kstep, voffB);
        PG8_WAIT_V(6); PG8_BAR;
    }
    for (;;) {
        const bool has_next = S.next(ui + 1, nxt);
        const char* nA = has_next ? (const char*)g.A + (size_t)nxt.pm * tstep : cA; const char* nB = has_next ? (const char*)g.Bt + (size_t)nxt.pn * tstep : cB;
        for (int t = 0; t < nt; t += 2) {
            const bool last = (t == nt - 2);
            const char* a1 = cA + (size_t)(t + 1) * kstep;
            const char* a2 = last ? nA : cA + (size_t)(t + 2) * kstep; const char* b2 = last ? nB : cB + (size_t)(t + 2) * kstep;
            const char* a3 = a2 + kstep; const char* b3 = b2 + kstep;
            if (last && has_next) S.a_ready(nxt);
            if constexpr (Epi::HAS_MID) { if (t == (nt >> 1)) E.mid(acc, cur, wr, wc, fr, fq); }
            if constexpr (SP2) {
            PG8_LDB(B0, 0, 0); PG8_LDB(B1, 0, 1); PG8_SCHED; PG8_LDA(At, 0, 0); PG8_STAGE(PG8_SA(1, 1), a1 + hstep, voffA);
            PG8_WAIT_V(8); PG8_WAIT_L(0); PG8_BAR; PG8_MMA(0, 0, At, B0); PG8_MMA(0, 1, At, B1); PG8_BAR; PG8_SCHED;
            PG8_LDA(At, 0, 1); PG8_STAGE(PG8_SB(0, 0), b2, voffB); PG8_STAGE(PG8_SB(0, 1), b2 + hstep, voffB); PG8_STAGE(PG8_SA(0, 0), a2, voffA);
            PG8_WAIT_V(8); PG8_WAIT_L(0); PG8_BAR; PG8_MMA(1, 0, At, B0); PG8_MMA(1, 1, At, B1); PG8_BAR; PG8_SCHED;
            PG8_LDB(B0, 1, 0); PG8_LDB(B1, 1, 1); PG8_SCHED; PG8_LDA(At, 1, 0); PG8_STAGE(PG8_SA(0, 1), a2 + hstep, voffA);
            PG8_WAIT_V(8); PG8_WAIT_L(0); PG8_BAR; PG8_MMA(0, 0, At, B0); PG8_MMA(0, 1, At, B1); PG8_BAR; PG8_SCHED;
            PG8_LDA(At, 1, 1); PG8_STAGE(PG8_SB(1, 0), b3, voffB); PG8_STAGE(PG8_SB(1, 1), b3 + hstep, voffB); PG8_STAGE(PG8_SA(1, 0), a3, voffA);
            PG8_WAIT_V(8); PG8_WAIT_L(0); PG8_BAR; PG8_MMA(1, 0, At, B0); PG8_MMA(1, 1, At, B1); PG8_BAR; PG8_SCHED;
            } else {
            PG8_LDB(B0, 0, 0); PG8_SCHED; PG8_LDA(At, 0, 0); PG8_STAGE(PG8_SA(1, 1), a1 + hstep, voffA);
            PG8_WAIT_L(8); PG8_BAR; PG8_WAIT_L(0); PG8_MMA(0, 0, At, B0); PG8_BAR; PG8_SCHED;
            PG8_LDB(B1, 0, 1); PG8_STAGE(PG8_SB(0, 0), b2, voffB);
            PG8_BAR; PG8_WAIT_L(0); PG8_MMA(0, 1, At, B1); PG8_BAR;
            PG8_LDA(At, 0, 1); PG8_STAGE(PG8_SA(0, 0), a2, voffA);
            PG8_BAR; PG8_WAIT_L(0); PG8_MMA(1, 0, At, B0); PG8_BAR; PG8_SCHED;
            PG8_STAGE(PG8_SB(0, 1), b2 + hstep, voffB);
            PG8_WAIT_V(6); PG8_BAR; PG8_MMA(1, 1, At, B1); PG8_BAR;
            PG8_LDB(B0, 1, 0); PG8_SCHED; PG8_LDA(At, 1, 0); PG8_STAGE(PG8_SA(0, 1), a2 + hstep, voffA);
            PG8_WAIT_L(8); PG8_BAR; PG8_WAIT_L(0); PG8_MMA(0, 0, At, B0); PG8_BAR; PG8_SCHED;
            PG8_LDB(B1, 1, 1); PG8_STAGE(PG8_SB(1, 0), b3, voffB);
            PG8_BAR; PG8_WAIT_L(0); PG8_MMA(0, 1, At, B1); PG8_BAR;
            PG8_LDA(At, 1, 1); PG8_STAGE(PG8_SA(1, 0), a3, voffA);
            PG8_BAR; PG8_WAIT_L(0); PG8_MMA(1, 0, At, B0); PG8_BAR; PG8_SCHED;
            PG8_STAGE(PG8_SB(1, 1), b3 + hstep, voffB);
            PG8_WAIT_V(6); PG8_BAR; PG8_MMA(1, 1, At, B1); PG8_BAR;
            }
        }
        if constexpr (ALIGN_EPI) { if (wr == 0) PG8_BAR; }
        if constexpr (!Epi::AFTER_DRAIN) { E(acc, cur, wr, wc, fr, fq); S.done(cur); }
        if (!has_next) break;
#pragma unroll
        for (int a = 0; a < 2; ++a)
#pragma unroll
            for (int b = 0; b < 2; ++b)
#pragma unroll
                for (int m = 0; m < 4; ++m)
#pragma unroll
                    for (int n = 0; n < 2; ++n) acc[a][b][m][n] = (f32x4){0.f, 0.f, 0.f, 0.f};
        cur = nxt; cA = nA; cB = nB; ++ui;
        if constexpr (ALIGN_EPI) { if (wr == 1) PG8_BAR; }
    }
    PG8_WAIT_V(0);
    if constexpr (!ALIGN_EPI) { if (wr == 0) PG8_BAR; }
    PG8_BAR;
    if constexpr (Epi::AFTER_DRAIN) { E.fused(acc, cur, wr, wc, fr, fq, lds, wid, lane); S.done(cur); }
#undef PG8_SA
#undef PG8_SB
#undef PG8_STAGE
#undef PG8_LDA
#undef PG8_LDB
#undef PG8_MMA
#undef PG8_WAIT_V
#undef PG8_WAIT_L
#undef PG8_BAR
#undef PG8_SCHED
}
}

template <class C> struct EpiChunk {
    static constexpr bool PERM = true, AFTER_DRAIN = false, HAS_MID = C::HAS_MID;
    C c;
    __device__ __forceinline__ void mid(pg8::f32x4 (&acc)[2][2][4][2], const pg8::Unit& u, int wr, int wc, int fr, int fq) const {
#pragma unroll
        for (int ai = 0; ai < 2; ++ai)
#pragma unroll
            for (int m = 0; m < 4; ++m) { const float f = c.mid_scale(u.pm * 256 + ai * 128 + wr * 64 + m * 16 + fr);
#pragma unroll
                for (int bj = 0; bj < 2; ++bj)
#pragma unroll
                    for (int n = 0; n < 2; ++n) acc[ai][bj][m][n] = acc[ai][bj][m][n] * f; }
    }
    __device__ __forceinline__ void operator()(const pg8::f32x4 (&acc)[2][2][4][2], const pg8::Unit& u, int wr, int wc, int fr_in, int fq_in) const {
        int fr = fr_in, fq = fq_in; asm volatile("" : "+v"(fr), "+v"(fq));
#pragma unroll
        for (int ai = 0; ai < 2; ++ai)
#pragma unroll
            for (int m = 0; m < 4; ++m) {
                const int row = u.pm * 256 + ai * 128 + wr * 64 + m * 16 + fr;
                const float rsc = c.row_scale(row);
#pragma unroll
                for (int bj = 0; bj < 2; ++bj) {
                    const int col0 = u.pn * 256 + bj * 128 + wc * 32 + 8 * fq;
                    const pg8::f32x4 a = acc[ai][bj][m][0], b = acc[ai][bj][m][1];
                    const float v[8] = {a[0], a[1], a[2], a[3], b[0], b[1], b[2], b[3]};
                    c.store8(row, col0, v, rsc);
                }
                asm volatile("" ::: "memory");
            }
    }
};
template <class C> __device__ __forceinline__ void gemm_mfma(const bf16_t* A, const bf16_t* Bt, int M, int N, int K, const C& c, int bid, int nblk, unsigned char* lds, int widx) {
    pg8::Gemm g; g.A = A; g.Bt = Bt; g.M = M; g.N = N; g.K = K; g.widx = widx;
    pg8::StaticOrder S; S.init(M, N, nblk, bid);
    EpiChunk<C> E{c};
    pg8::gemm_phase<EpiChunk<C>, pg8::StaticOrder, true, true>((PG8_LAS unsigned char*)lds, g, S, E);
}

template <class Epi>
__device__ __forceinline__ void gemm_ref(const bf16_t* A, int lda, const bf16_t* Bt, int ldb, int M, int N, int K, const Epi& E, int bid, int nblk) {
    const int tid = (int)threadIdx.x, tn = N / 64, ntile = (M / 64) * tn;
    for (int tile = bid; tile < ntile; tile += nblk) {
        const int row = (tile / tn) * 64 + (tid >> 3), col0 = (tile % tn) * 64 + (tid & 7) * 8;
        float acc[8];
#pragma unroll
        for (int j = 0; j < 8; ++j) acc[j] = 0.f;
        const bf16_t* ap = A + (size_t)row * lda; const bf16_t* bp = Bt + (size_t)col0 * ldb;
        for (int k0 = 0; k0 < K; k0 += 8) {
            const uint4 av = *(const uint4*)(ap + k0);
#pragma unroll
            for (int j = 0; j < 8; ++j) { const uint4 bv = *(const uint4*)(bp + (size_t)j * ldb + k0); acc[j] += dot8(av, bv); }
        }
        E.store8(row, col0, acc, E.row_scale(row));
    }
}

constexpr int J_ADA = 192, J_WIN = 64, J_WO = 32, J_WPQ = 32, J_WUQ = 24, J_WUKV = 32, J_KEYS = 16, J_ROPE = 16;
constexpr int J0_END = J_ADA, J1_END = J0_END + J_WIN, J2_END = J1_END + J_WO, J3_END = J2_END + J_WPQ, J4_END = J3_END + J_WUQ,
              J5_END = J4_END + J_WUKV, J6_END = J5_END + J_KEYS, J7_END = J6_END + J_ROPE, J8_END = J7_END + 1024;

__device__ __forceinline__ void job_ada(const Params& p, int it, float* lds) {
    const int tid = tid_fresh(p.widx);
    float* sc = lds;
    float* red = lds + 4096;
    for (int i = tid; i < 4096; i += 512) { const float v = p.c[i]; sc[i] = v / (1.0f + __expf(-v)); }
    __syncthreads();
    const int cg = tid & 15, rl = tid >> 4, c0 = it * 64 + cg * 4;
    float4 a0 = {0.f, 0.f, 0.f, 0.f}, a1 = {0.f, 0.f, 0.f, 0.f};
#pragma unroll 8
    for (int i = 0; i < 64; ++i) {
        const int k = rl + 32 * i;
        const float4 w = *(const float4*)(p.w_ada + (size_t)k * 12288 + c0);
        const float s0 = sc[k], s1 = sc[2048 + k];
        a0.x += s0 * w.x; a0.y += s0 * w.y; a0.z += s0 * w.z; a0.w += s0 * w.w;
        a1.x += s1 * w.x; a1.y += s1 * w.y; a1.z += s1 * w.z; a1.w += s1 * w.w;
    }
    float* r0 = red + rl * 128 + cg * 4;
    r0[0] = a0.x; r0[1] = a0.y; r0[2] = a0.z; r0[3] = a0.w; r0[64] = a1.x; r0[65] = a1.y; r0[66] = a1.z; r0[67] = a1.w;
    __syncthreads();
    if (tid < 128) {
        float s = 0.f;
        for (int r = 0; r < 32; ++r) s += red[r * 128 + tid];
        const int b = tid >> 6, col = it * 64 + (tid & 63);
        WS<float>(p, OFF_MOD)[(size_t)b * 12288 + col] = s + p.b_ada[col];
    }
    __syncthreads();
}

template <int W> __device__ __forceinline__ int tr_dst_row(int n) {
    if (W == 0) { if (n < 3840) return n; const int e = n - 3840; return 3840 + 2 * (e & 31) + (e >> 5); }
    if (W == 3) { const int h = n / 192, d = n % 192; if (d < 128) return n; const int e = d - 128; return h * 192 + 128 + 2 * (e & 31) + (e >> 5); }
    return n;
}
template <int W> __device__ __forceinline__ float tr_scale(const Params& p, int k) {
    if (W == 1) return k < 1024 ? p.osb_g[k] : p.omla_g[k - 1024];
    if (W == 3) return p.qn_g[k];
    if (W == 4) return p.kvn_g[k];
    return 1.0f;
}
template <int W> __device__ __forceinline__ void job_transpose(const Params& p, int it, float* tile) {
    constexpr int K = (W == 3) ? 512 : (W == 4) ? 256 : 2048;
    constexpr int NS = (W == 0) ? NIN : (W == 3) ? 1536 : 2048;
    constexpr int TS = 68;
    const float* src = (W == 0) ? p.w_in : (W == 1) ? p.w_o : (W == 2) ? p.w_pq : (W == 3) ? p.w_uq : p.w_ukv;
    bf16_t* dst = WS<bf16_t>(p, (W == 0) ? OFF_WIN_T : (W == 1) ? OFF_WO_T : (W == 2) ? OFF_WPQ_T : (W == 3) ? OFF_WUQ_T : OFF_WUKV_T);
    const int tid = tid_fresh(p.widx), n0 = it * 64;
    if (W == 0 && n0 >= NIN) {
        const uint4 z = {0u, 0u, 0u, 0u};
        for (int i = tid; i < 64 * K / 8; i += 512) *(uint4*)(dst + (size_t)n0 * K + (size_t)i * 8) = z;
        return;
    }
    const int lr = tid >> 4, lc = (tid & 15) * 4;
    const int sn = tid >> 3, skc = tid & 7;
    const size_t drow = (size_t)tr_dst_row<W>(n0 + sn) * K;
    for (int k0 = 0; k0 < K; k0 += 256) {
        float4 r[8];
#pragma unroll
        for (int i = 0; i < 8; ++i) r[i] = *(const float4*)(src + (size_t)(k0 + lr + 32 * i) * NS + n0 + lc);
#pragma unroll
        for (int i = 0; i < 8; ++i) *(float4*)(tile + (lr + 32 * i) * TS + lc) = r[i];
        __syncthreads();
#pragma unroll
        for (int q = 0; q < 4; ++q) {
            const int kk = skc * 32 + q * 8;
            float v[8];
#pragma unroll
            for (int j = 0; j < 8; ++j) v[j] = tile[(kk + j) * TS + sn] * tr_scale<W>(p, k0 + kk + j);
            uint4 w; w.x = pack2(v[0], v[1]); w.y = pack2(v[2], v[3]); w.z = pack2(v[4], v[5]); w.w = pack2(v[6], v[7]);
            *(uint4*)(dst + drow + k0 + kk) = w;
        }
        __syncthreads();
    }
}
__device__ __forceinline__ void job_keys(const Params& p, int slot) {
    const float* src = ((slot & 1) ? p.keys2 : p.keys1) + (size_t)(slot >> 1) * 16384;
    bf16_t* dst = WS<bf16_t>(p, OFF_KEYS) + (size_t)slot * 16384;
    for (int i = tid_fresh(p.widx); i < 16384; i += 512) dst[i] = f2bf(src[i]);
}
__device__ __forceinline__ void job_rope(const Params& p, int it) {
    float* cosT = WS<float>(p, OFF_COS); float* sinT = WS<float>(p, OFF_SIN);
    for (int j = 0; j < 32; ++j) {
        const int idx = tid_fresh(p.widx) + 512 * j, t = it * 512 + (idx >> 5), i = idx & 31;
        double inv = 1.0;
        for (int q = 0; q < i; ++q) inv *= 0.7498942093324559;
        const double ang = (double)p.pos[t] * inv;
        const double n = rint(ang * 0.15915494309189535);
        const double r = fma(-n, 6.283185307179586, ang) - n * 2.4492935982947064e-16;
        const float rf = (float)r;
        cosT[(size_t)t * 32 + i] = cosf(rf); sinT[(size_t)t * 32 + i] = sinf(rf);
    }
}
template <int EB> __device__ __forceinline__ void job_table(const Params& p, int it);
__device__ __forceinline__ void job_table6(const Params& p, int it);
__device__ __forceinline__ void phase0(const Params& p, int bid, int nblk, float* lds) {
    for (int it = bid; it < J7_END; it += nblk) {
        if (it < J0_END) job_ada(p, it, lds);
        else if (it < J1_END) job_transpose<0>(p, it - J0_END, lds);
        else if (it < J2_END) job_transpose<1>(p, it - J1_END, lds);
        else if (it < J3_END) job_transpose<2>(p, it - J2_END, lds);
        else if (it < J4_END) job_transpose<3>(p, it - J3_END, lds);
        else if (it < J5_END) job_transpose<4>(p, it - J4_END, lds);
        else if (it < J6_END) job_keys(p, it - J5_END);
        else if (it < J7_END) job_rope(p, it - J6_END);
        else if (TAB_EB == 6) job_table6(p, it - J7_END);
        else job_table<TAB_EB == 6 ? 1 : TAB_EB>(p, it - J7_END);
    }
}

template <class TS> __device__ __forceinline__ void phase_norm_mod(const Params& p, const TS* src, const float* gain, int sh_idx, int sc_idx, bf16_t* dst, int bid, int nblk, float* lds) {
    const int tid = tid_fresh(p.widx), lane = tid & 63, wid = tid >> 6;
    const float* mod = WS<float>(p, OFF_MOD);
    float* av = lds;
    float* sv = lds + 4096;
    for (int i = tid; i < 4096; i += 512) { const int b = i >> 11, col = i & 2047;
        av[i] = gain[col] * (1.0f + mod[(size_t)b * 12288 + sc_idx * 2048 + col]); sv[i] = mod[(size_t)b * 12288 + sh_idx * 2048 + col]; }
    __syncthreads();
    for (int t = bid * 8 + wid; t < TOK; t += nblk * 8) {
        const int b = t >> 12;
        const TS* xr = src + (size_t)t * DM;
        float4 v[8]; float ss = 0.f;
#pragma unroll
        for (int j = 0; j < 8; ++j) {
            if constexpr (sizeof(TS) == 4) v[j] = *(const float4*)(xr + (j * 64 + lane) * 4);
            else { const uint2 w = *(const uint2*)(xr + (j * 64 + lane) * 4); v[j].x = lo_f(w.x); v[j].y = hi_f(w.x); v[j].z = lo_f(w.y); v[j].w = hi_f(w.y); }
            ss += v[j].x * v[j].x + v[j].y * v[j].y + v[j].z * v[j].z + v[j].w * v[j].w; }
        ss = wave_sum(ss);
        const float rstd = rsqrtf(ss * (1.0f / DM) + EPS);
#pragma unroll
        for (int j = 0; j < 8; ++j) {
            const int col = (j * 64 + lane) * 4;
            const float4 a = *(const float4*)(av + b * 2048 + col), s = *(const float4*)(sv + b * 2048 + col);
            uint2 w; w.x = pack2(v[j].x * rstd * a.x + s.x, v[j].y * rstd * a.y + s.y); w.y = pack2(v[j].z * rstd * a.z + s.z, v[j].w * rstd * a.w + s.w);
            *(uint2*)(dst + (size_t)t * DM + col) = w;
        }
    }
    __syncthreads();
}

__device__ __forceinline__ void phase_rowstats(const Params& p, int bid, int nblk) {
    const int tidf = tid_fresh(p.widx), lane = tidf & 63, wid = tidf >> 6;
    const bf16_t* cq = WS<bf16_t>(p, OFF_CQ); const bf16_t* ckv = WS<bf16_t>(p, OFF_CKV);
    for (int t = bid * 8 + wid; t < TOK; t += nblk * 8) {
        const uint4 a = *(const uint4*)(cq + (size_t)t * 512 + lane * 8);
        float s1 = dot8(a, a), s2 = 0.f;
        if (lane < 32) { const uint4 b = *(const uint4*)(ckv + (size_t)t * 256 + lane * 8); s2 = dot8(b, b); }
        s1 = wave_sum(s1); s2 = wave_sum(s2);
        if (lane == 0) { WS<float>(p, OFF_RSQ)[t] = rsqrtf(s1 * (1.0f / 512.0f) + EPS); WS<float>(p, OFF_RSKV)[t] = rsqrtf(s2 * (1.0f / 256.0f) + EPS); }
    }
}

__device__ __forceinline__ void phase_attn_ref(const Params& p, int bid, int nblk) {
    const int tid = tid_fresh(p.widx), ql = tid >> 2, part = tid & 3;
    const bf16_t* qsb = WS<bf16_t>(p, OFF_QSB); const bf16_t* ksb = WS<bf16_t>(p, OFF_KSB); const bf16_t* vsb = WS<bf16_t>(p, OFF_VSB);
    const bf16_t* qml = WS<bf16_t>(p, OFF_QMLA); const bf16_t* kml = WS<bf16_t>(p, OFF_KMLA); const bf16_t* vml = WS<bf16_t>(p, OFF_VMLA);
    bf16_t* O = WS<bf16_t>(p, OFF_O); float* ssq = WS<float>(p, OFF_SSQ);
    for (int it = bid; it < 1024; it += nblk) {
        const int g = it >> 9, rem = it & 511, b = rem >> 8, h = (rem >> 5) & 7, qb = 31 - (rem & 31);
        const int t = qb * 128 + ql; const size_t tok = (size_t)b * SEQ + t;
        const int tmax = qb * 128 + (ql | 15);
        float o[32];
#pragma unroll
        for (int d = 0; d < 32; ++d) o[d] = 0.f;
        if (g == 0) {
            uint4 q[4];
#pragma unroll
            for (int j = 0; j < 4; ++j) q[j] = *(const uint4*)(qsb + tok * 1024 + h * 128 + part * 32 + j * 8);
            float between = 0.f;
            for (int s = tmax - 1; s >= 0; --s) {
                const size_t kt = (size_t)b * SEQ + s;
                float z2 = 0.f;
#pragma unroll
                for (int j = 0; j < 4; ++j) z2 += dot8(q[j], *(const uint4*)(ksb + kt * 1024 + h * 128 + part * 32 + j * 8));
                z2 += __shfl_xor(z2, 1); z2 += __shfl_xor(z2, 2);
                if (s < t) {
                    const float z = z2 * LN2;
                    const float l1p = log1pf(__expf(-fabsf(z)));
                    const float lsig = fminf(z, 0.f) - l1p, lsign = -fmaxf(z, 0.f) - l1p;
                    const float w = __expf(lsig + between);
                    between += lsign;
#pragma unroll
                    for (int j = 0; j < 4; ++j) { const uint4 vv = *(const uint4*)(vsb + kt * 1024 + h * 128 + part * 32 + j * 8);
                        o[j * 8 + 0] += w * lo_f(vv.x); o[j * 8 + 1] += w * hi_f(vv.x); o[j * 8 + 2] += w * lo_f(vv.y); o[j * 8 + 3] += w * hi_f(vv.y);
                        o[j * 8 + 4] += w * lo_f(vv.z); o[j * 8 + 5] += w * hi_f(vv.z); o[j * 8 + 6] += w * lo_f(vv.w); o[j * 8 + 7] += w * hi_f(vv.w); }
                }
            }
        } else {
            uint4 q[6];
#pragma unroll
            for (int j = 0; j < 6; ++j) q[j] = *(const uint4*)(qml + tok * 1536 + h * 192 + part * 48 + j * 8);
            float m = -1e30f, l = 0.f;
            for (int s = 0; s <= tmax; ++s) {
                const size_t kt = (size_t)b * SEQ + s;
                float sc = 0.f;
#pragma unroll
                for (int j = 0; j < 6; ++j) sc += dot8(q[j], *(const uint4*)(kml + kt * 1536 + h * 192 + part * 48 + j * 8));
                sc += __shfl_xor(sc, 1); sc += __shfl_xor(sc, 2);
                if (s <= t) {
                    const float mn = fmaxf(m, sc), alpha = exp2f(m - mn), pw = exp2f(sc - mn);
                    l = l * alpha + pw; m = mn;
#pragma unroll
                    for (int j = 0; j < 4; ++j) { const uint4 vv = *(const uint4*)(vml + kt * 1024 + h * 128 + part * 32 + j * 8);
                        o[j * 8 + 0] = o[j * 8 + 0] * alpha + pw * lo_f(vv.x); o[j * 8 + 1] = o[j * 8 + 1] * alpha + pw * hi_f(vv.x);
                        o[j * 8 + 2] = o[j * 8 + 2] * alpha + pw * lo_f(vv.y); o[j * 8 + 3] = o[j * 8 + 3] * alpha + pw * hi_f(vv.y);
                        o[j * 8 + 4] = o[j * 8 + 4] * alpha + pw * lo_f(vv.z); o[j * 8 + 5] = o[j * 8 + 5] * alpha + pw * hi_f(vv.z);
                        o[j * 8 + 6] = o[j * 8 + 6] * alpha + pw * lo_f(vv.w); o[j * 8 + 7] = o[j * 8 + 7] * alpha + pw * hi_f(vv.w); }
                }
            }
            const float inv = 1.0f / l;
#pragma unroll
            for (int d = 0; d < 32; ++d) o[d] *= inv;
        }
        float ss = 0.f;
#pragma unroll
        for (int d = 0; d < 32; ++d) ss += o[d] * o[d];
        ss += __shfl_xor(ss, 1); ss += __shfl_xor(ss, 2);
        if (part == 0) ssq[tok * 16 + g * 8 + h] = ss;
        bf16_t* op = O + tok * 2048 + g * 1024 + h * 128 + part * 32;
#pragma unroll
        for (int j = 0; j < 4; ++j) { uint4 w; w.x = pack2(o[j * 8], o[j * 8 + 1]); w.y = pack2(o[j * 8 + 2], o[j * 8 + 3]); w.z = pack2(o[j * 8 + 4], o[j * 8 + 5]); w.w = pack2(o[j * 8 + 6], o[j * 8 + 7]);
            *(uint4*)(op + j * 8) = w; }
    }
}


typedef short bf16x8_t __attribute__((ext_vector_type(8)));
typedef short s16x4_t __attribute__((ext_vector_type(4)));
typedef float f32x16_t __attribute__((ext_vector_type(16)));
typedef float f32x2_t __attribute__((ext_vector_type(2)));
typedef unsigned u32x4_t __attribute__((ext_vector_type(4)));
typedef __bf16 bf16x2_t __attribute__((ext_vector_type(2)));
__device__ __forceinline__ unsigned cvt_pk_bf16(float lo, float hi) { f32x2_t v = {lo, hi}; bf16x2_t b = __builtin_convertvector(v, bf16x2_t); return __builtin_bit_cast(unsigned, b); }
__device__ __forceinline__ void swap32(float a, float& lo, float& hi) {
    auto r = __builtin_amdgcn_permlane32_swap(__float_as_uint(a), __float_as_uint(a), false, false);
    lo = __uint_as_float(r[0]); hi = __uint_as_float(r[1]);
}
constexpr int LDS_TAB_OFF = 131072 + 16;
constexpr int ATT_VSTR = 320;
constexpr int ATT_STAGE_MAX = 64 * (192 * 2 + 16) + 64 * ATT_VSTR;
constexpr int ATT_BC_OFF = 2 * 64 * (192 * 2 + 16) + 3 * 64 * ATT_VSTR;
constexpr int ATT_HEAD_WORD = 3840;

template <int G>
__device__ __forceinline__ void attn_qk(const LAS unsigned char* kbuf, const bf16x8_t (&qf)[G ? 12 : 8], f32x16_t& s0, f32x16_t& s1, unsigned kread) {
    constexpr int DK = G ? 192 : 128, NKS = DK / 16, KSTR = DK * 2 + 16;
#pragma unroll
    for (int r = 0; r < 16; ++r) { s0[r] = 0.f; s1[r] = 0.f; }
    const LAS unsigned char* kp = kbuf + kread;
#pragma unroll
    for (int ks = 0; ks < NKS; ++ks) {
        const bf16x8_t a0 = *(const LAS bf16x8_t*)(kp + ks * 32), a1 = *(const LAS bf16x8_t*)(kp + 32 * KSTR + ks * 32);
        s0 = __builtin_amdgcn_mfma_f32_32x32x16_bf16(a0, qf[ks], s0, 0, 0, 0);
        s1 = __builtin_amdgcn_mfma_f32_32x32x16_bf16(a1, qf[ks], s1, 0, 0, 0);
    }
    __builtin_amdgcn_sched_group_barrier(0x100, 6, 0);
#pragma unroll
    for (int i = 0; i < 2 * NKS - 6; ++i) { __builtin_amdgcn_sched_group_barrier(0x8, 1, 0); __builtin_amdgcn_sched_group_barrier(0x100, 1, 0); }
#pragma unroll
    for (int i = 0; i < 6; ++i) __builtin_amdgcn_sched_group_barrier(0x8, 1, 0);
}
__device__ __forceinline__ void pv_half_pinned(const LAS unsigned char* vp, int kb, const unsigned (&pkh)[8], f32x16_t (&o)[4]) {
    constexpr int VSTR = ATT_VSTR;
    bf16x8_t pf[2];
#pragma unroll
    for (int s = 0; s < 2; ++s) { const unsigned w0 = pkh[4 * s], w1 = pkh[4 * s + 1], w2 = pkh[4 * s + 2], w3 = pkh[4 * s + 3];
        pf[s][0] = (short)(w0 & 0xffff); pf[s][1] = (short)(w0 >> 16); pf[s][2] = (short)(w1 & 0xffff); pf[s][3] = (short)(w1 >> 16);
        pf[s][4] = (short)(w2 & 0xffff); pf[s][5] = (short)(w2 >> 16); pf[s][6] = (short)(w3 & 0xffff); pf[s][7] = (short)(w3 >> 16); }
    s16x4_t lo[8], hi[8];
#define PVP_LD(i) do { const LAS unsigned char* vq_ = vp + (32 * kb + 16 * ((i) >> 2)) * VSTR + ((i) & 3) * 64; \
        lo[i] = __builtin_amdgcn_ds_read_tr16_b64_v4i16((LAS s16x4_t*)(vq_)); hi[i] = __builtin_amdgcn_ds_read_tr16_b64_v4i16((LAS s16x4_t*)(vq_ + 8 * VSTR)); } while (0)
    PVP_LD(0); PVP_LD(1); PVP_LD(2);
    __builtin_amdgcn_sched_barrier(0x6);
#pragma unroll
    for (int i = 0; i < 8; ++i) {
        const bf16x8_t vf = {lo[i][0], lo[i][1], lo[i][2], lo[i][3], hi[i][0], hi[i][1], hi[i][2], hi[i][3]};
        o[i & 3] = __builtin_amdgcn_mfma_f32_32x32x16_bf16(vf, pf[i >> 2], o[i & 3], 0, 0, 0);
        if (i + 3 < 8) PVP_LD(i + 3);
        __builtin_amdgcn_sched_barrier(0x6);
    }
#undef PVP_LD
}
__device__ __forceinline__ void attn_qk_pinned(const LAS unsigned char* kbuf, const bf16x8_t (&qf)[12], f32x16_t& s0, f32x16_t& s1, unsigned kread) {
    constexpr int KSTR = 192 * 2 + 16;
    const LAS unsigned char* kp = kbuf + kread;
    bf16x8_t fa[12], fb[12];
#pragma unroll
    for (int ks = 0; ks < 3; ++ks) { fa[ks] = *(const LAS bf16x8_t*)(kp + ks * 32); fb[ks] = *(const LAS bf16x8_t*)(kp + 32 * KSTR + ks * 32); }
#pragma unroll
    for (int r = 0; r < 16; ++r) { s0[r] = 0.f; s1[r] = 0.f; }
    __builtin_amdgcn_sched_barrier(0x6);
#pragma unroll
    for (int ks = 0; ks < 12; ++ks) {
        s0 = __builtin_amdgcn_mfma_f32_32x32x16_bf16(fa[ks], qf[ks], s0, 0, 0, 0);
        if (ks + 3 < 12) fa[ks + 3] = *(const LAS bf16x8_t*)(kp + (ks + 3) * 32);
        __builtin_amdgcn_sched_barrier(0x6);
        s1 = __builtin_amdgcn_mfma_f32_32x32x16_bf16(fb[ks], qf[ks], s1, 0, 0, 0);
        if (ks + 3 < 12) fb[ks + 3] = *(const LAS bf16x8_t*)(kp + 32 * KSTR + (ks + 3) * 32);
        __builtin_amdgcn_sched_barrier(0x6);
    }
}
template <int G>
__device__ __forceinline__ void attn_sm(bool need_mask, f32x16_t& s0, f32x16_t& s1, unsigned (&pk)[2][8], f32x16_t (&o)[4], float& st0, float& st1, int lim, int hh) {
    if (need_mask) {
        asm volatile("" ::: "memory");
        const float neg = G ? -INFINITY : -100.0f;
#pragma unroll
        for (int r = 0; r < 16; ++r) { const int kr = (r & 3) + 8 * (r >> 2) + 4 * hh;
            s0[r] = (G ? (kr <= lim) : (kr < lim)) ? s0[r] : neg; s1[r] = (G ? (32 + kr <= lim) : (32 + kr < lim)) ? s1[r] : neg; }
    }
    if (G == 0) {
        float R = st0;
#pragma unroll
        for (int kb = 1; kb >= 0; --kb) {
#pragma unroll
            for (int g = 3; g >= 0; --g) {
                float sg[4], om[4];
#pragma unroll
                for (int rr = 0; rr < 4; ++rr) {
                    const float z2 = kb ? s1[4 * g + rr] : s0[4 * g + rr];
                    const float e = __builtin_amdgcn_exp2f(-z2);
                    const float sig = __builtin_amdgcn_rcpf(1.0f + e);
                    sg[rr] = sig; om[rr] = e * sig;
                }
                const float gown = (om[0] * om[1]) * (om[2] * om[3]);
                float glo, ghi; swap32(gown, glo, ghi);
                const float E = hh ? R : R * ghi;
                const float e2 = E * om[3], e1 = e2 * om[2], e0 = e1 * om[1];
                pk[kb][2 * g] = cvt_pk_bf16(sg[0] * e0, sg[1] * e1); pk[kb][2 * g + 1] = cvt_pk_bf16(sg[2] * e2, sg[3] * E);
                R = R * (glo * ghi);
            }
        }
        st0 = R;
    } else {
        float mx = fmaxf(s0[0], s1[0]);
#pragma unroll
        for (int r = 1; r < 16; ++r) mx = fmaxf(mx, fmaxf(s0[r], s1[r]));
        float mlo, mhi; swap32(mx, mlo, mhi);
        const float mn = fmaxf(st0, fmaxf(mlo, mhi)), alpha = __builtin_amdgcn_exp2f(st0 - mn);
        st0 = mn;
        float ls = 0.f;
#pragma unroll
        for (int g = 0; g < 4; ++g) {
            float a[4], bq[4];
#pragma unroll
            for (int rr = 0; rr < 4; ++rr) { a[rr] = __builtin_amdgcn_exp2f(s0[4 * g + rr] - mn); bq[rr] = __builtin_amdgcn_exp2f(s1[4 * g + rr] - mn); ls += a[rr] + bq[rr]; }
            pk[0][2 * g] = cvt_pk_bf16(a[0], a[1]); pk[0][2 * g + 1] = cvt_pk_bf16(a[2], a[3]);
            pk[1][2 * g] = cvt_pk_bf16(bq[0], bq[1]); pk[1][2 * g + 1] = cvt_pk_bf16(bq[2], bq[3]);
        }
        st1 = st1 * alpha + ls;
        if (__builtin_amdgcn_ballot_w64(alpha != 1.0f) != 0ull) {
#pragma unroll
            for (int d = 0; d < 4; ++d) o[d] = o[d] * alpha;
        }
    }
}
__device__ __forceinline__ void attn_pv(const LAS unsigned char* vbuf, const unsigned (&pk)[2][8], f32x16_t (&o)[4], unsigned vread) {
    constexpr int VSTR = ATT_VSTR;
    const LAS unsigned char* vp = vbuf + vread;
#pragma unroll
    for (int kb = 0; kb < 2; ++kb)
#pragma unroll
        for (int s = 0; s < 2; ++s) {
            bf16x8_t pf;
            { const unsigned w0 = pk[kb][4 * s], w1 = pk[kb][4 * s + 1], w2 = pk[kb][4 * s + 2], w3 = pk[kb][4 * s + 3];
              pf[0] = (short)(w0 & 0xffff); pf[1] = (short)(w0 >> 16); pf[2] = (short)(w1 & 0xffff); pf[3] = (short)(w1 >> 16);
              pf[4] = (short)(w2 & 0xffff); pf[5] = (short)(w2 >> 16); pf[6] = (short)(w3 & 0xffff); pf[7] = (short)(w3 >> 16); }
#pragma unroll
            for (int d = 0; d < 4; ++d) {
                const LAS unsigned char* vq = vp + (32 * kb + 16 * s) * VSTR + d * 64;
                const s16x4_t lo = __builtin_amdgcn_ds_read_tr16_b64_v4i16((LAS s16x4_t*)(vq));
                const s16x4_t hi = __builtin_amdgcn_ds_read_tr16_b64_v4i16((LAS s16x4_t*)(vq + 8 * VSTR));
                const bf16x8_t vf = {lo[0], lo[1], lo[2], lo[3], hi[0], hi[1], hi[2], hi[3]};
                o[d] = __builtin_amdgcn_mfma_f32_32x32x16_bf16(vf, pf, o[d], 0, 0, 0);
            }
        }
    __builtin_amdgcn_sched_group_barrier(0x100, 6, 0);
#pragma unroll
    for (int i = 0; i < 13; ++i) { __builtin_amdgcn_sched_group_barrier(0x8, 1, 0); __builtin_amdgcn_sched_group_barrier(0x100, 2, 0); }
#pragma unroll
    for (int i = 0; i < 3; ++i) __builtin_amdgcn_sched_group_barrier(0x8, 1, 0);
}

__device__ __forceinline__ void sb_half_math(const f32x16_t& s, unsigned (&pkh)[8], float& R, int hh) {
#pragma unroll
    for (int g = 3; g >= 0; --g) {
        float sg[4], om[4];
#pragma unroll
        for (int rr = 0; rr < 4; ++rr) { const float e = __builtin_amdgcn_exp2f(fminf(-s[4 * g + rr], 120.0f)); const float sig = __builtin_amdgcn_rcpf(1.0f + e); sg[rr] = sig; om[rr] = e * sig; }
        const float gown = (om[0] * om[1]) * (om[2] * om[3]);
        float glo, ghi; swap32(gown, glo, ghi);
        const float E = hh ? R : R * ghi;
        const float e2 = E * om[3], e1 = e2 * om[2], e0 = e1 * om[1];
        pkh[2 * g] = cvt_pk_bf16(sg[0] * e0, sg[1] * e1); pkh[2 * g + 1] = cvt_pk_bf16(sg[2] * e2, sg[3] * E);
        R = R * (glo * ghi);
    }
}
__device__ __forceinline__ void pv_half(const LAS unsigned char* vp, int kb, const unsigned (&pkh)[8], f32x16_t (&o)[4]) {
    constexpr int VSTR = ATT_VSTR;
#pragma unroll
    for (int s = 0; s < 2; ++s) {
        bf16x8_t pf;
        { const unsigned w0 = pkh[4 * s], w1 = pkh[4 * s + 1], w2 = pkh[4 * s + 2], w3 = pkh[4 * s + 3];
          pf[0] = (short)(w0 & 0xffff); pf[1] = (short)(w0 >> 16); pf[2] = (short)(w1 & 0xffff); pf[3] = (short)(w1 >> 16);
          pf[4] = (short)(w2 & 0xffff); pf[5] = (short)(w2 >> 16); pf[6] = (short)(w3 & 0xffff); pf[7] = (short)(w3 >> 16); }
#pragma unroll
        for (int d = 0; d < 4; ++d) {
            const LAS unsigned char* vq = vp + (32 * kb + 16 * s) * VSTR + d * 64;
            const s16x4_t lo = __builtin_amdgcn_ds_read_tr16_b64_v4i16((LAS s16x4_t*)(vq));
            const s16x4_t hi = __builtin_amdgcn_ds_read_tr16_b64_v4i16((LAS s16x4_t*)(vq + 8 * VSTR));
            const bf16x8_t vf = {lo[0], lo[1], lo[2], lo[3], hi[0], hi[1], hi[2], hi[3]};
            o[d] = __builtin_amdgcn_mfma_f32_32x32x16_bf16(vf, pf, o[d], 0, 0, 0);
        }
    }
}
__device__ __forceinline__ void attn_tile_sb(bool need_mask, const LAS unsigned char* base, const bf16x8_t (&qf)[8], f32x16_t (&o)[4], float& st0, int lim, unsigned kread, unsigned vread, int hh) {
    constexpr int KSTR = 128 * 2 + 16;
    const LAS unsigned char* kp = base + kread;
    f32x16_t s0, s1;
#pragma unroll
    for (int r = 0; r < 16; ++r) { s0[r] = 0.f; s1[r] = 0.f; }
#pragma unroll
    for (int ks = 0; ks < 8; ++ks) s1 = __builtin_amdgcn_mfma_f32_32x32x16_bf16(*(const LAS bf16x8_t*)(kp + 32 * KSTR + ks * 32), qf[ks], s1, 0, 0, 0);
#pragma unroll
    for (int ks = 0; ks < 8; ++ks) s0 = __builtin_amdgcn_mfma_f32_32x32x16_bf16(*(const LAS bf16x8_t*)(kp + ks * 32), qf[ks], s0, 0, 0, 0);
    if (need_mask) {
        asm volatile("" ::: "memory");
#pragma unroll
        for (int r = 0; r < 16; ++r) { const int kr = (r & 3) + 8 * (r >> 2) + 4 * hh; s0[r] = (kr < lim) ? s0[r] : -100.0f; s1[r] = (32 + kr < lim) ? s1[r] : -100.0f; }
    }
    unsigned pk1[8], pk0[8]; float R = st0;
    sb_half_math(s1, pk1, R, hh);
    pv_half(base + vread, 1, pk1, o);
    sb_half_math(s0, pk0, R, hh);
    pv_half(base + vread, 0, pk0, o);
    st0 = R;
}

__device__ __forceinline__ void attn_tile_mla(bool need_mask, const LAS unsigned char* base, const bf16x8_t (&qf)[12], f32x16_t (&o)[4], float& st0, float& st1, int lim, unsigned kread, unsigned vread, int hh) {
    f32x16_t s0, s1;
    attn_qk<1>(base, qf, s0, s1, kread);
    if (need_mask) {
        asm volatile("" ::: "memory");
#pragma unroll
        for (int r = 0; r < 16; ++r) { const int kr = (r & 3) + 8 * (r >> 2) + 4 * hh; s0[r] = (kr <= lim) ? s0[r] : -INFINITY; s1[r] = (32 + kr <= lim) ? s1[r] : -INFINITY; }
    }
    float mx = fmaxf(s0[0], s1[0]);
#pragma unroll
    for (int r = 1; r < 16; ++r) mx = fmaxf(mx, fmaxf(s0[r], s1[r]));
    float mlo, mhi; swap32(mx, mlo, mhi);
    const float mn = fmaxf(st0, fmaxf(mlo, mhi)), alpha = __builtin_amdgcn_exp2f(st0 - mn);
    st0 = mn;
    if (__builtin_amdgcn_ballot_w64(alpha != 1.0f) != 0ull) {
#pragma unroll
        for (int d = 0; d < 4; ++d) o[d] = o[d] * alpha;
    }
    unsigned pk1[8], pk0[8]; float ls = 0.f;
#pragma unroll
    for (int g = 0; g < 4; ++g) { float a[4];
#pragma unroll
        for (int rr = 0; rr < 4; ++rr) { a[rr] = __builtin_amdgcn_exp2f(s1[4 * g + rr] - mn); ls += a[rr]; }
        pk1[2 * g] = cvt_pk_bf16(a[0], a[1]); pk1[2 * g + 1] = cvt_pk_bf16(a[2], a[3]); }
    pv_half(base + vread, 1, pk1, o);
#pragma unroll
    for (int g = 0; g < 4; ++g) { float a[4];
#pragma unroll
        for (int rr = 0; rr < 4; ++rr) { a[rr] = __builtin_amdgcn_exp2f(s0[4 * g + rr] - mn); ls += a[rr]; }
        pk0[2 * g] = cvt_pk_bf16(a[0], a[1]); pk0[2 * g + 1] = cvt_pk_bf16(a[2], a[3]); }
    pv_half(base + vread, 0, pk0, o);
    st1 = st1 * alpha + ls;
}
template <int G>
__device__ __forceinline__ void attn_tile(bool need_mask, const LAS unsigned char* base, const bf16x8_t (&qf)[G ? 12 : 8], f32x16_t (&o)[4], float& st0, float& st1, int lim, unsigned kread, unsigned vread, int hh) {
    f32x16_t s0, s1; unsigned pk[2][8];
    attn_qk<G>(base, qf, s0, s1, kread);
    attn_sm<G>(need_mask, s0, s1, pk, o, st0, st1, lim, hh);
    attn_pv(base, pk, o, vread);
}
template <int G>
__device__ __forceinline__ void attn_unit2(const Params& p, int b, int h, int qb, LAS unsigned char* lds, int tid_in) {
    int tid = tid_in; asm volatile("" : "+v"(tid));
    constexpr int DK = G ? 192 : 128, NKS = DK / 16, KCH = DK / 8, KSTR = DK * 2 + 16, VSTR = ATT_VSTR;
    constexpr int KTILE = 64 * KSTR, VTILE = 64 * VSTR, NKL = KCH * 64 / 512, QP = G ? 1536 : 1024;
    const int lane = tid & 63, wid = __builtin_amdgcn_readfirstlane(tid >> 6), c = lane & 31, hh = lane >> 5, H = wid >> 2;
    const bf16_t* Qg = WS<bf16_t>(p, G ? OFF_QMLA : OFF_QSB); const bf16_t* Kg = WS<bf16_t>(p, G ? OFF_KMLA : OFF_KSB); const bf16_t* Vg = WS<bf16_t>(p, G ? OFF_VMLA : OFF_VSB);
    const size_t tok0 = (size_t)b * SEQ;
    const int trow = qb * 256 + wid * 32 + c;
    bf16x8_t qf[NKS];
    { const bf16_t* qp = Qg + (tok0 + trow) * QP + h * DK + hh * 8;
#pragma unroll
      for (int ks = 0; ks < NKS; ++ks) qf[ks] = *(const bf16x8_t*)(qp + ks * 16); }
    f32x16_t o[4];
#pragma unroll
    for (int d = 0; d < 4; ++d)
#pragma unroll
        for (int r = 0; r < 16; ++r) o[d][r] = 0.f;
    float st0 = G ? -1e30f : 1.0f, st1 = 0.f;
    const int srow = tid >> 3, sch = tid & 7;
    const bf16_t* Kb = Kg + tok0 * QP + (size_t)srow * QP + h * DK + sch * 8; const bf16_t* Vb = Vg + tok0 * 1024 + (size_t)srow * 1024 + h * 128 + sch * 8;
    const unsigned klds0 = (unsigned)(srow * KSTR + sch * 16), vlds0 = (unsigned)(2 * KTILE + srow * VSTR + sch * 16);
    const unsigned kread = (unsigned)(c * KSTR + hh * 16);
    const unsigned vread = (unsigned)(2 * KTILE + (4 * hh + ((lane & 15) >> 2)) * VSTR + (16 * ((lane >> 4) & 1) + 4 * (lane & 3)) * 2);
    const int jmax = 4 * qb + 3, T = jmax + 1, wb = wid >> 1;
    u32x4_t kreg[NKL], vreg[2];
#pragma unroll
    for (int i = 0; i < NKL; ++i) kreg[i] = *(const u32x4_t*)(Kb + (size_t)jmax * 64 * QP + i * 64);
#pragma unroll
    for (int i = 0; i < NKL; ++i) *(LAS u32x4_t*)(lds + klds0 + i * 128) = kreg[i];
#pragma unroll
    for (int i = 0; i < NKL; ++i) kreg[i] = *(const u32x4_t*)(Kb + (size_t)(jmax - 1) * 64 * QP + i * 64);
#pragma unroll
    for (int i = 0; i < 2; ++i) vreg[i] = *(const u32x4_t*)(Vb + (size_t)jmax * 64 * 1024 + i * 64);
    __syncthreads();
    f32x16_t s0, s1; unsigned pk[2][8];
#pragma unroll
    for (int r = 0; r < 16; ++r) { s0[r] = 0.f; s1[r] = 0.f; }
#pragma unroll
    for (int i = 0; i < 8; ++i) { pk[0][i] = 0u; pk[1][i] = 0u; }
#pragma unroll 1
    for (int slot = 0; slot < 2 * T + 2; ++slot) {
        if ((slot & 1) == 0) {
            const int s = slot >> 1;
            if (s + 1 < T) {
#pragma unroll
                for (int i = 0; i < NKL; ++i) *(LAS u32x4_t*)(lds + ((s + 1) & 1) * KTILE + klds0 + i * 128) = kreg[i];
            }
            if (s < T) {
#pragma unroll
                for (int i = 0; i < 2; ++i) *(LAS u32x4_t*)(lds + (s & 1) * VTILE + vlds0 + i * 128) = vreg[i];
            }
            if (s + 2 < T) {
#pragma unroll
                for (int i = 0; i < NKL; ++i) kreg[i] = *(const u32x4_t*)(Kb + (size_t)(jmax - s - 2) * 64 * QP + i * 64);
            }
            if (s + 1 < T) {
#pragma unroll
                for (int i = 0; i < 2; ++i) vreg[i] = *(const u32x4_t*)(Vb + (size_t)(jmax - s - 1) * 64 * 1024 + i * 64);
            }
        }
        if ((slot & 1) == H) {
            const int sm = (slot - H) >> 1;
            if (sm >= 1) { const int sp = sm - 1, jb = (jmax - sp) - 4 * qb; if (jb <= wb) attn_pv(lds + (sp & 1) * VTILE, pk, o, vread); }
            if (sm < T) { const int jb = (jmax - sm) - 4 * qb; if (jb <= wb) attn_qk<G>(lds + (sm & 1) * KTILE, qf, s0, s1, kread); }
        } else if (slot >= 1 + H) {
            const int sv = (slot - 1 - H) >> 1;
            if (sv < T) { const int j = jmax - sv, jb = j - 4 * qb; if (jb <= wb) attn_sm<G>(jb == wb, s0, s1, pk, o, st0, st1, trow - 64 * j, hh); }
        }
        __syncthreads();
    }
    if (G == 1) { float llo, lhi; swap32(st1, llo, lhi); const float inv = 1.0f / (llo + lhi);
#pragma unroll
        for (int d = 0; d < 4; ++d) o[d] = o[d] * inv; }
    float ss = 0.f;
    bf16_t* op = WS<bf16_t>(p, OFF_O) + (tok0 + trow) * 2048 + G * 1024 + h * 128 + 4 * hh;
#pragma unroll
    for (int d = 0; d < 4; ++d)
#pragma unroll
        for (int g = 0; g < 4; ++g) {
            const float v0 = o[d][4 * g], v1 = o[d][4 * g + 1], v2 = o[d][4 * g + 2], v3 = o[d][4 * g + 3];
            ss += v0 * v0 + v1 * v1 + v2 * v2 + v3 * v3;
            uint2 w; w.x = cvt_pk_bf16(v0, v1); w.y = cvt_pk_bf16(v2, v3);
            *(uint2*)(op + 32 * d + 8 * g) = w;
        }
    float slo, shi; swap32(ss, slo, shi);
    if (hh == 0) WS<float>(p, OFF_SSQ)[(tok0 + trow) * 16 + G * 8 + h] = slo + shi;
}

template <int G>
__device__ __forceinline__ void attn_unit(const Params& p, int b, int h, int qb, LAS unsigned char* lds, int tid_in) {
    int tid = tid_in; asm volatile("" : "+v"(tid));
    constexpr int DK = G ? 192 : 128, NKS = DK / 16, KCH = DK / 8, KSTR = DK * 2 + 16, VSTR = ATT_VSTR;
    constexpr int KTILE = 64 * KSTR, VTILE = 64 * VSTR, STAGE = KTILE + VTILE, NKL = KCH * 64 / 512, QP = G ? 1536 : 1024;
    const int lane = tid & 63, wid = __builtin_amdgcn_readfirstlane(tid >> 6), c = lane & 31, hh = lane >> 5;
    const bf16_t* Qg = WS<bf16_t>(p, G ? OFF_QMLA : OFF_QSB); const bf16_t* Kg = WS<bf16_t>(p, G ? OFF_KMLA : OFF_KSB); const bf16_t* Vg = WS<bf16_t>(p, G ? OFF_VMLA : OFF_VSB);
    const size_t tok0 = (size_t)b * SEQ;
    const int trow = qb * 256 + wid * 32 + c;
    bf16x8_t qf[NKS];
    { const bf16_t* qp = Qg + (tok0 + trow) * QP + h * DK + hh * 8;
#pragma unroll
      for (int ks = 0; ks < NKS; ++ks) qf[ks] = *(const bf16x8_t*)(qp + ks * 16); }
    f32x16_t o[4];
#pragma unroll
    for (int d = 0; d < 4; ++d)
#pragma unroll
        for (int r = 0; r < 16; ++r) o[d][r] = 0.f;
    float st0 = G ? -1e30f : 1.0f, st1 = 0.f;
    const int srow = tid >> 3, sch = tid & 7;
    const bf16_t* Kb = Kg + tok0 * QP + (size_t)srow * QP + h * DK + sch * 8; const bf16_t* Vb = Vg + tok0 * 1024 + (size_t)srow * 1024 + h * 128 + sch * 8;
    const unsigned klds0 = (unsigned)(srow * KSTR + sch * 16), vlds0 = (unsigned)(KTILE + srow * VSTR + sch * 16);
    u32x4_t kreg[NKL], vreg[2];
    const int jmax = 4 * qb + 3;
#pragma unroll
    for (int i = 0; i < NKL; ++i) kreg[i] = *(const u32x4_t*)(Kb + (size_t)jmax * 64 * QP + i * 64);
#pragma unroll
    for (int i = 0; i < 2; ++i) vreg[i] = *(const u32x4_t*)(Vb + (size_t)jmax * 64 * 1024 + i * 64);
    const unsigned kread = (unsigned)(c * KSTR + hh * 16);
    const unsigned vread = (unsigned)(KTILE + (4 * hh + ((lane & 15) >> 2)) * VSTR + (16 * ((lane >> 4) & 1) + 4 * (lane & 3)) * 2);
    LAS unsigned* aflag = (LAS unsigned*)(lds + ATT_BC_OFF + 16);
    if (G == 0) { if (tid < 3) aflag[tid] = 0u; }
    int f_cur = 0, f_prev = 2, f_next = 1;
    for (int j = jmax; j >= 0; --j) {
        LAS unsigned char* base = lds + ((jmax - j) & 1) * STAGE;
#pragma unroll
        for (int i = 0; i < NKL; ++i) *(LAS u32x4_t*)(base + klds0 + i * 128) = kreg[i];
#pragma unroll
        for (int i = 0; i < 2; ++i) *(LAS u32x4_t*)(base + vlds0 + i * 128) = vreg[i];
        __syncthreads();
        if (G == 0) {
            if (j < jmax) { const unsigned alive = (unsigned)__builtin_amdgcn_readfirstlane((int)aflag[f_prev]); if (alive == 0u) break; }
            if (tid == 0) aflag[f_next] = 0u;
        }
        if (j > 0) {
#pragma unroll
            for (int i = 0; i < NKL; ++i) kreg[i] = *(const u32x4_t*)(Kb + (size_t)(j - 1) * 64 * QP + i * 64);
#pragma unroll
            for (int i = 0; i < 2; ++i) vreg[i] = *(const u32x4_t*)(Vb + (size_t)(j - 1) * 64 * 1024 + i * 64);
        }
        const int jb = j - 4 * qb;
        if (jb <= (wid >> 1)) {
            const bool need_mask = (jb == (wid >> 1));
            const int lim = trow - 64 * j;
            if constexpr (G == 0) attn_tile_sb(need_mask, base, qf, o, st0, lim, kread, vread, hh); else attn_tile_mla(need_mask, base, qf, o, st0, st1, lim, kread, vread, hh);
        }
        if (G == 0) {
            if (__builtin_amdgcn_ballot_w64(st0 >= 9.094947e-13f) != 0ull) { if (lane == 0) aflag[f_cur] = 1u; }
            const int t_ = f_prev; f_prev = f_cur; f_cur = f_next; f_next = t_;
        }
    }
    if (G == 1) { float llo, lhi; swap32(st1, llo, lhi); const float inv = 1.0f / (llo + lhi);
#pragma unroll
        for (int d = 0; d < 4; ++d) o[d] = o[d] * inv; }
    float ss = 0.f;
    bf16_t* op = WS<bf16_t>(p, OFF_O) + (tok0 + trow) * 2048 + G * 1024 + h * 128 + 4 * hh;
#pragma unroll
    for (int d = 0; d < 4; ++d)
#pragma unroll
        for (int g = 0; g < 4; ++g) {
            const float v0 = o[d][4 * g], v1 = o[d][4 * g + 1], v2 = o[d][4 * g + 2], v3 = o[d][4 * g + 3];
            ss += v0 * v0 + v1 * v1 + v2 * v2 + v3 * v3;
            uint2 w; w.x = cvt_pk_bf16(v0, v1); w.y = cvt_pk_bf16(v2, v3);
            *(uint2*)(op + 32 * d + 8 * g) = w;
        }
    float slo, shi; swap32(ss, slo, shi);
    if (hh == 0) WS<float>(p, OFF_SSQ)[(tok0 + trow) * 16 + G * 8 + h] = slo + shi;
    __syncthreads();
}


__device__ __forceinline__ void attn_unit_mla_mid(const Params& p, int b, int h, int qb, LAS unsigned char* lds, int tid_in) {
    int tid = tid_in; asm volatile("" : "+v"(tid));
    constexpr int DK = 192, NKS = 12, KSTR = DK * 2 + 16, VSTR = ATT_VSTR, KTILE = 64 * KSTR, VTILE = 64 * VSTR, STAGE = KTILE + VTILE, NKL = 3, QP = 1536;
    const int lane = tid & 63, wid = __builtin_amdgcn_readfirstlane(tid >> 6), c = lane & 31, hh = lane >> 5;
    const bf16_t* Qg = WS<bf16_t>(p, OFF_QMLA); const bf16_t* Kg = WS<bf16_t>(p, OFF_KMLA); const bf16_t* Vg = WS<bf16_t>(p, OFF_VMLA);
    const size_t tok0 = (size_t)b * SEQ;
    const int trow = qb * 256 + wid * 32 + c;
    bf16x8_t qf[NKS];
    { const bf16_t* qp = Qg + (tok0 + trow) * QP + h * DK + hh * 8;
#pragma unroll
      for (int ks = 0; ks < NKS; ++ks) qf[ks] = *(const bf16x8_t*)(qp + ks * 16); }
    f32x16_t o[4];
#pragma unroll
    for (int d = 0; d < 4; ++d)
#pragma unroll
        for (int r = 0; r < 16; ++r) o[d][r] = 0.f;
    float st0 = -1e30f, st1 = 0.f;
    const int srow = tid >> 3, sch = tid & 7;
    const bf16_t* Kb = Kg + tok0 * QP + (size_t)srow * QP + h * DK + sch * 8; const bf16_t* Vb = Vg + tok0 * 1024 + (size_t)srow * 1024 + h * 128 + sch * 8;
    const unsigned klds0 = (unsigned)(srow * KSTR + sch * 16), vlds0 = (unsigned)(KTILE + srow * VSTR + sch * 16);
    u32x4_t kreg[NKL], vreg[2];
    const int jmax = 4 * qb + 3;
#pragma unroll
    for (int i = 0; i < NKL; ++i) kreg[i] = *(const u32x4_t*)(Kb + (size_t)jmax * 64 * QP + i * 64);
#pragma unroll
    for (int i = 0; i < 2; ++i) vreg[i] = *(const u32x4_t*)(Vb + (size_t)jmax * 64 * 1024 + i * 64);
#pragma unroll
    for (int i = 0; i < NKL; ++i) *(LAS u32x4_t*)(lds + klds0 + i * 128) = kreg[i];
#pragma unroll
    for (int i = 0; i < 2; ++i) *(LAS u32x4_t*)(lds + vlds0 + i * 128) = vreg[i];
#pragma unroll
    for (int i = 0; i < NKL; ++i) kreg[i] = *(const u32x4_t*)(Kb + (size_t)(jmax - 1) * 64 * QP + i * 64);
#pragma unroll
    for (int i = 0; i < 2; ++i) vreg[i] = *(const u32x4_t*)(Vb + (size_t)(jmax - 1) * 64 * 1024 + i * 64);
    const unsigned kread = (unsigned)(c * KSTR + hh * 16);
    const unsigned vread = (unsigned)(KTILE + (4 * hh + ((lane & 15) >> 2)) * VSTR + (16 * ((lane >> 4) & 1) + 4 * (lane & 3)) * 2);
    for (int j = jmax; j >= 0; --j) {
        LAS unsigned char* base = lds + ((jmax - j) & 1) * STAGE;
        LAS unsigned char* nbase = lds + ((jmax - j + 1) & 1) * STAGE;
        __syncthreads();
        const int jb = j - 4 * qb;
        const bool act = jb <= (wid >> 1);
        f32x16_t s0, s1; unsigned pk1[8], pk0[8]; float ls = 0.f, alpha = 1.0f, mn = st0;
        if (act) {
            attn_qk_pinned(base, qf, s0, s1, kread);
            if (jb == (wid >> 1)) {
                asm volatile("" ::: "memory");
                const int lim = trow - 64 * j;
#pragma unroll
                for (int r = 0; r < 16; ++r) { const int kr = (r & 3) + 8 * (r >> 2) + 4 * hh; s0[r] = (kr <= lim) ? s0[r] : -INFINITY; s1[r] = (32 + kr <= lim) ? s1[r] : -INFINITY; }
            }
            float mx = fmaxf(s0[0], s1[0]);
#pragma unroll
            for (int r = 1; r < 16; ++r) mx = fmaxf(mx, fmaxf(s0[r], s1[r]));
            float mlo, mhi; swap32(mx, mlo, mhi);
            mn = fmaxf(st0, fmaxf(mlo, mhi)); alpha = __builtin_amdgcn_exp2f(st0 - mn);
            st0 = mn;
            if (__builtin_amdgcn_ballot_w64(alpha != 1.0f) != 0ull) {
#pragma unroll
                for (int d = 0; d < 4; ++d) o[d] = o[d] * alpha;
            }
#pragma unroll
            for (int g = 0; g < 4; ++g) { float a[4];
#pragma unroll
                for (int rr = 0; rr < 4; ++rr) { a[rr] = __builtin_amdgcn_exp2f(s1[4 * g + rr] - mn); ls += a[rr]; }
                pk1[2 * g] = cvt_pk_bf16(a[0], a[1]); pk1[2 * g + 1] = cvt_pk_bf16(a[2], a[3]); }
        }
        if (j > 0) {
#pragma unroll
            for (int i = 0; i < NKL; ++i) *(LAS u32x4_t*)(nbase + klds0 + i * 128) = kreg[i];
#pragma unroll
            for (int i = 0; i < 2; ++i) *(LAS u32x4_t*)(nbase + vlds0 + i * 128) = vreg[i];
            if (j > 1) {
#pragma unroll
                for (int i = 0; i < NKL; ++i) kreg[i] = *(const u32x4_t*)(Kb + (size_t)(j - 2) * 64 * QP + i * 64);
#pragma unroll
                for (int i = 0; i < 2; ++i) vreg[i] = *(const u32x4_t*)(Vb + (size_t)(j - 2) * 64 * 1024 + i * 64);
            }
        }
        if (act) {
            pv_half_pinned(base + vread, 1, pk1, o);
#pragma unroll
            for (int g = 0; g < 4; ++g) { float a[4];
#pragma unroll
                for (int rr = 0; rr < 4; ++rr) { a[rr] = __builtin_amdgcn_exp2f(s0[4 * g + rr] - mn); ls += a[rr]; }
                pk0[2 * g] = cvt_pk_bf16(a[0], a[1]); pk0[2 * g + 1] = cvt_pk_bf16(a[2], a[3]); }
            pv_half_pinned(base + vread, 0, pk0, o);
            st1 = st1 * alpha + ls;
        }
    }
    { float llo, lhi; swap32(st1, llo, lhi); const float inv = 1.0f / (llo + lhi);
#pragma unroll
      for (int d = 0; d < 4; ++d) o[d] = o[d] * inv; }
    float ss = 0.f;
    bf16_t* op = WS<bf16_t>(p, OFF_O) + (tok0 + trow) * 2048 + 1024 + h * 128 + 4 * hh;
#pragma unroll
    for (int d = 0; d < 4; ++d)
#pragma unroll
        for (int g = 0; g < 4; ++g) {
            const float v0 = o[d][4 * g], v1 = o[d][4 * g + 1], v2 = o[d][4 * g + 2], v3 = o[d][4 * g + 3];
            ss += v0 * v0 + v1 * v1 + v2 * v2 + v3 * v3;
            uint2 w; w.x = cvt_pk_bf16(v0, v1); w.y = cvt_pk_bf16(v2, v3);
            *(uint2*)(op + 32 * d + 8 * g) = w;
        }
    float slo, shi; swap32(ss, slo, shi);
    if (hh == 0) WS<float>(p, OFF_SSQ)[(tok0 + trow) * 16 + 8 + h] = slo + shi;
    __syncthreads();
}

template <int G, int NKL>
__device__ __forceinline__ void att3_step(int s, int T, int jmax, int s_first, int trow, int hh, LAS unsigned char* lds, int& vslot,
        u32x4_t (&kreg)[NKL], u32x4_t (&vreg)[2], const bf16_t* Kb, const bf16_t* Vb, unsigned klds0, unsigned vlds0, unsigned kread, unsigned vread,
        const bf16x8_t (&qf)[G ? 12 : 8], f32x16_t (&o)[4], float& st0, float& st1, f32x16_t& n0, f32x16_t& n1, f32x16_t& p0, f32x16_t& p1, unsigned (&pk)[2][8]) {
    constexpr int DK = G ? 192 : 128, KSTR = DK * 2 + 16, KTILE = 64 * KSTR, VTILE = 64 * ATT_VSTR, QP = G ? 1536 : 1024;
#pragma unroll
    for (int i = 0; i < NKL; ++i) *(LAS u32x4_t*)(lds + (s & 1) * KTILE + klds0 + i * 128) = kreg[i];
#pragma unroll
    for (int i = 0; i < 2; ++i) *(LAS u32x4_t*)(lds + vslot * VTILE + vlds0 + i * 128) = vreg[i];
    __syncthreads();
    if (s + 1 < T) {
#pragma unroll
        for (int i = 0; i < NKL; ++i) kreg[i] = *(const u32x4_t*)(Kb + (size_t)(jmax - s - 1) * 64 * QP + i * 64);
#pragma unroll
        for (int i = 0; i < 2; ++i) vreg[i] = *(const u32x4_t*)(Vb + (size_t)(jmax - s - 1) * 64 * 1024 + i * 64);
    }
    const int vprev = vslot == 0 ? 2 : vslot - 1;
    if (s > s_first + 1) {
        attn_qk<G>(lds + (s & 1) * KTILE, qf, n0, n1, kread);
        attn_sm<G>(false, p0, p1, pk, o, st0, st1, 0, hh);
        attn_pv(lds + vprev * VTILE, pk, o, vread);
    } else {
        if (s >= s_first) attn_qk<G>(lds + (s & 1) * KTILE, qf, n0, n1, kread);
        if (s - 1 >= s_first) { attn_sm<G>(s - 1 == s_first, p0, p1, pk, o, st0, st1, trow - 64 * (jmax - s + 1), hh); attn_pv(lds + vprev * VTILE, pk, o, vread); }
    }
    vslot = vslot == 2 ? 0 : vslot + 1;
}
template <int G>
__device__ __forceinline__ void attn_unit3(const Params& p, int b, int h, int qb, LAS unsigned char* lds, int tid_in) {
    int tid = tid_in; asm volatile("" : "+v"(tid));
    constexpr int DK = G ? 192 : 128, NKS = DK / 16, KCH = DK / 8, KSTR = DK * 2 + 16, VSTR = ATT_VSTR;
    constexpr int KTILE = 64 * KSTR, VTILE = 64 * VSTR, NKL = KCH * 64 / 512, QP = G ? 1536 : 1024;
    const int lane = tid & 63, wid = __builtin_amdgcn_readfirstlane(tid >> 6), c = lane & 31, hh = lane >> 5;
    const bf16_t* Qg = WS<bf16_t>(p, G ? OFF_QMLA : OFF_QSB); const bf16_t* Kg = WS<bf16_t>(p, G ? OFF_KMLA : OFF_KSB); const bf16_t* Vg = WS<bf16_t>(p, G ? OFF_VMLA : OFF_VSB);
    const size_t tok0 = (size_t)b * SEQ;
    const int trow = qb * 256 + wid * 32 + c;
    bf16x8_t qf[NKS];
    { const bf16_t* qp = Qg + (tok0 + trow) * QP + h * DK + hh * 8;
#pragma unroll
      for (int ks = 0; ks < NKS; ++ks) qf[ks] = *(const bf16x8_t*)(qp + ks * 16); }
    f32x16_t o[4];
#pragma unroll
    for (int d = 0; d < 4; ++d)
#pragma unroll
        for (int r = 0; r < 16; ++r) o[d][r] = 0.f;
    float st0 = G ? -1e30f : 1.0f, st1 = 0.f;
    const int srow = tid >> 3, sch = tid & 7;
    const bf16_t* Kb = Kg + tok0 * QP + (size_t)srow * QP + h * DK + sch * 8; const bf16_t* Vb = Vg + tok0 * 1024 + (size_t)srow * 1024 + h * 128 + sch * 8;
    const unsigned klds0 = (unsigned)(srow * KSTR + sch * 16), vlds0 = (unsigned)(2 * KTILE + srow * VSTR + sch * 16);
    const unsigned kread = (unsigned)(c * KSTR + hh * 16);
    const unsigned vread = (unsigned)(2 * KTILE + (4 * hh + ((lane & 15) >> 2)) * VSTR + (16 * ((lane >> 4) & 1) + 4 * (lane & 3)) * 2);
    const int jmax = 4 * qb + 3, T = jmax + 1, s_first = 3 - (wid >> 1);
    u32x4_t kreg[NKL], vreg[2];
#pragma unroll
    for (int i = 0; i < NKL; ++i) kreg[i] = *(const u32x4_t*)(Kb + (size_t)jmax * 64 * QP + i * 64);
#pragma unroll
    for (int i = 0; i < 2; ++i) vreg[i] = *(const u32x4_t*)(Vb + (size_t)jmax * 64 * 1024 + i * 64);
    f32x16_t sa0, sa1, sb0, sb1; unsigned pk[2][8];
#pragma unroll
    for (int r = 0; r < 16; ++r) { sa0[r] = 0.f; sa1[r] = 0.f; sb0[r] = 0.f; sb1[r] = 0.f; }
    int vslot = 0;
#pragma unroll 1
    for (int s = 0; s < T; s += 2) {
        att3_step<G, NKL>(s, T, jmax, s_first, trow, hh, lds, vslot, kreg, vreg, Kb, Vb, klds0, vlds0, kread, vread, qf, o, st0, st1, sa0, sa1, sb0, sb1, pk);
        att3_step<G, NKL>(s + 1, T, jmax, s_first, trow, hh, lds, vslot, kreg, vreg, Kb, Vb, klds0, vlds0, kread, vread, qf, o, st0, st1, sb0, sb1, sa0, sa1, pk);
    }
    { const int vprev = vslot == 0 ? 2 : vslot - 1;
      attn_sm<G>(T - 1 == s_first, sb0, sb1, pk, o, st0, st1, trow, hh);
      attn_pv(lds + vprev * VTILE, pk, o, vread); }
    if (G == 1) { float llo, lhi; swap32(st1, llo, lhi); const float inv = 1.0f / (llo + lhi);
#pragma unroll
        for (int d = 0; d < 4; ++d) o[d] = o[d] * inv; }
    float ss = 0.f;
    bf16_t* op = WS<bf16_t>(p, OFF_O) + (tok0 + trow) * 2048 + G * 1024 + h * 128 + 4 * hh;
#pragma unroll
    for (int d = 0; d < 4; ++d)
#pragma unroll
        for (int g = 0; g < 4; ++g) {
            const float v0 = o[d][4 * g], v1 = o[d][4 * g + 1], v2 = o[d][4 * g + 2], v3 = o[d][4 * g + 3];
            ss += v0 * v0 + v1 * v1 + v2 * v2 + v3 * v3;
            uint2 w; w.x = cvt_pk_bf16(v0, v1); w.y = cvt_pk_bf16(v2, v3);
            *(uint2*)(op + 32 * d + 8 * g) = w;
        }
    float slo, shi; swap32(ss, slo, shi);
    if (hh == 0) WS<float>(p, OFF_SSQ)[(tok0 + trow) * 16 + G * 8 + h] = slo + shi;
    __syncthreads();
}

__device__ __forceinline__ void phase_attn_mfma(const Params& p, float* ldsf, int headw = 0) {
    LAS unsigned char* lds = (LAS unsigned char*)ldsf;
    unsigned* head = WS<unsigned>(p, OFF_BAR) + ATT_HEAD_WORD + 64 * headw;
    for (;;) {
        const int tid = tid_fresh(p.widx);
        LAS unsigned* bc = (LAS unsigned*)(lds + ATT_BC_OFF);
        if (tid == 0) *bc = __hip_atomic_fetch_add(head, 1u, __ATOMIC_RELAXED, __HIP_MEMORY_SCOPE_AGENT);
        __syncthreads();
        const unsigned u = (unsigned)__builtin_amdgcn_readfirstlane((int)*bc);
        __syncthreads();
        if (u >= 1536u) break;
        const unsigned u3 = u / 3u, um = u - 3u * u3;
        if (headw != 0 && (um != 0u || (int)(u3 & 1u) != (PROBE_ATTN_G))) continue;
        if (um != 0u) { if (TAB_EB == 6) job_table6(p, (int)(2u * u3 + um - 1u)); else job_table<TAB_EB == 6 ? 1 : TAB_EB>(p, (int)(2u * u3 + um - 1u)); continue; }
        const int qb = 15 - (int)(u3 >> 5), rest = (int)(u3 & 31u), g = rest & 1, b = (rest >> 1) & 1, h = rest >> 2;
#if ATT_ANTIPHASE
        if (g == 0) attn_unit<0>(p, b, h, qb, lds, tid); else attn_unit_mla_mid(p, b, h, qb, lds, tid);
#else
        if (g == 0) attn_unit<0>(p, b, h, qb, lds, tid); else attn_unit<1>(p, b, h, qb, lds, tid);
#endif
    }
}

__device__ __forceinline__ void phase_onorm(const Params& p, int bid, int nblk) {
    const int tidf = tid_fresh(p.widx), lane = tidf & 63, wid = tidf >> 6;
    bf16_t* O = WS<bf16_t>(p, OFF_O); const float* ssq = WS<float>(p, OFF_SSQ);
    for (int t = bid * 8 + wid; t < TOK; t += nblk * 8) {
        float s0 = 0.f, s1 = 0.f;
#pragma unroll
        for (int h = 0; h < 8; ++h) { s0 += ssq[(size_t)t * 16 + h]; s1 += ssq[(size_t)t * 16 + 8 + h]; }
        const float r0 = rsqrtf(s0 * (1.0f / 1024.0f) + EPS), r1 = rsqrtf(s1 * (1.0f / 1024.0f) + EPS);
#pragma unroll
        for (int j = 0; j < 4; ++j) {
            const int off = (j * 64 + lane) * 8; const float r = off < 1024 ? r0 : r1;
            uint4 v = *(uint4*)(O + (size_t)t * 2048 + off);
            v.x = pack2(lo_f(v.x) * r, hi_f(v.x) * r); v.y = pack2(lo_f(v.y) * r, hi_f(v.y) * r); v.z = pack2(lo_f(v.z) * r, hi_f(v.z) * r); v.w = pack2(lo_f(v.w) * r, hi_f(v.w) * r);
            *(uint4*)(O + (size_t)t * 2048 + off) = v;
        }
    }
}

__device__ __forceinline__ void wave_argmax(float& v, int& i) {
#pragma unroll
    for (int o = 32; o > 0; o >>= 1) { const float ov = __shfl_xor(v, o); const int oi = __shfl_xor(i, o); if (ov > v || (ov == v && oi < i)) { v = ov; i = oi; } }
}
__device__ __forceinline__ void phase_route_ref(const Params& p, int bid, int nblk) {
    const int tidf = tid_fresh(p.widx), lane = tidf & 63, wid = tidf >> 6;
    const bf16_t* qp = WS<bf16_t>(p, OFF_QP); const bf16_t* keys = WS<bf16_t>(p, OFF_KEYS);
    int* ridx = WS<int>(p, OFF_RIDX); float* rgate = WS<float>(p, OFF_RGATE);
    for (int it = bid * 8 + wid; it < TOK * 8; it += nblk * 8) {
        const int t = it >> 3, h = it & 7;
        float tv[2]; int ti[2];
#pragma unroll
        for (int half = 0; half < 2; ++half) {
            const bf16_t* q = qp + (size_t)t * 2048 + h * 256 + half * 128;
            const bf16_t* kb = keys + (size_t)(h * 2 + half) * 16384;
            float s0 = 0.f, s1 = 0.f;
            for (int d = 0; d < 128; d += 8) { const uint4 qv = *(const uint4*)(q + d);
                s0 += dot8(qv, *(const uint4*)(kb + (size_t)lane * 128 + d)); s1 += dot8(qv, *(const uint4*)(kb + (size_t)(lane + 64) * 128 + d)); }
            float mv = 0.f; int mi = 0;
            for (int r = 0; r < 16; ++r) {
                float v; int i;
                if (s0 >= s1) { v = s0; i = lane; } else { v = s1; i = lane + 64; }
                wave_argmax(v, i);
                if (i == lane) s0 = -INFINITY;
                if (i == lane + 64) s1 = -INFINITY;
                if (lane == r) { mv = v; mi = i; }
            }
            tv[half] = mv; ti[half] = mi;
        }
        float cv[4];
#pragma unroll
        for (int j = 0; j < 4; ++j) { const int c = lane * 4 + j; cv[j] = __shfl(tv[0], c >> 4) + __shfl(tv[1], c & 15); }
        float bv = 0.f; int bc = 0;
        for (int r = 0; r < 16; ++r) {
            float v = cv[0]; int i = lane * 4;
#pragma unroll
            for (int j = 1; j < 4; ++j) if (cv[j] > v) { v = cv[j]; i = lane * 4 + j; }
            wave_argmax(v, i);
#pragma unroll
            for (int j = 0; j < 4; ++j) if (i == lane * 4 + j) cv[j] = -INFINITY;
            if (lane == r) { bv = v; bc = i; }
        }
        const float mx = __shfl(bv, 0);
        float e = lane < 16 ? __expf(bv - mx) : 0.f;
        const float sum = wave_sum(e);
        const int i1 = __shfl(ti[0], bc >> 4), i2 = __shfl(ti[1], bc & 15);
        if (lane < 16) { ridx[(size_t)t * 128 + h * 16 + lane] = i1 * 128 + i2; rgate[(size_t)t * 128 + h * 16 + lane] = e / sum; }
    }
}


__device__ __forceinline__ unsigned f2key(float f) { const unsigned u = __float_as_uint(f); return (u & 0x80000000u) ? ~u : (u | 0x80000000u); }
__device__ __forceinline__ float key2f(unsigned k) { return __uint_as_float((k & 0x80000000u) ? (k & 0x7fffffffu) : ~k); }
#define RT_CE(a, b) do { const unsigned _h = max((a), (b)), _l = min((a), (b)); (a) = _h; (b) = _l; } while (0)
__device__ __forceinline__ void sort16_desc(unsigned* a) {
#pragma unroll
    for (int k = 2; k <= 16; k <<= 1)
#pragma unroll
        for (int j = k >> 1; j > 0; j >>= 1)
#pragma unroll
            for (int i = 0; i < 16; ++i) { const int l = i ^ j; if (l > i) { if ((i & k) == 0) RT_CE(a[i], a[l]); else RT_CE(a[l], a[i]); } }
}
__device__ __forceinline__ void merge16_desc(unsigned* a, const unsigned* b) {
#pragma unroll
    for (int i = 0; i < 16; ++i) a[i] = max(a[i], b[15 - i]);
#pragma unroll
    for (int j = 8; j > 0; j >>= 1)
#pragma unroll
        for (int i = 0; i < 16; ++i) { const int l = i ^ j; if (l > i) RT_CE(a[i], a[l]); }
}
__device__ __forceinline__ void top16_of_64(unsigned* v) {
    sort16_desc(v); sort16_desc(v + 16); sort16_desc(v + 32); sort16_desc(v + 48);
    merge16_desc(v, v + 16); merge16_desc(v + 32, v + 48); merge16_desc(v, v + 32);
}
constexpr int rt_cand_pos(int i, int j) { int n = 0; for (int a = 0; a < 16; ++a) for (int b = 0; b < 16; ++b) { if (a == i && b == j) return n; if ((a + 1) * (b + 1) <= 16) ++n; } return n; }
static_assert(rt_cand_pos(15, 1) == 50, "50 staircase candidates");

__device__ __forceinline__ void phase_route_mfma(const Params& p, int bid, int nblk, float* ldsf) {
    const int tidf = tid_fresh(p.widx), lane = tidf & 63, wid = __builtin_amdgcn_readfirstlane(tidf >> 6), c = lane & 31, hh = lane >> 5;
    const bf16_t* qp = WS<bf16_t>(p, OFF_QP); const bf16_t* keys = WS<bf16_t>(p, OFF_KEYS);
    int* ridx = WS<int>(p, OFF_RIDX); float* rgate = WS<float>(p, OFF_RGATE);
    LAS unsigned* tbl = (LAS unsigned*)ldsf + wid * 2048;
    for (int it = bid * 8 + wid; it < 2048; it += nblk * 8) {
        const int tile = it >> 3, h = it & 7, t = (nblk * 32 == TOK) ? tile * 8 + (c & 7) + (c >> 3) * (TOK / 4) : tile * 32 + c;
#pragma unroll 1
        for (int half = 0; half < 2; ++half) {
            const bf16_t* kb = keys + (size_t)(h * 2 + half) * 16384 + (size_t)c * 128 + hh * 8;
            const bf16_t* qq = qp + (size_t)t * 2048 + h * 256 + half * 128 + hh * 8;
            bf16x8_t qf[8];
#pragma unroll
            for (int ks = 0; ks < 8; ++ks) qf[ks] = *(const bf16x8_t*)(qq + ks * 16);
            unsigned v[64];
#pragma unroll
            for (int blk = 0; blk < 4; ++blk) {
                f32x16_t s;
#pragma unroll
                for (int r = 0; r < 16; ++r) s[r] = 0.f;
#pragma unroll
                for (int ks = 0; ks < 8; ++ks) { const bf16x8_t a = *(const bf16x8_t*)(kb + (size_t)blk * 32 * 128 + ks * 16); s = __builtin_amdgcn_mfma_f32_32x32x16_bf16(a, qf[ks], s, 0, 0, 0); }
#pragma unroll
                for (int r = 0; r < 16; ++r) { const int n = 32 * blk + (r & 3) + 8 * (r >> 2) + 4 * hh; v[blk * 16 + r] = (f2key(s[r]) & ~127u) | (unsigned)(127 - n); }
            }
            top16_of_64(v);
            unsigned o[16];
#pragma unroll
            for (int i = 0; i < 16; ++i) { auto r2 = __builtin_amdgcn_permlane32_swap(v[i], v[i], false, false); o[i] = hh ? r2[0] : r2[1]; }
            merge16_desc(v, o);
#pragma unroll
            for (int i = 0; i < 16; ++i) tbl[(half * 16 + i) * 64 + lane] = v[i];
        }
        float f1[16], f2[16];
#pragma unroll
        for (int i = 0; i < 16; ++i) { f1[i] = key2f(tbl[i * 64 + lane] & ~127u); f2[i] = key2f(tbl[(16 + i) * 64 + lane] & ~127u); }
        unsigned cd[64];
#pragma unroll
        for (int i = 0; i < 64; ++i) cd[i] = 0u;
#pragma unroll
        for (int i = 0; i < 16; ++i)
#pragma unroll
            for (int j = 0; j < 16; ++j)
                if ((i + 1) * (j + 1) <= 16) cd[rt_cand_pos(i, j)] = (f2key(f1[i] + f2[j]) & ~255u) | (unsigned)(255 - (i * 16 + j));
        top16_of_64(cd);
        float e[16], sum = 0.f; const float mx = key2f(cd[0] & ~255u);
#pragma unroll
        for (int k = 0; k < 16; ++k) { e[k] = __expf(key2f(cd[k] & ~255u) - mx); sum += e[k]; }
        const float inv = 1.0f / sum;
        if (hh == 0) {
#pragma unroll
            for (int k = 0; k < 16; ++k) {
                const int pid = 255 - (int)(cd[k] & 255u), i = pid >> 4, j = pid & 15;
                const int n1 = 127 - (int)(tbl[i * 64 + lane] & 127u), n2 = 127 - (int)(tbl[(16 + j) * 64 + lane] & 127u);
                ridx[(size_t)t * 128 + h * 16 + k] = n1 * 128 + n2; rgate[(size_t)t * 128 + h * 16 + k] = e[k] * inv;
            }
        }
    }
}

__device__ __forceinline__ void phase_peer_ref(const Params& p, int bid, int nblk) {
    const int tidf = tid_fresh(p.widx), lane = tidf & 63, wid = tidf >> 6;
    const bf16_t* h2 = WS<bf16_t>(p, OFF_H); const float* x1 = WS<float>(p, OFF_X1); const float* mod = WS<float>(p, OFF_MOD);
    const int* ridx = WS<int>(p, OFF_RIDX); const float* rgate = WS<float>(p, OFF_RGATE);
    for (int t = bid * 8 + wid; t < TOK; t += nblk * 8) {
        const int b = t >> 12;
        float4 hv[8], y[8];
#pragma unroll
        for (int j = 0; j < 8; ++j) { const uint2 w = *(const uint2*)(h2 + (size_t)t * DM + (j * 64 + lane) * 4);
            hv[j].x = lo_f(w.x); hv[j].y = hi_f(w.x); hv[j].z = lo_f(w.y); hv[j].w = hi_f(w.y); y[j] = (float4){0.f, 0.f, 0.f, 0.f}; }
        for (int e = 0; e < 128; ++e) {
            const int ex = ridx[(size_t)t * 128 + e]; const float gt = rgate[(size_t)t * 128 + e];
            const float* ur = p.u_tab + (size_t)ex * DM; const float* vr = p.v_tab + (size_t)ex * DM;
            float d = 0.f;
#pragma unroll
            for (int j = 0; j < 8; ++j) { const float4 u = *(const float4*)(ur + (j * 64 + lane) * 4); d += u.x * hv[j].x + u.y * hv[j].y + u.z * hv[j].z + u.w * hv[j].w; }
            d = wave_sum(d);
            const float cf = gt * gelu_exact(d);
#pragma unroll
            for (int j = 0; j < 8; ++j) { const float4 v = *(const float4*)(vr + (j * 64 + lane) * 4); y[j].x += cf * v.x; y[j].y += cf * v.y; y[j].z += cf * v.z; y[j].w += cf * v.w; }
        }
        float ss = 0.f;
#pragma unroll
        for (int j = 0; j < 8; ++j) { const int col = (j * 64 + lane) * 4;
            const float4 xv = *(const float4*)(x1 + (size_t)t * DM + col); const float4 g2 = *(const float4*)(mod + (size_t)b * 12288 + 5 * 2048 + col);
            y[j].x = xv.x + g2.x * y[j].x; y[j].y = xv.y + g2.y * y[j].y; y[j].z = xv.z + g2.z * y[j].z; y[j].w = xv.w + g2.w * y[j].w;
            ss += y[j].x * y[j].x + y[j].y * y[j].y + y[j].z * y[j].z + y[j].w * y[j].w; }
        ss = wave_sum(ss);
        const float rstd = rsqrtf(ss * (1.0f / DM) + EPS);
#pragma unroll
        for (int j = 0; j < 8; ++j) { const int col = (j * 64 + lane) * 4; const float4 fg = *(const float4*)(p.fin_g + col);
            float4 o; o.x = y[j].x * rstd * fg.x; o.y = y[j].y * rstd * fg.y; o.z = y[j].z * rstd * fg.z; o.w = y[j].w * rstd * fg.w;
            *(float4*)(p.out + (size_t)t * DM + col) = o; }
    }
}


template <int EB> __device__ __forceinline__ void job_table(const Params& p, int it) {
    const int tidf = tid_fresh(p.widx), lane = tidf & 63, wid = tidf >> 6;
    const int tab = it >> 9, r0 = (it & 511) * 32;
    const float* src = tab ? p.v_tab : p.u_tab;
    unsigned char* dst = p.ws + (tab ? OFF_VTAB : OFF_UTAB);
    float* scl = WS<float>(p, tab ? OFF_VSC : OFF_USC);
#pragma unroll 1
    for (int rr = 0; rr < 4; ++rr) {
        const int row = r0 + wid * 4 + rr;
        float4 v[8]; float am = 0.f;
#pragma unroll
        for (int j = 0; j < 8; ++j) { v[j] = *(const float4*)(src + (size_t)row * DM + (j * 64 + lane) * 4);
            am = fmaxf(am, fmaxf(fmaxf(fabsf(v[j].x), fabsf(v[j].y)), fmaxf(fabsf(v[j].z), fabsf(v[j].w)))); }
#pragma unroll
        for (int o = 32; o > 0; o >>= 1) am = fmaxf(am, __shfl_xor(am, o));
        if (EB == 1) {
            const int e = (int)((__float_as_uint(am) >> 23) & 255u) - 127;
            const float sc = am > 0.f ? __uint_as_float((unsigned)(127 + 7 - e) << 23) : 1.0f;
            if (lane == 0) scl[row] = am > 0.f ? __uint_as_float((unsigned)(127 - 7 + e) << 23) : 1.0f;
#pragma unroll
            for (int j = 0; j < 8; ++j) {
                int w = __builtin_amdgcn_cvt_pk_fp8_f32(v[j].x * sc, v[j].y * sc, 0, false);
                w = __builtin_amdgcn_cvt_pk_fp8_f32(v[j].z * sc, v[j].w * sc, w, true);
                *(int*)(dst + (size_t)row * 2048 + (j * 64 + lane) * 4) = w;
            }
        } else {
            if (lane == 0) scl[row] = 1.0f;
#pragma unroll
            for (int j = 0; j < 8; ++j) { uint2 w; w.x = pack2(v[j].x, v[j].y); w.y = pack2(v[j].z, v[j].w);
                *(uint2*)(dst + (size_t)row * 4096 + (j * 64 + lane) * 8) = w; }
        }
    }
}

template <int EB> __device__ __forceinline__ void dec_chunk(const u32x4_t r, float* f) {
    if (EB == 1) {
#pragma unroll
        for (int w = 0; w < 4; ++w) { const f32x2_t a = __builtin_amdgcn_cvt_pk_f32_fp8((int)r[w], false), b = __builtin_amdgcn_cvt_pk_f32_fp8((int)r[w], true);
            f[4 * w] = a[0]; f[4 * w + 1] = a[1]; f[4 * w + 2] = b[0]; f[4 * w + 3] = b[1]; }
    } else {
#pragma unroll
        for (int w = 0; w < 4; ++w) { f[2 * w] = lo_f(r[w]); f[2 * w + 1] = hi_f(r[w]); }
    }
}

template <int EB> __device__ __forceinline__ void phase_peer_gather(const Params& p, int bid, int nblk) {
    constexpr int EPC = 16 / EB, NCH = 32 / EPC, ROWB = 2048 * EB;
    const int tidf = tid_fresh(p.widx), lane = tidf & 63, wid = tidf >> 6;
    const unsigned char* utab = p.ws + OFF_UTAB; const unsigned char* vtab = p.ws + OFF_VTAB;
    const float* usc = WS<float>(p, OFF_USC); const float* vsc = WS<float>(p, OFF_VSC);
    const bf16_t* h2 = WS<bf16_t>(p, OFF_H); const float* x1 = WS<float>(p, OFF_X1); const float* mod = WS<float>(p, OFF_MOD);
    const int* ridx = WS<int>(p, OFF_RIDX); const float* rgate = WS<float>(p, OFF_RGATE);
    for (int t = bid * 8 + wid; t < TOK; t += nblk * 8) {
        const int b = t >> 12;
        float hv[32];
#pragma unroll
        for (int j = 0; j < NCH; ++j) {
            const bf16_t* hp = h2 + (size_t)t * DM + (j * 64 + lane) * EPC;
#pragma unroll
            for (int q8 = 0; q8 < EPC / 8; ++q8) { const uint4 w = *(const uint4*)(hp + q8 * 8);
                float* f = hv + j * EPC + q8 * 8;
                f[0] = lo_f(w.x); f[1] = hi_f(w.x); f[2] = lo_f(w.y); f[3] = hi_f(w.y); f[4] = lo_f(w.z); f[5] = hi_f(w.z); f[6] = lo_f(w.w); f[7] = hi_f(w.w); }
        }
        const int myi0 = ridx[(size_t)t * 128 + lane], myi1 = ridx[(size_t)t * 128 + 64 + lane];
        const float myg0 = rgate[(size_t)t * 128 + lane], myg1 = rgate[(size_t)t * 128 + 64 + lane];
        float dots0 = 0.f, dots1 = 0.f;
#pragma unroll 1
        for (int eb = 0; eb < 128; eb += 8) {
            const int idxv = eb < 64 ? myi0 : myi1;
            u32x4_t r[8][NCH];
#pragma unroll
            for (int k = 0; k < 8; ++k) {
                const int idx = __builtin_amdgcn_readlane(idxv, (eb & 63) + k);
                const unsigned char* row = utab + (size_t)idx * ROWB + lane * 16;
#pragma unroll
                for (int j = 0; j < NCH; ++j) r[k][j] = *(const u32x4_t*)(row + j * 1024);
            }
            float d[8];
#pragma unroll
            for (int k = 0; k < 8; ++k) {
                float s = 0.f;
#pragma unroll
                for (int j = 0; j < NCH; ++j) { float f[EPC]; dec_chunk<EB>(r[k][j], f);
#pragma unroll
                    for (int q = 0; q < EPC; ++q) s += f[q] * hv[j * EPC + q]; }
                asm volatile("" : "+v"(s));
                d[k] = s;
                __builtin_amdgcn_sched_barrier(0);
            }
            float n4[4], n2[2];
#pragma unroll
            for (int i = 0; i < 4; ++i) { const bool hi = lane & 1; const float send = hi ? d[2 * i] : d[2 * i + 1], keep = hi ? d[2 * i + 1] : d[2 * i]; n4[i] = keep + __shfl_xor(send, 1); }
#pragma unroll
            for (int i = 0; i < 2; ++i) { const bool hi = lane & 2; const float send = hi ? n4[2 * i] : n4[2 * i + 1], keep = hi ? n4[2 * i + 1] : n4[2 * i]; n2[i] = keep + __shfl_xor(send, 2); }
            float tot;
            { const bool hi = lane & 4; const float send = hi ? n2[0] : n2[1], keep = hi ? n2[1] : n2[0]; tot = keep + __shfl_xor(send, 4); }
            tot += __shfl_xor(tot, 8); tot += __shfl_xor(tot, 16); tot += __shfl_xor(tot, 32);
            const bool mine = (lane >> 3) == ((eb & 63) >> 3);
            if (eb < 64) dots0 = mine ? tot : dots0; else dots1 = mine ? tot : dots1;
        }
        const float cf0 = myg0 * gelu_exact(dots0 * usc[myi0]) * vsc[myi0], cf1 = myg1 * gelu_exact(dots1 * usc[myi1]) * vsc[myi1];
        float y[32];
#pragma unroll
        for (int q = 0; q < 32; ++q) y[q] = 0.f;
#pragma unroll 1
        for (int eb = 0; eb < 128; eb += 8) {
            const int idxv = eb < 64 ? myi0 : myi1; const float cfv = eb < 64 ? cf0 : cf1;
            u32x4_t r[8][NCH];
#pragma unroll
            for (int k = 0; k < 8; ++k) {
                const int idx = __builtin_amdgcn_readlane(idxv, (eb & 63) + k);
                const unsigned char* row = vtab + (size_t)idx * ROWB + lane * 16;
#pragma unroll
                for (int j = 0; j < NCH; ++j) r[k][j] = *(const u32x4_t*)(row + j * 1024);
            }
#pragma unroll
            for (int k = 0; k < 8; ++k) {
                const float cf = __uint_as_float((unsigned)__builtin_amdgcn_readlane((int)__float_as_uint(cfv), (eb & 63) + k));
#pragma unroll
                for (int j = 0; j < NCH; ++j) { float f[EPC]; dec_chunk<EB>(r[k][j], f);
#pragma unroll
                    for (int q = 0; q < EPC; ++q) y[j * EPC + q] += cf * f[q]; }
                asm volatile("" : "+v"(y[0]), "+v"(y[1]), "+v"(y[2]), "+v"(y[3]), "+v"(y[4]), "+v"(y[5]), "+v"(y[6]), "+v"(y[7]), "+v"(y[8]), "+v"(y[9]), "+v"(y[10]), "+v"(y[11]), "+v"(y[12]), "+v"(y[13]), "+v"(y[14]), "+v"(y[15]));
                asm volatile("" : "+v"(y[16]), "+v"(y[17]), "+v"(y[18]), "+v"(y[19]), "+v"(y[20]), "+v"(y[21]), "+v"(y[22]), "+v"(y[23]), "+v"(y[24]), "+v"(y[25]), "+v"(y[26]), "+v"(y[27]), "+v"(y[28]), "+v"(y[29]), "+v"(y[30]), "+v"(y[31]));
                __builtin_amdgcn_sched_barrier(0);
            }
        }
        float ss = 0.f;
#pragma unroll
        for (int j = 0; j < NCH; ++j)
#pragma unroll
            for (int q4 = 0; q4 < EPC / 4; ++q4) {
                const int col = (j * 64 + lane) * EPC + q4 * 4;
                const float4 xv = *(const float4*)(x1 + (size_t)t * DM + col); const float4 g2 = *(const float4*)(mod + (size_t)b * 12288 + 5 * 2048 + col);
                float* yy = y + j * EPC + q4 * 4;
                yy[0] = xv.x + g2.x * yy[0]; yy[1] = xv.y + g2.y * yy[1]; yy[2] = xv.z + g2.z * yy[2]; yy[3] = xv.w + g2.w * yy[3];
                ss += yy[0] * yy[0] + yy[1] * yy[1] + yy[2] * yy[2] + yy[3] * yy[3];
                if (q4 & 1) __builtin_amdgcn_sched_barrier(0);
            }
        ss = wave_sum(ss);
        const float rstd = rsqrtf(ss * (1.0f / DM) + EPS);
#pragma unroll
        for (int j = 0; j < NCH; ++j)
#pragma unroll
            for (int q4 = 0; q4 < EPC / 4; ++q4) {
                const int col = (j * 64 + lane) * EPC + q4 * 4; const float4 fg = *(const float4*)(p.fin_g + col);
                const float* yy = y + j * EPC + q4 * 4;
                float4 o; o.x = yy[0] * rstd * fg.x; o.y = yy[1] * rstd * fg.y; o.z = yy[2] * rstd * fg.z; o.w = yy[3] * rstd * fg.w;
                *(float4*)(p.out + (size_t)t * DM + col) = o;
                if (q4 & 1) __builtin_amdgcn_sched_barrier(0);
            }
    }
}


typedef float v32f_t __attribute__((ext_vector_type(32)));
typedef float v16f_t __attribute__((ext_vector_type(16)));
typedef unsigned v6u_t __attribute__((ext_vector_type(6)));
typedef _Float16 v32h_t __attribute__((ext_vector_type(32)));
typedef _Float16 h2_t __attribute__((ext_vector_type(2)));
typedef _Float16 h4_t __attribute__((ext_vector_type(4)));
typedef float f32x4v_t __attribute__((ext_vector_type(4)));
typedef unsigned u32x2_t __attribute__((ext_vector_type(2)));
__device__ __forceinline__ float wave_max_noaddr(float v) {
    v = fmaxf(v, __int_as_float(__builtin_amdgcn_ds_swizzle(__float_as_int(v), (1 << 10) | 0x1f)));
    v = fmaxf(v, __int_as_float(__builtin_amdgcn_ds_swizzle(__float_as_int(v), (2 << 10) | 0x1f)));
    v = fmaxf(v, __int_as_float(__builtin_amdgcn_ds_swizzle(__float_as_int(v), (4 << 10) | 0x1f)));
    v = fmaxf(v, __int_as_float(__builtin_amdgcn_ds_swizzle(__float_as_int(v), (8 << 10) | 0x1f)));
    v = fmaxf(v, __int_as_float(__builtin_amdgcn_ds_swizzle(__float_as_int(v), (16 << 10) | 0x1f)));
    auto r = __builtin_amdgcn_permlane32_swap(__float_as_uint(v), __float_as_uint(v), false, false);
    return fmaxf(__uint_as_float(r[0]), __uint_as_float(r[1]));
}
__device__ __forceinline__ void job_table6(const Params& p, int it) {
    const int tidf = tid_fresh(p.widx), lane = tidf & 63, wid = tidf >> 6;
    const int tab = it >> 9, r0 = (it & 511) * 32;
    const float* src = tab ? p.v_tab : p.u_tab;
    unsigned char* dst = p.ws + (tab ? OFF_VTAB : OFF_UTAB);
    float* scl = WS<float>(p, tab ? OFF_VSC : OFF_USC);
    typedef float f32x4v __attribute__((ext_vector_type(4)));
    f32x4v v[4][8];
#pragma unroll
    for (int rr = 0; rr < 4; ++rr)
#pragma unroll
        for (int j = 0; j < 8; ++j) v[rr][j] = __builtin_nontemporal_load((const f32x4v*)(src + (size_t)(r0 + wid * 4 + rr) * DM + (j * 64 + lane) * 4));
#pragma unroll
    for (int rr = 0; rr < 4; ++rr) {
        const int row = r0 + wid * 4 + rr;
        v16f_t a, b; float am = 0.f;
#pragma unroll
        for (int j = 0; j < 8; ++j) { const f32x4v w = v[rr][j];
            a[2 * j] = w.x; b[2 * j] = w.y; a[2 * j + 1] = w.z; b[2 * j + 1] = w.w; am = fmaxf(am, fmaxf(fmaxf(fabsf(w.x), fabsf(w.y)), fmaxf(fabsf(w.z), fabsf(w.w)))); }
        am = wave_max_noaddr(am);
        const int e = (int)((__float_as_uint(am) >> 23) & 255u) - 127;
        const float sc = am > 0.f ? __uint_as_float((unsigned)(127 + 2 - e) << 23) : 1.0f;
        if (lane == 0) scl[row] = am > 0.f ? __uint_as_float((unsigned)(127 - 2 + e) << 23) : 1.0f;
        a = a * sc; b = b * sc;
        const v6u_t pk = __builtin_amdgcn_cvt_scalef32_2xpk16_fp6_f32(a, b, 1.0f);
#if PEER_SLICED
        { unsigned char* d6 = dst + ((size_t)(lane >> 3) * NEXP + row) * 192;
          u32x4_t w0 = {pk[0], pk[1], pk[2], pk[3]}; u32x2_t w1 = {pk[4], pk[5]};
          *(u32x4_t*)(d6 + (lane & 7) * 16) = w0; *(u32x2_t*)(d6 + 128 + (lane & 7) * 8) = w1; }
#else
        u32x4_t w0 = {pk[0], pk[1], pk[2], pk[3]}; u32x2_t w1 = {pk[4], pk[5]};
        *(u32x4_t*)(dst + (size_t)row * 1536 + lane * 16) = w0;
        *(u32x2_t*)(dst + (size_t)row * 1536 + 1024 + lane * 8) = w1;
#endif
    }
}

#define PG6_LOAD(RA, RB, tab, iv, e0) do { _Pragma("unroll") for (int k = 0; k < 8; ++k) { \
        const unsigned idx_ = (unsigned)__builtin_amdgcn_readlane((iv), (e0) + k); const unsigned char* row_ = (tab) + (size_t)idx_ * 1536u;     \
        RA[k] = *(const u32x4_t*)(row_ + lane16); RB[k] = *(const u32x2_t*)(row_ + 1024u + lane8); } } while (0)
#define PG6_CU(RA, RB, eb) do { float d[8]; \
        _Pragma("unroll") for (int k = 0; k < 8; ++k) { \
            const v6u_t pk_ = {RA[k][0], RA[k][1], RA[k][2], RA[k][3], RB[k][0], RB[k][1]}; \
            const v32h_t f_ = __builtin_amdgcn_cvt_scalef32_pk32_f16_fp6(pk_, 1.0f); float s0_ = 0.f, s1_ = 0.f, s2_ = 0.f, s3_ = 0.f; \
            _Pragma("unroll") for (int q = 0; q < 16; q += 4) { \
                s0_ = __builtin_amdgcn_fdot2((h2_t){f_[2 * q], f_[2 * q + 1]}, hvh[q], s0_, false); s1_ = __builtin_amdgcn_fdot2((h2_t){f_[2 * q + 2], f_[2 * q + 3]}, hvh[q + 1], s1_, false); \
                s2_ = __builtin_amdgcn_fdot2((h2_t){f_[2 * q + 4], f_[2 * q + 5]}, hvh[q + 2], s2_, false); s3_ = __builtin_amdgcn_fdot2((h2_t){f_[2 * q + 6], f_[2 * q + 7]}, hvh[q + 3], s3_, false); } \
            float s_ = (s0_ + s1_) + (s2_ + s3_);             \
            asm volatile("" : "+v"(s_)); d[k] = s_; __builtin_amdgcn_sched_barrier(0); } \
        float n4[4], n2[2], tot; \
        _Pragma("unroll") for (int i_ = 0; i_ < 4; ++i_) { const bool hi_ = lane & 1; const float send = hi_ ? d[2 * i_] : d[2 * i_ + 1], keep = hi_ ? d[2 * i_ + 1] : d[2 * i_]; n4[i_] = keep + __shfl_xor(send, 1); } \
        _Pragma("unroll") for (int i_ = 0; i_ < 2; ++i_) { const bool hi_ = lane & 2; const float send = hi_ ? n4[2 * i_] : n4[2 * i_ + 1], keep = hi_ ? n4[2 * i_ + 1] : n4[2 * i_]; n2[i_] = keep + __shfl_xor(send, 2); } \
        { const bool hi_ = lane & 4; const float send = hi_ ? n2[0] : n2[1], keep = hi_ ? n2[1] : n2[0]; tot = keep + __shfl_xor(send, 4); } \
        tot += __shfl_xor(tot, 8); tot += __shfl_xor(tot, 16); tot += __shfl_xor(tot, 32); \
        const bool mine_ = (lane >> 3) == (((eb) & 63) >> 3); \
        if ((eb) < 64) dots0 = mine_ ? tot : dots0; else dots1 = mine_ ? tot : dots1; } while (0)
#define PG6_CU4(RA, RB, eb) do { float d[8]; \
        _Pragma("unroll") for (int k = 0; k < 8; k += 2) { \
            const v6u_t pka_ = {RA[k][0], RA[k][1], RA[k][2], RA[k][3], RB[k][0], RB[k][1]}; const v6u_t pkb_ = {RA[k + 1][0], RA[k + 1][1], RA[k + 1][2], RA[k + 1][3], RB[k + 1][0], RB[k + 1][1]}; \
            const v32h_t fa_ = __builtin_amdgcn_cvt_scalef32_pk32_f16_fp6(pka_, 1.0f), fb_ = __builtin_amdgcn_cvt_scalef32_pk32_f16_fp6(pkb_, 1.0f); \
            f32x4v_t ca_ = {0.f, 0.f, 0.f, 0.f}, cb_ = {0.f, 0.f, 0.f, 0.f}; \
            _Pragma("unroll") for (int q = 0; q < 8; ++q) { \
                ca_ = __builtin_amdgcn_mfma_f32_4x4x4f16((h4_t){fa_[4 * q], fa_[4 * q + 1], fa_[4 * q + 2], fa_[4 * q + 3]}, hv4[q], ca_, 0, 0, 0); \
                cb_ = __builtin_amdgcn_mfma_f32_4x4x4f16((h4_t){fb_[4 * q], fb_[4 * q + 1], fb_[4 * q + 2], fb_[4 * q + 3]}, hv4[q], cb_, 0, 0, 0); } \
            float sa_ = l3b1 ? (l3b0 ? ca_[3] : ca_[2]) : (l3b0 ? ca_[1] : ca_[0]), sb_ = l3b1 ? (l3b0 ? cb_[3] : cb_[2]) : (l3b0 ? cb_[1] : cb_[0]); \
            asm volatile("" : "+v"(sa_), "+v"(sb_)); d[k] = sa_; d[k + 1] = sb_; __builtin_amdgcn_sched_barrier(0); } \
        float n4[4], n2[2], tot; \
        _Pragma("unroll") for (int i_ = 0; i_ < 4; ++i_) { const bool hi_ = lane & 1; const float send = hi_ ? d[2 * i_] : d[2 * i_ + 1], keep = hi_ ? d[2 * i_ + 1] : d[2 * i_]; n4[i_] = keep + __shfl_xor(send, 1); } \
        _Pragma("unroll") for (int i_ = 0; i_ < 2; ++i_) { const bool hi_ = lane & 2; const float send = hi_ ? n4[2 * i_] : n4[2 * i_ + 1], keep = hi_ ? n4[2 * i_ + 1] : n4[2 * i_]; n2[i_] = keep + __shfl_xor(send, 2); } \
        { const bool hi_ = lane & 4; const float send = hi_ ? n2[0] : n2[1], keep = hi_ ? n2[1] : n2[0]; tot = keep + __shfl_xor(send, 4); } \
        tot += __shfl_xor(tot, 8); tot += __shfl_xor(tot, 16); tot += __shfl_xor(tot, 32); \
        const bool mine_ = (lane >> 3) == (((eb) & 63) >> 3); \
        if ((eb) < 64) dots0 = mine_ ? tot : dots0; else dots1 = mine_ ? tot : dots1; } while (0)
#define PG6_CV(RA, RB, eb) do { const float cfv_ = (eb) < 64 ? cf0 : cf1; \
        _Pragma("unroll") for (int k = 0; k < 8; ++k) { \
            const _Float16 ch_ = (_Float16)__uint_as_float((unsigned)__builtin_amdgcn_readlane((int)__float_as_uint(cfv_), ((eb) & 63) + k)); const h2_t c2_ = {ch_, ch_}; \
            const v6u_t pk_ = {RA[k][0], RA[k][1], RA[k][2], RA[k][3], RB[k][0], RB[k][1]}; \
            const v32h_t f_ = __builtin_amdgcn_cvt_scalef32_pk32_f16_fp6(pk_, 1.0f); \
            _Pragma("unroll") for (int q = 0; q < 16; ++q) yh[q] = (h2_t){f_[2 * q], f_[2 * q + 1]} * c2_ + yh[q]; \
            asm volatile("" : "+v"(yh[0]), "+v"(yh[1]), "+v"(yh[2]), "+v"(yh[3]), "+v"(yh[4]), "+v"(yh[5]), "+v"(yh[6]), "+v"(yh[7]), "+v"(yh[8]), "+v"(yh[9]), "+v"(yh[10]), "+v"(yh[11]), "+v"(yh[12]), "+v"(yh[13]), "+v"(yh[14]), "+v"(yh[15])); \
            __builtin_amdgcn_sched_barrier(0); } } while (0)
#define PG6_CV4(RA, RB, eb) do { const unsigned ccv_ = (eb) < 64 ? cc0 : cc1; \
        _Pragma("unroll") for (int k = 0; k < 8; ++k) { \
            const unsigned cs_ = (unsigned)__builtin_amdgcn_readlane((int)ccv_, ((eb) & 63) + k); \
            union { unsigned u[2]; h4_t h; } am_; am_.u[0] = cs_ & am0; am_.u[1] = cs_ & am1; \
            const v6u_t pk_ = {RA[k][0], RA[k][1], RA[k][2], RA[k][3], RB[k][0], RB[k][1]}; \
            const v32h_t f_ = __builtin_amdgcn_cvt_scalef32_pk32_f16_fp6(pk_, 1.0f); \
            _Pragma("unroll") for (int q = 0; q < 8; ++q) ya[q] = __builtin_amdgcn_mfma_f32_4x4x4f16(am_.h, (h4_t){f_[4 * q], f_[4 * q + 1], f_[4 * q + 2], f_[4 * q + 3]}, ya[q], 0, 0, 0); \
            if (k & 1) __builtin_amdgcn_sched_barrier(0); } } while (0)
__device__ __forceinline__ void phase_peer_gather6(const Params& p, int bid, int nblk) {
    const int tidf = tid_fresh(p.widx), lane = tidf & 63, wid = tidf >> 6;
    const unsigned lane16 = (unsigned)lane * 16u, lane8 = (unsigned)lane * 8u;
    const unsigned char* utab = p.ws + OFF_UTAB; const unsigned char* vtab = p.ws + OFF_VTAB;
    const float* usc = WS<float>(p, OFF_USC); const float* vsc = WS<float>(p, OFF_VSC);
    const bf16_t* h2 = WS<bf16_t>(p, OFF_H); const float* x1 = WS<float>(p, OFF_X1); const float* mod = WS<float>(p, OFF_MOD);
    const int* ridx = WS<int>(p, OFF_RIDX); const float* rgate = WS<float>(p, OFF_RGATE);
    const int tstep = nblk * 8;
    int t = bid * 8 + wid;
    if (t >= TOK) return;
    int myi0 = ridx[(size_t)t * 128 + lane], myi1 = ridx[(size_t)t * 128 + 64 + lane];
    u32x4_t a4[8], b4[8]; u32x2_t a2[8], b2[8];
    PG6_LOAD(a4, a2, utab, myi0, 0);
    for (; t < TOK; t += tstep) {
        const int b = t >> 12;
        const int tn = t + tstep; const bool more = tn < TOK;
        const int ni0 = more ? ridx[(size_t)tn * 128 + lane] : 0, ni1 = more ? ridx[(size_t)tn * 128 + 64 + lane] : 0;
        const float myg0 = rgate[(size_t)t * 128 + lane], myg1 = rgate[(size_t)t * 128 + 64 + lane];
        float hv[32];
        { const bf16_t* hp = h2 + (size_t)t * DM + lane * 4;
#pragma unroll
          for (int j = 0; j < 8; ++j) { const uint2 w = *(const uint2*)(hp + j * 256); float* f = hv + j * 4;
              f[0] = lo_f(w.x); f[1] = hi_f(w.x); f[2] = lo_f(w.y); f[3] = hi_f(w.y); } }
        h2_t hvh[16];
#pragma unroll
        for (int q = 0; q < 16; ++q) hvh[q] = (h2_t){(_Float16)hv[2 * q], (_Float16)hv[2 * q + 1]};
        float dots0 = 0.f, dots1 = 0.f;
#pragma unroll 1
        for (int eb = 0; eb < 128; eb += 16) {
            { const int e1 = eb + 8; PG6_LOAD(b4, b2, utab, (e1 < 64 ? myi0 : myi1), (e1 & 63)); }
            PG6_CU(a4, a2, eb);
            if (eb + 16 < 128) { const int e2 = eb + 16; PG6_LOAD(a4, a2, utab, (e2 < 64 ? myi0 : myi1), (e2 & 63)); }
            else PG6_LOAD(a4, a2, vtab, myi0, 0);
            PG6_CU(b4, b2, eb + 8);
        }
        const float cf0 = myg0 * gelu_exact(dots0 * usc[myi0]) * vsc[myi0], cf1 = myg1 * gelu_exact(dots1 * usc[myi1]) * vsc[myi1];
        h2_t yh[16];
#pragma unroll
        for (int q = 0; q < 16; ++q) yh[q] = (h2_t){(_Float16)0.f, (_Float16)0.f};
#pragma unroll 1
        for (int eb = 0; eb < 128; eb += 16) {
            { const int e1 = eb + 8; PG6_LOAD(b4, b2, vtab, (e1 < 64 ? myi0 : myi1), (e1 & 63)); }
            PG6_CV(a4, a2, eb);
            if (eb + 16 < 128) { const int e2 = eb + 16; PG6_LOAD(a4, a2, vtab, (e2 < 64 ? myi0 : myi1), (e2 & 63)); }
            else if (more) PG6_LOAD(a4, a2, utab, ni0, 0);
            PG6_CV(b4, b2, eb + 8);
        }
        myi0 = ni0; myi1 = ni1;
        float y[32];
#pragma unroll
        for (int q = 0; q < 16; ++q) { y[2 * q] = (float)yh[q][0]; y[2 * q + 1] = (float)yh[q][1]; }
        float ss = 0.f;
#pragma unroll
        for (int q4 = 0; q4 < 8; ++q4) {
            const int col = (q4 * 64 + lane) * 4;
            const float4 xv = *(const float4*)(x1 + (size_t)t * DM + col); const float4 g2 = *(const float4*)(mod + (size_t)b * 12288 + 5 * 2048 + col);
            float* yy = y + q4 * 4;
            yy[0] = xv.x + g2.x * yy[0]; yy[1] = xv.y + g2.y * yy[1]; yy[2] = xv.z + g2.z * yy[2]; yy[3] = xv.w + g2.w * yy[3];
            ss += yy[0] * yy[0] + yy[1] * yy[1] + yy[2] * yy[2] + yy[3] * yy[3];
            if (q4 & 1) __builtin_amdgcn_sched_barrier(0);
        }
        ss = wave_sum(ss);
        const float rstd = rsqrtf(ss * (1.0f / DM) + EPS);
#pragma unroll
        for (int q4 = 0; q4 < 8; ++q4) {
            const int col = (q4 * 64 + lane) * 4; const float4 fg = *(const float4*)(p.fin_g + col);
            const float* yy = y + q4 * 4;
            float4 o; o.x = yy[0] * rstd * fg.x; o.y = yy[1] * rstd * fg.y; o.z = yy[2] * rstd * fg.z; o.w = yy[3] * rstd * fg.w;
            *(float4*)(p.out + (size_t)t * DM + col) = o;
            if (q4 & 1) __builtin_amdgcn_sched_barrier(0);
        }
    }
}


__device__ __forceinline__ int ld_agent(const int* q) { return __hip_atomic_load(q, __ATOMIC_RELAXED, __HIP_MEMORY_SCOPE_AGENT); }
__device__ __forceinline__ float ld_agent(const float* q) { return __hip_atomic_load(q, __ATOMIC_RELAXED, __HIP_MEMORY_SCOPE_AGENT); }
__device__ __forceinline__ void phase_peer_u6(const Params& p, int bid, int nblk) {
    const int tidf = tid_fresh(p.widx), lane = tidf & 63, wid = tidf >> 6;
    const unsigned lane16 = (unsigned)lane * 16u, lane8 = (unsigned)lane * 8u;
    const unsigned char* utab = p.ws + OFF_UTAB;
    const float* usc = WS<float>(p, OFF_USC); const float* vsc = WS<float>(p, OFF_VSC);
    const bf16_t* h2 = WS<bf16_t>(p, OFF_H); const int* ridx = WS<int>(p, OFF_RIDX); const float* rgate = WS<float>(p, OFF_RGATE); float* cfo = WS<float>(p, OFF_PD);
    const int tstep = nblk * 8;
    const bool l3b0 = (lane & 1) != 0, l3b1 = (lane & 2) != 0;
    int t = bid * 8 + wid;
    if (t >= TOK) return;
    int myi0 = ld_agent(ridx + (size_t)t * 128 + lane), myi1 = ld_agent(ridx + (size_t)t * 128 + 64 + lane);
    u32x4_t a4[8], b4[8]; u32x2_t a2[8], b2[8];
    PG6_LOAD(a4, a2, utab, myi0, 0);
    for (; t < TOK; t += tstep) {
        const int tn = t + tstep; const bool more = tn < TOK;
        const int ni0 = more ? ld_agent(ridx + (size_t)tn * 128 + lane) : 0, ni1 = more ? ld_agent(ridx + (size_t)tn * 128 + 64 + lane) : 0;
        const float myg0 = ld_agent(rgate + (size_t)t * 128 + lane), myg1 = ld_agent(rgate + (size_t)t * 128 + 64 + lane);
        const float us0 = usc[myi0], us1 = usc[myi1], vs0 = vsc[myi0], vs1 = vsc[myi1];
        h4_t hv4[8];
        { const bf16_t* hp = h2 + (size_t)t * DM + lane * 4;
#pragma unroll
          for (int j = 0; j < 8; ++j) { const uint2 w = *(const uint2*)(hp + j * 256);
              hv4[j] = (h4_t){(_Float16)lo_f(w.x), (_Float16)hi_f(w.x), (_Float16)lo_f(w.y), (_Float16)hi_f(w.y)}; } }
        float dots0 = 0.f, dots1 = 0.f;
#pragma unroll 1
        for (int eb = 0; eb < 128; eb += 16) {
            { const int e1 = eb + 8; PG6_LOAD(b4, b2, utab, (e1 < 64 ? myi0 : myi1), (e1 & 63)); }
            PG6_CU4(a4, a2, eb);
            if (eb + 16 < 128) { const int e2 = eb + 16; PG6_LOAD(a4, a2, utab, (e2 < 64 ? myi0 : myi1), (e2 & 63)); }
            else if (more) PG6_LOAD(a4, a2, utab, ni0, 0);
            PG6_CU4(b4, b2, eb + 8);
        }
        cfo[(size_t)t * 128 + lane] = myg0 * gelu_exact(dots0 * us0) * vs0;
        cfo[(size_t)t * 128 + 64 + lane] = myg1 * gelu_exact(dots1 * us1) * vs1;
        myi0 = ni0; myi1 = ni1;
    }
}
__device__ __forceinline__ void phase_peer_v6(const Params& p, int bid, int nblk) {
    const int tidf = tid_fresh(p.widx), lane = tidf & 63, wid = tidf >> 6;
    const unsigned lane16 = (unsigned)lane * 16u, lane8 = (unsigned)lane * 8u;
    const unsigned char* vtab = p.ws + OFF_VTAB;
    const bf16_t* x1 = WS<bf16_t>(p, OFF_X1); const float* mod = WS<float>(p, OFF_MOD);
    const int* ridx = WS<int>(p, OFF_RIDX); const float* cfi = WS<float>(p, OFF_PD);
    const int tstep = nblk * 8;
    int t = bid * 8 + wid;
    if (t >= TOK) return;
    int myi0 = ld_agent(ridx + (size_t)t * 128 + lane), myi1 = ld_agent(ridx + (size_t)t * 128 + 64 + lane);
    const unsigned am0 = (lane & 3) == 0 ? 0x0000ffffu : ((lane & 3) == 1 ? 0xffff0000u : 0u), am1 = (lane & 3) == 2 ? 0x0000ffffu : ((lane & 3) == 3 ? 0xffff0000u : 0u);
    float cf0 = __hip_atomic_load(cfi + (size_t)t * 128 + lane, __ATOMIC_RELAXED, __HIP_MEMORY_SCOPE_AGENT), cf1 = __hip_atomic_load(cfi + (size_t)t * 128 + 64 + lane, __ATOMIC_RELAXED, __HIP_MEMORY_SCOPE_AGENT);
    u32x4_t a4[8], b4[8]; u32x2_t a2[8], b2[8];
    PG6_LOAD(a4, a2, vtab, myi0, 0);
    for (; t < TOK; t += tstep) {
        const int b = t >> 12;
        const int tn = t + tstep; const bool more = tn < TOK;
        const int ni0 = more ? ld_agent(ridx + (size_t)tn * 128 + lane) : 0, ni1 = more ? ld_agent(ridx + (size_t)tn * 128 + 64 + lane) : 0;
        const float nc0 = more ? __hip_atomic_load(cfi + (size_t)tn * 128 + lane, __ATOMIC_RELAXED, __HIP_MEMORY_SCOPE_AGENT) : 0.f, nc1 = more ? __hip_atomic_load(cfi + (size_t)tn * 128 + 64 + lane, __ATOMIC_RELAXED, __HIP_MEMORY_SCOPE_AGENT) : 0.f;
        uint2 xr[8];
#pragma unroll
        for (int q4 = 0; q4 < 8; ++q4) xr[q4] = *(const uint2*)(x1 + (size_t)t * DM + (q4 * 64 + lane) * 4);
        f32x4v_t ya[8];
#pragma unroll
        for (int q = 0; q < 8; ++q) ya[q] = (f32x4v_t){0.f, 0.f, 0.f, 0.f};
        unsigned cc0, cc1;
        { union { h2_t h; unsigned u; } c_; c_.h = (h2_t){(_Float16)cf0, (_Float16)cf0}; cc0 = c_.u; c_.h = (h2_t){(_Float16)cf1, (_Float16)cf1}; cc1 = c_.u; }
#pragma unroll 1
        for (int eb = 0; eb < 128; eb += 16) {
            { const int e1 = eb + 8; PG6_LOAD(b4, b2, vtab, (e1 < 64 ? myi0 : myi1), (e1 & 63)); }
            PG6_CV4(a4, a2, eb);
            if (eb + 16 < 128) { const int e2 = eb + 16; PG6_LOAD(a4, a2, vtab, (e2 < 64 ? myi0 : myi1), (e2 & 63)); }
            else if (more) PG6_LOAD(a4, a2, vtab, ni0, 0);
            PG6_CV4(b4, b2, eb + 8);
        }
        myi0 = ni0; myi1 = ni1; cf0 = nc0; cf1 = nc1;
        float y[32];
#pragma unroll
        for (int q = 0; q < 8; ++q) { y[4 * q] = ya[q][0]; y[4 * q + 1] = ya[q][1]; y[4 * q + 2] = ya[q][2]; y[4 * q + 3] = ya[q][3]; }
        float ss = 0.f;
#pragma unroll
        for (int q4 = 0; q4 < 8; ++q4) {
            const int col = (q4 * 64 + lane) * 4;
            const uint2 xw = xr[q4]; const float4 g2 = *(const float4*)(mod + (size_t)b * 12288 + 5 * 2048 + col);
            float4 xv; xv.x = lo_f(xw.x); xv.y = hi_f(xw.x); xv.z = lo_f(xw.y); xv.w = hi_f(xw.y);
            float* yy = y + q4 * 4;
            yy[0] = xv.x + g2.x * yy[0]; yy[1] = xv.y + g2.y * yy[1]; yy[2] = xv.z + g2.z * yy[2]; yy[3] = xv.w + g2.w * yy[3];
            ss += yy[0] * yy[0] + yy[1] * yy[1] + yy[2] * yy[2] + yy[3] * yy[3];
            if (q4 & 1) __builtin_amdgcn_sched_barrier(0);
        }
        ss = wave_sum(ss);
        const float rstd = rsqrtf(ss * (1.0f / DM) + EPS);
#pragma unroll
        for (int q4 = 0; q4 < 8; ++q4) {
            const int col = (q4 * 64 + lane) * 4; const float4 fg = *(const float4*)(p.fin_g + col);
            const float* yy = y + q4 * 4;
            float4 o; o.x = yy[0] * rstd * fg.x; o.y = yy[1] * rstd * fg.y; o.z = yy[2] * rstd * fg.z; o.w = yy[3] * rstd * fg.w;
            *(float4*)(p.out + (size_t)t * DM + col) = o;
            if (q4 & 1) __builtin_amdgcn_sched_barrier(0);
        }
    }
}

#define XB_TMO      128
#define XB_XCNT(j)  (256  + 64 * (j))
#define XB_XSUB(j)  (1280 + 64 * (j))
#define XB_XGEN(j)  (2304 + 64 * (j))
#define XB_TOP      3328
#define XB_TOPGEN   3392
#define XCD_BAR_WORDS 3456
#define XB_SPIN_CAP (1u << 18)

__device__ __forceinline__ unsigned xb_ld(unsigned* p)              { return __hip_atomic_load(p, __ATOMIC_RELAXED, __HIP_MEMORY_SCOPE_AGENT); }
__device__ __forceinline__ unsigned xb_add(unsigned* p, unsigned v) { return __hip_atomic_fetch_add(p, v, __ATOMIC_RELAXED, __HIP_MEMORY_SCOPE_AGENT); }
__device__ __forceinline__ unsigned xb_xcc_id() { return (unsigned)__builtin_amdgcn_s_getreg((3 << 11) | 20) & 0xFu; }
#define XB_SPIN(cond, bar) do { unsigned _sp = 0; while (cond) { __builtin_amdgcn_s_sleep(1); \
    if ((++_sp & 255u) == 0u) { if (xb_ld(&(bar)[XB_TMO])) break; if (_sp > XB_SPIN_CAP) { atomicAdd(&(bar)[XB_TMO], 1u); break; } } } } while (0)

struct XcdBarrier {
    int widx;
    unsigned* bar; unsigned x;
    volatile LAS unsigned* st;
};

__device__ __forceinline__ bool xb_thread0(int widx) { unsigned m = ~0u; asm volatile("" : "+s"(m)); return widx == 0 && __builtin_amdgcn_mbcnt_hi(m, __builtin_amdgcn_mbcnt_lo(m, 0u)) == 0u; }
__device__ __forceinline__ XcdBarrier xcd_barrier_post(unsigned* bar, volatile LAS unsigned* st, int widx) {
    XcdBarrier b; b.widx = widx; b.bar = bar; b.x = xb_xcc_id(); b.st = st;
    if (xb_thread0(widx)) (void)xb_add(&bar[XB_XCNT(b.x)], 1u);
    return b;
}
__device__ __forceinline__ void xcd_barrier_complete(unsigned* bar, unsigned x, unsigned& nloc, unsigned& nx) {
    const unsigned G = gridDim.x * gridDim.y * gridDim.z;
    unsigned sum, cnt, mine, sp = 0u;
    for (;;) {
        sum = 0u; cnt = 0u; mine = 0u;
#pragma unroll
        for (unsigned j = 0; j < 16; ++j) { const unsigned c = xb_ld(&bar[XB_XCNT(j)]); sum += c; cnt += (c > 0u) ? 1u : 0u; mine = (j == x) ? c : mine; }
        if (sum == G) break;
        __builtin_amdgcn_s_sleep(1);
        if ((++sp & 255u) == 0u) { if (xb_ld(&bar[XB_TMO])) break; if (sp > XB_SPIN_CAP) { atomicAdd(&bar[XB_TMO], 1u); break; } }
    }
    nloc = mine > 0u ? mine : 1u; nx = cnt > 0u ? cnt : 1u;
}

__device__ __forceinline__ void xcd_barrier(const XcdBarrier& b) {
    asm volatile("s_waitcnt vmcnt(0)" ::: "memory");
    __syncthreads();
    if (xb_thread0(b.widx)) {
        unsigned* bar = b.bar;
        __builtin_amdgcn_s_waitcnt(0);
        unsigned nloc = b.st[0], nx = b.st[1];
        if (nloc == 0u) { xcd_barrier_complete(bar, b.x, nloc, nx); b.st[0] = nloc; b.st[1] = nx; }
        const unsigned old = xb_add(&bar[XB_XSUB(b.x)], 1u);
        const unsigned gen = old / nloc;
        if (old + 1u == (gen + 1u) * nloc) {
            __builtin_amdgcn_fence(__ATOMIC_RELEASE, "agent");
            asm volatile("s_waitcnt vmcnt(0)" ::: "memory");
            const unsigned og = xb_add(&bar[XB_TOP], 1u);
            const unsigned tg = og / nx;
            if (og + 1u == (tg + 1u) * nx) xb_add(&bar[XB_TOPGEN], 1u);
            else XB_SPIN(xb_ld(&bar[XB_TOPGEN]) == tg, bar);
            __builtin_amdgcn_fence(__ATOMIC_ACQUIRE, "agent");
            xb_add(&bar[XB_XGEN(b.x)], 1u);
            asm volatile("s_waitcnt vmcnt(0)" ::: "memory");
        } else {
            XB_SPIN(xb_ld(&bar[XB_XGEN(b.x)]) == gen, bar);
            __builtin_amdgcn_fence(__ATOMIC_ACQUIRE, "agent");
            asm volatile("s_waitcnt vmcnt(0)" ::: "memory");
        }
    }
    __syncthreads();
}


constexpr int PS_Q_WORD = 3968;
__device__ __forceinline__ unsigned ps_next(unsigned* q, LAS unsigned* bc, int tid) {
    if (tid == 0) *bc = __hip_atomic_fetch_add(q, 1u, __ATOMIC_RELAXED, __HIP_MEMORY_SCOPE_AGENT);
    __syncthreads();
    const unsigned u = (unsigned)__builtin_amdgcn_readfirstlane((int)*bc);
    __syncthreads();
    return u;
}
#define PS_LOADH(RA, RB, tb, idv) do { _Pragma("unroll") for (int bt = 0; bt < 8; ++bt) { const int idx_ = __shfl((idv), bt * 8 + g); const unsigned char* rp_ = (tb) + (size_t)idx_ * 192; \
        RA[bt] = *(const u32x4_t*)(rp_ + j * 16); RB[bt] = *(const u32x2_t*)(rp_ + 128 + j * 8); } } while (0)
#define PS_CU(RA, RB, outp) do { float mine_ = 0.f; \
        _Pragma("unroll") for (int bt = 0; bt < 8; ++bt) { \
            const v6u_t pk_ = {RA[bt][0], RA[bt][1], RA[bt][2], RA[bt][3], RB[bt][0], RB[bt][1]}; \
            const v32f_t f_ = __builtin_amdgcn_cvt_scalef32_pk32_f32_fp6(pk_, 1.0f); float sd_ = 0.f; \
            _Pragma("unroll") for (int qq = 0; qq < 32; ++qq) sd_ += f_[qq] * hv[qq]; \
            sd_ += __shfl_xor(sd_, 1); sd_ += __shfl_xor(sd_, 2); sd_ += __shfl_xor(sd_, 4); \
            mine_ = (j == bt) ? sd_ : mine_; __builtin_amdgcn_sched_barrier(0); } \
        __builtin_nontemporal_store(mine_, (outp) + j * 8 + g); } while (0)
#define PS_CV(RA, RB, cfv) do { \
        _Pragma("unroll") for (int bt = 0; bt < 8; ++bt) { const float cf_ = __shfl((cfv), bt * 8 + g); \
            const v6u_t pk_ = {RA[bt][0], RA[bt][1], RA[bt][2], RA[bt][3], RB[bt][0], RB[bt][1]}; \
            const v32f_t f_ = __builtin_amdgcn_cvt_scalef32_pk32_f32_fp6(pk_, 1.0f); \
            _Pragma("unroll") for (int qq = 0; qq < 32; ++qq) y[qq] += cf_ * f_[qq]; \
            asm volatile("" : "+v"(y[0]), "+v"(y[1]), "+v"(y[2]), "+v"(y[3]), "+v"(y[4]), "+v"(y[5]), "+v"(y[6]), "+v"(y[7]), "+v"(y[8]), "+v"(y[9]), "+v"(y[10]), "+v"(y[11]), "+v"(y[12]), "+v"(y[13]), "+v"(y[14]), "+v"(y[15])); \
            asm volatile("" : "+v"(y[16]), "+v"(y[17]), "+v"(y[18]), "+v"(y[19]), "+v"(y[20]), "+v"(y[21]), "+v"(y[22]), "+v"(y[23]), "+v"(y[24]), "+v"(y[25]), "+v"(y[26]), "+v"(y[27]), "+v"(y[28]), "+v"(y[29]), "+v"(y[30]), "+v"(y[31])); \
            __builtin_amdgcn_sched_barrier(0); } } while (0)
constexpr int PS_CHUNK = 64;
__device__ __forceinline__ void phase_peer_u_sliced(const Params& p, float* ldsf) {
    const int tid = tid_fresh(p.widx), lane = tid & 63, wid = tid >> 6, g = lane >> 3, j = lane & 7;
    LAS unsigned* bc = (LAS unsigned*)ldsf;
    const unsigned char* utab = p.ws + OFF_UTAB;
    const bf16_t* h2 = WS<bf16_t>(p, OFF_H); const int* ridx = WS<int>(p, OFF_RIDX); float* pd = WS<float>(p, OFF_PD);
    const int x0 = (int)(xb_xcc_id() & 7u);
#pragma unroll 1
    for (int so = 0; so < 8; ++so) {
        const int s = (x0 + so) & 7;
        unsigned* q = WS<unsigned>(p, OFF_BAR) + PS_Q_WORD + 8 * s;
        const unsigned char* tb = utab + (size_t)s * NEXP * 192;
        const bf16_t* hb = h2 + s * 256 + j * 32;
#pragma unroll 1
        for (;;) {
            const unsigned ch = ps_next(q, bc, tid);
            if (ch >= TOK / PS_CHUNK) break;
            int t = (int)ch * PS_CHUNK + wid;
            int i0 = __builtin_nontemporal_load(ridx + (size_t)t * 128 + lane), i1 = __builtin_nontemporal_load(ridx + (size_t)t * 128 + 64 + lane);
            uint4 hp[4];
#pragma unroll
            for (int q8 = 0; q8 < 4; ++q8) hp[q8] = *(const uint4*)(hb + (size_t)t * DM + q8 * 8);
            u32x4_t a4[8], b4[8]; u32x2_t a2[8], b2[8];
            PS_LOADH(a4, a2, tb, i0);
#pragma unroll 1
            for (int k = 0; k < PS_CHUNK / 8; ++k, t += 8) {
                float hv[32];
#pragma unroll
                for (int q8 = 0; q8 < 4; ++q8) { const uint4 w = hp[q8]; float* f = hv + q8 * 8;
                    f[0] = lo_f(w.x); f[1] = hi_f(w.x); f[2] = lo_f(w.y); f[3] = hi_f(w.y); f[4] = lo_f(w.z); f[5] = hi_f(w.z); f[6] = lo_f(w.w); f[7] = hi_f(w.w); }
                const bool more = k + 1 < PS_CHUNK / 8; const int tn = more ? t + 8 : t;
                const int n0 = __builtin_nontemporal_load(ridx + (size_t)tn * 128 + lane), n1 = __builtin_nontemporal_load(ridx + (size_t)tn * 128 + 64 + lane);
#pragma unroll
                for (int q8 = 0; q8 < 4; ++q8) hp[q8] = *(const uint4*)(hb + (size_t)tn * DM + q8 * 8);
                PS_LOADH(b4, b2, tb, i1);
                PS_CU(a4, a2, pd + ((size_t)s * TOK + t) * 128);
                if (more) PS_LOADH(a4, a2, tb, n0);
                PS_CU(b4, b2, pd + ((size_t)s * TOK + t) * 128 + 64);
                i0 = n0; i1 = n1;
            }
        }
    }
}
__device__ __forceinline__ void phase_peer_v_sliced(const Params& p, float* ldsf) {
    const int tid = tid_fresh(p.widx), lane = tid & 63, wid = tid >> 6, g = lane >> 3, j = lane & 7;
    LAS unsigned* bc = (LAS unsigned*)ldsf;
    const unsigned char* vtab = p.ws + OFF_VTAB;
    const float* usc = WS<float>(p, OFF_USC); const float* vsc = WS<float>(p, OFF_VSC);
    const int* ridx = WS<int>(p, OFF_RIDX); const float* rgate = WS<float>(p, OFF_RGATE); const float* pd = WS<float>(p, OFF_PD);
    float* x1 = WS<float>(p, OFF_X1); const float* mod = WS<float>(p, OFF_MOD); float* ssqp = WS<float>(p, OFF_SSQP);
    const int x0 = (int)(xb_xcc_id() & 7u);
    const int cofs = j * 32 + 16 * (g & 1) + 8 * ((g >> 1) & 1) + 4 * (g >> 2);
#pragma unroll 1
    for (int so = 0; so < 8; ++so) {
        const int s = (x0 + so) & 7;
        unsigned* q = WS<unsigned>(p, OFF_BAR) + PS_Q_WORD + 64 + 8 * s;
        const unsigned char* tb = vtab + (size_t)s * NEXP * 192;
#pragma unroll 1
        for (;;) {
            const unsigned ch = ps_next(q, bc, tid);
            if (ch >= TOK / PS_CHUNK) break;
            int t = (int)ch * PS_CHUNK + wid;
            int i0 = __builtin_nontemporal_load(ridx + (size_t)t * 128 + lane), i1 = __builtin_nontemporal_load(ridx + (size_t)t * 128 + 64 + lane);
            float d0 = 0.f, d1 = 0.f;
#pragma unroll
            for (int x = 0; x < 8; ++x) { d0 += __builtin_nontemporal_load(pd + ((size_t)x * TOK + t) * 128 + lane); d1 += __builtin_nontemporal_load(pd + ((size_t)x * TOK + t) * 128 + 64 + lane); }
            float g0 = __builtin_nontemporal_load(rgate + (size_t)t * 128 + lane), g1 = __builtin_nontemporal_load(rgate + (size_t)t * 128 + 64 + lane);
            u32x4_t a4[8], b4[8]; u32x2_t a2[8], b2[8];
            PS_LOADH(a4, a2, tb, i0);
#pragma unroll 1
            for (int k = 0; k < PS_CHUNK / 8; ++k, t += 8) {
                const int b = t >> 12, col = s * 256 + cofs;
                const float cf0 = g0 * gelu_exact(d0 * usc[i0]) * vsc[i0], cf1 = g1 * gelu_exact(d1 * usc[i1]) * vsc[i1];
                const float4 xv = *(const float4*)(x1 + (size_t)t * DM + col); const float4 gg = *(const float4*)(mod + (size_t)b * 12288 + 5 * 2048 + col);
                const bool more = k + 1 < PS_CHUNK / 8; const int tn = more ? t + 8 : t;
                const int n0 = __builtin_nontemporal_load(ridx + (size_t)tn * 128 + lane), n1 = __builtin_nontemporal_load(ridx + (size_t)tn * 128 + 64 + lane);
                float e0 = 0.f, e1 = 0.f;
#pragma unroll
                for (int x = 0; x < 8; ++x) { e0 += __builtin_nontemporal_load(pd + ((size_t)x * TOK + tn) * 128 + lane); e1 += __builtin_nontemporal_load(pd + ((size_t)x * TOK + tn) * 128 + 64 + lane); }
                const float ng0 = __builtin_nontemporal_load(rgate + (size_t)tn * 128 + lane), ng1 = __builtin_nontemporal_load(rgate + (size_t)tn * 128 + 64 + lane);
                float y[32];
#pragma unroll
                for (int qq = 0; qq < 32; ++qq) y[qq] = 0.f;
                PS_LOADH(b4, b2, tb, i1);
                PS_CV(a4, a2, cf0);
                if (more) PS_LOADH(a4, a2, tb, n0);
                PS_CV(b4, b2, cf1);
                float w16[16], w8[8], w4[4];
                { const bool hi = (g & 1) != 0;
#pragma unroll
                  for (int i = 0; i < 16; ++i) { const float send = hi ? y[i] : y[16 + i], keep = hi ? y[16 + i] : y[i]; w16[i] = keep + __shfl_xor(send, 8); } }
                { const bool hi = (g & 2) != 0;
#pragma unroll
                  for (int i = 0; i < 8; ++i) { const float send = hi ? w16[i] : w16[8 + i], keep = hi ? w16[8 + i] : w16[i]; w8[i] = keep + __shfl_xor(send, 16); } }
                { const bool hi = (g & 4) != 0;
#pragma unroll
                  for (int i = 0; i < 4; ++i) { const float send = hi ? w8[i] : w8[4 + i], keep = hi ? w8[4 + i] : w8[i]; w4[i] = keep + __shfl_xor(send, 32); } }
                float4 o; o.x = xv.x + gg.x * w4[0]; o.y = xv.y + gg.y * w4[1]; o.z = xv.z + gg.z * w4[2]; o.w = xv.w + gg.w * w4[3];
                *(float4*)(x1 + (size_t)t * DM + col) = o;
                const float ss = wave_sum(o.x * o.x + o.y * o.y + o.z * o.z + o.w * o.w);
                if (lane == 0) ssqp[(size_t)s * TOK + t] = ss;
                i0 = n0; i1 = n1; d0 = e0; d1 = e1; g0 = ng0; g1 = ng1;
            }
        }
    }
}
__device__ __forceinline__ void phase_peer_final(const Params& p, int bid, int nblk) {
    const int tidf = tid_fresh(p.widx), lane = tidf & 63, wid = tidf >> 6;
    const float* x2 = WS<float>(p, OFF_X1); const float* ssqp = WS<float>(p, OFF_SSQP);
    for (int t = bid * 8 + wid; t < TOK; t += nblk * 8) {
        float ss = 0.f;
#pragma unroll
        for (int s = 0; s < 8; ++s) ss += ssqp[(size_t)s * TOK + t];
        const float rstd = rsqrtf(ss * (1.0f / DM) + EPS);
#pragma unroll
        for (int jj = 0; jj < 8; ++jj) { const int col = (jj * 64 + lane) * 4;
            const float4 v = *(const float4*)(x2 + (size_t)t * DM + col), fg = *(const float4*)(p.fin_g + col);
            float4 o; o.x = v.x * rstd * fg.x; o.y = v.y * rstd * fg.y; o.z = v.z * rstd * fg.z; o.w = v.w * rstd * fg.w;
            *(float4*)(p.out + (size_t)t * DM + col) = o; }
    }
}

constexpr int NPHASE = 12;
#ifndef USE_FAST_ROUTE
#define USE_FAST_ROUTE 1
#endif
#ifndef USE_FAST_PEER
#define USE_FAST_PEER 1
#endif
#ifndef USE_MFMA_ATTN
#define USE_MFMA_ATTN 1
#endif
#ifndef USE_MFMA_GEMM
#define USE_MFMA_GEMM 1
#endif
#if !(FUSED && USE_FAST_PEER && PEER_SPLIT && TAB_EB == 6 && !PEER_SLICED)
#error "x1 is kept in bf16: only the default (live) path reads it that way"
#endif
#if USE_MFMA_GEMM
#define GEMM(A, Bt, M, N, K, E) gemm_mfma(A, Bt, M, N, K, E, bid, nblk, (unsigned char*)lds, p.widx)
#else
#define GEMM(A, Bt, M, N, K, E) gemm_ref(A, K, Bt, K, M, N, K, E, bid, nblk)
#endif
template <int PH, int RERUN = 0> __device__ __forceinline__ void run_phase(const Params& p, int bid, int nblk, float* lds) {
    if (PH == 0) phase0(p, bid, nblk, lds);
    if (PH == 1) phase_norm_mod(p, p.x, p.norm1_g, 0, 1, WS<bf16_t>(p, OFF_H), bid, nblk, lds);
    if (PH == 2) { EpiInProj E{WS<bf16_t>(p, OFF_QSB), WS<bf16_t>(p, OFF_KSB), WS<bf16_t>(p, OFF_VSB), WS<bf16_t>(p, OFF_CQ), WS<bf16_t>(p, OFF_CKV), WS<bf16_t>(p, OFF_KMLA),
                                WS<float>(p, OFF_COS), WS<float>(p, OFF_SIN), WS<float>(p, OFF_RSP)};
        GEMM(WS<bf16_t>(p, OFF_H), WS<bf16_t>(p, OFF_WIN_T), TOK, NINP, DM, E); }
    if (PH == 3) phase_rowstats(p, bid, nblk);
    if (PH == 4) {
        LAS float* tab = (LAS float*)((LAS unsigned char*)lds + LDS_TAB_OFF); const int tid = tid_fresh(p.widx);
        { pg8::StaticOrder S; S.init(TOK, 1536, nblk, bid); pg8::Unit u0; const int pm0 = S.next(0, u0) ? u0.pm : -1;
          EpiUq E1{WS<bf16_t>(p, OFF_QMLA), WS<float>(p, OFF_RSP), WS<float>(p, OFF_COS), WS<float>(p, OFF_SIN), tab, pm0};
          if (pm0 >= 0 && tid < 256) tab[tid] = E1.slow_scale(pm0 * 256 + tid);
          __syncthreads();
          GEMM(WS<bf16_t>(p, OFF_CQ), WS<bf16_t>(p, OFF_WUQ_T), TOK, 1536, 512, E1); }
        __syncthreads();
        { pg8::StaticOrder S; S.init(TOK, 2048, nblk, bid); pg8::Unit u0; const int pm0 = S.next(0, u0) ? u0.pm : -1;
          EpiUkv E2{WS<bf16_t>(p, OFF_KMLA), WS<bf16_t>(p, OFF_VMLA), WS<float>(p, OFF_RSP), tab, pm0};
          if (pm0 >= 0 && tid < 256) tab[tid] = E2.slow_scale(pm0 * 256 + tid);
          __syncthreads();
          GEMM(WS<bf16_t>(p, OFF_CKV), WS<bf16_t>(p, OFF_WUKV_T), TOK, 2048, 256, E2); } }
#if USE_MFMA_ATTN
    if (PH == 5) phase_attn_mfma(p, lds, RERUN);
#else
    if (PH == 5) phase_attn_ref(p, bid, nblk);
#endif
    if (PH == 6) phase_onorm(p, bid, nblk);
    if (PH == 7) { LAS float* tab = (LAS float*)((LAS unsigned char*)lds + LDS_TAB_OFF); const int tid = tid_fresh(p.widx);
        pg8::StaticOrder S; S.init(TOK, DM, nblk, bid); pg8::Unit u0; const int pm0 = S.next(0, u0) ? u0.pm : -1;
        EpiWo E{p.x, WS<float>(p, OFF_MOD), WS<bf16_t>(p, OFF_X1), WS<float>(p, OFF_SSQ), tab, pm0};
        if (pm0 >= 0 && tid < 256) { float r0, r1; E.rstd2(pm0 * 256 + tid, r0, r1); tab[2 * tid] = r0 / r1; tab[2 * tid + 1] = r1; }
        __syncthreads();
        GEMM(WS<bf16_t>(p, OFF_O), WS<bf16_t>(p, OFF_WO_T), TOK, DM, DM, E); }
    if (PH == 8) phase_norm_mod(p, WS<bf16_t>(p, OFF_X1), p.norm2_g, 3, 4, WS<bf16_t>(p, OFF_H), bid, nblk, lds);
    if (PH == 9) { EpiQp E{WS<bf16_t>(p, OFF_QP)};
        GEMM(WS<bf16_t>(p, OFF_H), WS<bf16_t>(p, OFF_WPQ_T), TOK, DM, DM, E); }
#if USE_FAST_ROUTE
    if (PH == 10) phase_route_mfma(p, bid, nblk, lds);
#else
    if (PH == 10) phase_route_ref(p, bid, nblk);
#endif
#if USE_FAST_PEER && PEER_SLICED
    if (PH == 11) phase_peer_u_sliced(p, lds);
    if (PH == 12) phase_peer_v_sliced(p, lds);
    if (PH == 13) phase_peer_final(p, bid, nblk);
#elif USE_FAST_PEER && PEER_SPLIT && TAB_EB == 6
    if (PH == 11) phase_peer_u6(p, bid, nblk);
    if (PH == 12) phase_peer_v6(p, bid, nblk);
#elif USE_FAST_PEER
    if (PH == 11) { if (TAB_EB == 6) phase_peer_gather6(p, bid, nblk); else phase_peer_gather<TAB_EB == 6 ? 1 : TAB_EB>(p, bid, nblk); }
#else
    if (PH == 11) phase_peer_ref(p, bid, nblk);
#endif
}

extern __shared__ __attribute__((aligned(16))) unsigned char dynlds[];
constexpr int LDS_MAIN = 131072;
constexpr int LDS_BYTES = LDS_MAIN + 16 + 2048;

template <int PH> __global__ void __launch_bounds__(512, 2) k_phase(Params pin) {
    Params p = pin; p.widx = __builtin_amdgcn_readfirstlane((int)(threadIdx.x >> 6));
    run_phase<PH>(p, blockIdx.x, gridDim.x, (float*)dynlds);
}

__global__ void __launch_bounds__(512, 2) k_fused(Params pin) {
    Params p = pin; p.widx = __builtin_amdgcn_readfirstlane((int)(threadIdx.x >> 6));
    float* lds = (float*)dynlds;
    volatile LAS unsigned* xbw = (volatile LAS unsigned*)(dynlds + LDS_MAIN);
    if (xb_thread0(p.widx)) { xbw[0] = 0u; xbw[1] = 0u; xbw[2] = 0u; xbw[3] = 0u; }
    __syncthreads();
    XcdBarrier bar = xcd_barrier_post(WS<unsigned>(p, OFF_BAR), xbw, p.widx);
    const int bid = blockIdx.x, nblk = gridDim.x;
    run_phase<0>(p, bid, nblk, lds); if (PROBE_DOUBLE & (1 << 0)) run_phase<0, 1>(p, bid, nblk, lds); xcd_barrier(bar);
    run_phase<1>(p, bid, nblk, lds); if (PROBE_DOUBLE & (1 << 1)) run_phase<1, 1>(p, bid, nblk, lds); xcd_barrier(bar);
    run_phase<2>(p, bid, nblk, lds); if (PROBE_DOUBLE & (1 << 2)) run_phase<2, 1>(p, bid, nblk, lds); xcd_barrier(bar);
    run_phase<4>(p, bid, nblk, lds); if (PROBE_DOUBLE & (1 << 4)) run_phase<4, 1>(p, bid, nblk, lds); xcd_barrier(bar);
    run_phase<5>(p, bid, nblk, lds); if (PROBE_DOUBLE & (1 << 5)) run_phase<5, 1>(p, bid, nblk, lds); xcd_barrier(bar);
    run_phase<7>(p, bid, nblk, lds); if (PROBE_DOUBLE & (1 << 7)) run_phase<7, 1>(p, bid, nblk, lds); xcd_barrier(bar);
    run_phase<8>(p, bid, nblk, lds); if (PROBE_DOUBLE & (1 << 8)) run_phase<8, 1>(p, bid, nblk, lds); xcd_barrier(bar);
    run_phase<9>(p, bid, nblk, lds); if (PROBE_DOUBLE & (1 << 9)) run_phase<9, 1>(p, bid, nblk, lds); xcd_barrier(bar);
    run_phase<10>(p, bid, nblk, lds); if (PROBE_DOUBLE & (1 << 10)) run_phase<10, 1>(p, bid, nblk, lds);
#if USE_FAST_ROUTE && USE_FAST_PEER && PEER_SPLIT && TAB_EB == 6 && !PEER_SLICED
    if (nblk * 32 == TOK) { asm volatile("s_waitcnt vmcnt(0)" ::: "memory"); __syncthreads(); }
    else xcd_barrier(bar);
#else
    xcd_barrier(bar);
#endif
    run_phase<11>(p, bid, nblk, lds); if (PROBE_DOUBLE & (1 << 11)) run_phase<11, 1>(p, bid, nblk, lds);
#if USE_FAST_PEER && PEER_SLICED
    xcd_barrier(bar); run_phase<12>(p, bid, nblk, lds);
    xcd_barrier(bar); run_phase<13>(p, bid, nblk, lds);
#elif USE_FAST_PEER && PEER_SPLIT && TAB_EB == 6
    asm volatile("s_waitcnt vmcnt(0)" ::: "memory");
    run_phase<12>(p, bid, nblk, lds);
#endif
}

template <int PH> static void launch_phase(const Params& p, int grid, hipStream_t st) {
    hipLaunchKernelGGL((k_phase<PH>), dim3(grid), dim3(512), LDS_BYTES, st, p);
}

extern "C" void kernel_launch(void* const* d_in, const int* in_sizes, int n_in, void* d_out, int out_size, void* d_ws, size_t ws_size, hipStream_t stream) {
    Params p{};
    p.x = (const float*)d_in[0]; p.c = (const float*)d_in[1]; p.pos = (const int*)d_in[2]; p.w_ada = (const float*)d_in[3]; p.b_ada = (const float*)d_in[4];
    p.norm1_g = (const float*)d_in[5]; p.w_in = (const float*)d_in[6]; p.qn_g = (const float*)d_in[7]; p.w_uq = (const float*)d_in[8]; p.kvn_g = (const float*)d_in[9];
    p.w_ukv = (const float*)d_in[10]; p.osb_g = (const float*)d_in[11]; p.omla_g = (const float*)d_in[12]; p.w_o = (const float*)d_in[13]; p.norm2_g = (const float*)d_in[14];
    p.w_pq = (const float*)d_in[15]; p.keys1 = (const float*)d_in[16]; p.keys2 = (const float*)d_in[17]; p.u_tab = (const float*)d_in[18]; p.v_tab = (const float*)d_in[19];
    p.fin_g = (const float*)d_in[20]; p.out = (float*)d_out; p.ws = (unsigned char*)d_ws;
#if FUSED
    static int grid = 0;
    if (!grid) {
        int dev = 0, cus = 0, per_cu = 0;
        hipGetDevice(&dev);
        hipDeviceGetAttribute(&cus, hipDeviceAttributeMultiprocessorCount, dev);
        hipFuncSetAttribute((const void*)k_fused, hipFuncAttributeMaxDynamicSharedMemorySize, LDS_BYTES);
        hipOccupancyMaxActiveBlocksPerMultiprocessor(&per_cu, k_fused, 512, LDS_BYTES);
        grid = per_cu >= 1 ? cus : 0;
    }
    hipMemsetAsync((unsigned char*)d_ws + OFF_BAR, 0, 16384, stream);
    if (grid) hipLaunchKernelGGL(k_fused, dim3(grid), dim3(512), LDS_BYTES, stream, p);
#else
    const int G = 1024;
    launch_phase<0>(p, G, stream); launch_phase<1>(p, G, stream); launch_phase<2>(p, G, stream); launch_phase<3>(p, G, stream);
    launch_phase<4>(p, G, stream); launch_phase<5>(p, G, stream); launch_phase<6>(p, G, stream); launch_phase<7>(p, G, stream);
    launch_phase<8>(p, G, stream); launch_phase<9>(p, G, stream); launch_phase<10>(p, G, stream); launch_phase<11>(p, G, stream);
#endif
}
```

```cpp
#include <hip/hip_runtime.h>
#include <stdint.h>

#ifndef TAB_EB
#define TAB_EB 6
#endif
#ifndef ATT_ANTIPHASE
#define ATT_ANTIPHASE 1
#endif
#ifndef PEER_SPLIT
#define PEER_SPLIT 1
#endif
#ifndef PEER_SLICED
#define PEER_SLICED 0
#endif
#ifndef PROBE_ATTN_G
#define PROBE_ATTN_G 0
#endif
#ifndef PROBE_DOUBLE
#define PROBE_DOUBLE 0
#endif
#ifndef FUSED
#define FUSED 1
#endif

typedef unsigned short bf16_t;
#define LAS __attribute__((address_space(3)))
__device__ __forceinline__ int tid_fresh(int widx) { unsigned m = ~0u; asm volatile("" : "+s"(m)); int t = (widx << 6) | (int)__builtin_amdgcn_mbcnt_hi(m, __builtin_amdgcn_mbcnt_lo(m, 0u)); asm volatile("" : "+v"(t)); return t; }

constexpr int TOK = 8192, DM = 2048, SEQ = 4096, NB = 2;
constexpr int NIN = 3904, NINP = 4096;
constexpr int NEXP = 16384;
constexpr float EPS = 1e-6f;
constexpr float LOG2E = 1.4426950408889634f, LN2 = 0.6931471805599453f;
constexpr float QS_SB = 0.12751743082459868f;
constexpr float QS_MLA = 0.10411754627697264f;

constexpr size_t MiB = 1ull << 20;
constexpr size_t OFF_BAR = 0;
constexpr size_t OFF_MOD = 16384;
constexpr size_t OFF_COS = OFF_MOD + 98304;
constexpr size_t OFF_SIN = OFF_COS + MiB;
constexpr size_t OFF_RSQ = OFF_SIN + MiB;
constexpr size_t OFF_RSKV = OFF_RSQ + 32768;
constexpr size_t OFF_SSQ = OFF_RSKV + 32768;
constexpr size_t OFF_KEYS = OFF_SSQ + 524288;
constexpr size_t OFF_USC = OFF_KEYS + 524288;
constexpr size_t OFF_VSC = OFF_USC + 65536;
static_assert(OFF_VSC + 65536 <= 4 * MiB, "ws map");
constexpr size_t OFF_WIN_T = 4 * MiB;
constexpr size_t OFF_WUQ_T = OFF_WIN_T + 16 * MiB;
constexpr size_t OFF_WUKV_T = OFF_WUQ_T + 2 * MiB;
constexpr size_t OFF_WO_T = OFF_WUKV_T + 1 * MiB;
constexpr size_t OFF_WPQ_T = OFF_WO_T + 8 * MiB;
constexpr size_t OFF_H = OFF_WPQ_T + 8 * MiB;
constexpr size_t OFF_QSB = OFF_H + 32 * MiB;
constexpr size_t OFF_KSB = OFF_QSB + 16 * MiB;
constexpr size_t OFF_VSB = OFF_KSB + 16 * MiB;
constexpr size_t OFF_CQ = OFF_VSB + 16 * MiB;
constexpr size_t OFF_CKV = OFF_CQ + 8 * MiB;
constexpr size_t OFF_QMLA = OFF_CKV + 4 * MiB;
constexpr size_t OFF_KMLA = OFF_QMLA + 24 * MiB;
constexpr size_t OFF_VMLA = OFF_KMLA + 24 * MiB;
constexpr size_t OFF_O = OFF_VMLA + 16 * MiB;
constexpr size_t OFF_X1 = OFF_O + 32 * MiB;
constexpr size_t OFF_QP = OFF_X1 + 64 * MiB;
constexpr size_t OFF_RIDX = OFF_QP + 32 * MiB;
constexpr size_t OFF_RGATE = OFF_RIDX + 4 * MiB;
constexpr size_t OFF_UTAB = OFF_RGATE + 4 * MiB;
constexpr size_t OFF_VTAB = OFF_UTAB + 64 * MiB;
constexpr size_t OFF_PD = OFF_VTAB + 64 * MiB;
constexpr size_t OFF_SSQP = OFF_PD + 32 * MiB;
constexpr size_t OFF_RSP = OFF_SSQP + 1 * MiB;
constexpr size_t WS_END = OFF_RSP + 1 * MiB;

struct Params {
    const float* x; const float* c; const int* pos; const float* w_ada; const float* b_ada; const float* norm1_g;
    const float* w_in; const float* qn_g; const float* w_uq; const float* kvn_g; const float* w_ukv;
    const float* osb_g; const float* omla_g; const float* w_o; const float* norm2_g; const float* w_pq;
    const float* keys1; const float* keys2; const float* u_tab; const float* v_tab; const float* fin_g;
    float* out; unsigned char* ws;
    int widx; int pad_;
};
template <class Tp> __device__ __forceinline__ Tp* WS(const Params& p, size_t off) { return (Tp*)(p.ws + off); }

__device__ __forceinline__ float bf2f(bf16_t v) { return __uint_as_float(((unsigned)v) << 16); }
__device__ __forceinline__ bf16_t f2bf(float f) { unsigned u = __float_as_uint(f); u += 0x7fffu + ((u >> 16) & 1u); return (bf16_t)(u >> 16); }
__device__ __forceinline__ unsigned pack2(float lo, float hi) { return (unsigned)f2bf(lo) | ((unsigned)f2bf(hi) << 16); }
__device__ __forceinline__ float lo_f(unsigned u) { return __uint_as_float(u << 16); }
__device__ __forceinline__ float hi_f(unsigned u) { return __uint_as_float(u & 0xffff0000u); }
__device__ __forceinline__ float dot8(uint4 a, uint4 b) {
    float s = lo_f(a.x) * lo_f(b.x); s += hi_f(a.x) * hi_f(b.x);
    s += lo_f(a.y) * lo_f(b.y); s += hi_f(a.y) * hi_f(b.y);
    s += lo_f(a.z) * lo_f(b.z); s += hi_f(a.z) * hi_f(b.z);
    s += lo_f(a.w) * lo_f(b.w); s += hi_f(a.w) * hi_f(b.w);
    return s;
}
__device__ __forceinline__ float wave_sum(float v) {
#pragma unroll
    for (int o = 32; o > 0; o >>= 1) v += __shfl_xor(v, o);
    return v;
}
__device__ __forceinline__ float gelu_exact(float x) { return 0.5f * x * (1.0f + erff(x * 0.70710678118654752f)); }

struct EpiInProj {
    static constexpr bool HAS_MID = false;
    bf16_t *qsb, *ksb, *vsb, *cq, *ckv, *kmla; const float *cosT, *sinT; float* rsp;
    __device__ __forceinline__ float row_scale(int) const { return 1.0f; }
    __device__ __forceinline__ float mid_scale(int) const { return 1.0f; }
    __device__ __forceinline__ void store8(int row, int col0, const float (&v)[8], float) const {
        if (col0 >= NIN) return;
        uint4 w;
        if (col0 < 3840) {
            float s = col0 < 1024 ? QS_SB : 1.0f;
            w.x = pack2(v[0] * s, v[1] * s); w.y = pack2(v[2] * s, v[3] * s); w.z = pack2(v[4] * s, v[5] * s); w.w = pack2(v[6] * s, v[7] * s);
            bf16_t* dst;
            if (col0 < 1024) dst = qsb + (size_t)row * 1024 + col0;
            else if (col0 < 2048) dst = ksb + (size_t)row * 1024 + (col0 - 1024);
            else if (col0 < 3072) dst = vsb + (size_t)row * 1024 + (col0 - 2048);
            else if (col0 < 3584) dst = cq + (size_t)row * 512 + (col0 - 3072);
            else dst = ckv + (size_t)row * 256 + (col0 - 3584);
            *(uint4*)dst = w;
            if (col0 >= 3072) {
                float ss = lo_f(w.x) * lo_f(w.x) + hi_f(w.x) * hi_f(w.x) + lo_f(w.y) * lo_f(w.y) + hi_f(w.y) * hi_f(w.y)
                         + lo_f(w.z) * lo_f(w.z) + hi_f(w.z) * hi_f(w.z) + lo_f(w.w) * lo_f(w.w) + hi_f(w.w) * hi_f(w.w);
                ss += __shfl_xor(ss, 16); ss += __shfl_xor(ss, 32);
                if ((tid_fresh(0) & 48) == 0) rsp[(size_t)row * 24 + ((col0 - 3072) >> 5)] = ss;
            }
        } else {
            const int e0 = col0 - 3840, i0 = e0 >> 1;
            float o[8];
#pragma unroll
            for (int j = 0; j < 4; ++j) {
                const float cs = cosT[(size_t)row * 32 + i0 + j], sn = sinT[(size_t)row * 32 + i0 + j];
                const float x1 = v[2 * j], x2 = v[2 * j + 1];
                o[2 * j] = x1 * cs - x2 * sn; o[2 * j + 1] = x2 * cs + x1 * sn;
            }
            w.x = pack2(o[0], o[1]); w.y = pack2(o[2], o[3]); w.z = pack2(o[4], o[5]); w.w = pack2(o[6], o[7]);
#pragma unroll
            for (int h = 0; h < 8; ++h) *(uint4*)(kmla + (size_t)row * 1536 + h * 192 + 128 + e0) = w;
        }
    }
};
struct EpiUq {
    static constexpr bool HAS_MID = false;
    bf16_t* qmla; const float *rsp, *cosT, *sinT; const LAS float* tab; int tab_pm;
    __device__ __forceinline__ float mid_scale(int) const { return 1.0f; }
    __device__ __forceinline__ float slow_scale(int row) const { float s = 0.f;
#pragma unroll
        for (int i = 0; i < 16; ++i) s += rsp[(size_t)row * 24 + i];
        return rsqrtf(s * (1.0f / 512.0f) + EPS) * QS_MLA; }
    __device__ __forceinline__ float row_scale(int row) const { return (row >> 8) == tab_pm ? tab[row & 255] : slow_scale(row); }
    __device__ __forceinline__ void store8(int row, int col0, const float (&v)[8], float r) const {
        const int d0 = col0 % 192;
        float o[8];
        if (d0 < 128) {
#pragma unroll
            for (int j = 0; j < 8; ++j) o[j] = v[j] * r;
        } else {
            const int i0 = (d0 - 128) >> 1;
#pragma unroll
            for (int j = 0; j < 4; ++j) {
                const float cs = cosT[(size_t)row * 32 + i0 + j], sn = sinT[(size_t)row * 32 + i0 + j];
                const float x1 = v[2 * j], x2 = v[2 * j + 1];
                o[2 * j] = (x1 * cs - x2 * sn) * r; o[2 * j + 1] = (x2 * cs + x1 * sn) * r;
            }
        }
        uint4 w; w.x = pack2(o[0], o[1]); w.y = pack2(o[2], o[3]); w.z = pack2(o[4], o[5]); w.w = pack2(o[6], o[7]);
        *(uint4*)(qmla + (size_t)row * 1536 + col0) = w;
    }
};
struct EpiUkv {
    static constexpr bool HAS_MID = false;
    bf16_t *kmla, *vmla; const float* rsp; const LAS float* tab; int tab_pm;
    __device__ __forceinline__ float mid_scale(int) const { return 1.0f; }
    __device__ __forceinline__ float slow_scale(int row) const { float s = 0.f;
#pragma unroll
        for (int i = 0; i < 8; ++i) s += rsp[(size_t)row * 24 + 16 + i];
        return rsqrtf(s * (1.0f / 256.0f) + EPS); }
    __device__ __forceinline__ float row_scale(int row) const { return (row >> 8) == tab_pm ? tab[row & 255] : slow_scale(row); }
    __device__ __forceinline__ void store8(int row, int col0, const float (&v)[8], float r) const {
        const int h = col0 >> 8, j0 = col0 & 255;
        uint4 w; w.x = pack2(v[0] * r, v[1] * r); w.y = pack2(v[2] * r, v[3] * r); w.z = pack2(v[4] * r, v[5] * r); w.w = pack2(v[6] * r, v[7] * r);
        bf16_t* dst = j0 < 128 ? kmla + (size_t)row * 1536 + h * 192 + j0 : vmla + (size_t)row * 1024 + h * 128 + (j0 - 128);
        *(uint4*)dst = w;
    }
};
struct EpiWo {
    static constexpr bool HAS_MID = true;
    const float* x; const float* mod; bf16_t* x1; const float* ssq; const LAS float* tab; int tab_pm;
    __device__ __forceinline__ void rstd2(int row, float& r0, float& r1) const { float s0 = 0.f, s1 = 0.f;
#pragma unroll
        for (int h = 0; h < 8; ++h) { s0 += ssq[(size_t)row * 16 + h]; s1 += ssq[(size_t)row * 16 + 8 + h]; }
        r0 = rsqrtf(s0 * (1.0f / 1024.0f) + EPS); r1 = rsqrtf(s1 * (1.0f / 1024.0f) + EPS); }
    __device__ __forceinline__ float mid_scale(int row) const { if ((row >> 8) == tab_pm) return tab[2 * (row & 255)]; float r0, r1; rstd2(row, r0, r1); return r0 / r1; }
    __device__ __forceinline__ float row_scale(int row) const { if ((row >> 8) == tab_pm) return tab[2 * (row & 255) + 1]; float r0, r1; rstd2(row, r0, r1); return r1; }
    __device__ __forceinline__ void store8(int row, int col0, const float (&vin)[8], float rsc) const {
        float v[8];
#pragma unroll
        for (int i = 0; i < 8; ++i) v[i] = vin[i] * rsc;
        const int b = row >> 12;
        const float* g1 = mod + (size_t)b * 12288 + 2 * 2048 + col0;
        const float4 xa = *(const float4*)(x + (size_t)row * DM + col0), xb = *(const float4*)(x + (size_t)row * DM + col0 + 4);
        const float4 ga = *(const float4*)g1, gb = *(const float4*)(g1 + 4);
        float4 oa, ob;
        oa.x = xa.x + ga.x * v[0]; oa.y = xa.y + ga.y * v[1]; oa.z = xa.z + ga.z * v[2]; oa.w = xa.w + ga.w * v[3];
        ob.x = xb.x + gb.x * v[4]; ob.y = xb.y + gb.y * v[5]; ob.z = xb.z + gb.z * v[6]; ob.w = xb.w + gb.w * v[7];
        uint4 w; w.x = pack2(oa.x, oa.y); w.y = pack2(oa.z, oa.w); w.z = pack2(ob.x, ob.y); w.w = pack2(ob.z, ob.w);
        *(uint4*)(x1 + (size_t)row * DM + col0) = w;
    }
};
struct EpiQp {
    static constexpr bool HAS_MID = false;
    bf16_t* qp;
    __device__ __forceinline__ float row_scale(int) const { return 1.0f; }
    __device__ __forceinline__ float mid_scale(int) const { return 1.0f; }
    __device__ __forceinline__ void store8(int row, int col0, const float (&v)[8], float) const {
        uint4 w; w.x = pack2(v[0], v[1]); w.y = pack2(v[2], v[3]); w.z = pack2(v[4], v[5]); w.w = pack2(v[6], v[7]);
        *(uint4*)(qp + (size_t)row * DM + col0) = w;
    }
};

namespace pg8 {
#define PG8_LAS __attribute__((address_space(3)))
typedef unsigned short bf16_t;
typedef short bf16x8 __attribute__((ext_vector_type(8)));
typedef float f32x4 __attribute__((ext_vector_type(4)));
typedef unsigned u32x4 __attribute__((ext_vector_type(4)));
constexpr int BM = 256, BK = 64, HALF = 128, HTB = HALF * BK * 2  , STAGE_BYTES = 8 * HTB, NXCD = 8, WGM = 8;

__host__ __device__ __forceinline__ int lds_byte(int r, int c) { const int st = (r >> 4) * 2 + (c >> 5), rr = r & 15, cc = c & 31, ob = rr * 64 + cc * 2; return st * 1024 + (ob ^ (((ob >> 9) & 1) << 5)); }
__host__ __device__ __forceinline__ void stage_rc(int b, int& R, int& C) { const int st = b / 1024, sb = b % 1024, swz = sb ^ (((sb >> 9) & 1) << 5); R = (st >> 1) * 16 + swz / 64; C = (st & 1) * 32 + (swz % 64) / 2; }
__host__ __device__ __forceinline__ int perm32(int rho) { const int n = rho >> 4, i = rho & 15; return 8 * (i >> 2) + 4 * n + (i & 3); }

struct Unit { int pm, pn; };
struct Gemm { const bf16_t* A; const bf16_t* Bt; int M, N, K, widx; };

struct StaticOrder {
    int nM, nN, nwg, G, c;
    __host__ __device__ __forceinline__ void init(int M, int N, int G_, int c_) { nM = M / BM; nN = N / BM; nwg = nM * nN; G = G_; c = c_; }
    __host__ __device__ bool next(int i, Unit& u) const {
        const long L = (long)i * G + c; if (L >= nwg) return false;
        int wgid = (int)L; { const int q = nwg / NXCD, r = nwg % NXCD, xcd = wgid % NXCD, off = wgid / NXCD; wgid = (xcd < r ? xcd * (q + 1) : r * (q + 1) + (xcd - r) * q) + off; }
        const int nig = WGM * nN, gid = wgid / nig, fm = gid * WGM, gsz = (nM - fm) < WGM ? (nM - fm) : WGM;
        u.pm = fm + ((wgid % nig) % gsz); u.pn = (wgid % nig) / gsz; return true;
    }
    __device__ __forceinline__ void a_ready(const Unit&) const {}
    __device__ __forceinline__ void done(const Unit&) const {}
};

template <class Epi, class Sched, bool ALIGN_EPI = false, bool SP2 = false>
__device__ __forceinline__ void gemm_phase(PG8_LAS unsigned char* lds, const Gemm g, const Sched& S, const Epi& E) {
    const int tid = tid_fresh(g.widx), wid = __builtin_amdgcn_readfirstlane(tid >> 6), lane = tid & 63, wr = wid >> 2, wc = wid & 3, fr = lane & 15, fq = lane >> 4;
    const int K = g.K, nt = K / BK;
    unsigned voffA[2], voffB[2];
#pragma unroll
    for (int i = 0; i < 2; ++i) { int R, C; stage_rc(tid * 16 + i * 8192, R, C); const int Rb = Epi::PERM ? ((R & ~31) + perm32(R & 31)) : R;
        voffA[i] = (unsigned)(R * K + C) * 2u; voffB[i] = (unsigned)(Rb * K + C) * 2u; }
    const size_t kstep = (size_t)(BK * 2);
    const size_t hstep = (size_t)HALF * K * 2;
    const size_t tstep = 2 * hstep;
    const unsigned ldsw = (unsigned)wid * 1024u;
    const int aoff = lds_byte(wr * 64 + fr, fq * 8), boff = lds_byte(wc * 32 + fr, fq * 8);
#define PG8_SA(b, h) (((b) * 2 + (h)) * HTB)
#define PG8_SB(b, h) ((4 + (b) * 2 + (h)) * HTB)
#define PG8_STAGE(bufoff, gbase, voff) do { _Pragma("unroll") for (int _i = 0; _i < 2; ++_i) \
        __builtin_amdgcn_global_load_lds((const unsigned*)((const char*)(gbase) + (voff)[_i]), (PG8_LAS unsigned*)(lds + (bufoff) + ldsw + _i * 8192), 16, 0, 0); } while (0)
#define PG8_LDA(dst, b, h) do { _Pragma("unroll") for (int m = 0; m < 4; ++m) _Pragma("unroll") for (int k = 0; k < 2; ++k) dst[m][k] = *(const PG8_LAS bf16x8*)(lds + PG8_SA(b, h) + aoff + m * 2048 + k * 1024); } while (0)
#define PG8_LDB(dst, b, h) do { _Pragma("unroll") for (int n = 0; n < 2; ++n) _Pragma("unroll") for (int k = 0; k < 2; ++k) dst[n][k] = *(const PG8_LAS bf16x8*)(lds + PG8_SB(b, h) + boff + n * 2048 + k * 1024); } while (0)
#define PG8_MMA(ai, bj, At, Bt) do { __builtin_amdgcn_s_setprio(1); _Pragma("unroll") for (int m = 0; m < 4; ++m) _Pragma("unroll") for (int n = 0; n < 2; ++n) _Pragma("unroll") for (int k = 0; k < 2; ++k) \
        acc[ai][bj][m][n] = __builtin_amdgcn_mfma_f32_16x16x32_bf16(Bt[n][k], At[m][k], acc[ai][bj][m][n], 0, 0, 0); __builtin_amdgcn_s_setprio(0); } while (0)
#define PG8_WAIT_V(n) asm volatile("s_waitcnt vmcnt(" #n ")" ::: "memory")
#define PG8_WAIT_L(n) asm volatile("s_waitcnt lgkmcnt(" #n ")" ::: "memory")
#define PG8_BAR __builtin_amdgcn_s_barrier()
#define PG8_SCHED __builtin_amdgcn_sched_barrier(0)
    Unit cur, nxt; int ui = 0;
    if (!S.next(0, cur)) return;
    f32x4 acc[2][2][4][2];
#pragma unroll
    for (int a = 0; a < 2; ++a)
#pragma unroll
        for (int b = 0; b < 2; ++b)
#pragma unroll
            for (int m = 0; m < 4; ++m)
#pragma unroll
                for (int n = 0; n < 2; ++n) acc[a][b][m][n] = (f32x4){0.f, 0.f, 0.f, 0.f};
    bf16x8 At[4][2], B0[2][2], B1[2][2];
    const char* cA = (const char*)g.A + (size_t)cur.pm * tstep; const char* cB = (const char*)g.Bt + (size_t)cur.pn * tstep;
    S.a_ready(cur);
    if constexpr (SP2) {
        PG8_STAGE(PG8_SB(0, 0), cB, voffB); PG8_STAGE(PG8_SB(0, 1), cB + hstep, voffB); PG8_STAGE(PG8_SA(0, 0), cA, voffA); PG8_STAGE(PG8_SA(0, 1), cA + hstep, voffA);
        if (wr == 1) PG8_BAR;
        PG8_WAIT_V(2); PG8_BAR;
        PG8_STAGE(PG8_SB(1, 0), cB + kstep, voffB); PG8_STAGE(PG8_SA(1, 0), cA + kstep, voffA); PG8_STAGE(PG8_SB(1, 1), cB + hstep + kstep, voffB);
        PG8_WAIT_V(6); PG8_BAR;
    } else {
        PG8_STAGE(PG8_SB(0, 0), cB, voffB); PG8_STAGE(PG8_SA(0, 0), cA, voffA); PG8_STAGE(PG8_SB(0, 1), cB + hstep, voffB); PG8_STAGE(PG8_SA(0, 1), cA + hstep, voffA);
        if (wr == 1) PG8_BAR;
        PG8_WAIT_V(4); PG8_BAR;
        PG8_STAGE(PG8_SB(1, 0), cB + kstep, voffB); PG8_STAGE(PG8_SA(1, 0), cA + kstep, voffA); PG8_STAGE(PG8_SB(1, 1), cB + hstep + kstep, voffB);
        PG8_WAIT_V(6); PG8_BAR;
    }
    for (;;) {
        const bool has_next = S.next(ui + 1, nxt);
        const char* nA = has_next ? (const char*)g.A + (size_t)nxt.pm * tstep : cA; const char* nB = has_next ? (const char*)g.Bt + (size_t)nxt.pn * tstep : cB;
        for (int t = 0; t < nt; t += 2) {
            const bool last = (t == nt - 2);
            const char* a1 = cA + (size_t)(t + 1) * kstep;
            const char* a2 = last ? nA : cA + (size_t)(t + 2) * kstep; const char* b2 = last ? nB : cB + (size_t)(t + 2) * kstep;
            const char* a3 = a2 + kstep; const char* b3 = b2 + kstep;
            if (last && has_next) S.a_ready(nxt);
            if constexpr (Epi::HAS_MID) { if (t == (nt >> 1)) E.mid(acc, cur, wr, wc, fr, fq); }
            if constexpr (SP2) {
            PG8_LDB(B0, 0, 0); PG8_LDB(B1, 0, 1); PG8_SCHED; PG8_LDA(At, 0, 0); PG8_STAGE(PG8_SA(1, 1), a1 + hstep, voffA);
            PG8_WAIT_V(8); PG8_WAIT_L(0); PG8_BAR; PG8_MMA(0, 0, At, B0); PG8_MMA(0, 1, At, B1); PG8_BAR; PG8_SCHED;
            PG8_LDA(At, 0, 1); PG8_STAGE(PG8_SB(0, 0), b2, voffB); PG8_STAGE(PG8_SB(0, 1), b2 + hstep, voffB); PG8_STAGE(PG8_SA(0, 0), a2, voffA);
            PG8_WAIT_V(8); PG8_WAIT_L(0); PG8_BAR; PG8_MMA(1, 0, At, B0); PG8_MMA(1, 1, At, B1); PG8_BAR; PG8_SCHED;
            PG8_LDB(B0, 1, 0); PG8_LDB(B1, 1, 1); PG8_SCHED; PG8_LDA(At, 1, 0); PG8_STAGE(PG8_SA(0, 1), a2 + hstep, voffA);
            PG8_WAIT_V(8); PG8_WAIT_L(0); PG8_BAR; PG8_MMA(0, 0, At, B0); PG8_MMA(0, 1, At, B1); PG8_BAR; PG8_SCHED;
            PG8_LDA(At, 1, 1); PG8_STAGE(PG8_SB(1, 0), b3, voffB); PG8_STAGE(PG8_SB(1, 1), b3 + hstep, voffB); PG8_STAGE(PG8_SA(1, 0), a3, voffA);
            PG8_WAIT_V(8); PG8_WAIT_L(0); PG8_BAR; PG8_MMA(1, 0, At, B0); PG8_MMA(1, 1, At, B1); PG8_BAR; PG8_SCHED;
            } else {
            PG8_LDB(B0, 0, 0); PG8_SCHED; PG8_LDA(At, 0, 0); PG8_STAGE(PG8_SA(1, 1), a1 + hstep, voffA);
            PG8_WAIT_L(8); PG8_BAR; PG8_WAIT_L(0); PG8_MMA(0, 0, At, B0); PG8_BAR; PG8_SCHED;
            PG8_LDB(B1, 0, 1); PG8_STAGE(PG8_SB(0, 0), b2, voffB);
            PG8_BAR; PG8_WAIT_L(0); PG8_MMA(0, 1, At, B1); PG8_BAR;
            PG8_LDA(At, 0, 1); PG8_STAGE(PG8_SA(0, 0), a2, voffA);
            PG8_BAR; PG8_WAIT_L(0); PG8_MMA(1, 0, At, B0); PG8_BAR; PG8_SCHED;
            PG8_STAGE(PG8_SB(0, 1), b2 + hstep, voffB);
            PG8_WAIT_V(6); PG8_BAR; PG8_MMA(1, 1, At, B1); PG8_BAR;
            PG8_LDB(B0, 1, 0); PG8_SCHED; PG8_LDA(At, 1, 0); PG8_STAGE(PG8_SA(0, 1), a2 + hstep, voffA);
            PG8_WAIT_L(8); PG8_BAR; PG8_WAIT_L(0); PG8_MMA(0, 0, At, B0); PG8_BAR; PG8_SCHED;
            PG8_LDB(B1, 1, 1); PG8_STAGE(PG8_SB(1, 0), b3, voffB);
            PG8_BAR; PG8_WAIT_L(0); PG8_MMA(0, 1, At, B1); PG8_BAR;
            PG8_LDA(At, 1, 1); PG8_STAGE(PG8_SA(1, 0), a3, voffA);
            PG8_BAR; PG8_WAIT_L(0); PG8_MMA(1, 0, At, B0); PG8_BAR; PG8_SCHED;
            PG8_STAGE(PG8_SB(1, 1), b3 + hstep, voffB);
            PG8_WAIT_V(6); PG8_BAR; PG8_MMA(1, 1, At, B1); PG8_BAR;
            }
        }
        if constexpr (ALIGN_EPI) { if (wr == 0) PG8_BAR; }
        if constexpr (!Epi::AFTER_DRAIN) { E(acc, cur, wr, wc, fr, fq); S.done(cur); }
        if (!has_next) break;
#pragma unroll
        for (int a = 0; a < 2; ++a)
#pragma unroll
            for (int b = 0; b < 2; ++b)
#pragma unroll
                for (int m = 0; m < 4; ++m)
#pragma unroll
                    for (int n = 0; n < 2; ++n) acc[a][b][m][n] = (f32x4){0.f, 0.f, 0.f, 0.f};
        cur = nxt; cA = nA; cB = nB; ++ui;
        if constexpr (ALIGN_EPI) { if (wr == 1) PG8_BAR; }
    }
    PG8_WAIT_V(0);
    if constexpr (!ALIGN_EPI) { if (wr == 0) PG8_BAR; }
    PG8_BAR;
    if constexpr (Epi::AFTER_DRAIN) { E.fused(acc, cur, wr, wc, fr, fq, lds, wid, lane); S.done(cur); }
#undef PG8_SA
#undef PG8_SB
#undef PG8_STAGE
#undef PG8_LDA
#undef PG8_LDB
#undef PG8_MMA
#undef PG8_WAIT_V
#undef PG8_WAIT_L
#undef PG8_BAR
#undef PG8_SCHED
}
}

template <class C> struct EpiChunk {
    static constexpr bool PERM = true, AFTER_DRAIN = false, HAS_MID = C::HAS_MID;
    C c;
    __device__ __forceinline__ void mid(pg8::f32x4 (&acc)[2][2][4][2], const pg8::Unit& u, int wr, int wc, int fr, int fq) const {
#pragma unroll
        for (int ai = 0; ai < 2; ++ai)
#pragma unroll
            for (int m = 0; m < 4; ++m) { const float f = c.mid_scale(u.pm * 256 + ai * 128 + wr * 64 + m * 16 + fr);
#pragma unroll
                for (int bj = 0; bj < 2; ++bj)
#pragma unroll
                    for (int n = 0; n < 2; ++n) acc[ai][bj][m][n] = acc[ai][bj][m][n] * f; }
    }
    __device__ __forceinline__ void operator()(const pg8::f32x4 (&acc)[2][2][4][2], const pg8::Unit& u, int wr, int wc, int fr_in, int fq_in) const {
        int fr = fr_in, fq = fq_in; asm volatile("" : "+v"(fr), "+v"(fq));
#pragma unroll
        for (int ai = 0; ai < 2; ++ai)
#pragma unroll
            for (int m = 0; m < 4; ++m) {
                const int row = u.pm * 256 + ai * 128 + wr * 64 + m * 16 + fr;
                const float rsc = c.row_scale(row);
#pragma unroll
                for (int bj = 0; bj < 2; ++bj) {
                    const int col0 = u.pn * 256 + bj * 128 + wc * 32 + 8 * fq;
                    const pg8::f32x4 a = acc[ai][bj][m][0], b = acc[ai][bj][m][1];
                    const float v[8] = {a[0], a[1], a[2], a[3], b[0], b[1], b[2], b[3]};
                    c.store8(row, col0, v, rsc);
                }
                asm volatile("" ::: "memory");
            }
    }
};
template <class C> __device__ __forceinline__ void gemm_mfma(const bf16_t* A, const bf16_t* Bt, int M, int N, int K, const C& c, int bid, int nblk, unsigned char* lds, int widx) {
    pg8::Gemm g; g.A = A; g.Bt = Bt; g.M = M; g.N = N; g.K = K; g.widx = widx;
    pg8::StaticOrder S; S.init(M, N, nblk, bid);
    EpiChunk<C> E{c};
    pg8::gemm_phase<EpiChunk<C>, pg8::StaticOrder, true, true>((PG8_LAS unsigned char*)lds, g, S, E);
}

template <class Epi>
__device__ __forceinline__ void gemm_ref(const bf16_t* A, int lda, const bf16_t* Bt, int ldb, int M, int N, int K, const Epi& E, int bid, int nblk) {
    const int tid = (int)threadIdx.x, tn = N / 64, ntile = (M / 64) * tn;
    for (int tile = bid; tile < ntile; tile += nblk) {
        const int row = (tile / tn) * 64 + (tid >> 3), col0 = (tile % tn) * 64 + (tid & 7) * 8;
        float acc[8];
#pragma unroll
        for (int j = 0; j < 8; ++j) acc[j] = 0.f;
        const bf16_t* ap = A + (size_t)row * lda; const bf16_t* bp = Bt + (size_t)col0 * ldb;
        for (int k0 = 0; k0 < K; k0 += 8) {
            const uint4 av = *(const uint4*)(ap + k0);
#pragma unroll
            for (int j = 0; j < 8; ++j) { const uint4 bv = *(const uint4*)(bp + (size_t)j * ldb + k0); acc[j] += dot8(av, bv); }
        }
        E.store8(row, col0, acc, E.row_scale(row));
    }
}

constexpr int J_ADA = 192, J_WIN = 64, J_WO = 32, J_WPQ = 32, J_WUQ = 24, J_WUKV = 32, J_KEYS = 16, J_ROPE = 256;
constexpr int J0_END = J_ADA, J1_END = J0_END + J_WIN, J2_END = J1_END + J_WO, J3_END = J2_END + J_WPQ, J4_END = J3_END + J_WUQ,
              J5_END = J4_END + J_WUKV, J6_END = J5_END + J_KEYS, J7_END = J6_END + J_ROPE, J8_END = J7_END + 1024;

__device__ __forceinline__ void job_ada(const Params& p, int it, float* lds) {
    const int tid = tid_fresh(p.widx);
    float* sc = lds;
    float* red = lds + 4096;
    for (int i = tid; i < 4096; i += 512) { const float v = p.c[i]; sc[i] = v / (1.0f + __expf(-v)); }
    __syncthreads();
    const int cg = tid & 15, rl = tid >> 4, c0 = it * 64 + cg * 4;
    float4 a0 = {0.f, 0.f, 0.f, 0.f}, a1 = {0.f, 0.f, 0.f, 0.f};
#pragma unroll 8
    for (int i = 0; i < 64; ++i) {
        const int k = rl + 32 * i;
        const float4 w = *(const float4*)(p.w_ada + (size_t)k * 12288 + c0);
        const float s0 = sc[k], s1 = sc[2048 + k];
        a0.x += s0 * w.x; a0.y += s0 * w.y; a0.z += s0 * w.z; a0.w += s0 * w.w;
        a1.x += s1 * w.x; a1.y += s1 * w.y; a1.z += s1 * w.z; a1.w += s1 * w.w;
    }
    float* r0 = red + rl * 128 + cg * 4;
    r0[0] = a0.x; r0[1] = a0.y; r0[2] = a0.z; r0[3] = a0.w; r0[64] = a1.x; r0[65] = a1.y; r0[66] = a1.z; r0[67] = a1.w;
    __syncthreads();
    if (tid < 128) {
        float s = 0.f;
        for (int r = 0; r < 32; ++r) s += red[r * 128 + tid];
        const int b = tid >> 6, col = it * 64 + (tid & 63);
        WS<float>(p, OFF_MOD)[(size_t)b * 12288 + col] = s + p.b_ada[col];
    }
    __syncthreads();
}

template <int W> __device__ __forceinline__ int tr_dst_row(int n) {
    if (W == 0) { if (n < 3840) return n; const int e = n - 3840; return 3840 + 2 * (e & 31) + (e >> 5); }
    if (W == 3) { const int h = n / 192, d = n % 192; if (d < 128) return n; const int e = d - 128; return h * 192 + 128 + 2 * (e & 31) + (e >> 5); }
    return n;
}
template <int W> __device__ __forceinline__ float tr_scale(const Params& p, int k) {
    if (W == 1) return k < 1024 ? p.osb_g[k] : p.omla_g[k - 1024];
    if (W == 3) return p.qn_g[k];
    if (W == 4) return p.kvn_g[k];
    return 1.0f;
}
template <int W> __device__ __forceinline__ void job_transpose(const Params& p, int it, float* tile) {
    constexpr int K = (W == 3) ? 512 : (W == 4) ? 256 : 2048;
    constexpr int NS = (W == 0) ? NIN : (W == 3) ? 1536 : 2048;
    constexpr int TS = 68;
    const float* src = (W == 0) ? p.w_in : (W == 1) ? p.w_o : (W == 2) ? p.w_pq : (W == 3) ? p.w_uq : p.w_ukv;
    bf16_t* dst = WS<bf16_t>(p, (W == 0) ? OFF_WIN_T : (W == 1) ? OFF_WO_T : (W == 2) ? OFF_WPQ_T : (W == 3) ? OFF_WUQ_T : OFF_WUKV_T);
    const int tid = tid_fresh(p.widx), n0 = it * 64;
    if (W == 0 && n0 >= NIN) {
        const uint4 z = {0u, 0u, 0u, 0u};
        for (int i = tid; i < 64 * K / 8; i += 512) *(uint4*)(dst + (size_t)n0 * K + (size_t)i * 8) = z;
        return;
    }
    const int lr = tid >> 4, lc = (tid & 15) * 4;
    const int sn = tid >> 3, skc = tid & 7;
    const size_t drow = (size_t)tr_dst_row<W>(n0 + sn) * K;
    for (int k0 = 0; k0 < K; k0 += 256) {
        float4 r[8];
#pragma unroll
        for (int i = 0; i < 8; ++i) r[i] = *(const float4*)(src + (size_t)(k0 + lr + 32 * i) * NS + n0 + lc);
#pragma unroll
        for (int i = 0; i < 8; ++i) *(float4*)(tile + (lr + 32 * i) * TS + lc) = r[i];
        __syncthreads();
#pragma unroll
        for (int q = 0; q < 4; ++q) {
            const int kk = skc * 32 + q * 8;
            float v[8];
#pragma unroll
            for (int j = 0; j < 8; ++j) v[j] = tile[(kk + j) * TS + sn] * tr_scale<W>(p, k0 + kk + j);
            uint4 w; w.x = pack2(v[0], v[1]); w.y = pack2(v[2], v[3]); w.z = pack2(v[4], v[5]); w.w = pack2(v[6], v[7]);
            *(uint4*)(dst + drow + k0 + kk) = w;
        }
        __syncthreads();
    }
}
__device__ __forceinline__ void job_keys(const Params& p, int slot) {
    const float* src = ((slot & 1) ? p.keys2 : p.keys1) + (size_t)(slot >> 1) * 16384;
    bf16_t* dst = WS<bf16_t>(p, OFF_KEYS) + (size_t)slot * 16384;
    for (int i = tid_fresh(p.widx); i < 16384; i += 512) dst[i] = f2bf(src[i]);
}
__device__ __forceinline__ void job_rope(const Params& p, int it) {
    float* cosT = WS<float>(p, OFF_COS); float* sinT = WS<float>(p, OFF_SIN);
    const int tid = tid_fresh(p.widx), i = tid & 31;
    double inv = 1.0;
    for (int q = 0; q < i; ++q) inv *= 0.7498942093324559;
#pragma unroll
    for (int j = 0; j < 2; ++j) {
        const int t = it * 32 + ((tid + 512 * j) >> 5);
        const double ang = (double)p.pos[t] * inv;
        const double n = rint(ang * 0.15915494309189535);
        const double r = fma(-n, 6.283185307179586, ang) - n * 2.4492935982947064e-16;
        const float rf = (float)r;
        cosT[(size_t)t * 32 + i] = cosf(rf); sinT[(size_t)t * 32 + i] = sinf(rf);
    }
}
template <int EB> __device__ __forceinline__ void job_table(const Params& p, int it);
__device__ __forceinline__ void job_table6(const Params& p, int it);
__device__ __forceinline__ void phase0(const Params& p, int bid, int nblk, float* lds) {
    constexpr int V1 = J_WIN, V2 = V1 + J_WO, V3 = V2 + J_WPQ, V4 = V3 + J_ADA, V5 = V4 + J_WUQ, V6 = V5 + J_WUKV, V7 = V6 + J_KEYS, V8 = V7 + J_ROPE;
    for (int r = 0; r * nblk < V8; ++r) {
        const int v = r * nblk + ((r & 1) ? nblk - 1 - bid : bid);
        if (v >= V8) continue;
        if (v < V1) job_transpose<0>(p, v, lds);
        else if (v < V2) job_transpose<1>(p, v - V1, lds);
        else if (v < V3) job_transpose<2>(p, v - V2, lds);
        else if (v < V4) job_ada(p, v - V3, lds);
        else if (v < V5) job_transpose<3>(p, v - V4, lds);
        else if (v < V6) job_transpose<4>(p, v - V5, lds);
        else if (v < V7) job_keys(p, v - V6);
        else job_rope(p, v - V7);
    }
}

template <class TS> __device__ __forceinline__ void phase_norm_mod(const Params& p, const TS* src, const float* gain, int sh_idx, int sc_idx, bf16_t* dst, int bid, int nblk, float* lds) {
    const int tid = tid_fresh(p.widx), lane = tid & 63, wid = tid >> 6;
    const float* mod = WS<float>(p, OFF_MOD);
    float* av = lds;
    float* sv = lds + 4096;
    for (int i = tid; i < 4096; i += 512) { const int b = i >> 11, col = i & 2047;
        av[i] = gain[col] * (1.0f + mod[(size_t)b * 12288 + sc_idx * 2048 + col]); sv[i] = mod[(size_t)b * 12288 + sh_idx * 2048 + col]; }
    __syncthreads();
    for (int t = bid * 8 + wid; t < TOK; t += nblk * 8) {
        const int b = t >> 12;
        const TS* xr = src + (size_t)t * DM;
        float4 v[8]; float ss = 0.f;
#pragma unroll
        for (int j = 0; j < 8; ++j) {
            if constexpr (sizeof(TS) == 4) v[j] = *(const float4*)(xr + (j * 64 + lane) * 4);
            else { const uint2 w = *(const uint2*)(xr + (j * 64 + lane) * 4); v[j].x = lo_f(w.x); v[j].y = hi_f(w.x); v[j].z = lo_f(w.y); v[j].w = hi_f(w.y); }
            ss += v[j].x * v[j].x + v[j].y * v[j].y + v[j].z * v[j].z + v[j].w * v[j].w; }
        ss = wave_sum(ss);
        const float rstd = rsqrtf(ss * (1.0f / DM) + EPS);
#pragma unroll
        for (int j = 0; j < 8; ++j) {
            const int col = (j * 64 + lane) * 4;
            const float4 a = *(const float4*)(av + b * 2048 + col), s = *(const float4*)(sv + b * 2048 + col);
            uint2 w; w.x = pack2(v[j].x * rstd * a.x + s.x, v[j].y * rstd * a.y + s.y); w.y = pack2(v[j].z * rstd * a.z + s.z, v[j].w * rstd * a.w + s.w);
            *(uint2*)(dst + (size_t)t * DM + col) = w;
        }
    }
    __syncthreads();
}

__device__ __forceinline__ void phase_rowstats(const Params& p, int bid, int nblk) {
    const int tidf = tid_fresh(p.widx), lane = tidf & 63, wid = tidf >> 6;
    const bf16_t* cq = WS<bf16_t>(p, OFF_CQ); const bf16_t* ckv = WS<bf16_t>(p, OFF_CKV);
    for (int t = bid * 8 + wid; t < TOK; t += nblk * 8) {
        const uint4 a = *(const uint4*)(cq + (size_t)t * 512 + lane * 8);
        float s1 = dot8(a, a), s2 = 0.f;
        if (lane < 32) { const uint4 b = *(const uint4*)(ckv + (size_t)t * 256 + lane * 8); s2 = dot8(b, b); }
        s1 = wave_sum(s1); s2 = wave_sum(s2);
        if (lane == 0) { WS<float>(p, OFF_RSQ)[t] = rsqrtf(s1 * (1.0f / 512.0f) + EPS); WS<float>(p, OFF_RSKV)[t] = rsqrtf(s2 * (1.0f / 256.0f) + EPS); }
    }
}

__device__ __forceinline__ void phase_attn_ref(const Params& p, int bid, int nblk) {
    const int tid = tid_fresh(p.widx), ql = tid >> 2, part = tid & 3;
    const bf16_t* qsb = WS<bf16_t>(p, OFF_QSB); const bf16_t* ksb = WS<bf16_t>(p, OFF_KSB); const bf16_t* vsb = WS<bf16_t>(p, OFF_VSB);
    const bf16_t* qml = WS<bf16_t>(p, OFF_QMLA); const bf16_t* kml = WS<bf16_t>(p, OFF_KMLA); const bf16_t* vml = WS<bf16_t>(p, OFF_VMLA);
    bf16_t* O = WS<bf16_t>(p, OFF_O); float* ssq = WS<float>(p, OFF_SSQ);
    for (int it = bid; it < 1024; it += nblk) {
        const int g = it >> 9, rem = it & 511, b = rem >> 8, h = (rem >> 5) & 7, qb = 31 - (rem & 31);
        const int t = qb * 128 + ql; const size_t tok = (size_t)b * SEQ + t;
        const int tmax = qb * 128 + (ql | 15);
        float o[32];
#pragma unroll
        for (int d = 0; d < 32; ++d) o[d] = 0.f;
        if (g == 0) {
            uint4 q[4];
#pragma unroll
            for (int j = 0; j < 4; ++j) q[j] = *(const uint4*)(qsb + tok * 1024 + h * 128 + part * 32 + j * 8);
            float between = 0.f;
            for (int s = tmax - 1; s >= 0; --s) {
                const size_t kt = (size_t)b * SEQ + s;
                float z2 = 0.f;
#pragma unroll
                for (int j = 0; j < 4; ++j) z2 += dot8(q[j], *(const uint4*)(ksb + kt * 1024 + h * 128 + part * 32 + j * 8));
                z2 += __shfl_xor(z2, 1); z2 += __shfl_xor(z2, 2);
                if (s < t) {
                    const float z = z2 * LN2;
                    const float l1p = log1pf(__expf(-fabsf(z)));
                    const float lsig = fminf(z, 0.f) - l1p, lsign = -fmaxf(z, 0.f) - l1p;
                    const float w = __expf(lsig + between);
                    between += lsign;
#pragma unroll
                    for (int j = 0; j < 4; ++j) { const uint4 vv = *(const uint4*)(vsb + kt * 1024 + h * 128 + part * 32 + j * 8);
                        o[j * 8 + 0] += w * lo_f(vv.x); o[j * 8 + 1] += w * hi_f(vv.x); o[j * 8 + 2] += w * lo_f(vv.y); o[j * 8 + 3] += w * hi_f(vv.y);
                        o[j * 8 + 4] += w * lo_f(vv.z); o[j * 8 + 5] += w * hi_f(vv.z); o[j * 8 + 6] += w * lo_f(vv.w); o[j * 8 + 7] += w * hi_f(vv.w); }
                }
            }
        } else {
            uint4 q[6];
#pragma unroll
            for (int j = 0; j < 6; ++j) q[j] = *(const uint4*)(qml + tok * 1536 + h * 192 + part * 48 + j * 8);
            float m = -1e30f, l = 0.f;
            for (int s = 0; s <= tmax; ++s) {
                const size_t kt = (size_t)b * SEQ + s;
                float sc = 0.f;
#pragma unroll
                for (int j = 0; j < 6; ++j) sc += dot8(q[j], *(const uint4*)(kml + kt * 1536 + h * 192 + part * 48 + j * 8));
                sc += __shfl_xor(sc, 1); sc += __shfl_xor(sc, 2);
                if (s <= t) {
                    const float mn = fmaxf(m, sc), alpha = exp2f(m - mn), pw = exp2f(sc - mn);
                    l = l * alpha + pw; m = mn;
#pragma unroll
                    for (int j = 0; j < 4; ++j) { const uint4 vv = *(const uint4*)(vml + kt * 1024 + h * 128 + part * 32 + j * 8);
                        o[j * 8 + 0] = o[j * 8 + 0] * alpha + pw * lo_f(vv.x); o[j * 8 + 1] = o[j * 8 + 1] * alpha + pw * hi_f(vv.x);
                        o[j * 8 + 2] = o[j * 8 + 2] * alpha + pw * lo_f(vv.y); o[j * 8 + 3] = o[j * 8 + 3] * alpha + pw * hi_f(vv.y);
                        o[j * 8 + 4] = o[j * 8 + 4] * alpha + pw * lo_f(vv.z); o[j * 8 + 5] = o[j * 8 + 5] * alpha + pw * hi_f(vv.z);
                        o[j * 8 + 6] = o[j * 8 + 6] * alpha + pw * lo_f(vv.w); o[j * 8 + 7] = o[j * 8 + 7] * alpha + pw * hi_f(vv.w); }
                }
            }
            const float inv = 1.0f / l;
#pragma unroll
            for (int d = 0; d < 32; ++d) o[d] *= inv;
        }
        float ss = 0.f;
#pragma unroll
        for (int d = 0; d < 32; ++d) ss += o[d] * o[d];
        ss += __shfl_xor(ss, 1); ss += __shfl_xor(ss, 2);
        if (part == 0) ssq[tok * 16 + g * 8 + h] = ss;
        bf16_t* op = O + tok * 2048 + g * 1024 + h * 128 + part * 32;
#pragma unroll
        for (int j = 0; j < 4; ++j) { uint4 w; w.x = pack2(o[j * 8], o[j * 8 + 1]); w.y = pack2(o[j * 8 + 2], o[j * 8 + 3]); w.z = pack2(o[j * 8 + 4], o[j * 8 + 5]); w.w = pack2(o[j * 8 + 6], o[j * 8 + 7]);
            *(uint4*)(op + j * 8) = w; }
    }
}


typedef short bf16x8_t __attribute__((ext_vector_type(8)));
typedef short s16x4_t __attribute__((ext_vector_type(4)));
typedef float f32x16_t __attribute__((ext_vector_type(16)));
typedef float f32x2_t __attribute__((ext_vector_type(2)));
typedef unsigned u32x4_t __attribute__((ext_vector_type(4)));
typedef __bf16 bf16x2_t __attribute__((ext_vector_type(2)));
__device__ __forceinline__ unsigned cvt_pk_bf16(float lo, float hi) { f32x2_t v = {lo, hi}; bf16x2_t b = __builtin_convertvector(v, bf16x2_t); return __builtin_bit_cast(unsigned, b); }
__device__ __forceinline__ void swap32(float a, float& lo, float& hi) {
    auto r = __builtin_amdgcn_permlane32_swap(__float_as_uint(a), __float_as_uint(a), false, false);
    lo = __uint_as_float(r[0]); hi = __uint_as_float(r[1]);
}
constexpr int LDS_TAB_OFF = 131072 + 16;
constexpr int ATT_VSTR = 320;
constexpr int ATT_STAGE_MAX = 64 * (192 * 2 + 16) + 64 * ATT_VSTR;
constexpr int ATT_BC_OFF = 2 * 64 * (192 * 2 + 16) + 3 * 64 * ATT_VSTR;
constexpr int ATT_HEAD_WORD = 3840;

template <int G>
__device__ __forceinline__ void attn_qk(const LAS unsigned char* kbuf, const bf16x8_t (&qf)[G ? 12 : 8], f32x16_t& s0, f32x16_t& s1, unsigned kread) {
    constexpr int DK = G ? 192 : 128, NKS = DK / 16, KSTR = DK * 2 + 16;
#pragma unroll
    for (int r = 0; r < 16; ++r) { s0[r] = 0.f; s1[r] = 0.f; }
    const LAS unsigned char* kp = kbuf + kread;
#pragma unroll
    for (int ks = 0; ks < NKS; ++ks) {
        const bf16x8_t a0 = *(const LAS bf16x8_t*)(kp + ks * 32), a1 = *(const LAS bf16x8_t*)(kp + 32 * KSTR + ks * 32);
        s0 = __builtin_amdgcn_mfma_f32_32x32x16_bf16(a0, qf[ks], s0, 0, 0, 0);
        s1 = __builtin_amdgcn_mfma_f32_32x32x16_bf16(a1, qf[ks], s1, 0, 0, 0);
    }
    __builtin_amdgcn_sched_group_barrier(0x100, 6, 0);
#pragma unroll
    for (int i = 0; i < 2 * NKS - 6; ++i) { __builtin_amdgcn_sched_group_barrier(0x8, 1, 0); __builtin_amdgcn_sched_group_barrier(0x100, 1, 0); }
#pragma unroll
    for (int i = 0; i < 6; ++i) __builtin_amdgcn_sched_group_barrier(0x8, 1, 0);
}
template <int G>
__device__ __forceinline__ void attn_sm(bool need_mask, f32x16_t& s0, f32x16_t& s1, unsigned (&pk)[2][8], f32x16_t (&o)[4], float& st0, float& st1, int lim, int hh) {
    if (need_mask) {
        asm volatile("" ::: "memory");
        const float neg = G ? -INFINITY : -100.0f;
#pragma unroll
        for (int r = 0; r < 16; ++r) { const int kr = (r & 3) + 8 * (r >> 2) + 4 * hh;
            s0[r] = (G ? (kr <= lim) : (kr < lim)) ? s0[r] : neg; s1[r] = (G ? (32 + kr <= lim) : (32 + kr < lim)) ? s1[r] : neg; }
    }
    if (G == 0) {
        float R = st0;
#pragma unroll
        for (int kb = 1; kb >= 0; --kb) {
#pragma unroll
            for (int g = 3; g >= 0; --g) {
                float sg[4], om[4];
#pragma unroll
                for (int rr = 0; rr < 4; ++rr) {
                    const float z2 = kb ? s1[4 * g + rr] : s0[4 * g + rr];
                    const float e = __builtin_amdgcn_exp2f(-z2);
                    const float sig = __builtin_amdgcn_rcpf(1.0f + e);
                    sg[rr] = sig; om[rr] = e * sig;
                }
                const float gown = (om[0] * om[1]) * (om[2] * om[3]);
                float glo, ghi; swap32(gown, glo, ghi);
                const float E = hh ? R : R * ghi;
                const float e2 = E * om[3], e1 = e2 * om[2], e0 = e1 * om[1];
                pk[kb][2 * g] = cvt_pk_bf16(sg[0] * e0, sg[1] * e1); pk[kb][2 * g + 1] = cvt_pk_bf16(sg[2] * e2, sg[3] * E);
                R = R * (glo * ghi);
            }
        }
        st0 = R;
    } else {
        float mx = fmaxf(s0[0], s1[0]);
#pragma unroll
        for (int r = 1; r < 16; ++r) mx = fmaxf(mx, fmaxf(s0[r], s1[r]));
        float mlo, mhi; swap32(mx, mlo, mhi);
        const float mn = fmaxf(st0, fmaxf(mlo, mhi)), alpha = __builtin_amdgcn_exp2f(st0 - mn);
        st0 = mn;
        float ls = 0.f;
#pragma unroll
        for (int g = 0; g < 4; ++g) {
            float a[4], bq[4];
#pragma unroll
            for (int rr = 0; rr < 4; ++rr) { a[rr] = __builtin_amdgcn_exp2f(s0[4 * g + rr] - mn); bq[rr] = __builtin_amdgcn_exp2f(s1[4 * g + rr] - mn); ls += a[rr] + bq[rr]; }
            pk[0][2 * g] = cvt_pk_bf16(a[0], a[1]); pk[0][2 * g + 1] = cvt_pk_bf16(a[2], a[3]);
            pk[1][2 * g] = cvt_pk_bf16(bq[0], bq[1]); pk[1][2 * g + 1] = cvt_pk_bf16(bq[2], bq[3]);
        }
        st1 = st1 * alpha + ls;
        if (__builtin_amdgcn_ballot_w64(alpha != 1.0f) != 0ull) {
#pragma unroll
            for (int d = 0; d < 4; ++d) o[d] = o[d] * alpha;
        }
    }
}
__device__ __forceinline__ void attn_pv(const LAS unsigned char* vbuf, const unsigned (&pk)[2][8], f32x16_t (&o)[4], unsigned vread) {
    constexpr int VSTR = ATT_VSTR;
    const LAS unsigned char* vp = vbuf + vread;
#pragma unroll
    for (int kb = 0; kb < 2; ++kb)
#pragma unroll
        for (int s = 0; s < 2; ++s) {
            bf16x8_t pf;
            { const unsigned w0 = pk[kb][4 * s], w1 = pk[kb][4 * s + 1], w2 = pk[kb][4 * s + 2], w3 = pk[kb][4 * s + 3];
              pf[0] = (short)(w0 & 0xffff); pf[1] = (short)(w0 >> 16); pf[2] = (short)(w1 & 0xffff); pf[3] = (short)(w1 >> 16);
              pf[4] = (short)(w2 & 0xffff); pf[5] = (short)(w2 >> 16); pf[6] = (short)(w3 & 0xffff); pf[7] = (short)(w3 >> 16); }
#pragma unroll
            for (int d = 0; d < 4; ++d) {
                const LAS unsigned char* vq = vp + (32 * kb + 16 * s) * VSTR + d * 64;
                const s16x4_t lo = __builtin_amdgcn_ds_read_tr16_b64_v4i16((LAS s16x4_t*)(vq));
                const s16x4_t hi = __builtin_amdgcn_ds_read_tr16_b64_v4i16((LAS s16x4_t*)(vq + 8 * VSTR));
                const bf16x8_t vf = {lo[0], lo[1], lo[2], lo[3], hi[0], hi[1], hi[2], hi[3]};
                o[d] = __builtin_amdgcn_mfma_f32_32x32x16_bf16(vf, pf, o[d], 0, 0, 0);
            }
        }
    __builtin_amdgcn_sched_group_barrier(0x100, 6, 0);
#pragma unroll
    for (int i = 0; i < 13; ++i) { __builtin_amdgcn_sched_group_barrier(0x8, 1, 0); __builtin_amdgcn_sched_group_barrier(0x100, 2, 0); }
#pragma unroll
    for (int i = 0; i < 3; ++i) __builtin_amdgcn_sched_group_barrier(0x8, 1, 0);
}

__device__ __forceinline__ void sb_half_math(const f32x16_t& s, unsigned (&pkh)[8], float& R, int hh) {
#pragma unroll
    for (int g = 3; g >= 0; --g) {
        float sg[4], om[4];
#pragma unroll
        for (int rr = 0; rr < 4; ++rr) { const float e = __builtin_amdgcn_exp2f(fminf(-s[4 * g + rr], 120.0f)); const float sig = __builtin_amdgcn_rcpf(1.0f + e); sg[rr] = sig; om[rr] = e * sig; }
        const float gown = (om[0] * om[1]) * (om[2] * om[3]);
        float glo, ghi; swap32(gown, glo, ghi);
        const float E = hh ? R : R * ghi;
        const float e2 = E * om[3], e1 = e2 * om[2], e0 = e1 * om[1];
        pkh[2 * g] = cvt_pk_bf16(sg[0] * e0, sg[1] * e1); pkh[2 * g + 1] = cvt_pk_bf16(sg[2] * e2, sg[3] * E);
        R = R * (glo * ghi);
    }
}
__device__ __forceinline__ void pv_half(const LAS unsigned char* vp, int kb, const unsigned (&pkh)[8], f32x16_t (&o)[4]) {
    constexpr int VSTR = ATT_VSTR;
#pragma unroll
    for (int s = 0; s < 2; ++s) {
        bf16x8_t pf;
        { const unsigned w0 = pkh[4 * s], w1 = pkh[4 * s + 1], w2 = pkh[4 * s + 2], w3 = pkh[4 * s + 3];
          pf[0] = (short)(w0 & 0xffff); pf[1] = (short)(w0 >> 16); pf[2] = (short)(w1 & 0xffff); pf[3] = (short)(w1 >> 16);
          pf[4] = (short)(w2 & 0xffff); pf[5] = (short)(w2 >> 16); pf[6] = (short)(w3 & 0xffff); pf[7] = (short)(w3 >> 16); }
#pragma unroll
        for (int d = 0; d < 4; ++d) {
            const LAS unsigned char* vq = vp + (32 * kb + 16 * s) * VSTR + d * 64;
            const s16x4_t lo = __builtin_amdgcn_ds_read_tr16_b64_v4i16((LAS s16x4_t*)(vq));
            const s16x4_t hi = __builtin_amdgcn_ds_read_tr16_b64_v4i16((LAS s16x4_t*)(vq + 8 * VSTR));
            const bf16x8_t vf = {lo[0], lo[1], lo[2], lo[3], hi[0], hi[1], hi[2], hi[3]};
            o[d] = __builtin_amdgcn_mfma_f32_32x32x16_bf16(vf, pf, o[d], 0, 0, 0);
        }
    }
}
__device__ __forceinline__ void attn_tile_sb(bool need_mask, const LAS unsigned char* base, const bf16x8_t (&qf)[8], f32x16_t (&o)[4], float& st0, int lim, unsigned kread, unsigned vread, int hh) {
    constexpr int KSTR = 128 * 2 + 16;
    const LAS unsigned char* kp = base + kread;
    f32x16_t s0, s1;
#pragma unroll
    for (int r = 0; r < 16; ++r) { s0[r] = 0.f; s1[r] = 0.f; }
#pragma unroll
    for (int ks = 0; ks < 8; ++ks) s1 = __builtin_amdgcn_mfma_f32_32x32x16_bf16(*(const LAS bf16x8_t*)(kp + 32 * KSTR + ks * 32), qf[ks], s1, 0, 0, 0);
#pragma unroll
    for (int ks = 0; ks < 8; ++ks) s0 = __builtin_amdgcn_mfma_f32_32x32x16_bf16(*(const LAS bf16x8_t*)(kp + ks * 32), qf[ks], s0, 0, 0, 0);
    if (need_mask) {
        asm volatile("" ::: "memory");
#pragma unroll
        for (int r = 0; r < 16; ++r) { const int kr = (r & 3) + 8 * (r >> 2) + 4 * hh; s0[r] = (kr < lim) ? s0[r] : -100.0f; s1[r] = (32 + kr < lim) ? s1[r] : -100.0f; }
    }
    unsigned pk1[8], pk0[8]; float R = st0;
    sb_half_math(s1, pk1, R, hh);
    pv_half(base + vread, 1, pk1, o);
    sb_half_math(s0, pk0, R, hh);
    pv_half(base + vread, 0, pk0, o);
    st0 = R;
}

__device__ __forceinline__ void attn_tile_mla(bool need_mask, const LAS unsigned char* base, const bf16x8_t (&qf)[12], f32x16_t (&o)[4], float& st0, float& st1, int lim, unsigned kread, unsigned vread, int hh) {
    f32x16_t s0, s1;
    attn_qk<1>(base, qf, s0, s1, kread);
    if (need_mask) {
        asm volatile("" ::: "memory");
#pragma unroll
        for (int r = 0; r < 16; ++r) { const int kr = (r & 3) + 8 * (r >> 2) + 4 * hh; s0[r] = (kr <= lim) ? s0[r] : -INFINITY; s1[r] = (32 + kr <= lim) ? s1[r] : -INFINITY; }
    }
    float mx = fmaxf(s0[0], s1[0]);
#pragma unroll
    for (int r = 1; r < 16; ++r) mx = fmaxf(mx, fmaxf(s0[r], s1[r]));
    float mlo, mhi; swap32(mx, mlo, mhi);
    const float mn = fmaxf(st0, fmaxf(mlo, mhi)), alpha = __builtin_amdgcn_exp2f(st0 - mn);
    st0 = mn;
    if (__builtin_amdgcn_ballot_w64(alpha != 1.0f) != 0ull) {
#pragma unroll
        for (int d = 0; d < 4; ++d) o[d] = o[d] * alpha;
    }
    unsigned pk1[8], pk0[8]; float ls = 0.f;
#pragma unroll
    for (int g = 0; g < 4; ++g) { float a[4];
#pragma unroll
        for (int rr = 0; rr < 4; ++rr) { a[rr] = __builtin_amdgcn_exp2f(s1[4 * g + rr] - mn); ls += a[rr]; }
        pk1[2 * g] = cvt_pk_bf16(a[0], a[1]); pk1[2 * g + 1] = cvt_pk_bf16(a[2], a[3]); }
    pv_half(base + vread, 1, pk1, o);
#pragma unroll
    for (int g = 0; g < 4; ++g) { float a[4];
#pragma unroll
        for (int rr = 0; rr < 4; ++rr) { a[rr] = __builtin_amdgcn_exp2f(s0[4 * g + rr] - mn); ls += a[rr]; }
        pk0[2 * g] = cvt_pk_bf16(a[0], a[1]); pk0[2 * g + 1] = cvt_pk_bf16(a[2], a[3]); }
    pv_half(base + vread, 0, pk0, o);
    st1 = st1 * alpha + ls;
}
template <int G>
__device__ __forceinline__ void attn_tile(bool need_mask, const LAS unsigned char* base, const bf16x8_t (&qf)[G ? 12 : 8], f32x16_t (&o)[4], float& st0, float& st1, int lim, unsigned kread, unsigned vread, int hh) {
    f32x16_t s0, s1; unsigned pk[2][8];
    attn_qk<G>(base, qf, s0, s1, kread);
    attn_sm<G>(need_mask, s0, s1, pk, o, st0, st1, lim, hh);
    attn_pv(base, pk, o, vread);
}
template <int G>
__device__ __forceinline__ void attn_unit2(const Params& p, int b, int h, int qb, LAS unsigned char* lds, int tid_in) {
    int tid = tid_in; asm volatile("" : "+v"(tid));
    constexpr int DK = G ? 192 : 128, NKS = DK / 16, KCH = DK / 8, KSTR = DK * 2 + 16, VSTR = ATT_VSTR;
    constexpr int KTILE = 64 * KSTR, VTILE = 64 * VSTR, NKL = KCH * 64 / 512, QP = G ? 1536 : 1024;
    const int lane = tid & 63, wid = __builtin_amdgcn_readfirstlane(tid >> 6), c = lane & 31, hh = lane >> 5, H = wid >> 2;
    const bf16_t* Qg = WS<bf16_t>(p, G ? OFF_QMLA : OFF_QSB); const bf16_t* Kg = WS<bf16_t>(p, G ? OFF_KMLA : OFF_KSB); const bf16_t* Vg = WS<bf16_t>(p, G ? OFF_VMLA : OFF_VSB);
    const size_t tok0 = (size_t)b * SEQ;
    const int trow = qb * 256 + wid * 32 + c;
    bf16x8_t qf[NKS];
    { const bf16_t* qp = Qg + (tok0 + trow) * QP + h * DK + hh * 8;
#pragma unroll
      for (int ks = 0; ks < NKS; ++ks) qf[ks] = *(const bf16x8_t*)(qp + ks * 16); }
    f32x16_t o[4];
#pragma unroll
    for (int d = 0; d < 4; ++d)
#pragma unroll
        for (int r = 0; r < 16; ++r) o[d][r] = 0.f;
    float st0 = G ? -1e30f : 1.0f, st1 = 0.f;
    const int srow = tid >> 3, sch = tid & 7;
    const bf16_t* Kb = Kg + tok0 * QP + (size_t)srow * QP + h * DK + sch * 8; const bf16_t* Vb = Vg + tok0 * 1024 + (size_t)srow * 1024 + h * 128 + sch * 8;
    const unsigned klds0 = (unsigned)(srow * KSTR + sch * 16), vlds0 = (unsigned)(2 * KTILE + srow * VSTR + sch * 16);
    const unsigned kread = (unsigned)(c * KSTR + hh * 16);
    const unsigned vread = (unsigned)(2 * KTILE + (4 * hh + ((lane & 15) >> 2)) * VSTR + (16 * ((lane >> 4) & 1) + 4 * (lane & 3)) * 2);
    const int jmax = 4 * qb + 3, T = jmax + 1, wb = wid >> 1;
    u32x4_t kreg[NKL], vreg[2];
#pragma unroll
    for (int i = 0; i < NKL; ++i) kreg[i] = *(const u32x4_t*)(Kb + (size_t)jmax * 64 * QP + i * 64);
#pragma unroll
    for (int i = 0; i < NKL; ++i) *(LAS u32x4_t*)(lds + klds0 + i * 128) = kreg[i];
#pragma unroll
    for (int i = 0; i < NKL; ++i) kreg[i] = *(const u32x4_t*)(Kb + (size_t)(jmax - 1) * 64 * QP + i * 64);
#pragma unroll
    for (int i = 0; i < 2; ++i) vreg[i] = *(const u32x4_t*)(Vb + (size_t)jmax * 64 * 1024 + i * 64);
    __syncthreads();
    f32x16_t s0, s1; unsigned pk[2][8];
#pragma unroll
    for (int r = 0; r < 16; ++r) { s0[r] = 0.f; s1[r] = 0.f; }
#pragma unroll
    for (int i = 0; i < 8; ++i) { pk[0][i] = 0u; pk[1][i] = 0u; }
#pragma unroll 1
    for (int slot = 0; slot < 2 * T + 2; ++slot) {
        if ((slot & 1) == 0) {
            const int s = slot >> 1;
            if (s + 1 < T) {
#pragma unroll
                for (int i = 0; i < NKL; ++i) *(LAS u32x4_t*)(lds + ((s + 1) & 1) * KTILE + klds0 + i * 128) = kreg[i];
            }
            if (s < T) {
#pragma unroll
                for (int i = 0; i < 2; ++i) *(LAS u32x4_t*)(lds + (s & 1) * VTILE + vlds0 + i * 128) = vreg[i];
            }
            if (s + 2 < T) {
#pragma unroll
                for (int i = 0; i < NKL; ++i) kreg[i] = *(const u32x4_t*)(Kb + (size_t)(jmax - s - 2) * 64 * QP + i * 64);
            }
            if (s + 1 < T) {
#pragma unroll
                for (int i = 0; i < 2; ++i) vreg[i] = *(const u32x4_t*)(Vb + (size_t)(jmax - s - 1) * 64 * 1024 + i * 64);
            }
        }
        if ((slot & 1) == H) {
            const int sm = (slot - H) >> 1;
            if (sm >= 1) { const int sp = sm - 1, jb = (jmax - sp) - 4 * qb; if (jb <= wb) attn_pv(lds + (sp & 1) * VTILE, pk, o, vread); }
            if (sm < T) { const int jb = (jmax - sm) - 4 * qb; if (jb <= wb) attn_qk<G>(lds + (sm & 1) * KTILE, qf, s0, s1, kread); }
        } else if (slot >= 1 + H) {
            const int sv = (slot - 1 - H) >> 1;
            if (sv < T) { const int j = jmax - sv, jb = j - 4 * qb; if (jb <= wb) attn_sm<G>(jb == wb, s0, s1, pk, o, st0, st1, trow - 64 * j, hh); }
        }
        __syncthreads();
    }
    if (G == 1) { float llo, lhi; swap32(st1, llo, lhi); const float inv = 1.0f / (llo + lhi);
#pragma unroll
        for (int d = 0; d < 4; ++d) o[d] = o[d] * inv; }
    float ss = 0.f;
    bf16_t* op = WS<bf16_t>(p, OFF_O) + (tok0 + trow) * 2048 + G * 1024 + h * 128 + 4 * hh;
#pragma unroll
    for (int d = 0; d < 4; ++d)
#pragma unroll
        for (int g = 0; g < 4; ++g) {
            const float v0 = o[d][4 * g], v1 = o[d][4 * g + 1], v2 = o[d][4 * g + 2], v3 = o[d][4 * g + 3];
            ss += v0 * v0 + v1 * v1 + v2 * v2 + v3 * v3;
            uint2 w; w.x = cvt_pk_bf16(v0, v1); w.y = cvt_pk_bf16(v2, v3);
            *(uint2*)(op + 32 * d + 8 * g) = w;
        }
    float slo, shi; swap32(ss, slo, shi);
    if (hh == 0) WS<float>(p, OFF_SSQ)[(tok0 + trow) * 16 + G * 8 + h] = slo + shi;
}

template <int G>
__device__ __forceinline__ void attn_unit(const Params& p, int b, int h, int qb, LAS unsigned char* lds, int tid_in) {
    int tid = tid_in; asm volatile("" : "+v"(tid));
    constexpr int DK = G ? 192 : 128, NKS = DK / 16, KCH = DK / 8, KSTR = DK * 2 + 16, VSTR = ATT_VSTR;
    constexpr int KTILE = 64 * KSTR, VTILE = 64 * VSTR, STAGE = KTILE + VTILE, NKL = KCH * 64 / 512, QP = G ? 1536 : 1024;
    const int lane = tid & 63, wid = __builtin_amdgcn_readfirstlane(tid >> 6), c = lane & 31, hh = lane >> 5;
    const bf16_t* Qg = WS<bf16_t>(p, G ? OFF_QMLA : OFF_QSB); const bf16_t* Kg = WS<bf16_t>(p, G ? OFF_KMLA : OFF_KSB); const bf16_t* Vg = WS<bf16_t>(p, G ? OFF_VMLA : OFF_VSB);
    const size_t tok0 = (size_t)b * SEQ;
    const int trow = qb * 256 + wid * 32 + c;
    bf16x8_t qf[NKS];
    { const bf16_t* qp = Qg + (tok0 + trow) * QP + h * DK + hh * 8;
#pragma unroll
      for (int ks = 0; ks < NKS; ++ks) qf[ks] = *(const bf16x8_t*)(qp + ks * 16); }
    f32x16_t o[4];
#pragma unroll
    for (int d = 0; d < 4; ++d)
#pragma unroll
        for (int r = 0; r < 16; ++r) o[d][r] = 0.f;
    float st0 = G ? -1e30f : 1.0f, st1 = 0.f;
    const int srow = tid >> 3, sch = tid & 7;
    const bf16_t* Kb = Kg + tok0 * QP + (size_t)srow * QP + h * DK + sch * 8; const bf16_t* Vb = Vg + tok0 * 1024 + (size_t)srow * 1024 + h * 128 + sch * 8;
    const unsigned klds0 = (unsigned)(srow * KSTR + sch * 16), vlds0 = (unsigned)(KTILE + srow * VSTR + sch * 16);
    u32x4_t kreg[NKL], vreg[2];
    const int jmax = 4 * qb + 3;
#pragma unroll
    for (int i = 0; i < NKL; ++i) kreg[i] = *(const u32x4_t*)(Kb + (size_t)jmax * 64 * QP + i * 64);
#pragma unroll
    for (int i = 0; i < 2; ++i) vreg[i] = *(const u32x4_t*)(Vb + (size_t)jmax * 64 * 1024 + i * 64);
    const unsigned kread = (unsigned)(c * KSTR + hh * 16);
    const unsigned vread = (unsigned)(KTILE + (4 * hh + ((lane & 15) >> 2)) * VSTR + (16 * ((lane >> 4) & 1) + 4 * (lane & 3)) * 2);
    LAS unsigned* aflag = (LAS unsigned*)(lds + ATT_BC_OFF + 16);
    if (G == 0) { if (tid < 3) aflag[tid] = 0u; }
    int f_cur = 0, f_prev = 2, f_next = 1;
    for (int j = jmax; j >= 0; --j) {
        LAS unsigned char* base = lds + ((jmax - j) & 1) * STAGE;
#pragma unroll
        for (int i = 0; i < NKL; ++i) *(LAS u32x4_t*)(base + klds0 + i * 128) = kreg[i];
#pragma unroll
        for (int i = 0; i < 2; ++i) *(LAS u32x4_t*)(base + vlds0 + i * 128) = vreg[i];
        __syncthreads();
        if (G == 0) {
            if (j < jmax) { const unsigned alive = (unsigned)__builtin_amdgcn_readfirstlane((int)aflag[f_prev]); if (alive == 0u) break; }
            if (tid == 0) aflag[f_next] = 0u;
        }
        if (j > 0) {
#pragma unroll
            for (int i = 0; i < NKL; ++i) kreg[i] = *(const u32x4_t*)(Kb + (size_t)(j - 1) * 64 * QP + i * 64);
#pragma unroll
            for (int i = 0; i < 2; ++i) vreg[i] = *(const u32x4_t*)(Vb + (size_t)(j - 1) * 64 * 1024 + i * 64);
        }
        const int jb = j - 4 * qb;
        if (jb <= (wid >> 1)) {
            const bool need_mask = (jb == (wid >> 1));
            const int lim = trow - 64 * j;
            if constexpr (G == 0) attn_tile_sb(need_mask, base, qf, o, st0, lim, kread, vread, hh); else attn_tile_mla(need_mask, base, qf, o, st0, st1, lim, kread, vread, hh);
        }
        if (G == 0) {
            if (__builtin_amdgcn_ballot_w64(st0 >= 9.094947e-13f) != 0ull) { if (lane == 0) aflag[f_cur] = 1u; }
            const int t_ = f_prev; f_prev = f_cur; f_cur = f_next; f_next = t_;
        }
    }
    if (G == 1) { float llo, lhi; swap32(st1, llo, lhi); const float inv = 1.0f / (llo + lhi);
#pragma unroll
        for (int d = 0; d < 4; ++d) o[d] = o[d] * inv; }
    float ss = 0.f;
    bf16_t* op = WS<bf16_t>(p, OFF_O) + (tok0 + trow) * 2048 + G * 1024 + h * 128 + 4 * hh;
#pragma unroll
    for (int d = 0; d < 4; ++d)
#pragma unroll
        for (int g = 0; g < 4; ++g) {
            const float v0 = o[d][4 * g], v1 = o[d][4 * g + 1], v2 = o[d][4 * g + 2], v3 = o[d][4 * g + 3];
            ss += v0 * v0 + v1 * v1 + v2 * v2 + v3 * v3;
            uint2 w; w.x = cvt_pk_bf16(v0, v1); w.y = cvt_pk_bf16(v2, v3);
            *(uint2*)(op + 32 * d + 8 * g) = w;
        }
    float slo, shi; swap32(ss, slo, shi);
    if (hh == 0) WS<float>(p, OFF_SSQ)[(tok0 + trow) * 16 + G * 8 + h] = slo + shi;
    __syncthreads();
}


__device__ __forceinline__ void attn_unit_mla_mid(const Params& p, int b, int h, int qb, LAS unsigned char* lds, int tid_in) {
    int tid = tid_in; asm volatile("" : "+v"(tid));
    constexpr int DK = 192, NKS = 12, KSTR = DK * 2 + 16, VSTR = ATT_VSTR, KTILE = 64 * KSTR, VTILE = 64 * VSTR, STAGE = KTILE + VTILE, NKL = 3, QP = 1536;
    const int lane = tid & 63, wid = __builtin_amdgcn_readfirstlane(tid >> 6), c = lane & 31, hh = lane >> 5;
    const bf16_t* Qg = WS<bf16_t>(p, OFF_QMLA); const bf16_t* Kg = WS<bf16_t>(p, OFF_KMLA); const bf16_t* Vg = WS<bf16_t>(p, OFF_VMLA);
    const size_t tok0 = (size_t)b * SEQ;
    const int trow = qb * 256 + wid * 32 + c;
    bf16x8_t qf[NKS];
    { const bf16_t* qp = Qg + (tok0 + trow) * QP + h * DK + hh * 8;
#pragma unroll
      for (int ks = 0; ks < NKS; ++ks) qf[ks] = *(const bf16x8_t*)(qp + ks * 16); }
    f32x16_t o[4];
#pragma unroll
    for (int d = 0; d < 4; ++d)
#pragma unroll
        for (int r = 0; r < 16; ++r) o[d][r] = 0.f;
    float st0 = -1e30f, st1 = 0.f;
    const int srow = tid >> 3, sch = tid & 7;
    const bf16_t* Kb = Kg + tok0 * QP + (size_t)srow * QP + h * DK + sch * 8; const bf16_t* Vb = Vg + tok0 * 1024 + (size_t)srow * 1024 + h * 128 + sch * 8;
    const unsigned klds0 = (unsigned)(srow * KSTR + sch * 16), vlds0 = (unsigned)(KTILE + srow * VSTR + sch * 16);
    u32x4_t kreg[NKL], vreg[2];
    const int jmax = 4 * qb + 3;
#pragma unroll
    for (int i = 0; i < NKL; ++i) kreg[i] = *(const u32x4_t*)(Kb + (size_t)jmax * 64 * QP + i * 64);
#pragma unroll
    for (int i = 0; i < 2; ++i) vreg[i] = *(const u32x4_t*)(Vb + (size_t)jmax * 64 * 1024 + i * 64);
#pragma unroll
    for (int i = 0; i < NKL; ++i) *(LAS u32x4_t*)(lds + klds0 + i * 128) = kreg[i];
#pragma unroll
    for (int i = 0; i < 2; ++i) *(LAS u32x4_t*)(lds + vlds0 + i * 128) = vreg[i];
#pragma unroll
    for (int i = 0; i < NKL; ++i) kreg[i] = *(const u32x4_t*)(Kb + (size_t)(jmax - 1) * 64 * QP + i * 64);
#pragma unroll
    for (int i = 0; i < 2; ++i) vreg[i] = *(const u32x4_t*)(Vb + (size_t)(jmax - 1) * 64 * 1024 + i * 64);
    const unsigned kread = (unsigned)(c * KSTR + hh * 16);
    const unsigned vread = (unsigned)(KTILE + (4 * hh + ((lane & 15) >> 2)) * VSTR + (16 * ((lane >> 4) & 1) + 4 * (lane & 3)) * 2);
    for (int j = jmax; j >= 0; --j) {
        LAS unsigned char* base = lds + ((jmax - j) & 1) * STAGE;
        LAS unsigned char* nbase = lds + ((jmax - j + 1) & 1) * STAGE;
        __syncthreads();
        const int jb = j - 4 * qb;
        const bool act = jb <= (wid >> 1);
        f32x16_t s0, s1; unsigned pk1[8], pk0[8]; float ls = 0.f, alpha = 1.0f, mn = st0;
        if (act) {
            attn_qk<1>(base, qf, s0, s1, kread);
            if (jb == (wid >> 1)) {
                asm volatile("" ::: "memory");
                const int lim = trow - 64 * j;
#pragma unroll
                for (int r = 0; r < 16; ++r) { const int kr = (r & 3) + 8 * (r >> 2) + 4 * hh; s0[r] = (kr <= lim) ? s0[r] : -INFINITY; s1[r] = (32 + kr <= lim) ? s1[r] : -INFINITY; }
            }
            float mx = fmaxf(s0[0], s1[0]);
#pragma unroll
            for (int r = 1; r < 16; ++r) mx = fmaxf(mx, fmaxf(s0[r], s1[r]));
            float mlo, mhi; swap32(mx, mlo, mhi);
            mn = fmaxf(st0, fmaxf(mlo, mhi)); alpha = __builtin_amdgcn_exp2f(st0 - mn);
            st0 = mn;
            if (__builtin_amdgcn_ballot_w64(alpha != 1.0f) != 0ull) {
#pragma unroll
                for (int d = 0; d < 4; ++d) o[d] = o[d] * alpha;
            }
#pragma unroll
            for (int g = 0; g < 4; ++g) { float a[4];
#pragma unroll
                for (int rr = 0; rr < 4; ++rr) { a[rr] = __builtin_amdgcn_exp2f(s1[4 * g + rr] - mn); ls += a[rr]; }
                pk1[2 * g] = cvt_pk_bf16(a[0], a[1]); pk1[2 * g + 1] = cvt_pk_bf16(a[2], a[3]); }
        }
        if (j > 0) {
#pragma unroll
            for (int i = 0; i < NKL; ++i) *(LAS u32x4_t*)(nbase + klds0 + i * 128) = kreg[i];
#pragma unroll
            for (int i = 0; i < 2; ++i) *(LAS u32x4_t*)(nbase + vlds0 + i * 128) = vreg[i];
            if (j > 1) {
#pragma unroll
                for (int i = 0; i < NKL; ++i) kreg[i] = *(const u32x4_t*)(Kb + (size_t)(j - 2) * 64 * QP + i * 64);
#pragma unroll
                for (int i = 0; i < 2; ++i) vreg[i] = *(const u32x4_t*)(Vb + (size_t)(j - 2) * 64 * 1024 + i * 64);
            }
        }
        if (act) {
            pv_half(base + vread, 1, pk1, o);
#pragma unroll
            for (int g = 0; g < 4; ++g) { float a[4];
#pragma unroll
                for (int rr = 0; rr < 4; ++rr) { a[rr] = __builtin_amdgcn_exp2f(s0[4 * g + rr] - mn); ls += a[rr]; }
                pk0[2 * g] = cvt_pk_bf16(a[0], a[1]); pk0[2 * g + 1] = cvt_pk_bf16(a[2], a[3]); }
            pv_half(base + vread, 0, pk0, o);
            st1 = st1 * alpha + ls;
        }
    }
    { float llo, lhi; swap32(st1, llo, lhi); const float inv = 1.0f / (llo + lhi);
#pragma unroll
      for (int d = 0; d < 4; ++d) o[d] = o[d] * inv; }
    float ss = 0.f;
    bf16_t* op = WS<bf16_t>(p, OFF_O) + (tok0 + trow) * 2048 + 1024 + h * 128 + 4 * hh;
#pragma unroll
    for (int d = 0; d < 4; ++d)
#pragma unroll
        for (int g = 0; g < 4; ++g) {
            const float v0 = o[d][4 * g], v1 = o[d][4 * g + 1], v2 = o[d][4 * g + 2], v3 = o[d][4 * g + 3];
            ss += v0 * v0 + v1 * v1 + v2 * v2 + v3 * v3;
            uint2 w; w.x = cvt_pk_bf16(v0, v1); w.y = cvt_pk_bf16(v2, v3);
            *(uint2*)(op + 32 * d + 8 * g) = w;
        }
    float slo, shi; swap32(ss, slo, shi);
    if (hh == 0) WS<float>(p, OFF_SSQ)[(tok0 + trow) * 16 + 8 + h] = slo + shi;
    __syncthreads();
}

template <int G, int NKL>
__device__ __forceinline__ void att3_step(int s, int T, int jmax, int s_first, int trow, int hh, LAS unsigned char* lds, int& vslot,
        u32x4_t (&kreg)[NKL], u32x4_t (&vreg)[2], const bf16_t* Kb, const bf16_t* Vb, unsigned klds0, unsigned vlds0, unsigned kread, unsigned vread,
        const bf16x8_t (&qf)[G ? 12 : 8], f32x16_t (&o)[4], float& st0, float& st1, f32x16_t& n0, f32x16_t& n1, f32x16_t& p0, f32x16_t& p1, unsigned (&pk)[2][8]) {
    constexpr int DK = G ? 192 : 128, KSTR = DK * 2 + 16, KTILE = 64 * KSTR, VTILE = 64 * ATT_VSTR, QP = G ? 1536 : 1024;
#pragma unroll
    for (int i = 0; i < NKL; ++i) *(LAS u32x4_t*)(lds + (s & 1) * KTILE + klds0 + i * 128) = kreg[i];
#pragma unroll
    for (int i = 0; i < 2; ++i) *(LAS u32x4_t*)(lds + vslot * VTILE + vlds0 + i * 128) = vreg[i];
    __syncthreads();
    if (s + 1 < T) {
#pragma unroll
        for (int i = 0; i < NKL; ++i) kreg[i] = *(const u32x4_t*)(Kb + (size_t)(jmax - s - 1) * 64 * QP + i * 64);
#pragma unroll
        for (int i = 0; i < 2; ++i) vreg[i] = *(const u32x4_t*)(Vb + (size_t)(jmax - s - 1) * 64 * 1024 + i * 64);
    }
    const int vprev = vslot == 0 ? 2 : vslot - 1;
    if (s > s_first + 1) {
        attn_qk<G>(lds + (s & 1) * KTILE, qf, n0, n1, kread);
        attn_sm<G>(false, p0, p1, pk, o, st0, st1, 0, hh);
        attn_pv(lds + vprev * VTILE, pk, o, vread);
    } else {
        if (s >= s_first) attn_qk<G>(lds + (s & 1) * KTILE, qf, n0, n1, kread);
        if (s - 1 >= s_first) { attn_sm<G>(s - 1 == s_first, p0, p1, pk, o, st0, st1, trow - 64 * (jmax - s + 1), hh); attn_pv(lds + vprev * VTILE, pk, o, vread); }
    }
    vslot = vslot == 2 ? 0 : vslot + 1;
}
template <int G>
__device__ __forceinline__ void attn_unit3(const Params& p, int b, int h, int qb, LAS unsigned char* lds, int tid_in) {
    int tid = tid_in; asm volatile("" : "+v"(tid));
    constexpr int DK = G ? 192 : 128, NKS = DK / 16, KCH = DK / 8, KSTR = DK * 2 + 16, VSTR = ATT_VSTR;
    constexpr int KTILE = 64 * KSTR, VTILE = 64 * VSTR, NKL = KCH * 64 / 512, QP = G ? 1536 : 1024;
    const int lane = tid & 63, wid = __builtin_amdgcn_readfirstlane(tid >> 6), c = lane & 31, hh = lane >> 5;
    const bf16_t* Qg = WS<bf16_t>(p, G ? OFF_QMLA : OFF_QSB); const bf16_t* Kg = WS<bf16_t>(p, G ? OFF_KMLA : OFF_KSB); const bf16_t* Vg = WS<bf16_t>(p, G ? OFF_VMLA : OFF_VSB);
    const size_t tok0 = (size_t)b * SEQ;
    const int trow = qb * 256 + wid * 32 + c;
    bf16x8_t qf[NKS];
    { const bf16_t* qp = Qg + (tok0 + trow) * QP + h * DK + hh * 8;
#pragma unroll
      for (int ks = 0; ks < NKS; ++ks) qf[ks] = *(const bf16x8_t*)(qp + ks * 16); }
    f32x16_t o[4];
#pragma unroll
    for (int d = 0; d < 4; ++d)
#pragma unroll
        for (int r = 0; r < 16; ++r) o[d][r] = 0.f;
    float st0 = G ? -1e30f : 1.0f, st1 = 0.f;
    const int srow = tid >> 3, sch = tid & 7;
    const bf16_t* Kb = Kg + tok0 * QP + (size_t)srow * QP + h * DK + sch * 8; const bf16_t* Vb = Vg + tok0 * 1024 + (size_t)srow * 1024 + h * 128 + sch * 8;
    const unsigned klds0 = (unsigned)(srow * KSTR + sch * 16), vlds0 = (unsigned)(2 * KTILE + srow * VSTR + sch * 16);
    const unsigned kread = (unsigned)(c * KSTR + hh * 16);
    const unsigned vread = (unsigned)(2 * KTILE + (4 * hh + ((lane & 15) >> 2)) * VSTR + (16 * ((lane >> 4) & 1) + 4 * (lane & 3)) * 2);
    const int jmax = 4 * qb + 3, T = jmax + 1, s_first = 3 - (wid >> 1);
    u32x4_t kreg[NKL], vreg[2];
#pragma unroll
    for (int i = 0; i < NKL; ++i) kreg[i] = *(const u32x4_t*)(Kb + (size_t)jmax * 64 * QP + i * 64);
#pragma unroll
    for (int i = 0; i < 2; ++i) vreg[i] = *(const u32x4_t*)(Vb + (size_t)jmax * 64 * 1024 + i * 64);
    f32x16_t sa0, sa1, sb0, sb1; unsigned pk[2][8];
#pragma unroll
    for (int r = 0; r < 16; ++r) { sa0[r] = 0.f; sa1[r] = 0.f; sb0[r] = 0.f; sb1[r] = 0.f; }
    int vslot = 0;
#pragma unroll 1
    for (int s = 0; s < T; s += 2) {
        att3_step<G, NKL>(s, T, jmax, s_first, trow, hh, lds, vslot, kreg, vreg, Kb, Vb, klds0, vlds0, kread, vread, qf, o, st0, st1, sa0, sa1, sb0, sb1, pk);
        att3_step<G, NKL>(s + 1, T, jmax, s_first, trow, hh, lds, vslot, kreg, vreg, Kb, Vb, klds0, vlds0, kread, vread, qf, o, st0, st1, sb0, sb1, sa0, sa1, pk);
    }
    { const int vprev = vslot == 0 ? 2 : vslot - 1;
      attn_sm<G>(T - 1 == s_first, sb0, sb1, pk, o, st0, st1, trow, hh);
      attn_pv(lds + vprev * VTILE, pk, o, vread); }
    if (G == 1) { float llo, lhi; swap32(st1, llo, lhi); const float inv = 1.0f / (llo + lhi);
#pragma unroll
        for (int d = 0; d < 4; ++d) o[d] = o[d] * inv; }
    float ss = 0.f;
    bf16_t* op = WS<bf16_t>(p, OFF_O) + (tok0 + trow) * 2048 + G * 1024 + h * 128 + 4 * hh;
#pragma unroll
    for (int d = 0; d < 4; ++d)
#pragma unroll
        for (int g = 0; g < 4; ++g) {
            const float v0 = o[d][4 * g], v1 = o[d][4 * g + 1], v2 = o[d][4 * g + 2], v3 = o[d][4 * g + 3];
            ss += v0 * v0 + v1 * v1 + v2 * v2 + v3 * v3;
            uint2 w; w.x = cvt_pk_bf16(v0, v1); w.y = cvt_pk_bf16(v2, v3);
            *(uint2*)(op + 32 * d + 8 * g) = w;
        }
    float slo, shi; swap32(ss, slo, shi);
    if (hh == 0) WS<float>(p, OFF_SSQ)[(tok0 + trow) * 16 + G * 8 + h] = slo + shi;
    __syncthreads();
}

__device__ __forceinline__ void phase_attn_mfma(const Params& p, float* ldsf, int headw = 0) {
    LAS unsigned char* lds = (LAS unsigned char*)ldsf;
    unsigned* head = WS<unsigned>(p, OFF_BAR) + ATT_HEAD_WORD + 64 * headw;
    for (;;) {
        const int tid = tid_fresh(p.widx);
        LAS unsigned* bc = (LAS unsigned*)(lds + ATT_BC_OFF);
        if (tid == 0) *bc = __hip_atomic_fetch_add(head, 1u, __ATOMIC_RELAXED, __HIP_MEMORY_SCOPE_AGENT);
        __syncthreads();
        const unsigned u = (unsigned)__builtin_amdgcn_readfirstlane((int)*bc);
        __syncthreads();
        if (u >= 1536u) break;
        const unsigned u3 = u / 3u, um = u - 3u * u3;
        if (headw != 0 && (um != 0u || (int)(u3 & 1u) != (PROBE_ATTN_G))) continue;
        if (um != 0u) { if (TAB_EB == 6) job_table6(p, (int)(2u * u3 + um - 1u)); else job_table<TAB_EB == 6 ? 1 : TAB_EB>(p, (int)(2u * u3 + um - 1u)); continue; }
        const int qb = 15 - (int)(u3 >> 5), rest = (int)(u3 & 31u), g = rest & 1, b = (rest >> 1) & 1, h = rest >> 2;
#if ATT_ANTIPHASE
        if (g == 0) attn_unit<0>(p, b, h, qb, lds, tid); else attn_unit_mla_mid(p, b, h, qb, lds, tid);
#else
        if (g == 0) attn_unit<0>(p, b, h, qb, lds, tid); else attn_unit<1>(p, b, h, qb, lds, tid);
#endif
    }
}

__device__ __forceinline__ void phase_onorm(const Params& p, int bid, int nblk) {
    const int tidf = tid_fresh(p.widx), lane = tidf & 63, wid = tidf >> 6;
    bf16_t* O = WS<bf16_t>(p, OFF_O); const float* ssq = WS<float>(p, OFF_SSQ);
    for (int t = bid * 8 + wid; t < TOK; t += nblk * 8) {
        float s0 = 0.f, s1 = 0.f;
#pragma unroll
        for (int h = 0; h < 8; ++h) { s0 += ssq[(size_t)t * 16 + h]; s1 += ssq[(size_t)t * 16 + 8 + h]; }
        const float r0 = rsqrtf(s0 * (1.0f / 1024.0f) + EPS), r1 = rsqrtf(s1 * (1.0f / 1024.0f) + EPS);
#pragma unroll
        for (int j = 0; j < 4; ++j) {
            const int off = (j * 64 + lane) * 8; const float r = off < 1024 ? r0 : r1;
            uint4 v = *(uint4*)(O + (size_t)t * 2048 + off);
            v.x = pack2(lo_f(v.x) * r, hi_f(v.x) * r); v.y = pack2(lo_f(v.y) * r, hi_f(v.y) * r); v.z = pack2(lo_f(v.z) * r, hi_f(v.z) * r); v.w = pack2(lo_f(v.w) * r, hi_f(v.w) * r);
            *(uint4*)(O + (size_t)t * 2048 + off) = v;
        }
    }
}

__device__ __forceinline__ void wave_argmax(float& v, int& i) {
#pragma unroll
    for (int o = 32; o > 0; o >>= 1) { const float ov = __shfl_xor(v, o); const int oi = __shfl_xor(i, o); if (ov > v || (ov == v && oi < i)) { v = ov; i = oi; } }
}
__device__ __forceinline__ void phase_route_ref(const Params& p, int bid, int nblk) {
    const int tidf = tid_fresh(p.widx), lane = tidf & 63, wid = tidf >> 6;
    const bf16_t* qp = WS<bf16_t>(p, OFF_QP); const bf16_t* keys = WS<bf16_t>(p, OFF_KEYS);
    int* ridx = WS<int>(p, OFF_RIDX); float* rgate = WS<float>(p, OFF_RGATE);
    for (int it = bid * 8 + wid; it < TOK * 8; it += nblk * 8) {
        const int t = it >> 3, h = it & 7;
        float tv[2]; int ti[2];
#pragma unroll
        for (int half = 0; half < 2; ++half) {
            const bf16_t* q = qp + (size_t)t * 2048 + h * 256 + half * 128;
            const bf16_t* kb = keys + (size_t)(h * 2 + half) * 16384;
            float s0 = 0.f, s1 = 0.f;
            for (int d = 0; d < 128; d += 8) { const uint4 qv = *(const uint4*)(q + d);
                s0 += dot8(qv, *(const uint4*)(kb + (size_t)lane * 128 + d)); s1 += dot8(qv, *(const uint4*)(kb + (size_t)(lane + 64) * 128 + d)); }
            float mv = 0.f; int mi = 0;
            for (int r = 0; r < 16; ++r) {
                float v; int i;
                if (s0 >= s1) { v = s0; i = lane; } else { v = s1; i = lane + 64; }
                wave_argmax(v, i);
                if (i == lane) s0 = -INFINITY;
                if (i == lane + 64) s1 = -INFINITY;
                if (lane == r) { mv = v; mi = i; }
            }
            tv[half] = mv; ti[half] = mi;
        }
        float cv[4];
#pragma unroll
        for (int j = 0; j < 4; ++j) { const int c = lane * 4 + j; cv[j] = __shfl(tv[0], c >> 4) + __shfl(tv[1], c & 15); }
        float bv = 0.f; int bc = 0;
        for (int r = 0; r < 16; ++r) {
            float v = cv[0]; int i = lane * 4;
#pragma unroll
            for (int j = 1; j < 4; ++j) if (cv[j] > v) { v = cv[j]; i = lane * 4 + j; }
            wave_argmax(v, i);
#pragma unroll
            for (int j = 0; j < 4; ++j) if (i == lane * 4 + j) cv[j] = -INFINITY;
            if (lane == r) { bv = v; bc = i; }
        }
        const float mx = __shfl(bv, 0);
        float e = lane < 16 ? __expf(bv - mx) : 0.f;
        const float sum = wave_sum(e);
        const int i1 = __shfl(ti[0], bc >> 4), i2 = __shfl(ti[1], bc & 15);
        if (lane < 16) { ridx[(size_t)t * 128 + h * 16 + lane] = i1 * 128 + i2; rgate[(size_t)t * 128 + h * 16 + lane] = e / sum; }
    }
}


__device__ __forceinline__ unsigned f2key(float f) { const unsigned u = __float_as_uint(f); return (u & 0x80000000u) ? ~u : (u | 0x80000000u); }
__device__ __forceinline__ float key2f(unsigned k) { return __uint_as_float((k & 0x80000000u) ? (k & 0x7fffffffu) : ~k); }
#define RT_CE(a, b) do { const unsigned _h = max((a), (b)), _l = min((a), (b)); (a) = _h; (b) = _l; } while (0)
__device__ __forceinline__ void sort16_desc(unsigned* a) {
#pragma unroll
    for (int k = 2; k <= 16; k <<= 1)
#pragma unroll
        for (int j = k >> 1; j > 0; j >>= 1)
#pragma unroll
            for (int i = 0; i < 16; ++i) { const int l = i ^ j; if (l > i) { if ((i & k) == 0) RT_CE(a[i], a[l]); else RT_CE(a[l], a[i]); } }
}
__device__ __forceinline__ void merge16_desc(unsigned* a, const unsigned* b) {
#pragma unroll
    for (int i = 0; i < 16; ++i) a[i] = max(a[i], b[15 - i]);
#pragma unroll
    for (int j = 8; j > 0; j >>= 1)
#pragma unroll
        for (int i = 0; i < 16; ++i) { const int l = i ^ j; if (l > i) RT_CE(a[i], a[l]); }
}
__device__ __forceinline__ void top16_of_64(unsigned* v) {
    sort16_desc(v); sort16_desc(v + 16); sort16_desc(v + 32); sort16_desc(v + 48);
    merge16_desc(v, v + 16); merge16_desc(v + 32, v + 48); merge16_desc(v, v + 32);
}
constexpr int rt_cand_pos(int i, int j) { int n = 0; for (int a = 0; a < 16; ++a) for (int b = 0; b < 16; ++b) { if (a == i && b == j) return n; if ((a + 1) * (b + 1) <= 16) ++n; } return n; }
static_assert(rt_cand_pos(15, 1) == 50, "50 staircase candidates");

__device__ __forceinline__ void phase_route_mfma(const Params& p, int bid, int nblk, float* ldsf) {
    const int tidf = tid_fresh(p.widx), lane = tidf & 63, wid = __builtin_amdgcn_readfirstlane(tidf >> 6), c = lane & 31, hh = lane >> 5;
    const bf16_t* qp = WS<bf16_t>(p, OFF_QP); const bf16_t* keys = WS<bf16_t>(p, OFF_KEYS);
    int* ridx = WS<int>(p, OFF_RIDX); float* rgate = WS<float>(p, OFF_RGATE);
    LAS unsigned* tbl = (LAS unsigned*)ldsf + wid * 2048;
    for (int it = bid * 8 + wid; it < 2048; it += nblk * 8) {
        const int tile = it >> 3, h = it & 7, t = (nblk * 32 == TOK) ? tile * 8 + (c & 7) + (c >> 3) * (TOK / 4) : tile * 32 + c;
#pragma unroll 1
        for (int half = 0; half < 2; ++half) {
            const bf16_t* kb = keys + (size_t)(h * 2 + half) * 16384 + (size_t)c * 128 + hh * 8;
            const bf16_t* qq = qp + (size_t)t * 2048 + h * 256 + half * 128 + hh * 8;
            bf16x8_t qf[8];
#pragma unroll
            for (int ks = 0; ks < 8; ++ks) qf[ks] = *(const bf16x8_t*)(qq + ks * 16);
            unsigned v[64];
#pragma unroll
            for (int blk = 0; blk < 4; ++blk) {
                f32x16_t s;
#pragma unroll
                for (int r = 0; r < 16; ++r) s[r] = 0.f;
#pragma unroll
                for (int ks = 0; ks < 8; ++ks) { const bf16x8_t a = *(const bf16x8_t*)(kb + (size_t)blk * 32 * 128 + ks * 16); s = __builtin_amdgcn_mfma_f32_32x32x16_bf16(a, qf[ks], s, 0, 0, 0); }
#pragma unroll
                for (int r = 0; r < 16; ++r) { const int n = 32 * blk + (r & 3) + 8 * (r >> 2) + 4 * hh; v[blk * 16 + r] = (f2key(s[r]) & ~127u) | (unsigned)(127 - n); }
            }
            top16_of_64(v);
            unsigned o[16];
#pragma unroll
            for (int i = 0; i < 16; ++i) { auto r2 = __builtin_amdgcn_permlane32_swap(v[i], v[i], false, false); o[i] = hh ? r2[0] : r2[1]; }
            merge16_desc(v, o);
#pragma unroll
            for (int i = 0; i < 16; ++i) tbl[(half * 16 + i) * 64 + lane] = v[i];
        }
        float f1[16], f2[16];
#pragma unroll
        for (int i = 0; i < 16; ++i) { f1[i] = key2f(tbl[i * 64 + lane] & ~127u); f2[i] = key2f(tbl[(16 + i) * 64 + lane] & ~127u); }
        unsigned cd[64];
#pragma unroll
        for (int i = 0; i < 64; ++i) cd[i] = 0u;
#pragma unroll
        for (int i = 0; i < 16; ++i)
#pragma unroll
            for (int j = 0; j < 16; ++j)
                if ((i + 1) * (j + 1) <= 16) cd[rt_cand_pos(i, j)] = (f2key(f1[i] + f2[j]) & ~255u) | (unsigned)(255 - (i * 16 + j));
        top16_of_64(cd);
        float e[16], sum = 0.f; const float mx = key2f(cd[0] & ~255u);
#pragma unroll
        for (int k = 0; k < 16; ++k) { e[k] = __expf(key2f(cd[k] & ~255u) - mx); sum += e[k]; }
        const float inv = 1.0f / sum;
        if (hh == 0) {
#pragma unroll
            for (int k = 0; k < 16; ++k) {
                const int pid = 255 - (int)(cd[k] & 255u), i = pid >> 4, j = pid & 15;
                const int n1 = 127 - (int)(tbl[i * 64 + lane] & 127u), n2 = 127 - (int)(tbl[(16 + j) * 64 + lane] & 127u);
                ridx[(size_t)t * 128 + h * 16 + k] = n1 * 128 + n2; rgate[(size_t)t * 128 + h * 16 + k] = e[k] * inv;
            }
        }
    }
}

__device__ __forceinline__ void phase_peer_ref(const Params& p, int bid, int nblk) {
    const int tidf = tid_fresh(p.widx), lane = tidf & 63, wid = tidf >> 6;
    const bf16_t* h2 = WS<bf16_t>(p, OFF_H); const float* x1 = WS<float>(p, OFF_X1); const float* mod = WS<float>(p, OFF_MOD);
    const int* ridx = WS<int>(p, OFF_RIDX); const float* rgate = WS<float>(p, OFF_RGATE);
    for (int t = bid * 8 + wid; t < TOK; t += nblk * 8) {
        const int b = t >> 12;
        float4 hv[8], y[8];
#pragma unroll
        for (int j = 0; j < 8; ++j) { const uint2 w = *(const uint2*)(h2 + (size_t)t * DM + (j * 64 + lane) * 4);
            hv[j].x = lo_f(w.x); hv[j].y = hi_f(w.x); hv[j].z = lo_f(w.y); hv[j].w = hi_f(w.y); y[j] = (float4){0.f, 0.f, 0.f, 0.f}; }
        for (int e = 0; e < 128; ++e) {
            const int ex = ridx[(size_t)t * 128 + e]; const float gt = rgate[(size_t)t * 128 + e];
            const float* ur = p.u_tab + (size_t)ex * DM; const float* vr = p.v_tab + (size_t)ex * DM;
            float d = 0.f;
#pragma unroll
            for (int j = 0; j < 8; ++j) { const float4 u = *(const float4*)(ur + (j * 64 + lane) * 4); d += u.x * hv[j].x + u.y * hv[j].y + u.z * hv[j].z + u.w * hv[j].w; }
            d = wave_sum(d);
            const float cf = gt * gelu_exact(d);
#pragma unroll
            for (int j = 0; j < 8; ++j) { const float4 v = *(const float4*)(vr + (j * 64 + lane) * 4); y[j].x += cf * v.x; y[j].y += cf * v.y; y[j].z += cf * v.z; y[j].w += cf * v.w; }
        }
        float ss = 0.f;
#pragma unroll
        for (int j = 0; j < 8; ++j) { const int col = (j * 64 + lane) * 4;
            const float4 xv = *(const float4*)(x1 + (size_t)t * DM + col); const float4 g2 = *(const float4*)(mod + (size_t)b * 12288 + 5 * 2048 + col);
            y[j].x = xv.x + g2.x * y[j].x; y[j].y = xv.y + g2.y * y[j].y; y[j].z = xv.z + g2.z * y[j].z; y[j].w = xv.w + g2.w * y[j].w;
            ss += y[j].x * y[j].x + y[j].y * y[j].y + y[j].z * y[j].z + y[j].w * y[j].w; }
        ss = wave_sum(ss);
        const float rstd = rsqrtf(ss * (1.0f / DM) + EPS);
#pragma unroll
        for (int j = 0; j < 8; ++j) { const int col = (j * 64 + lane) * 4; const float4 fg = *(const float4*)(p.fin_g + col);
            float4 o; o.x = y[j].x * rstd * fg.x; o.y = y[j].y * rstd * fg.y; o.z = y[j].z * rstd * fg.z; o.w = y[j].w * rstd * fg.w;
            *(float4*)(p.out + (size_t)t * DM + col) = o; }
    }
}


template <int EB> __device__ __forceinline__ void job_table(const Params& p, int it) {
    const int tidf = tid_fresh(p.widx), lane = tidf & 63, wid = tidf >> 6;
    const int tab = it >> 9, r0 = (it & 511) * 32;
    const float* src = tab ? p.v_tab : p.u_tab;
    unsigned char* dst = p.ws + (tab ? OFF_VTAB : OFF_UTAB);
    float* scl = WS<float>(p, tab ? OFF_VSC : OFF_USC);
#pragma unroll 1
    for (int rr = 0; rr < 4; ++rr) {
        const int row = r0 + wid * 4 + rr;
        float4 v[8]; float am = 0.f;
#pragma unroll
        for (int j = 0; j < 8; ++j) { v[j] = *(const float4*)(src + (size_t)row * DM + (j * 64 + lane) * 4);
            am = fmaxf(am, fmaxf(fmaxf(fabsf(v[j].x), fabsf(v[j].y)), fmaxf(fabsf(v[j].z), fabsf(v[j].w)))); }
#pragma unroll
        for (int o = 32; o > 0; o >>= 1) am = fmaxf(am, __shfl_xor(am, o));
        if (EB == 1) {
            const int e = (int)((__float_as_uint(am) >> 23) & 255u) - 127;
            const float sc = am > 0.f ? __uint_as_float((unsigned)(127 + 7 - e) << 23) : 1.0f;
            if (lane == 0) scl[row] = am > 0.f ? __uint_as_float((unsigned)(127 - 7 + e) << 23) : 1.0f;
#pragma unroll
            for (int j = 0; j < 8; ++j) {
                int w = __builtin_amdgcn_cvt_pk_fp8_f32(v[j].x * sc, v[j].y * sc, 0, false);
                w = __builtin_amdgcn_cvt_pk_fp8_f32(v[j].z * sc, v[j].w * sc, w, true);
                *(int*)(dst + (size_t)row * 2048 + (j * 64 + lane) * 4) = w;
            }
        } else {
            if (lane == 0) scl[row] = 1.0f;
#pragma unroll
            for (int j = 0; j < 8; ++j) { uint2 w; w.x = pack2(v[j].x, v[j].y); w.y = pack2(v[j].z, v[j].w);
                *(uint2*)(dst + (size_t)row * 4096 + (j * 64 + lane) * 8) = w; }
        }
    }
}

template <int EB> __device__ __forceinline__ void dec_chunk(const u32x4_t r, float* f) {
    if (EB == 1) {
#pragma unroll
        for (int w = 0; w < 4; ++w) { const f32x2_t a = __builtin_amdgcn_cvt_pk_f32_fp8((int)r[w], false), b = __builtin_amdgcn_cvt_pk_f32_fp8((int)r[w], true);
            f[4 * w] = a[0]; f[4 * w + 1] = a[1]; f[4 * w + 2] = b[0]; f[4 * w + 3] = b[1]; }
    } else {
#pragma unroll
        for (int w = 0; w < 4; ++w) { f[2 * w] = lo_f(r[w]); f[2 * w + 1] = hi_f(r[w]); }
    }
}

template <int EB> __device__ __forceinline__ void phase_peer_gather(const Params& p, int bid, int nblk) {
    constexpr int EPC = 16 / EB, NCH = 32 / EPC, ROWB = 2048 * EB;
    const int tidf = tid_fresh(p.widx), lane = tidf & 63, wid = tidf >> 6;
    const unsigned char* utab = p.ws + OFF_UTAB; const unsigned char* vtab = p.ws + OFF_VTAB;
    const float* usc = WS<float>(p, OFF_USC); const float* vsc = WS<float>(p, OFF_VSC);
    const bf16_t* h2 = WS<bf16_t>(p, OFF_H); const float* x1 = WS<float>(p, OFF_X1); const float* mod = WS<float>(p, OFF_MOD);
    const int* ridx = WS<int>(p, OFF_RIDX); const float* rgate = WS<float>(p, OFF_RGATE);
    for (int t = bid * 8 + wid; t < TOK; t += nblk * 8) {
        const int b = t >> 12;
        float hv[32];
#pragma unroll
        for (int j = 0; j < NCH; ++j) {
            const bf16_t* hp = h2 + (size_t)t * DM + (j * 64 + lane) * EPC;
#pragma unroll
            for (int q8 = 0; q8 < EPC / 8; ++q8) { const uint4 w = *(const uint4*)(hp + q8 * 8);
                float* f = hv + j * EPC + q8 * 8;
                f[0] = lo_f(w.x); f[1] = hi_f(w.x); f[2] = lo_f(w.y); f[3] = hi_f(w.y); f[4] = lo_f(w.z); f[5] = hi_f(w.z); f[6] = lo_f(w.w); f[7] = hi_f(w.w); }
        }
        const int myi0 = ridx[(size_t)t * 128 + lane], myi1 = ridx[(size_t)t * 128 + 64 + lane];
        const float myg0 = rgate[(size_t)t * 128 + lane], myg1 = rgate[(size_t)t * 128 + 64 + lane];
        float dots0 = 0.f, dots1 = 0.f;
#pragma unroll 1
        for (int eb = 0; eb < 128; eb += 8) {
            const int idxv = eb < 64 ? myi0 : myi1;
            u32x4_t r[8][NCH];
#pragma unroll
            for (int k = 0; k < 8; ++k) {
                const int idx = __builtin_amdgcn_readlane(idxv, (eb & 63) + k);
                const unsigned char* row = utab + (size_t)idx * ROWB + lane * 16;
#pragma unroll
                for (int j = 0; j < NCH; ++j) r[k][j] = *(const u32x4_t*)(row + j * 1024);
            }
            float d[8];
#pragma unroll
            for (int k = 0; k < 8; ++k) {
                float s = 0.f;
#pragma unroll
                for (int j = 0; j < NCH; ++j) { float f[EPC]; dec_chunk<EB>(r[k][j], f);
#pragma unroll
                    for (int q = 0; q < EPC; ++q) s += f[q] * hv[j * EPC + q]; }
                asm volatile("" : "+v"(s));
                d[k] = s;
                __builtin_amdgcn_sched_barrier(0);
            }
            float n4[4], n2[2];
#pragma unroll
            for (int i = 0; i < 4; ++i) { const bool hi = lane & 1; const float send = hi ? d[2 * i] : d[2 * i + 1], keep = hi ? d[2 * i + 1] : d[2 * i]; n4[i] = keep + __shfl_xor(send, 1); }
#pragma unroll
            for (int i = 0; i < 2; ++i) { const bool hi = lane & 2; const float send = hi ? n4[2 * i] : n4[2 * i + 1], keep = hi ? n4[2 * i + 1] : n4[2 * i]; n2[i] = keep + __shfl_xor(send, 2); }
            float tot;
            { const bool hi = lane & 4; const float send = hi ? n2[0] : n2[1], keep = hi ? n2[1] : n2[0]; tot = keep + __shfl_xor(send, 4); }
            tot += __shfl_xor(tot, 8); tot += __shfl_xor(tot, 16); tot += __shfl_xor(tot, 32);
            const bool mine = (lane >> 3) == ((eb & 63) >> 3);
            if (eb < 64) dots0 = mine ? tot : dots0; else dots1 = mine ? tot : dots1;
        }
        const float cf0 = myg0 * gelu_exact(dots0 * usc[myi0]) * vsc[myi0], cf1 = myg1 * gelu_exact(dots1 * usc[myi1]) * vsc[myi1];
        float y[32];
#pragma unroll
        for (int q = 0; q < 32; ++q) y[q] = 0.f;
#pragma unroll 1
        for (int eb = 0; eb < 128; eb += 8) {
            const int idxv = eb < 64 ? myi0 : myi1; const float cfv = eb < 64 ? cf0 : cf1;
            u32x4_t r[8][NCH];
#pragma unroll
            for (int k = 0; k < 8; ++k) {
                const int idx = __builtin_amdgcn_readlane(idxv, (eb & 63) + k);
                const unsigned char* row = vtab + (size_t)idx * ROWB + lane * 16;
#pragma unroll
                for (int j = 0; j < NCH; ++j) r[k][j] = *(const u32x4_t*)(row + j * 1024);
            }
#pragma unroll
            for (int k = 0; k < 8; ++k) {
                const float cf = __uint_as_float((unsigned)__builtin_amdgcn_readlane((int)__float_as_uint(cfv), (eb & 63) + k));
#pragma unroll
                for (int j = 0; j < NCH; ++j) { float f[EPC]; dec_chunk<EB>(r[k][j], f);
#pragma unroll
                    for (int q = 0; q < EPC; ++q) y[j * EPC + q] += cf * f[q]; }
                asm volatile("" : "+v"(y[0]), "+v"(y[1]), "+v"(y[2]), "+v"(y[3]), "+v"(y[4]), "+v"(y[5]), "+v"(y[6]), "+v"(y[7]), "+v"(y[8]), "+v"(y[9]), "+v"(y[10]), "+v"(y[11]), "+v"(y[12]), "+v"(y[13]), "+v"(y[14]), "+v"(y[15]));
                asm volatile("" : "+v"(y[16]), "+v"(y[17]), "+v"(y[18]), "+v"(y[19]), "+v"(y[20]), "+v"(y[21]), "+v"(y[22]), "+v"(y[23]), "+v"(y[24]), "+v"(y[25]), "+v"(y[26]), "+v"(y[27]), "+v"(y[28]), "+v"(y[29]), "+v"(y[30]), "+v"(y[31]));
                __builtin_amdgcn_sched_barrier(0);
            }
        }
        float ss = 0.f;
#pragma unroll
        for (int j = 0; j < NCH; ++j)
#pragma unroll
            for (int q4 = 0; q4 < EPC / 4; ++q4) {
                const int col = (j * 64 + lane) * EPC + q4 * 4;
                const float4 xv = *(const float4*)(x1 + (size_t)t * DM + col); const float4 g2 = *(const float4*)(mod + (size_t)b * 12288 + 5 * 2048 + col);
                float* yy = y + j * EPC + q4 * 4;
                yy[0] = xv.x + g2.x * yy[0]; yy[1] = xv.y + g2.y * yy[1]; yy[2] = xv.z + g2.z * yy[2]; yy[3] = xv.w + g2.w * yy[3];
                ss += yy[0] * yy[0] + yy[1] * yy[1] + yy[2] * yy[2] + yy[3] * yy[3];
                if (q4 & 1) __builtin_amdgcn_sched_barrier(0);
            }
        ss = wave_sum(ss);
        const float rstd = rsqrtf(ss * (1.0f / DM) + EPS);
#pragma unroll
        for (int j = 0; j < NCH; ++j)
#pragma unroll
            for (int q4 = 0; q4 < EPC / 4; ++q4) {
                const int col = (j * 64 + lane) * EPC + q4 * 4; const float4 fg = *(const float4*)(p.fin_g + col);
                const float* yy = y + j * EPC + q4 * 4;
                float4 o; o.x = yy[0] * rstd * fg.x; o.y = yy[1] * rstd * fg.y; o.z = yy[2] * rstd * fg.z; o.w = yy[3] * rstd * fg.w;
                *(float4*)(p.out + (size_t)t * DM + col) = o;
                if (q4 & 1) __builtin_amdgcn_sched_barrier(0);
            }
    }
}


typedef float v32f_t __attribute__((ext_vector_type(32)));
typedef float v16f_t __attribute__((ext_vector_type(16)));
typedef unsigned v6u_t __attribute__((ext_vector_type(6)));
typedef _Float16 v32h_t __attribute__((ext_vector_type(32)));
typedef _Float16 h2_t __attribute__((ext_vector_type(2)));
typedef _Float16 h4_t __attribute__((ext_vector_type(4)));
typedef float f32x4v_t __attribute__((ext_vector_type(4)));
typedef unsigned u32x2_t __attribute__((ext_vector_type(2)));
__device__ __forceinline__ float wave_max_noaddr(float v) {
    v = fmaxf(v, __int_as_float(__builtin_amdgcn_ds_swizzle(__float_as_int(v), (1 << 10) | 0x1f)));
    v = fmaxf(v, __int_as_float(__builtin_amdgcn_ds_swizzle(__float_as_int(v), (2 << 10) | 0x1f)));
    v = fmaxf(v, __int_as_float(__builtin_amdgcn_ds_swizzle(__float_as_int(v), (4 << 10) | 0x1f)));
    v = fmaxf(v, __int_as_float(__builtin_amdgcn_ds_swizzle(__float_as_int(v), (8 << 10) | 0x1f)));
    v = fmaxf(v, __int_as_float(__builtin_amdgcn_ds_swizzle(__float_as_int(v), (16 << 10) | 0x1f)));
    auto r = __builtin_amdgcn_permlane32_swap(__float_as_uint(v), __float_as_uint(v), false, false);
    return fmaxf(__uint_as_float(r[0]), __uint_as_float(r[1]));
}
__device__ __forceinline__ void job_table6(const Params& p, int it) {
    const int tidf = tid_fresh(p.widx), lane = tidf & 63, wid = tidf >> 6;
    const int tab = it >> 9, r0 = (it & 511) * 32;
    const float* src = tab ? p.v_tab : p.u_tab;
    unsigned char* dst = p.ws + (tab ? OFF_VTAB : OFF_UTAB);
    float* scl = WS<float>(p, tab ? OFF_VSC : OFF_USC);
    typedef float f32x4v __attribute__((ext_vector_type(4)));
    f32x4v v[4][8];
#pragma unroll
    for (int rr = 0; rr < 4; ++rr)
#pragma unroll
        for (int j = 0; j < 8; ++j) v[rr][j] = __builtin_nontemporal_load((const f32x4v*)(src + (size_t)(r0 + wid * 4 + rr) * DM + (j * 64 + lane) * 4));
#pragma unroll
    for (int rr = 0; rr < 4; ++rr) {
        const int row = r0 + wid * 4 + rr;
        v16f_t a, b; float am = 0.f;
#pragma unroll
        for (int j = 0; j < 8; ++j) { const f32x4v w = v[rr][j];
            a[2 * j] = w.x; b[2 * j] = w.y; a[2 * j + 1] = w.z; b[2 * j + 1] = w.w; am = fmaxf(am, fmaxf(fmaxf(fabsf(w.x), fabsf(w.y)), fmaxf(fabsf(w.z), fabsf(w.w)))); }
        am = wave_max_noaddr(am);
        const int e = (int)((__float_as_uint(am) >> 23) & 255u) - 127;
        const float sc = am > 0.f ? __uint_as_float((unsigned)(127 + 2 - e) << 23) : 1.0f;
        if (lane == 0) scl[row] = am > 0.f ? __uint_as_float((unsigned)(127 - 2 + e) << 23) : 1.0f;
        a = a * sc; b = b * sc;
        const v6u_t pk = __builtin_amdgcn_cvt_scalef32_2xpk16_fp6_f32(a, b, 1.0f);
#if PEER_SLICED
        { unsigned char* d6 = dst + ((size_t)(lane >> 3) * NEXP + row) * 192;
          u32x4_t w0 = {pk[0], pk[1], pk[2], pk[3]}; u32x2_t w1 = {pk[4], pk[5]};
          *(u32x4_t*)(d6 + (lane & 7) * 16) = w0; *(u32x2_t*)(d6 + 128 + (lane & 7) * 8) = w1; }
#else
        u32x4_t w0 = {pk[0], pk[1], pk[2], pk[3]}; u32x2_t w1 = {pk[4], pk[5]};
        *(u32x4_t*)(dst + (size_t)row * 1536 + lane * 16) = w0;
        *(u32x2_t*)(dst + (size_t)row * 1536 + 1024 + lane * 8) = w1;
#endif
    }
}

#define PG6_LOAD(RA, RB, tab, iv, e0) do { _Pragma("unroll") for (int k = 0; k < 8; ++k) { \
        const unsigned idx_ = (unsigned)__builtin_amdgcn_readlane((iv), (e0) + k); const unsigned char* row_ = (tab) + (size_t)idx_ * 1536u;     \
        RA[k] = *(const u32x4_t*)(row_ + lane16); RB[k] = *(const u32x2_t*)(row_ + 1024u + lane8); } } while (0)
#define PG6_CU(RA, RB, eb) do { float d[8]; \
        _Pragma("unroll") for (int k = 0; k < 8; ++k) { \
            const v6u_t pk_ = {RA[k][0], RA[k][1], RA[k][2], RA[k][3], RB[k][0], RB[k][1]}; \
            const v32h_t f_ = __builtin_amdgcn_cvt_scalef32_pk32_f16_fp6(pk_, 1.0f); float s0_ = 0.f, s1_ = 0.f, s2_ = 0.f, s3_ = 0.f; \
            _Pragma("unroll") for (int q = 0; q < 16; q += 4) { \
                s0_ = __builtin_amdgcn_fdot2((h2_t){f_[2 * q], f_[2 * q + 1]}, hvh[q], s0_, false); s1_ = __builtin_amdgcn_fdot2((h2_t){f_[2 * q + 2], f_[2 * q + 3]}, hvh[q + 1], s1_, false); \
                s2_ = __builtin_amdgcn_fdot2((h2_t){f_[2 * q + 4], f_[2 * q + 5]}, hvh[q + 2], s2_, false); s3_ = __builtin_amdgcn_fdot2((h2_t){f_[2 * q + 6], f_[2 * q + 7]}, hvh[q + 3], s3_, false); } \
            float s_ = (s0_ + s1_) + (s2_ + s3_);             \
            asm volatile("" : "+v"(s_)); d[k] = s_; __builtin_amdgcn_sched_barrier(0); } \
        float n4[4], n2[2], tot; \
        _Pragma("unroll") for (int i_ = 0; i_ < 4; ++i_) { const bool hi_ = lane & 1; const float send = hi_ ? d[2 * i_] : d[2 * i_ + 1], keep = hi_ ? d[2 * i_ + 1] : d[2 * i_]; n4[i_] = keep + __shfl_xor(send, 1); } \
        _Pragma("unroll") for (int i_ = 0; i_ < 2; ++i_) { const bool hi_ = lane & 2; const float send = hi_ ? n4[2 * i_] : n4[2 * i_ + 1], keep = hi_ ? n4[2 * i_ + 1] : n4[2 * i_]; n2[i_] = keep + __shfl_xor(send, 2); } \
        { const bool hi_ = lane & 4; const float send = hi_ ? n2[0] : n2[1], keep = hi_ ? n2[1] : n2[0]; tot = keep + __shfl_xor(send, 4); } \
        tot += __shfl_xor(tot, 8); tot += __shfl_xor(tot, 16); tot += __shfl_xor(tot, 32); \
        const bool mine_ = (lane >> 3) == (((eb) & 63) >> 3); \
        if ((eb) < 64) dots0 = mine_ ? tot : dots0; else dots1 = mine_ ? tot : dots1; } while (0)
#define PG6_CU4(RA, RB, eb) do { float d[8]; \
        _Pragma("unroll") for (int k = 0; k < 8; k += 2) { \
            const v6u_t pka_ = {RA[k][0], RA[k][1], RA[k][2], RA[k][3], RB[k][0], RB[k][1]}; const v6u_t pkb_ = {RA[k + 1][0], RA[k + 1][1], RA[k + 1][2], RA[k + 1][3], RB[k + 1][0], RB[k + 1][1]}; \
            const v32h_t fa_ = __builtin_amdgcn_cvt_scalef32_pk32_f16_fp6(pka_, 1.0f), fb_ = __builtin_amdgcn_cvt_scalef32_pk32_f16_fp6(pkb_, 1.0f); \
            f32x4v_t ca_ = {0.f, 0.f, 0.f, 0.f}, cb_ = {0.f, 0.f, 0.f, 0.f}; \
            _Pragma("unroll") for (int q = 0; q < 8; ++q) { \
                ca_ = __builtin_amdgcn_mfma_f32_4x4x4f16((h4_t){fa_[4 * q], fa_[4 * q + 1], fa_[4 * q + 2], fa_[4 * q + 3]}, hv4[q], ca_, 0, 0, 0); \
                cb_ = __builtin_amdgcn_mfma_f32_4x4x4f16((h4_t){fb_[4 * q], fb_[4 * q + 1], fb_[4 * q + 2], fb_[4 * q + 3]}, hv4[q], cb_, 0, 0, 0); } \
            float sa_ = l3b1 ? (l3b0 ? ca_[3] : ca_[2]) : (l3b0 ? ca_[1] : ca_[0]), sb_ = l3b1 ? (l3b0 ? cb_[3] : cb_[2]) : (l3b0 ? cb_[1] : cb_[0]); \
            asm volatile("" : "+v"(sa_), "+v"(sb_)); d[k] = sa_; d[k + 1] = sb_; __builtin_amdgcn_sched_barrier(0); } \
        float n4[4], n2[2], tot; \
        _Pragma("unroll") for (int i_ = 0; i_ < 4; ++i_) { const bool hi_ = lane & 1; const float send = hi_ ? d[2 * i_] : d[2 * i_ + 1], keep = hi_ ? d[2 * i_ + 1] : d[2 * i_]; n4[i_] = keep + __shfl_xor(send, 1); } \
        _Pragma("unroll") for (int i_ = 0; i_ < 2; ++i_) { const bool hi_ = lane & 2; const float send = hi_ ? n4[2 * i_] : n4[2 * i_ + 1], keep = hi_ ? n4[2 * i_ + 1] : n4[2 * i_]; n2[i_] = keep + __shfl_xor(send, 2); } \
        { const bool hi_ = lane & 4; const float send = hi_ ? n2[0] : n2[1], keep = hi_ ? n2[1] : n2[0]; tot = keep + __shfl_xor(send, 4); } \
        tot += __shfl_xor(tot, 8); tot += __shfl_xor(tot, 16); tot += __shfl_xor(tot, 32); \
        const bool mine_ = (lane >> 3) == (((eb) & 63) >> 3); \
        if ((eb) < 64) dots0 = mine_ ? tot : dots0; else dots1 = mine_ ? tot : dots1; } while (0)
#define PG6_CV(RA, RB, eb) do { const float cfv_ = (eb) < 64 ? cf0 : cf1; \
        _Pragma("unroll") for (int k = 0; k < 8; ++k) { \
            const _Float16 ch_ = (_Float16)__uint_as_float((unsigned)__builtin_amdgcn_readlane((int)__float_as_uint(cfv_), ((eb) & 63) + k)); const h2_t c2_ = {ch_, ch_}; \
            const v6u_t pk_ = {RA[k][0], RA[k][1], RA[k][2], RA[k][3], RB[k][0], RB[k][1]}; \
            const v32h_t f_ = __builtin_amdgcn_cvt_scalef32_pk32_f16_fp6(pk_, 1.0f); \
            _Pragma("unroll") for (int q = 0; q < 16; ++q) yh[q] = (h2_t){f_[2 * q], f_[2 * q + 1]} * c2_ + yh[q]; \
            asm volatile("" : "+v"(yh[0]), "+v"(yh[1]), "+v"(yh[2]), "+v"(yh[3]), "+v"(yh[4]), "+v"(yh[5]), "+v"(yh[6]), "+v"(yh[7]), "+v"(yh[8]), "+v"(yh[9]), "+v"(yh[10]), "+v"(yh[11]), "+v"(yh[12]), "+v"(yh[13]), "+v"(yh[14]), "+v"(yh[15])); \
            __builtin_amdgcn_sched_barrier(0); } } while (0)
#define PG6_CV4(RA, RB, eb) do { const unsigned ccv_ = (eb) < 64 ? cc0 : cc1; \
        _Pragma("unroll") for (int k = 0; k < 8; ++k) { \
            const unsigned cs_ = (unsigned)__builtin_amdgcn_readlane((int)ccv_, ((eb) & 63) + k); \
            union { unsigned u[2]; h4_t h; } am_; am_.u[0] = cs_ & am0; am_.u[1] = cs_ & am1; \
            const v6u_t pk_ = {RA[k][0], RA[k][1], RA[k][2], RA[k][3], RB[k][0], RB[k][1]}; \
            const v32h_t f_ = __builtin_amdgcn_cvt_scalef32_pk32_f16_fp6(pk_, 1.0f); \
            _Pragma("unroll") for (int q = 0; q < 8; ++q) ya[q] = __builtin_amdgcn_mfma_f32_4x4x4f16(am_.h, (h4_t){f_[4 * q], f_[4 * q + 1], f_[4 * q + 2], f_[4 * q + 3]}, ya[q], 0, 0, 0); \
            if (k & 1) __builtin_amdgcn_sched_barrier(0); } } while (0)
__device__ __forceinline__ void phase_peer_gather6(const Params& p, int bid, int nblk) {
    const int tidf = tid_fresh(p.widx), lane = tidf & 63, wid = tidf >> 6;
    const unsigned lane16 = (unsigned)lane * 16u, lane8 = (unsigned)lane * 8u;
    const unsigned char* utab = p.ws + OFF_UTAB; const unsigned char* vtab = p.ws + OFF_VTAB;
    const float* usc = WS<float>(p, OFF_USC); const float* vsc = WS<float>(p, OFF_VSC);
    const bf16_t* h2 = WS<bf16_t>(p, OFF_H); const float* x1 = WS<float>(p, OFF_X1); const float* mod = WS<float>(p, OFF_MOD);
    const int* ridx = WS<int>(p, OFF_RIDX); const float* rgate = WS<float>(p, OFF_RGATE);
    const int tstep = nblk * 8;
    int t = bid * 8 + wid;
    if (t >= TOK) return;
    int myi0 = ridx[(size_t)t * 128 + lane], myi1 = ridx[(size_t)t * 128 + 64 + lane];
    u32x4_t a4[8], b4[8]; u32x2_t a2[8], b2[8];
    PG6_LOAD(a4, a2, utab, myi0, 0);
    for (; t < TOK; t += tstep) {
        const int b = t >> 12;
        const int tn = t + tstep; const bool more = tn < TOK;
        const int ni0 = more ? ridx[(size_t)tn * 128 + lane] : 0, ni1 = more ? ridx[(size_t)tn * 128 + 64 + lane] : 0;
        const float myg0 = rgate[(size_t)t * 128 + lane], myg1 = rgate[(size_t)t * 128 + 64 + lane];
        float hv[32];
        { const bf16_t* hp = h2 + (size_t)t * DM + lane * 4;
#pragma unroll
          for (int j = 0; j < 8; ++j) { const uint2 w = *(const uint2*)(hp + j * 256); float* f = hv + j * 4;
              f[0] = lo_f(w.x); f[1] = hi_f(w.x); f[2] = lo_f(w.y); f[3] = hi_f(w.y); } }
        h2_t hvh[16];
#pragma unroll
        for (int q = 0; q < 16; ++q) hvh[q] = (h2_t){(_Float16)hv[2 * q], (_Float16)hv[2 * q + 1]};
        float dots0 = 0.f, dots1 = 0.f;
#pragma unroll 1
        for (int eb = 0; eb < 128; eb += 16) {
            { const int e1 = eb + 8; PG6_LOAD(b4, b2, utab, (e1 < 64 ? myi0 : myi1), (e1 & 63)); }
            PG6_CU(a4, a2, eb);
            if (eb + 16 < 128) { const int e2 = eb + 16; PG6_LOAD(a4, a2, utab, (e2 < 64 ? myi0 : myi1), (e2 & 63)); }
            else PG6_LOAD(a4, a2, vtab, myi0, 0);
            PG6_CU(b4, b2, eb + 8);
        }
        const float cf0 = myg0 * gelu_exact(dots0 * usc[myi0]) * vsc[myi0], cf1 = myg1 * gelu_exact(dots1 * usc[myi1]) * vsc[myi1];
        h2_t yh[16];
#pragma unroll
        for (int q = 0; q < 16; ++q) yh[q] = (h2_t){(_Float16)0.f, (_Float16)0.f};
#pragma unroll 1
        for (int eb = 0; eb < 128; eb += 16) {
            { const int e1 = eb + 8; PG6_LOAD(b4, b2, vtab, (e1 < 64 ? myi0 : myi1), (e1 & 63)); }
            PG6_CV(a4, a2, eb);
            if (eb + 16 < 128) { const int e2 = eb + 16; PG6_LOAD(a4, a2, vtab, (e2 < 64 ? myi0 : myi1), (e2 & 63)); }
            else if (more) PG6_LOAD(a4, a2, utab, ni0, 0);
            PG6_CV(b4, b2, eb + 8);
        }
        myi0 = ni0; myi1 = ni1;
        float y[32];
#pragma unroll
        for (int q = 0; q < 16; ++q) { y[2 * q] = (float)yh[q][0]; y[2 * q + 1] = (float)yh[q][1]; }
        float ss = 0.f;
#pragma unroll
        for (int q4 = 0; q4 < 8; ++q4) {
            const int col = (q4 * 64 + lane) * 4;
            const float4 xv = *(const float4*)(x1 + (size_t)t * DM + col); const float4 g2 = *(const float4*)(mod + (size_t)b * 12288 + 5 * 2048 + col);
            float* yy = y + q4 * 4;
            yy[0] = xv.x + g2.x * yy[0]; yy[1] = xv.y + g2.y * yy[1]; yy[2] = xv.z + g2.z * yy[2]; yy[3] = xv.w + g2.w * yy[3];
            ss += yy[0] * yy[0] + yy[1] * yy[1] + yy[2] * yy[2] + yy[3] * yy[3];
            if (q4 & 1) __builtin_amdgcn_sched_barrier(0);
        }
        ss = wave_sum(ss);
        const float rstd = rsqrtf(ss * (1.0f / DM) + EPS);
#pragma unroll
        for (int q4 = 0; q4 < 8; ++q4) {
            const int col = (q4 * 64 + lane) * 4; const float4 fg = *(const float4*)(p.fin_g + col);
            const float* yy = y + q4 * 4;
            float4 o; o.x = yy[0] * rstd * fg.x; o.y = yy[1] * rstd * fg.y; o.z = yy[2] * rstd * fg.z; o.w = yy[3] * rstd * fg.w;
            *(float4*)(p.out + (size_t)t * DM + col) = o;
            if (q4 & 1) __builtin_amdgcn_sched_barrier(0);
        }
    }
}


__device__ __forceinline__ int ld_agent(const int* q) { return __hip_atomic_load(q, __ATOMIC_RELAXED, __HIP_MEMORY_SCOPE_AGENT); }
__device__ __forceinline__ float ld_agent(const float* q) { return __hip_atomic_load(q, __ATOMIC_RELAXED, __HIP_MEMORY_SCOPE_AGENT); }
__device__ __forceinline__ void phase_peer_u6(const Params& p, int bid, int nblk) {
    const int tidf = tid_fresh(p.widx), lane = tidf & 63, wid = tidf >> 6;
    const unsigned lane16 = (unsigned)lane * 16u, lane8 = (unsigned)lane * 8u;
    const unsigned char* utab = p.ws + OFF_UTAB;
    const float* usc = WS<float>(p, OFF_USC); const float* vsc = WS<float>(p, OFF_VSC);
    const bf16_t* h2 = WS<bf16_t>(p, OFF_H); const int* ridx = WS<int>(p, OFF_RIDX); const float* rgate = WS<float>(p, OFF_RGATE); float* cfo = WS<float>(p, OFF_PD);
    const int tstep = nblk * 8;
    const bool l3b0 = (lane & 1) != 0, l3b1 = (lane & 2) != 0;
    int t = bid * 8 + wid;
    if (t >= TOK) return;
    int myi0 = ld_agent(ridx + (size_t)t * 128 + lane), myi1 = ld_agent(ridx + (size_t)t * 128 + 64 + lane);
    u32x4_t a4[8], b4[8]; u32x2_t a2[8], b2[8];
    PG6_LOAD(a4, a2, utab, myi0, 0);
    for (; t < TOK; t += tstep) {
        const int tn = t + tstep; const bool more = tn < TOK;
        const int ni0 = more ? ld_agent(ridx + (size_t)tn * 128 + lane) : 0, ni1 = more ? ld_agent(ridx + (size_t)tn * 128 + 64 + lane) : 0;
        const float myg0 = ld_agent(rgate + (size_t)t * 128 + lane), myg1 = ld_agent(rgate + (size_t)t * 128 + 64 + lane);
        const float us0 = usc[myi0], us1 = usc[myi1], vs0 = vsc[myi0], vs1 = vsc[myi1];
        h4_t hv4[8];
        { const bf16_t* hp = h2 + (size_t)t * DM + lane * 4;
#pragma unroll
          for (int j = 0; j < 8; ++j) { const uint2 w = *(const uint2*)(hp + j * 256);
              hv4[j] = (h4_t){(_Float16)lo_f(w.x), (_Float16)hi_f(w.x), (_Float16)lo_f(w.y), (_Float16)hi_f(w.y)}; } }
        float dots0 = 0.f, dots1 = 0.f;
#pragma unroll 1
        for (int eb = 0; eb < 128; eb += 16) {
            { const int e1 = eb + 8; PG6_LOAD(b4, b2, utab, (e1 < 64 ? myi0 : myi1), (e1 & 63)); }
            PG6_CU4(a4, a2, eb);
            if (eb + 16 < 128) { const int e2 = eb + 16; PG6_LOAD(a4, a2, utab, (e2 < 64 ? myi0 : myi1), (e2 & 63)); }
            else if (more) PG6_LOAD(a4, a2, utab, ni0, 0);
            PG6_CU4(b4, b2, eb + 8);
        }
        cfo[(size_t)t * 128 + lane] = myg0 * gelu_exact(dots0 * us0) * vs0;
        cfo[(size_t)t * 128 + 64 + lane] = myg1 * gelu_exact(dots1 * us1) * vs1;
        myi0 = ni0; myi1 = ni1;
    }
}
__device__ __forceinline__ void phase_peer_v6(const Params& p, int bid, int nblk) {
    const int tidf = tid_fresh(p.widx), lane = tidf & 63, wid = tidf >> 6;
    const unsigned lane16 = (unsigned)lane * 16u, lane8 = (unsigned)lane * 8u;
    const unsigned char* vtab = p.ws + OFF_VTAB;
    const bf16_t* x1 = WS<bf16_t>(p, OFF_X1); const float* mod = WS<float>(p, OFF_MOD);
    const int* ridx = WS<int>(p, OFF_RIDX); const float* cfi = WS<float>(p, OFF_PD);
    const int tstep = nblk * 8;
    int t = bid * 8 + wid;
    if (t >= TOK) return;
    int myi0 = ld_agent(ridx + (size_t)t * 128 + lane), myi1 = ld_agent(ridx + (size_t)t * 128 + 64 + lane);
    const unsigned am0 = (lane & 3) == 0 ? 0x0000ffffu : ((lane & 3) == 1 ? 0xffff0000u : 0u), am1 = (lane & 3) == 2 ? 0x0000ffffu : ((lane & 3) == 3 ? 0xffff0000u : 0u);
    float cf0 = __hip_atomic_load(cfi + (size_t)t * 128 + lane, __ATOMIC_RELAXED, __HIP_MEMORY_SCOPE_AGENT), cf1 = __hip_atomic_load(cfi + (size_t)t * 128 + 64 + lane, __ATOMIC_RELAXED, __HIP_MEMORY_SCOPE_AGENT);
    u32x4_t a4[8], b4[8]; u32x2_t a2[8], b2[8];
    PG6_LOAD(a4, a2, vtab, myi0, 0);
    for (; t < TOK; t += tstep) {
        const int b = t >> 12;
        const int tn = t + tstep; const bool more = tn < TOK;
        const int ni0 = more ? ld_agent(ridx + (size_t)tn * 128 + lane) : 0, ni1 = more ? ld_agent(ridx + (size_t)tn * 128 + 64 + lane) : 0;
        const float nc0 = more ? __hip_atomic_load(cfi + (size_t)tn * 128 + lane, __ATOMIC_RELAXED, __HIP_MEMORY_SCOPE_AGENT) : 0.f, nc1 = more ? __hip_atomic_load(cfi + (size_t)tn * 128 + 64 + lane, __ATOMIC_RELAXED, __HIP_MEMORY_SCOPE_AGENT) : 0.f;
        uint2 xr[8];
#pragma unroll
        for (int q4 = 0; q4 < 8; ++q4) xr[q4] = *(const uint2*)(x1 + (size_t)t * DM + (q4 * 64 + lane) * 4);
        f32x4v_t ya[8];
#pragma unroll
        for (int q = 0; q < 8; ++q) ya[q] = (f32x4v_t){0.f, 0.f, 0.f, 0.f};
        unsigned cc0, cc1;
        { union { h2_t h; unsigned u; } c_; c_.h = (h2_t){(_Float16)cf0, (_Float16)cf0}; cc0 = c_.u; c_.h = (h2_t){(_Float16)cf1, (_Float16)cf1}; cc1 = c_.u; }
#pragma unroll 1
        for (int eb = 0; eb < 128; eb += 16) {
            { const int e1 = eb + 8; PG6_LOAD(b4, b2, vtab, (e1 < 64 ? myi0 : myi1), (e1 & 63)); }
            PG6_CV4(a4, a2, eb);
            if (eb + 16 < 128) { const int e2 = eb + 16; PG6_LOAD(a4, a2, vtab, (e2 < 64 ? myi0 : myi1), (e2 & 63)); }
            else if (more) PG6_LOAD(a4, a2, vtab, ni0, 0);
            PG6_CV4(b4, b2, eb + 8);
        }
        myi0 = ni0; myi1 = ni1; cf0 = nc0; cf1 = nc1;
        float y[32];
#pragma unroll
        for (int q = 0; q < 8; ++q) { y[4 * q] = ya[q][0]; y[4 * q + 1] = ya[q][1]; y[4 * q + 2] = ya[q][2]; y[4 * q + 3] = ya[q][3]; }
        float ss = 0.f;
#pragma unroll
        for (int q4 = 0; q4 < 8; ++q4) {
            const int col = (q4 * 64 + lane) * 4;
            const uint2 xw = xr[q4]; const float4 g2 = *(const float4*)(mod + (size_t)b * 12288 + 5 * 2048 + col);
            float4 xv; xv.x = lo_f(xw.x); xv.y = hi_f(xw.x); xv.z = lo_f(xw.y); xv.w = hi_f(xw.y);
            float* yy = y + q4 * 4;
            yy[0] = xv.x + g2.x * yy[0]; yy[1] = xv.y + g2.y * yy[1]; yy[2] = xv.z + g2.z * yy[2]; yy[3] = xv.w + g2.w * yy[3];
            ss += yy[0] * yy[0] + yy[1] * yy[1] + yy[2] * yy[2] + yy[3] * yy[3];
            if (q4 & 1) __builtin_amdgcn_sched_barrier(0);
        }
        ss = wave_sum(ss);
        const float rstd = rsqrtf(ss * (1.0f / DM) + EPS);
#pragma unroll
        for (int q4 = 0; q4 < 8; ++q4) {
            const int col = (q4 * 64 + lane) * 4; const float4 fg = *(const float4*)(p.fin_g + col);
            const float* yy = y + q4 * 4;
            float4 o; o.x = yy[0] * rstd * fg.x; o.y = yy[1] * rstd * fg.y; o.z = yy[2] * rstd * fg.z; o.w = yy[3] * rstd * fg.w;
            *(float4*)(p.out + (size_t)t * DM + col) = o;
            if (q4 & 1) __builtin_amdgcn_sched_barrier(0);
        }
    }
}

#define XB_TMO      128
#define XB_XCNT(j)  (256  + 64 * (j))
#define XB_XSUB(j)  (1280 + 64 * (j))
#define XB_XGEN(j)  (2304 + 64 * (j))
#define XB_TOP      3328
#define XB_TOPGEN   3392
#define XCD_BAR_WORDS 3456
#define XB_SPIN_CAP (1u << 18)

__device__ __forceinline__ unsigned xb_ld(unsigned* p)              { return __hip_atomic_load(p, __ATOMIC_RELAXED, __HIP_MEMORY_SCOPE_AGENT); }
__device__ __forceinline__ unsigned xb_add(unsigned* p, unsigned v) { return __hip_atomic_fetch_add(p, v, __ATOMIC_RELAXED, __HIP_MEMORY_SCOPE_AGENT); }
__device__ __forceinline__ unsigned xb_xcc_id() { return (unsigned)__builtin_amdgcn_s_getreg((3 << 11) | 20) & 0xFu; }
#define XB_SPIN(cond, bar) do { unsigned _sp = 0; while (cond) { __builtin_amdgcn_s_sleep(1); \
    if ((++_sp & 255u) == 0u) { if (xb_ld(&(bar)[XB_TMO])) break; if (_sp > XB_SPIN_CAP) { atomicAdd(&(bar)[XB_TMO], 1u); break; } } } } while (0)

struct XcdBarrier {
    int widx;
    unsigned* bar; unsigned x;
    volatile LAS unsigned* st;
};

__device__ __forceinline__ bool xb_thread0(int widx) { unsigned m = ~0u; asm volatile("" : "+s"(m)); return widx == 0 && __builtin_amdgcn_mbcnt_hi(m, __builtin_amdgcn_mbcnt_lo(m, 0u)) == 0u; }
__device__ __forceinline__ XcdBarrier xcd_barrier_post(unsigned* bar, volatile LAS unsigned* st, int widx) {
    XcdBarrier b; b.widx = widx; b.bar = bar; b.x = xb_xcc_id(); b.st = st;
    if (xb_thread0(widx)) (void)xb_add(&bar[XB_XCNT(b.x)], 1u);
    return b;
}
__device__ __forceinline__ void xcd_barrier_complete(unsigned* bar, unsigned x, unsigned& nloc, unsigned& nx) {
    const unsigned G = gridDim.x * gridDim.y * gridDim.z;
    unsigned sum, cnt, mine, sp = 0u;
    for (;;) {
        sum = 0u; cnt = 0u; mine = 0u;
#pragma unroll
        for (unsigned j = 0; j < 16; ++j) { const unsigned c = xb_ld(&bar[XB_XCNT(j)]); sum += c; cnt += (c > 0u) ? 1u : 0u; mine = (j == x) ? c : mine; }
        if (sum == G) break;
        __builtin_amdgcn_s_sleep(1);
        if ((++sp & 255u) == 0u) { if (xb_ld(&bar[XB_TMO])) break; if (sp > XB_SPIN_CAP) { atomicAdd(&bar[XB_TMO], 1u); break; } }
    }
    nloc = mine > 0u ? mine : 1u; nx = cnt > 0u ? cnt : 1u;
}

__device__ __forceinline__ void xcd_barrier(const XcdBarrier& b) {
    asm volatile("s_waitcnt vmcnt(0)" ::: "memory");
    __syncthreads();
    if (xb_thread0(b.widx)) {
        unsigned* bar = b.bar;
        __builtin_amdgcn_s_waitcnt(0);
        unsigned nloc = b.st[0], nx = b.st[1];
        if (nloc == 0u) { xcd_barrier_complete(bar, b.x, nloc, nx); b.st[0] = nloc; b.st[1] = nx; }
        const unsigned old = xb_add(&bar[XB_XSUB(b.x)], 1u);
        const unsigned gen = old / nloc;
        if (old + 1u == (gen + 1u) * nloc) {
            __builtin_amdgcn_fence(__ATOMIC_RELEASE, "agent");
            asm volatile("s_waitcnt vmcnt(0)" ::: "memory");
            const unsigned og = xb_add(&bar[XB_TOP], 1u);
            const unsigned tg = og / nx;
            if (og + 1u == (tg + 1u) * nx) xb_add(&bar[XB_TOPGEN], 1u);
            else XB_SPIN(xb_ld(&bar[XB_TOPGEN]) == tg, bar);
            __builtin_amdgcn_fence(__ATOMIC_ACQUIRE, "agent");
            xb_add(&bar[XB_XGEN(b.x)], 1u);
            asm volatile("s_waitcnt vmcnt(0)" ::: "memory");
        } else {
            XB_SPIN(xb_ld(&bar[XB_XGEN(b.x)]) == gen, bar);
            __builtin_amdgcn_fence(__ATOMIC_ACQUIRE, "agent");
            asm volatile("s_waitcnt vmcnt(0)" ::: "memory");
        }
    }
    __syncthreads();
}


constexpr int PS_Q_WORD = 3968;
__device__ __forceinline__ unsigned ps_next(unsigned* q, LAS unsigned* bc, int tid) {
    if (tid == 0) *bc = __hip_atomic_fetch_add(q, 1u, __ATOMIC_RELAXED, __HIP_MEMORY_SCOPE_AGENT);
    __syncthreads();
    const unsigned u = (unsigned)__builtin_amdgcn_readfirstlane((int)*bc);
    __syncthreads();
    return u;
}
#define PS_LOADH(RA, RB, tb, idv) do { _Pragma("unroll") for (int bt = 0; bt < 8; ++bt) { const int idx_ = __shfl((idv), bt * 8 + g); const unsigned char* rp_ = (tb) + (size_t)idx_ * 192; \
        RA[bt] = *(const u32x4_t*)(rp_ + j * 16); RB[bt] = *(const u32x2_t*)(rp_ + 128 + j * 8); } } while (0)
#define PS_CU(RA, RB, outp) do { float mine_ = 0.f; \
        _Pragma("unroll") for (int bt = 0; bt < 8; ++bt) { \
            const v6u_t pk_ = {RA[bt][0], RA[bt][1], RA[bt][2], RA[bt][3], RB[bt][0], RB[bt][1]}; \
            const v32f_t f_ = __builtin_amdgcn_cvt_scalef32_pk32_f32_fp6(pk_, 1.0f); float sd_ = 0.f; \
            _Pragma("unroll") for (int qq = 0; qq < 32; ++qq) sd_ += f_[qq] * hv[qq]; \
            sd_ += __shfl_xor(sd_, 1); sd_ += __shfl_xor(sd_, 2); sd_ += __shfl_xor(sd_, 4); \
            mine_ = (j == bt) ? sd_ : mine_; __builtin_amdgcn_sched_barrier(0); } \
        __builtin_nontemporal_store(mine_, (outp) + j * 8 + g); } while (0)
#define PS_CV(RA, RB, cfv) do { \
        _Pragma("unroll") for (int bt = 0; bt < 8; ++bt) { const float cf_ = __shfl((cfv), bt * 8 + g); \
            const v6u_t pk_ = {RA[bt][0], RA[bt][1], RA[bt][2], RA[bt][3], RB[bt][0], RB[bt][1]}; \
            const v32f_t f_ = __builtin_amdgcn_cvt_scalef32_pk32_f32_fp6(pk_, 1.0f); \
            _Pragma("unroll") for (int qq = 0; qq < 32; ++qq) y[qq] += cf_ * f_[qq]; \
            asm volatile("" : "+v"(y[0]), "+v"(y[1]), "+v"(y[2]), "+v"(y[3]), "+v"(y[4]), "+v"(y[5]), "+v"(y[6]), "+v"(y[7]), "+v"(y[8]), "+v"(y[9]), "+v"(y[10]), "+v"(y[11]), "+v"(y[12]), "+v"(y[13]), "+v"(y[14]), "+v"(y[15])); \
            asm volatile("" : "+v"(y[16]), "+v"(y[17]), "+v"(y[18]), "+v"(y[19]), "+v"(y[20]), "+v"(y[21]), "+v"(y[22]), "+v"(y[23]), "+v"(y[24]), "+v"(y[25]), "+v"(y[26]), "+v"(y[27]), "+v"(y[28]), "+v"(y[29]), "+v"(y[30]), "+v"(y[31])); \
            __builtin_amdgcn_sched_barrier(0); } } while (0)
constexpr int PS_CHUNK = 64;
__device__ __forceinline__ void phase_peer_u_sliced(const Params& p, float* ldsf) {
    const int tid = tid_fresh(p.widx), lane = tid & 63, wid = tid >> 6, g = lane >> 3, j = lane & 7;
    LAS unsigned* bc = (LAS unsigned*)ldsf;
    const unsigned char* utab = p.ws + OFF_UTAB;
    const bf16_t* h2 = WS<bf16_t>(p, OFF_H); const int* ridx = WS<int>(p, OFF_RIDX); float* pd = WS<float>(p, OFF_PD);
    const int x0 = (int)(xb_xcc_id() & 7u);
#pragma unroll 1
    for (int so = 0; so < 8; ++so) {
        const int s = (x0 + so) & 7;
        unsigned* q = WS<unsigned>(p, OFF_BAR) + PS_Q_WORD + 8 * s;
        const unsigned char* tb = utab + (size_t)s * NEXP * 192;
        const bf16_t* hb = h2 + s * 256 + j * 32;
#pragma unroll 1
        for (;;) {
            const unsigned ch = ps_next(q, bc, tid);
            if (ch >= TOK / PS_CHUNK) break;
            int t = (int)ch * PS_CHUNK + wid;
            int i0 = __builtin_nontemporal_load(ridx + (size_t)t * 128 + lane), i1 = __builtin_nontemporal_load(ridx + (size_t)t * 128 + 64 + lane);
            uint4 hp[4];
#pragma unroll
            for (int q8 = 0; q8 < 4; ++q8) hp[q8] = *(const uint4*)(hb + (size_t)t * DM + q8 * 8);
            u32x4_t a4[8], b4[8]; u32x2_t a2[8], b2[8];
            PS_LOADH(a4, a2, tb, i0);
#pragma unroll 1
            for (int k = 0; k < PS_CHUNK / 8; ++k, t += 8) {
                float hv[32];
#pragma unroll
                for (int q8 = 0; q8 < 4; ++q8) { const uint4 w = hp[q8]; float* f = hv + q8 * 8;
                    f[0] = lo_f(w.x); f[1] = hi_f(w.x); f[2] = lo_f(w.y); f[3] = hi_f(w.y); f[4] = lo_f(w.z); f[5] = hi_f(w.z); f[6] = lo_f(w.w); f[7] = hi_f(w.w); }
                const bool more = k + 1 < PS_CHUNK / 8; const int tn = more ? t + 8 : t;
                const int n0 = __builtin_nontemporal_load(ridx + (size_t)tn * 128 + lane), n1 = __builtin_nontemporal_load(ridx + (size_t)tn * 128 + 64 + lane);
#pragma unroll
                for (int q8 = 0; q8 < 4; ++q8) hp[q8] = *(const uint4*)(hb + (size_t)tn * DM + q8 * 8);
                PS_LOADH(b4, b2, tb, i1);
                PS_CU(a4, a2, pd + ((size_t)s * TOK + t) * 128);
                if (more) PS_LOADH(a4, a2, tb, n0);
                PS_CU(b4, b2, pd + ((size_t)s * TOK + t) * 128 + 64);
                i0 = n0; i1 = n1;
            }
        }
    }
}
__device__ __forceinline__ void phase_peer_v_sliced(const Params& p, float* ldsf) {
    const int tid = tid_fresh(p.widx), lane = tid & 63, wid = tid >> 6, g = lane >> 3, j = lane & 7;
    LAS unsigned* bc = (LAS unsigned*)ldsf;
    const unsigned char* vtab = p.ws + OFF_VTAB;
    const float* usc = WS<float>(p, OFF_USC); const float* vsc = WS<float>(p, OFF_VSC);
    const int* ridx = WS<int>(p, OFF_RIDX); const float* rgate = WS<float>(p, OFF_RGATE); const float* pd = WS<float>(p, OFF_PD);
    float* x1 = WS<float>(p, OFF_X1); const float* mod = WS<float>(p, OFF_MOD); float* ssqp = WS<float>(p, OFF_SSQP);
    const int x0 = (int)(xb_xcc_id() & 7u);
    const int cofs = j * 32 + 16 * (g & 1) + 8 * ((g >> 1) & 1) + 4 * (g >> 2);
#pragma unroll 1
    for (int so = 0; so < 8; ++so) {
        const int s = (x0 + so) & 7;
        unsigned* q = WS<unsigned>(p, OFF_BAR) + PS_Q_WORD + 64 + 8 * s;
        const unsigned char* tb = vtab + (size_t)s * NEXP * 192;
#pragma unroll 1
        for (;;) {
            const unsigned ch = ps_next(q, bc, tid);
            if (ch >= TOK / PS_CHUNK) break;
            int t = (int)ch * PS_CHUNK + wid;
            int i0 = __builtin_nontemporal_load(ridx + (size_t)t * 128 + lane), i1 = __builtin_nontemporal_load(ridx + (size_t)t * 128 + 64 + lane);
            float d0 = 0.f, d1 = 0.f;
#pragma unroll
            for (int x = 0; x < 8; ++x) { d0 += __builtin_nontemporal_load(pd + ((size_t)x * TOK + t) * 128 + lane); d1 += __builtin_nontemporal_load(pd + ((size_t)x * TOK + t) * 128 + 64 + lane); }
            float g0 = __builtin_nontemporal_load(rgate + (size_t)t * 128 + lane), g1 = __builtin_nontemporal_load(rgate + (size_t)t * 128 + 64 + lane);
            u32x4_t a4[8], b4[8]; u32x2_t a2[8], b2[8];
            PS_LOADH(a4, a2, tb, i0);
#pragma unroll 1
            for (int k = 0; k < PS_CHUNK / 8; ++k, t += 8) {
                const int b = t >> 12, col = s * 256 + cofs;
                const float cf0 = g0 * gelu_exact(d0 * usc[i0]) * vsc[i0], cf1 = g1 * gelu_exact(d1 * usc[i1]) * vsc[i1];
                const float4 xv = *(const float4*)(x1 + (size_t)t * DM + col); const float4 gg = *(const float4*)(mod + (size_t)b * 12288 + 5 * 2048 + col);
                const bool more = k + 1 < PS_CHUNK / 8; const int tn = more ? t + 8 : t;
                const int n0 = __builtin_nontemporal_load(ridx + (size_t)tn * 128 + lane), n1 = __builtin_nontemporal_load(ridx + (size_t)tn * 128 + 64 + lane);
                float e0 = 0.f, e1 = 0.f;
#pragma unroll
                for (int x = 0; x < 8; ++x) { e0 += __builtin_nontemporal_load(pd + ((size_t)x * TOK + tn) * 128 + lane); e1 += __builtin_nontemporal_load(pd + ((size_t)x * TOK + tn) * 128 + 64 + lane); }
                const float ng0 = __builtin_nontemporal_load(rgate + (size_t)tn * 128 + lane), ng1 = __builtin_nontemporal_load(rgate + (size_t)tn * 128 + 64 + lane);
                float y[32];
#pragma unroll
                for (int qq = 0; qq < 32; ++qq) y[qq] = 0.f;
                PS_LOADH(b4, b2, tb, i1);
                PS_CV(a4, a2, cf0);
                if (more) PS_LOADH(a4, a2, tb, n0);
                PS_CV(b4, b2, cf1);
                float w16[16], w8[8], w4[4];
                { const bool hi = (g & 1) != 0;
#pragma unroll
                  for (int i = 0; i < 16; ++i) { const float send = hi ? y[i] : y[16 + i], keep = hi ? y[16 + i] : y[i]; w16[i] = keep + __shfl_xor(send, 8); } }
                { const bool hi = (g & 2) != 0;
#pragma unroll
                  for (int i = 0; i < 8; ++i) { const float send = hi ? w16[i] : w16[8 + i], keep = hi ? w16[8 + i] : w16[i]; w8[i] = keep + __shfl_xor(send, 16); } }
                { const bool hi = (g & 4) != 0;
#pragma unroll
                  for (int i = 0; i < 4; ++i) { const float send = hi ? w8[i] : w8[4 + i], keep = hi ? w8[4 + i] : w8[i]; w4[i] = keep + __shfl_xor(send, 32); } }
                float4 o; o.x = xv.x + gg.x * w4[0]; o.y = xv.y + gg.y * w4[1]; o.z = xv.z + gg.z * w4[2]; o.w = xv.w + gg.w * w4[3];
                *(float4*)(x1 + (size_t)t * DM + col) = o;
                const float ss = wave_sum(o.x * o.x + o.y * o.y + o.z * o.z + o.w * o.w);
                if (lane == 0) ssqp[(size_t)s * TOK + t] = ss;
                i0 = n0; i1 = n1; d0 = e0; d1 = e1; g0 = ng0; g1 = ng1;
            }
        }
    }
}
__device__ __forceinline__ void phase_peer_final(const Params& p, int bid, int nblk) {
    const int tidf = tid_fresh(p.widx), lane = tidf & 63, wid = tidf >> 6;
    const float* x2 = WS<float>(p, OFF_X1); const float* ssqp = WS<float>(p, OFF_SSQP);
    for (int t = bid * 8 + wid; t < TOK; t += nblk * 8) {
        float ss = 0.f;
#pragma unroll
        for (int s = 0; s < 8; ++s) ss += ssqp[(size_t)s * TOK + t];
        const float rstd = rsqrtf(ss * (1.0f / DM) + EPS);
#pragma unroll
        for (int jj = 0; jj < 8; ++jj) { const int col = (jj * 64 + lane) * 4;
            const float4 v = *(const float4*)(x2 + (size_t)t * DM + col), fg = *(const float4*)(p.fin_g + col);
            float4 o; o.x = v.x * rstd * fg.x; o.y = v.y * rstd * fg.y; o.z = v.z * rstd * fg.z; o.w = v.w * rstd * fg.w;
            *(float4*)(p.out + (size_t)t * DM + col) = o; }
    }
}

constexpr int NPHASE = 12;
#ifndef USE_FAST_ROUTE
#define USE_FAST_ROUTE 1
#endif
#ifndef USE_FAST_PEER
#define USE_FAST_PEER 1
#endif
#ifndef USE_MFMA_ATTN
#define USE_MFMA_ATTN 1
#endif
#ifndef USE_MFMA_GEMM
#define USE_MFMA_GEMM 1
#endif
#if !(FUSED && USE_FAST_PEER && PEER_SPLIT && TAB_EB == 6 && !PEER_SLICED)
#error "x1 is kept in bf16: only the default (live) path reads it that way"
#endif
#if USE_MFMA_GEMM
#define GEMM(A, Bt, M, N, K, E) gemm_mfma(A, Bt, M, N, K, E, bid, nblk, (unsigned char*)lds, p.widx)
#else
#define GEMM(A, Bt, M, N, K, E) gemm_ref(A, K, Bt, K, M, N, K, E, bid, nblk)
#endif
template <int PH, int RERUN = 0> __device__ __forceinline__ void run_phase(const Params& p, int bid, int nblk, float* lds) {
    if (PH == 0) phase0(p, bid, nblk, lds);
    if (PH == 1) phase_norm_mod(p, p.x, p.norm1_g, 0, 1, WS<bf16_t>(p, OFF_H), bid, nblk, lds);
    if (PH == 2) { EpiInProj E{WS<bf16_t>(p, OFF_QSB), WS<bf16_t>(p, OFF_KSB), WS<bf16_t>(p, OFF_VSB), WS<bf16_t>(p, OFF_CQ), WS<bf16_t>(p, OFF_CKV), WS<bf16_t>(p, OFF_KMLA),
                                WS<float>(p, OFF_COS), WS<float>(p, OFF_SIN), WS<float>(p, OFF_RSP)};
        GEMM(WS<bf16_t>(p, OFF_H), WS<bf16_t>(p, OFF_WIN_T), TOK, NINP, DM, E); }
    if (PH == 3) phase_rowstats(p, bid, nblk);
    if (PH == 4) {
        LAS float* tab = (LAS float*)((LAS unsigned char*)lds + LDS_TAB_OFF); const int tid = tid_fresh(p.widx);
        { pg8::StaticOrder S; S.init(TOK, 1536, nblk, bid); pg8::Unit u0; const int pm0 = S.next(0, u0) ? u0.pm : -1;
          EpiUq E1{WS<bf16_t>(p, OFF_QMLA), WS<float>(p, OFF_RSP), WS<float>(p, OFF_COS), WS<float>(p, OFF_SIN), tab, pm0};
          if (pm0 >= 0 && tid < 256) tab[tid] = E1.slow_scale(pm0 * 256 + tid);
          __syncthreads();
          GEMM(WS<bf16_t>(p, OFF_CQ), WS<bf16_t>(p, OFF_WUQ_T), TOK, 1536, 512, E1); }
        __syncthreads();
        { pg8::StaticOrder S; S.init(TOK, 2048, nblk, bid); pg8::Unit u0; const int pm0 = S.next(0, u0) ? u0.pm : -1;
          EpiUkv E2{WS<bf16_t>(p, OFF_KMLA), WS<bf16_t>(p, OFF_VMLA), WS<float>(p, OFF_RSP), tab, pm0};
          if (pm0 >= 0 && tid < 256) tab[tid] = E2.slow_scale(pm0 * 256 + tid);
          __syncthreads();
          GEMM(WS<bf16_t>(p, OFF_CKV), WS<bf16_t>(p, OFF_WUKV_T), TOK, 2048, 256, E2); } }
#if USE_MFMA_ATTN
    if (PH == 5) phase_attn_mfma(p, lds, RERUN);
#else
    if (PH == 5) phase_attn_ref(p, bid, nblk);
#endif
    if (PH == 6) phase_onorm(p, bid, nblk);
    if (PH == 7) { LAS float* tab = (LAS float*)((LAS unsigned char*)lds + LDS_TAB_OFF); const int tid = tid_fresh(p.widx);
        pg8::StaticOrder S; S.init(TOK, DM, nblk, bid); pg8::Unit u0; const int pm0 = S.next(0, u0) ? u0.pm : -1;
        EpiWo E{p.x, WS<float>(p, OFF_MOD), WS<bf16_t>(p, OFF_X1), WS<float>(p, OFF_SSQ), tab, pm0};
        if (pm0 >= 0 && tid < 256) { float r0, r1; E.rstd2(pm0 * 256 + tid, r0, r1); tab[2 * tid] = r0 / r1; tab[2 * tid + 1] = r1; }
        __syncthreads();
        GEMM(WS<bf16_t>(p, OFF_O), WS<bf16_t>(p, OFF_WO_T), TOK, DM, DM, E); }
    if (PH == 8) phase_norm_mod(p, WS<bf16_t>(p, OFF_X1), p.norm2_g, 3, 4, WS<bf16_t>(p, OFF_H), bid, nblk, lds);
    if (PH == 9) { EpiQp E{WS<bf16_t>(p, OFF_QP)};
        GEMM(WS<bf16_t>(p, OFF_H), WS<bf16_t>(p, OFF_WPQ_T), TOK, DM, DM, E); }
#if USE_FAST_ROUTE
    if (PH == 10) phase_route_mfma(p, bid, nblk, lds);
#else
    if (PH == 10) phase_route_ref(p, bid, nblk);
#endif
#if USE_FAST_PEER && PEER_SLICED
    if (PH == 11) phase_peer_u_sliced(p, lds);
    if (PH == 12) phase_peer_v_sliced(p, lds);
    if (PH == 13) phase_peer_final(p, bid, nblk);
#elif USE_FAST_PEER && PEER_SPLIT && TAB_EB == 6
    if (PH == 11) phase_peer_u6(p, bid, nblk);
    if (PH == 12) phase_peer_v6(p, bid, nblk);
#elif USE_FAST_PEER
    if (PH == 11) { if (TAB_EB == 6) phase_peer_gather6(p, bid, nblk); else phase_peer_gather<TAB_EB == 6 ? 1 : TAB_EB>(p, bid, nblk); }
#else
    if (PH == 11) phase_peer_ref(p, bid, nblk);
#endif
}

extern __shared__ __attribute__((aligned(16))) unsigned char dynlds[];
constexpr int LDS_MAIN = 131072;
constexpr int LDS_BYTES = LDS_MAIN + 16 + 2048;

template <int PH> __global__ void __launch_bounds__(512, 2) k_phase(Params pin) {
    Params p = pin; p.widx = __builtin_amdgcn_readfirstlane((int)(threadIdx.x >> 6));
    run_phase<PH>(p, blockIdx.x, gridDim.x, (float*)dynlds);
}

__global__ void __launch_bounds__(512, 2) k_fused(Params pin) {
    Params p = pin; p.widx = __builtin_amdgcn_readfirstlane((int)(threadIdx.x >> 6));
    float* lds = (float*)dynlds;
    volatile LAS unsigned* xbw = (volatile LAS unsigned*)(dynlds + LDS_MAIN);
    if (xb_thread0(p.widx)) { xbw[0] = 0u; xbw[1] = 0u; xbw[2] = 0u; xbw[3] = 0u; }
    __syncthreads();
    XcdBarrier bar = xcd_barrier_post(WS<unsigned>(p, OFF_BAR), xbw, p.widx);
    const int bid = blockIdx.x, nblk = gridDim.x;
    run_phase<0>(p, bid, nblk, lds); if (PROBE_DOUBLE & (1 << 0)) run_phase<0, 1>(p, bid, nblk, lds); xcd_barrier(bar);
    run_phase<1>(p, bid, nblk, lds); if (PROBE_DOUBLE & (1 << 1)) run_phase<1, 1>(p, bid, nblk, lds); xcd_barrier(bar);
    run_phase<2>(p, bid, nblk, lds); if (PROBE_DOUBLE & (1 << 2)) run_phase<2, 1>(p, bid, nblk, lds); xcd_barrier(bar);
    run_phase<4>(p, bid, nblk, lds); if (PROBE_DOUBLE & (1 << 4)) run_phase<4, 1>(p, bid, nblk, lds); xcd_barrier(bar);
    run_phase<5>(p, bid, nblk, lds); if (PROBE_DOUBLE & (1 << 5)) run_phase<5, 1>(p, bid, nblk, lds); xcd_barrier(bar);
    run_phase<7>(p, bid, nblk, lds); if (PROBE_DOUBLE & (1 << 7)) run_phase<7, 1>(p, bid, nblk, lds); xcd_barrier(bar);
    run_phase<8>(p, bid, nblk, lds); if (PROBE_DOUBLE & (1 << 8)) run_phase<8, 1>(p, bid, nblk, lds); xcd_barrier(bar);
    run_phase<9>(p, bid, nblk, lds); if (PROBE_DOUBLE & (1 << 9)) run_phase<9, 1>(p, bid, nblk, lds); xcd_barrier(bar);
    run_phase<10>(p, bid, nblk, lds); if (PROBE_DOUBLE & (1 << 10)) run_phase<10, 1>(p, bid, nblk, lds);
#if USE_FAST_ROUTE && USE_FAST_PEER && PEER_SPLIT && TAB_EB == 6 && !PEER_SLICED
    if (nblk * 32 == TOK) { asm volatile("s_waitcnt vmcnt(0)" ::: "memory"); __syncthreads(); }
    else xcd_barrier(bar);
#else
    xcd_barrier(bar);
#endif
    run_phase<11>(p, bid, nblk, lds); if (PROBE_DOUBLE & (1 << 11)) run_phase<11, 1>(p, bid, nblk, lds);
#if USE_FAST_PEER && PEER_SLICED
    xcd_barrier(bar); run_phase<12>(p, bid, nblk, lds);
    xcd_barrier(bar); run_phase<13>(p, bid, nblk, lds);
#elif USE_FAST_PEER && PEER_SPLIT && TAB_EB == 6
    asm volatile("s_waitcnt vmcnt(0)" ::: "memory");
    run_phase<12>(p, bid, nblk, lds);
#endif
}

template <int PH> static void launch_phase(const Params& p, int grid, hipStream_t st) {
    hipLaunchKernelGGL((k_phase<PH>), dim3(grid), dim3(512), LDS_BYTES, st, p);
}

extern "C" void kernel_launch(void* const* d_in, const int* in_sizes, int n_in, void* d_out, int out_size, void* d_ws, size_t ws_size, hipStream_t stream) {
    Params p{};
    p.x = (const float*)d_in[0]; p.c = (const float*)d_in[1]; p.pos = (const int*)d_in[2]; p.w_ada = (const float*)d_in[3]; p.b_ada = (const float*)d_in[4];
    p.norm1_g = (const float*)d_in[5]; p.w_in = (const float*)d_in[6]; p.qn_g = (const float*)d_in[7]; p.w_uq = (const float*)d_in[8]; p.kvn_g = (const float*)d_in[9];
    p.w_ukv = (const float*)d_in[10]; p.osb_g = (const float*)d_in[11]; p.omla_g = (const float*)d_in[12]; p.w_o = (const float*)d_in[13]; p.norm2_g = (const float*)d_in[14];
    p.w_pq = (const float*)d_in[15]; p.keys1 = (const float*)d_in[16]; p.keys2 = (const float*)d_in[17]; p.u_tab = (const float*)d_in[18]; p.v_tab = (const float*)d_in[19];
    p.fin_g = (const float*)d_in[20]; p.out = (float*)d_out; p.ws = (unsigned char*)d_ws;
#if FUSED
    static int grid = 0;
    if (!grid) {
        int dev = 0, cus = 0, per_cu = 0;
        hipGetDevice(&dev);
        hipDeviceGetAttribute(&cus, hipDeviceAttributeMultiprocessorCount, dev);
        hipFuncSetAttribute((const void*)k_fused, hipFuncAttributeMaxDynamicSharedMemorySize, LDS_BYTES);
        hipOccupancyMaxActiveBlocksPerMultiprocessor(&per_cu, k_fused, 512, LDS_BYTES);
        grid = per_cu >= 1 ? cus : 0;
    }
    hipMemsetAsync((unsigned char*)d_ws + OFF_BAR, 0, 16384, stream);
    if (grid) hipLaunchKernelGGL(k_fused, dim3(grid), dim3(512), LDS_BYTES, stream, p);
#else
    const int G = 1024;
    launch_phase<0>(p, G, stream); launch_phase<1>(p, G, stream); launch_phase<2>(p, G, stream); launch_phase<3>(p, G, stream);
    launch_phase<4>(p, G, stream); launch_phase<5>(p, G, stream); launch_phase<6>(p, G, stream); launch_phase<7>(p, G, stream);
    launch_phase<8>(p, G, stream); launch_phase<9>(p, G, stream); launch_phase<10>(p, G, stream); launch_phase<11>(p, G, stream);
#endif
}
```

```cpp
#include <hip/hip_runtime.h>
#include <stdint.h>

#ifndef TAB_EB
#define TAB_EB 6
#endif
#ifndef ATT_ANTIPHASE
#define ATT_ANTIPHASE 1
#endif
#ifndef PEER_SPLIT
#define PEER_SPLIT 1
#endif
#ifndef PEER_SLICED
#define PEER_SLICED 0
#endif
#ifndef PROBE_ATTN_G
#define PROBE_ATTN_G 0
#endif
#ifndef PROBE_DOUBLE
#define PROBE_DOUBLE 0
#endif
#ifndef FUSED
#define FUSED 1
#endif

typedef unsigned short bf16_t;
#define LAS __attribute__((address_space(3)))
__device__ __forceinline__ int tid_fresh(int widx) { unsigned m = ~0u; asm volatile("" : "+s"(m)); int t = (widx << 6) | (int)__builtin_amdgcn_mbcnt_hi(m, __builtin_amdgcn_mbcnt_lo(m, 0u)); asm volatile("" : "+v"(t)); return t; }

constexpr int TOK = 8192, DM = 2048, SEQ = 4096, NB = 2;
constexpr int NIN = 3904, NINP = 4096;
constexpr int NEXP = 16384;
constexpr float EPS = 1e-6f;
constexpr float LOG2E = 1.4426950408889634f, LN2 = 0.6931471805599453f;
constexpr float QS_SB = 0.12751743082459868f;
constexpr float QS_MLA = 0.10411754627697264f;

constexpr size_t MiB = 1ull << 20;
constexpr size_t OFF_BAR = 0;
constexpr size_t OFF_MOD = 16384;
constexpr size_t OFF_COS = OFF_MOD + 98304;
constexpr size_t OFF_SIN = OFF_COS + MiB;
constexpr size_t OFF_RSQ = OFF_SIN + MiB;
constexpr size_t OFF_RSKV = OFF_RSQ + 32768;
constexpr size_t OFF_SSQ = OFF_RSKV + 32768;
constexpr size_t OFF_KEYS = OFF_SSQ + 524288;
constexpr size_t OFF_USC = OFF_KEYS + 524288;
constexpr size_t OFF_VSC = OFF_USC + 65536;
static_assert(OFF_VSC + 65536 <= 4 * MiB, "ws map");
constexpr size_t OFF_WIN_T = 4 * MiB;
constexpr size_t OFF_WUQ_T = OFF_WIN_T + 16 * MiB;
constexpr size_t OFF_WUKV_T = OFF_WUQ_T + 2 * MiB;
constexpr size_t OFF_WO_T = OFF_WUKV_T + 1 * MiB;
constexpr size_t OFF_WPQ_T = OFF_WO_T + 8 * MiB;
constexpr size_t OFF_H = OFF_WPQ_T + 8 * MiB;
constexpr size_t OFF_QSB = OFF_H + 32 * MiB;
constexpr size_t OFF_KSB = OFF_QSB + 16 * MiB;
constexpr size_t OFF_VSB = OFF_KSB + 16 * MiB;
constexpr size_t OFF_CQ = OFF_VSB + 16 * MiB;
constexpr size_t OFF_CKV = OFF_CQ + 8 * MiB;
constexpr size_t OFF_QMLA = OFF_CKV + 4 * MiB;
constexpr size_t OFF_KMLA = OFF_QMLA + 24 * MiB;
constexpr size_t OFF_VMLA = OFF_KMLA + 24 * MiB;
constexpr size_t OFF_O = OFF_VMLA + 16 * MiB;
constexpr size_t OFF_X1 = OFF_O + 32 * MiB;
constexpr size_t OFF_QP = OFF_X1 + 64 * MiB;
constexpr size_t OFF_RIDX = OFF_QP + 32 * MiB;
constexpr size_t OFF_RGATE = OFF_RIDX + 4 * MiB;
constexpr size_t OFF_UTAB = OFF_RGATE + 4 * MiB;
constexpr size_t OFF_VTAB = OFF_UTAB + 64 * MiB;
constexpr size_t OFF_PD = OFF_VTAB + 64 * MiB;
constexpr size_t OFF_SSQP = OFF_PD + 32 * MiB;
constexpr size_t OFF_RSP = OFF_SSQP + 1 * MiB;
constexpr size_t WS_END = OFF_RSP + 1 * MiB;

struct Params {
    const float* x; const float* c; const int* pos; const float* w_ada; const float* b_ada; const float* norm1_g;
    const float* w_in; const float* qn_g; const float* w_uq; const float* kvn_g; const float* w_ukv;
    const float* osb_g; const float* omla_g; const float* w_o; const float* norm2_g; const float* w_pq;
    const float* keys1; const float* keys2; const float* u_tab; const float* v_tab; const float* fin_g;
    float* out; unsigned char* ws;
    int widx; int pad_;
};
template <class Tp> __device__ __forceinline__ Tp* WS(const Params& p, size_t off) { return (Tp*)(p.ws + off); }

__device__ __forceinline__ float bf2f(bf16_t v) { return __uint_as_float(((unsigned)v) << 16); }
__device__ __forceinline__ bf16_t f2bf(float f) { unsigned u = __float_as_uint(f); u += 0x7fffu + ((u >> 16) & 1u); return (bf16_t)(u >> 16); }
__device__ __forceinline__ unsigned pack2(float lo, float hi) { return (unsigned)f2bf(lo) | ((unsigned)f2bf(hi) << 16); }
__device__ __forceinline__ float lo_f(unsigned u) { return __uint_as_float(u << 16); }
__device__ __forceinline__ float hi_f(unsigned u) { return __uint_as_float(u & 0xffff0000u); }
__device__ __forceinline__ float dot8(uint4 a, uint4 b) {
    float s = lo_f(a.x) * lo_f(b.x); s += hi_f(a.x) * hi_f(b.x);
    s += lo_f(a.y) * lo_f(b.y); s += hi_f(a.y) * hi_f(b.y);
    s += lo_f(a.z) * lo_f(b.z); s += hi_f(a.z) * hi_f(b.z);
    s += lo_f(a.w) * lo_f(b.w); s += hi_f(a.w) * hi_f(b.w);
    return s;
}
__device__ __forceinline__ float wave_sum(float v) {
#pragma unroll
    for (int o = 32; o > 0; o >>= 1) v += __shfl_xor(v, o);
    return v;
}
__device__ __forceinline__ float gelu_exact(float x) { return 0.5f * x * (1.0f + erff(x * 0.70710678118654752f)); }

struct EpiInProj {
    static constexpr bool HAS_MID = false;
    bf16_t *qsb, *ksb, *vsb, *cq, *ckv, *kmla; const float *cosT, *sinT; float* rsp;
    __device__ __forceinline__ float row_scale(int) const { return 1.0f; }
    __device__ __forceinline__ float mid_scale(int) const { return 1.0f; }
    __device__ __forceinline__ void store8(int row, int col0, const float (&v)[8], float) const {
        if (col0 >= NIN) return;
        uint4 w;
        if (col0 < 3840) {
            float s = col0 < 1024 ? QS_SB : 1.0f;
            w.x = pack2(v[0] * s, v[1] * s); w.y = pack2(v[2] * s, v[3] * s); w.z = pack2(v[4] * s, v[5] * s); w.w = pack2(v[6] * s, v[7] * s);
            bf16_t* dst;
            if (col0 < 1024) dst = qsb + (size_t)row * 1024 + col0;
            else if (col0 < 2048) dst = ksb + (size_t)row * 1024 + (col0 - 1024);
            else if (col0 < 3072) dst = vsb + (size_t)row * 1024 + (col0 - 2048);
            else if (col0 < 3584) dst = cq + (size_t)row * 512 + (col0 - 3072);
            else dst = ckv + (size_t)row * 256 + (col0 - 3584);
            *(uint4*)dst = w;
            if (col0 >= 3072) {
                float ss = lo_f(w.x) * lo_f(w.x) + hi_f(w.x) * hi_f(w.x) + lo_f(w.y) * lo_f(w.y) + hi_f(w.y) * hi_f(w.y)
                         + lo_f(w.z) * lo_f(w.z) + hi_f(w.z) * hi_f(w.z) + lo_f(w.w) * lo_f(w.w) + hi_f(w.w) * hi_f(w.w);
                ss += __shfl_xor(ss, 16); ss += __shfl_xor(ss, 32);
                if ((tid_fresh(0) & 48) == 0) rsp[(size_t)row * 24 + ((col0 - 3072) >> 5)] = ss;
            }
        } else {
            const int e0 = col0 - 3840, i0 = e0 >> 1;
            float o[8];
#pragma unroll
            for (int j = 0; j < 4; ++j) {
                const float cs = cosT[(size_t)row * 32 + i0 + j], sn = sinT[(size_t)row * 32 + i0 + j];
                const float x1 = v[2 * j], x2 = v[2 * j + 1];
                o[2 * j] = x1 * cs - x2 * sn; o[2 * j + 1] = x2 * cs + x1 * sn;
            }
            w.x = pack2(o[0], o[1]); w.y = pack2(o[2], o[3]); w.z = pack2(o[4], o[5]); w.w = pack2(o[6], o[7]);
#pragma unroll
            for (int h = 0; h < 8; ++h) *(uint4*)(kmla + (size_t)row * 1536 + h * 192 + 128 + e0) = w;
        }
    }
};
struct EpiUq {
    static constexpr bool HAS_MID = false;
    bf16_t* qmla; const float *rsp, *cosT, *sinT; const LAS float* tab; int tab_pm;
    __device__ __forceinline__ float mid_scale(int) const { return 1.0f; }
    __device__ __forceinline__ float slow_scale(int row) const { float s = 0.f;
#pragma unroll
        for (int i = 0; i < 16; ++i) s += rsp[(size_t)row * 24 + i];
        return rsqrtf(s * (1.0f / 512.0f) + EPS) * QS_MLA; }
    __device__ __forceinline__ float row_scale(int row) const { return (row >> 8) == tab_pm ? tab[row & 255] : slow_scale(row); }
    __device__ __forceinline__ void store8(int row, int col0, const float (&v)[8], float r) const {
        const int d0 = col0 % 192;
        float o[8];
        if (d0 < 128) {
#pragma unroll
            for (int j = 0; j < 8; ++j) o[j] = v[j] * r;
        } else {
            const int i0 = (d0 - 128) >> 1;
#pragma unroll
            for (int j = 0; j < 4; ++j) {
                const float cs = cosT[(size_t)row * 32 + i0 + j], sn = sinT[(size_t)row * 32 + i0 + j];
                const float x1 = v[2 * j], x2 = v[2 * j + 1];
                o[2 * j] = (x1 * cs - x2 * sn) * r; o[2 * j + 1] = (x2 * cs + x1 * sn) * r;
            }
        }
        uint4 w; w.x = pack2(o[0], o[1]); w.y = pack2(o[2], o[3]); w.z = pack2(o[4], o[5]); w.w = pack2(o[6], o[7]);
        *(uint4*)(qmla + (size_t)row * 1536 + col0) = w;
    }
};
struct EpiUkv {
    static constexpr bool HAS_MID = false;
    bf16_t *kmla, *vmla; const float* rsp; const LAS float* tab; int tab_pm;
    __device__ __forceinline__ float mid_scale(int) const { return 1.0f; }
    __device__ __forceinline__ float slow_scale(int row) const { float s = 0.f;
#pragma unroll
        for (int i = 0; i < 8; ++i) s += rsp[(size_t)row * 24 + 16 + i];
        return rsqrtf(s * (1.0f / 256.0f) + EPS); }
    __device__ __forceinline__ float row_scale(int row) const { return (row >> 8) == tab_pm ? tab[row & 255] : slow_scale(row); }
    __device__ __forceinline__ void store8(int row, int col0, const float (&v)[8], float r) const {
        const int h = col0 >> 8, j0 = col0 & 255;
        uint4 w; w.x = pack2(v[0] * r, v[1] * r); w.y = pack2(v[2] * r, v[3] * r); w.z = pack2(v[4] * r, v[5] * r); w.w = pack2(v[6] * r, v[7] * r);
        bf16_t* dst = j0 < 128 ? kmla + (size_t)row * 1536 + h * 192 + j0 : vmla + (size_t)row * 1024 + h * 128 + (j0 - 128);
        *(uint4*)dst = w;
    }
};
struct EpiWo {
    static constexpr bool HAS_MID = true;
    const float* x; const float* mod; bf16_t* x1; const float* ssq; const LAS float* tab; int tab_pm;
    __device__ __forceinline__ void rstd2(int row, float& r0, float& r1) const { float s0 = 0.f, s1 = 0.f;
#pragma unroll
        for (int h = 0; h < 8; ++h) { s0 += ssq[(size_t)row * 16 + h]; s1 += ssq[(size_t)row * 16 + 8 + h]; }
        r0 = rsqrtf(s0 * (1.0f / 1024.0f) + EPS); r1 = rsqrtf(s1 * (1.0f / 1024.0f) + EPS); }
    __device__ __forceinline__ float mid_scale(int row) const { if ((row >> 8) == tab_pm) return tab[2 * (row & 255)]; float r0, r1; rstd2(row, r0, r1); return r0 / r1; }
    __device__ __forceinline__ float row_scale(int row) const { if ((row >> 8) == tab_pm) return tab[2 * (row & 255) + 1]; float r0, r1; rstd2(row, r0, r1); return r1; }
    __device__ __forceinline__ void store8(int row, int col0, const float (&vin)[8], float rsc) const {
        float v[8];
#pragma unroll
        for (int i = 0; i < 8; ++i) v[i] = vin[i] * rsc;
        const int b = row >> 12;
        const float* g1 = mod + (size_t)b * 12288 + 2 * 2048 + col0;
        const float4 xa = *(const float4*)(x + (size_t)row * DM + col0), xb = *(const float4*)(x + (size_t)row * DM + col0 + 4);
        const float4 ga = *(const float4*)g1, gb = *(const float4*)(g1 + 4);
        float4 oa, ob;
        oa.x = xa.x + ga.x * v[0]; oa.y = xa.y + ga.y * v[1]; oa.z = xa.z + ga.z * v[2]; oa.w = xa.w + ga.w * v[3];
        ob.x = xb.x + gb.x * v[4]; ob.y = xb.y + gb.y * v[5]; ob.z = xb.z + gb.z * v[6]; ob.w = xb.w + gb.w * v[7];
        uint4 w; w.x = pack2(oa.x, oa.y); w.y = pack2(oa.z, oa.w); w.z = pack2(ob.x, ob.y); w.w = pack2(ob.z, ob.w);
        *(uint4*)(x1 + (size_t)row * DM + col0) = w;
    }
};
struct EpiQp {
    static constexpr bool HAS_MID = false;
    bf16_t* qp;
    __device__ __forceinline__ float row_scale(int) const { return 1.0f; }
    __device__ __forceinline__ float mid_scale(int) const { return 1.0f; }
    __device__ __forceinline__ void store8(int row, int col0, const float (&v)[8], float) const {
        uint4 w; w.x = pack2(v[0], v[1]); w.y = pack2(v[2], v[3]); w.z = pack2(v[4], v[5]); w.w = pack2(v[6], v[7]);
        *(uint4*)(qp + (size_t)row * DM + col0) = w;
    }
};

namespace pg8 {
#define PG8_LAS __attribute__((address_space(3)))
typedef unsigned short bf16_t;
typedef short bf16x8 __attribute__((ext_vector_type(8)));
typedef float f32x4 __attribute__((ext_vector_type(4)));
typedef unsigned u32x4 __attribute__((ext_vector_type(4)));
constexpr int BM = 256, BK = 64, HALF = 128, HTB = HALF * BK * 2  , STAGE_BYTES = 8 * HTB, NXCD = 8, WGM = 8;

__host__ __device__ __forceinline__ int lds_byte(int r, int c) { const int st = (r >> 4) * 2 + (c >> 5), rr = r & 15, cc = c & 31, ob = rr * 64 + cc * 2; return st * 1024 + (ob ^ (((ob >> 9) & 1) << 5)); }
__host__ __device__ __forceinline__ void stage_rc(int b, int& R, int& C) { const int st = b / 1024, sb = b % 1024, swz = sb ^ (((sb >> 9) & 1) << 5); R = (st >> 1) * 16 + swz / 64; C = (st & 1) * 32 + (swz % 64) / 2; }
__host__ __device__ __forceinline__ int perm32(int rho) { const int n = rho >> 4, i = rho & 15; return 8 * (i >> 2) + 4 * n + (i & 3); }

struct Unit { int pm, pn; };
struct Gemm { const bf16_t* A; const bf16_t* Bt; int M, N, K, widx; };

struct StaticOrder {
    int nM, nN, nwg, G, c;
    __host__ __device__ __forceinline__ void init(int M, int N, int G_, int c_) { nM = M / BM; nN = N / BM; nwg = nM * nN; G = G_; c = c_; }
    __host__ __device__ bool next(int i, Unit& u) const {
        const long L = (long)i * G + c; if (L >= nwg) return false;
        int wgid = (int)L; { const int q = nwg / NXCD, r = nwg % NXCD, xcd = wgid % NXCD, off = wgid / NXCD; wgid = (xcd < r ? xcd * (q + 1) : r * (q + 1) + (xcd - r) * q) + off; }
        const int nig = WGM * nN, gid = wgid / nig, fm = gid * WGM, gsz = (nM - fm) < WGM ? (nM - fm) : WGM;
        u.pm = fm + ((wgid % nig) % gsz); u.pn = (wgid % nig) / gsz; return true;
    }
    __device__ __forceinline__ void a_ready(const Unit&) const {}
    __device__ __forceinline__ void done(const Unit&) const {}
};

template <class Epi, class Sched, bool ALIGN_EPI = false, bool SP2 = false>
__device__ __forceinline__ void gemm_phase(PG8_LAS unsigned char* lds, const Gemm g, const Sched& S, const Epi& E) {
    const int tid = tid_fresh(g.widx), wid = __builtin_amdgcn_readfirstlane(tid >> 6), lane = tid & 63, wr = wid >> 2, wc = wid & 3, fr = lane & 15, fq = lane >> 4;
    const int K = g.K, nt = K / BK;
    unsigned voffA[2], voffB[2];
#pragma unroll
    for (int i = 0; i < 2; ++i) { int R, C; stage_rc(tid * 16 + i * 8192, R, C); const int Rb = Epi::PERM ? ((R & ~31) + perm32(R & 31)) : R;
        voffA[i] = (unsigned)(R * K + C) * 2u; voffB[i] = (unsigned)(Rb * K + C) * 2u; }
    const size_t kstep = (size_t)(BK * 2);
    const size_t hstep = (size_t)HALF * K * 2;
    const size_t tstep = 2 * hstep;
    const unsigned ldsw = (unsigned)wid * 1024u;
    const int aoff = lds_byte(wr * 64 + fr, fq * 8), boff = lds_byte(wc * 32 + fr, fq * 8);
#define PG8_SA(b, h) (((b) * 2 + (h)) * HTB)
#define PG8_SB(b, h) ((4 + (b) * 2 + (h)) * HTB)
#define PG8_STAGE(bufoff, gbase, voff) do { _Pragma("unroll") for (int _i = 0; _i < 2; ++_i) \
        __builtin_amdgcn_global_load_lds((const unsigned*)((const char*)(gbase) + (voff)[_i]), (PG8_LAS unsigned*)(lds + (bufoff) + ldsw + _i * 8192), 16, 0, 0); } while (0)
#define PG8_LDA(dst, b, h) do { _Pragma("unroll") for (int m = 0; m < 4; ++m) _Pragma("unroll") for (int k = 0; k < 2; ++k) dst[m][k] = *(const PG8_LAS bf16x8*)(lds + PG8_SA(b, h) + aoff + m * 2048 + k * 1024); } while (0)
#define PG8_LDB(dst, b, h) do { _Pragma("unroll") for (int n = 0; n < 2; ++n) _Pragma("unroll") for (int k = 0; k < 2; ++k) dst[n][k] = *(const PG8_LAS bf16x8*)(lds + PG8_SB(b, h) + boff + n * 2048 + k * 1024); } while (0)
#define PG8_MMA(ai, bj, At, Bt) do { __builtin_amdgcn_s_setprio(1); _Pragma("unroll") for (int m = 0; m < 4; ++m) _Pragma("unroll") for (int n = 0; n < 2; ++n) _Pragma("unroll") for (int k = 0; k < 2; ++k) \
        acc[ai][bj][m][n] = __builtin_amdgcn_mfma_f32_16x16x32_bf16(Bt[n][k], At[m][k], acc[ai][bj][m][n], 0, 0, 0); __builtin_amdgcn_s_setprio(0); } while (0)
#define PG8_WAIT_V(n) asm volatile("s_waitcnt vmcnt(" #n ")" ::: "memory")
#define PG8_WAIT_L(n) asm volatile("s_waitcnt lgkmcnt(" #n ")" ::: "memory")
#define PG8_BAR __builtin_amdgcn_s_barrier()
#define PG8_SCHED __builtin_amdgcn_sched_barrier(0)
    Unit cur, nxt; int ui = 0;
    if (!S.next(0, cur)) return;
    f32x4 acc[2][2][4][2];
#pragma unroll
    for (int a = 0; a < 2; ++a)
#pragma unroll
        for (int b = 0; b < 2; ++b)
#pragma unroll
            for (int m = 0; m < 4; ++m)
#pragma unroll
                for (int n = 0; n < 2; ++n) acc[a][b][m][n] = (f32x4){0.f, 0.f, 0.f, 0.f};
    bf16x8 At[4][2], B0[2][2], B1[2][2];
    const char* cA = (const char*)g.A + (size_t)cur.pm * tstep; const char* cB = (const char*)g.Bt + (size_t)cur.pn * tstep;
    S.a_ready(cur);
    if constexpr (SP2) {
        PG8_STAGE(PG8_SB(0, 0), cB, voffB); PG8_STAGE(PG8_SB(0, 1), cB + hstep, voffB); PG8_STAGE(PG8_SA(0, 0), cA, voffA); PG8_STAGE(PG8_SA(0, 1), cA + hstep, voffA);
        if (wr == 1) PG8_BAR;
        PG8_WAIT_V(2); PG8_BAR;
        PG8_STAGE(PG8_SB(1, 0), cB + kstep, voffB); PG8_STAGE(PG8_SA(1, 0), cA + kstep, voffA); PG8_STAGE(PG8_SB(1, 1), cB + hstep + kstep, voffB);
        PG8_WAIT_V(6); PG8_BAR;
    } else {
        PG8_STAGE(PG8_SB(0, 0), cB, voffB); PG8_STAGE(PG8_SA(0, 0), cA, voffA); PG8_STAGE(PG8_SB(0, 1), cB + hstep, voffB); PG8_STAGE(PG8_SA(0, 1), cA + hstep, voffA);
        if (wr == 1) PG8_BAR;
        PG8_WAIT_V(4); PG8_BAR;
        PG8_STAGE(PG8_SB(1, 0), cB + kstep, voffB); PG8_STAGE(PG8_SA(1, 0), cA + kstep, voffA); PG8_STAGE(PG8_SB(1, 1), cB + hstep + kstep, voffB);
        PG8_WAIT_V(6); PG8_BAR;
    }
    for (;;) {
        const bool has_next = S.next(ui + 1, nxt);
        const char* nA = has_next ? (const char*)g.A + (size_t)nxt.pm * tstep : cA; const char* nB = has_next ? (const char*)g.Bt + (size_t)nxt.pn * tstep : cB;
        for (int t = 0; t < nt; t += 2) {
            const bool last = (t == nt - 2);
            const char* a1 = cA + (size_t)(t + 1) * kstep;
            const char* a2 = last ? nA : cA + (size_t)(t + 2) * kstep; const char* b2 = last ? nB : cB + (size_t)(t + 2) * kstep;
            const char* a3 = a2 + kstep; const char* b3 = b2 + kstep;
            if (last && has_next) S.a_ready(nxt);
            if constexpr (Epi::HAS_MID) { if (t == (nt >> 1)) E.mid(acc, cur, wr, wc, fr, fq); }
            if constexpr (SP2) {
            PG8_LDB(B0, 0, 0); PG8_LDB(B1, 0, 1); PG8_SCHED; PG8_LDA(At, 0, 0); PG8_STAGE(PG8_SA(1, 1), a1 + hstep, voffA);
            PG8_WAIT_V(8); PG8_WAIT_L(0); PG8_BAR; PG8_MMA(0, 0, At, B0); PG8_MMA(0, 1, At, B1); PG8_BAR; PG8_SCHED;
            PG8_LDA(At, 0, 1); PG8_STAGE(PG8_SB(0, 0), b2, voffB); PG8_STAGE(PG8_SB(0, 1), b2 + hstep, voffB); PG8_STAGE(PG8_SA(0, 0), a2, voffA);
            PG8_WAIT_V(8); PG8_WAIT_L(0); PG8_BAR; PG8_MMA(1, 0, At, B0); PG8_MMA(1, 1, At, B1); PG8_BAR; PG8_SCHED;
            PG8_LDB(B0, 1, 0); PG8_LDB(B1, 1, 1); PG8_SCHED; PG8_LDA(At, 1, 0); PG8_STAGE(PG8_SA(0, 1), a2 + hstep, voffA);
            PG8_WAIT_V(8); PG8_WAIT_L(0); PG8_BAR; PG8_MMA(0, 0, At, B0); PG8_MMA(0, 1, At, B1); PG8_BAR; PG8_SCHED;
            PG8_LDA(At, 1, 1); PG8_STAGE(PG8_SB(1, 0), b3, voffB); PG8_STAGE(PG8_SB(1, 1), b3 + hstep, voffB); PG8_STAGE(PG8_SA(1, 0), a3, voffA);
            PG8_WAIT_V(8); PG8_WAIT_L(0); PG8_BAR; PG8_MMA(1, 0, At, B0); PG8_MMA(1, 1, At, B1); PG8_BAR; PG8_SCHED;
            } else {
            PG8_LDB(B0, 0, 0); PG8_SCHED; PG8_LDA(At, 0, 0); PG8_STAGE(PG8_SA(1, 1), a1 + hstep, voffA);
            PG8_WAIT_L(8); PG8_BAR; PG8_WAIT_L(0); PG8_MMA(0, 0, At, B0); PG8_BAR; PG8_SCHED;
            PG8_LDB(B1, 0, 1); PG8_STAGE(PG8_SB(0, 0), b2, voffB);
            PG8_BAR; PG8_WAIT_L(0); PG8_MMA(0, 1, At, B1); PG8_BAR;
            PG8_LDA(At, 0, 1); PG8_STAGE(PG8_SA(0, 0), a2, voffA);
            PG8_BAR; PG8_WAIT_L(0); PG8_MMA(1, 0, At, B0); PG8_BAR; PG8_SCHED;
            PG8_STAGE(PG8_SB(0, 1), b2 + hstep, voffB);
            PG8_WAIT_V(6); PG8_BAR; PG8_MMA(1, 1, At, B1); PG8_BAR;
            PG8_LDB(B0, 1, 0); PG8_SCHED; PG8_LDA(At, 1, 0); PG8_STAGE(PG8_SA(0, 1), a2 + hstep, voffA);
            PG8_WAIT_L(8); PG8_BAR; PG8_WAIT_L(0); PG8_MMA(0, 0, At, B0); PG8_BAR; PG8_SCHED;
            PG8_LDB(B1, 1, 1); PG8_STAGE(PG8_SB(1, 0), b3, voffB);
            PG8_BAR; PG8_WAIT_L(0); PG8_MMA(0, 1, At, B1); PG8_BAR;
            PG8_LDA(At, 1, 1); PG8_STAGE(PG8_SA(1, 0), a3, voffA);
            PG8_BAR; PG8_WAIT_L(0); PG8_MMA(1, 0, At, B0); PG8_BAR; PG8_SCHED;
            PG8_STAGE(PG8_SB(1, 1), b3 + hstep, voffB);
            PG8_WAIT_V(6); PG8_BAR; PG8_MMA(1, 1, At, B1); PG8_BAR;
            }
        }
        if constexpr (ALIGN_EPI) { if (wr == 0) PG8_BAR; }
        if constexpr (!Epi::AFTER_DRAIN) { E(acc, cur, wr, wc, fr, fq); S.done(cur); }
        if (!has_next) break;
#pragma unroll
        for (int a = 0; a < 2; ++a)
#pragma unroll
            for (int b = 0; b < 2; ++b)
#pragma unroll
                for (int m = 0; m < 4; ++m)
#pragma unroll
                    for (int n = 0; n < 2; ++n) acc[a][b][m][n] = (f32x4){0.f, 0.f, 0.f, 0.f};
        cur = nxt; cA = nA; cB = nB; ++ui;
        if constexpr (ALIGN_EPI) { if (wr == 1) PG8_BAR; }
    }
    PG8_WAIT_V(0);
    if constexpr (!ALIGN_EPI) { if (wr == 0) PG8_BAR; }
    PG8_BAR;
    if constexpr (Epi::AFTER_DRAIN) { E.fused(acc, cur, wr, wc, fr, fq, lds, wid, lane); S.done(cur); }
#undef PG8_SA
#undef PG8_SB
#undef PG8_STAGE
#undef PG8_LDA
#undef PG8_LDB
#undef PG8_MMA
#undef PG8_WAIT_V
#undef PG8_WAIT_L
#undef PG8_BAR
#undef PG8_SCHED
}
}

template <class C> struct EpiChunk {
    static constexpr bool PERM = true, AFTER_DRAIN = false, HAS_MID = C::HAS_MID;
    C c;
    __device__ __forceinline__ void mid(pg8::f32x4 (&acc)[2][2][4][2], const pg8::Unit& u, int wr, int wc, int fr, int fq) const {
#pragma unroll
        for (int ai = 0; ai < 2; ++ai)
#pragma unroll
            for (int m = 0; m < 4; ++m) { const float f = c.mid_scale(u.pm * 256 + ai * 128 + wr * 64 + m * 16 + fr);
#pragma unroll
                for (int bj = 0; bj < 2; ++bj)
#pragma unroll
                    for (int n = 0; n < 2; ++n) acc[ai][bj][m][n] = acc[ai][bj][m][n] * f; }
    }
    __device__ __forceinline__ void operator()(const pg8::f32x4 (&acc)[2][2][4][2], const pg8::Unit& u, int wr, int wc, int fr_in, int fq_in) const {
        int fr = fr_in, fq = fq_in; asm volatile("" : "+v"(fr), "+v"(fq));
#pragma unroll
        for (int ai = 0; ai < 2; ++ai)
#pragma unroll
            for (int m = 0; m < 4; ++m) {
                const int row = u.pm * 256 + ai * 128 + wr * 64 + m * 16 + fr;
                const float rsc = c.row_scale(row);
#pragma unroll
                for (int bj = 0; bj < 2; ++bj) {
                    const int col0 = u.pn * 256 + bj * 128 + wc * 32 + 8 * fq;
                    const pg8::f32x4 a = acc[ai][bj][m][0], b = acc[ai][bj][m][1];
                    const float v[8] = {a[0], a[1], a[2], a[3], b[0], b[1], b[2], b[3]};
                    c.store8(row, col0, v, rsc);
                }
                asm volatile("" ::: "memory");
            }
    }
};
template <class C> __device__ __forceinline__ void gemm_mfma(const bf16_t* A, const bf16_t* Bt, int M, int N, int K, const C& c, int bid, int nblk, unsigned char* lds, int widx) {
    pg8::Gemm g; g.A = A; g.Bt = Bt; g.M = M; g.N = N; g.K = K; g.widx = widx;
    pg8::StaticOrder S; S.init(M, N, nblk, bid);
    EpiChunk<C> E{c};
    pg8::gemm_phase<EpiChunk<C>, pg8::StaticOrder, true, true>((PG8_LAS unsigned char*)lds, g, S, E);
}

template <class Epi>
__device__ __forceinline__ void gemm_ref(const bf16_t* A, int lda, const bf16_t* Bt, int ldb, int M, int N, int K, const Epi& E, int bid, int nblk) {
    const int tid = (int)threadIdx.x, tn = N / 64, ntile = (M / 64) * tn;
    for (int tile = bid; tile < ntile; tile += nblk) {
        const int row = (tile / tn) * 64 + (tid >> 3), col0 = (tile % tn) * 64 + (tid & 7) * 8;
        float acc[8];
#pragma unroll
        for (int j = 0; j < 8; ++j) acc[j] = 0.f;
        const bf16_t* ap = A + (size_t)row * lda; const bf16_t* bp = Bt + (size_t)col0 * ldb;
        for (int k0 = 0; k0 < K; k0 += 8) {
            const uint4 av = *(const uint4*)(ap + k0);
#pragma unroll
            for (int j = 0; j < 8; ++j) { const uint4 bv = *(const uint4*)(bp + (size_t)j * ldb + k0); acc[j] += dot8(av, bv); }
        }
        E.store8(row, col0, acc, E.row_scale(row));
    }
}

constexpr int J_ADA = 192, J_WIN = 64, J_WO = 32, J_WPQ = 32, J_WUQ = 24, J_WUKV = 32, J_KEYS = 16, J_ROPE = 256;
constexpr int J0_END = J_ADA, J1_END = J0_END + J_WIN, J2_END = J1_END + J_WO, J3_END = J2_END + J_WPQ, J4_END = J3_END + J_WUQ,
              J5_END = J4_END + J_WUKV, J6_END = J5_END + J_KEYS, J7_END = J6_END + J_ROPE, J8_END = J7_END + 1024;

__device__ __forceinline__ void job_ada(const Params& p, int it, float* lds) {
    const int tid = tid_fresh(p.widx);
    float* sc = lds;
    float* red = lds + 4096;
    for (int i = tid; i < 4096; i += 512) { const float v = p.c[i]; sc[i] = v / (1.0f + __expf(-v)); }
    __syncthreads();
    const int cg = tid & 15, rl = tid >> 4, c0 = it * 64 + cg * 4;
    float4 a0 = {0.f, 0.f, 0.f, 0.f}, a1 = {0.f, 0.f, 0.f, 0.f};
#pragma unroll 8
    for (int i = 0; i < 64; ++i) {
        const int k = rl + 32 * i;
        const float4 w = *(const float4*)(p.w_ada + (size_t)k * 12288 + c0);
        const float s0 = sc[k], s1 = sc[2048 + k];
        a0.x += s0 * w.x; a0.y += s0 * w.y; a0.z += s0 * w.z; a0.w += s0 * w.w;
        a1.x += s1 * w.x; a1.y += s1 * w.y; a1.z += s1 * w.z; a1.w += s1 * w.w;
    }
    float* r0 = red + rl * 128 + cg * 4;
    r0[0] = a0.x; r0[1] = a0.y; r0[2] = a0.z; r0[3] = a0.w; r0[64] = a1.x; r0[65] = a1.y; r0[66] = a1.z; r0[67] = a1.w;
    __syncthreads();
    if (tid < 128) {
        float s = 0.f;
        for (int r = 0; r < 32; ++r) s += red[r * 128 + tid];
        const int b = tid >> 6, col = it * 64 + (tid & 63);
        WS<float>(p, OFF_MOD)[(size_t)b * 12288 + col] = s + p.b_ada[col];
    }
    __syncthreads();
}

template <int W> __device__ __forceinline__ int tr_dst_row(int n) {
    if (W == 0) { if (n < 3840) return n; const int e = n - 3840; return 3840 + 2 * (e & 31) + (e >> 5); }
    if (W == 3) { const int h = n / 192, d = n % 192; if (d < 128) return n; const int e = d - 128; return h * 192 + 128 + 2 * (e & 31) + (e >> 5); }
    return n;
}
template <int W> __device__ __forceinline__ float tr_scale(const Params& p, int k) {
    if (W == 1) return k < 1024 ? p.osb_g[k] : p.omla_g[k - 1024];
    if (W == 3) return p.qn_g[k];
    if (W == 4) return p.kvn_g[k];
    return 1.0f;
}
template <int W> __device__ __forceinline__ void job_transpose(const Params& p, int it, float* tile, int kpart = 0, int kparts = 1) {
    constexpr int K = (W == 3) ? 512 : (W == 4) ? 256 : 2048;
    constexpr int NS = (W == 0) ? NIN : (W == 3) ? 1536 : 2048;
    constexpr int TS = 68;
    const float* src = (W == 0) ? p.w_in : (W == 1) ? p.w_o : (W == 2) ? p.w_pq : (W == 3) ? p.w_uq : p.w_ukv;
    bf16_t* dst = WS<bf16_t>(p, (W == 0) ? OFF_WIN_T : (W == 1) ? OFF_WO_T : (W == 2) ? OFF_WPQ_T : (W == 3) ? OFF_WUQ_T : OFF_WUKV_T);
    const int tid = tid_fresh(p.widx), n0 = it * 64;
    if (W == 0 && n0 >= NIN) {
        const uint4 z = {0u, 0u, 0u, 0u};
        if (kpart == 0) for (int i = tid; i < 64 * K / 8; i += 512) *(uint4*)(dst + (size_t)n0 * K + (size_t)i * 8) = z;
        return;
    }
    const int lr = tid >> 4, lc = (tid & 15) * 4;
    const int sn = tid >> 3, skc = tid & 7;
    const size_t drow = (size_t)tr_dst_row<W>(n0 + sn) * K;
    for (int k0 = kpart * (K / kparts); k0 < (kpart + 1) * (K / kparts); k0 += 256) {
        float4 r[8];
#pragma unroll
        for (int i = 0; i < 8; ++i) r[i] = *(const float4*)(src + (size_t)(k0 + lr + 32 * i) * NS + n0 + lc);
#pragma unroll
        for (int i = 0; i < 8; ++i) *(float4*)(tile + (lr + 32 * i) * TS + lc) = r[i];
        __syncthreads();
#pragma unroll
        for (int q = 0; q < 4; ++q) {
            const int kk = skc * 32 + q * 8;
            float v[8];
#pragma unroll
            for (int j = 0; j < 8; ++j) v[j] = tile[(kk + j) * TS + sn] * tr_scale<W>(p, k0 + kk + j);
            uint4 w; w.x = pack2(v[0], v[1]); w.y = pack2(v[2], v[3]); w.z = pack2(v[4], v[5]); w.w = pack2(v[6], v[7]);
            *(uint4*)(dst + drow + k0 + kk) = w;
        }
        __syncthreads();
    }
}
__device__ __forceinline__ void job_keys(const Params& p, int slot) {
    const float* src = ((slot & 1) ? p.keys2 : p.keys1) + (size_t)(slot >> 1) * 16384;
    bf16_t* dst = WS<bf16_t>(p, OFF_KEYS) + (size_t)slot * 16384;
    for (int i = tid_fresh(p.widx); i < 16384; i += 512) dst[i] = f2bf(src[i]);
}
__device__ __forceinline__ void job_rope(const Params& p, int it) {
    float* cosT = WS<float>(p, OFF_COS); float* sinT = WS<float>(p, OFF_SIN);
    const int tid = tid_fresh(p.widx), i = tid & 31;
    double inv = 1.0;
    for (int q = 0; q < i; ++q) inv *= 0.7498942093324559;
#pragma unroll
    for (int j = 0; j < 2; ++j) {
        const int t = it * 32 + ((tid + 512 * j) >> 5);
        const double ang = (double)p.pos[t] * inv;
        const double n = rint(ang * 0.15915494309189535);
        const double r = fma(-n, 6.283185307179586, ang) - n * 2.4492935982947064e-16;
        const float rf = (float)r;
        cosT[(size_t)t * 32 + i] = cosf(rf); sinT[(size_t)t * 32 + i] = sinf(rf);
    }
}
template <int EB> __device__ __forceinline__ void job_table(const Params& p, int it);
__device__ __forceinline__ void job_table6(const Params& p, int it);
__device__ __forceinline__ void phase0(const Params& p, int bid, int nblk, float* lds) {
    constexpr int V0 = J_ADA, V1 = V0 + 2 * J_WIN, V2 = V1 + 2 * J_WO, V3 = V2 + 2 * J_WPQ, V5 = V3 + J_WUQ, V6 = V5 + J_WUKV, V7 = V6 + J_KEYS, V8 = V7 + J_ROPE;
    for (int r = 0; r * nblk < V8; ++r) {
        const int v = r * nblk + ((r & 1) ? nblk - 1 - bid : bid);
        if (v >= V8) continue;
        if (v < V0) job_ada(p, v, lds);
        else if (v < V1) job_transpose<0>(p, (v - V0) >> 1, lds, (v - V0) & 1, 2);
        else if (v < V2) job_transpose<1>(p, (v - V1) >> 1, lds, (v - V1) & 1, 2);
        else if (v < V3) job_transpose<2>(p, (v - V2) >> 1, lds, (v - V2) & 1, 2);
        else if (v < V5) job_transpose<3>(p, v - V3, lds);
        else if (v < V6) job_transpose<4>(p, v - V5, lds);
        else if (v < V7) job_keys(p, v - V6);
        else job_rope(p, v - V7);
    }
}

template <class TS> __device__ __forceinline__ void phase_norm_mod(const Params& p, const TS* src, const float* gain, int sh_idx, int sc_idx, bf16_t* dst, int bid, int nblk, float* lds) {
    const int tid = tid_fresh(p.widx), lane = tid & 63, wid = tid >> 6;
    const float* mod = WS<float>(p, OFF_MOD);
    float* av = lds;
    float* sv = lds + 4096;
    for (int i = tid; i < 4096; i += 512) { const int b = i >> 11, col = i & 2047;
        av[i] = gain[col] * (1.0f + mod[(size_t)b * 12288 + sc_idx * 2048 + col]); sv[i] = mod[(size_t)b * 12288 + sh_idx * 2048 + col]; }
    __syncthreads();
    for (int t = bid * 8 + wid; t < TOK; t += nblk * 8) {
        const int b = t >> 12;
        const TS* xr = src + (size_t)t * DM;
        float4 v[8]; float ss = 0.f;
#pragma unroll
        for (int j = 0; j < 8; ++j) {
            if constexpr (sizeof(TS) == 4) v[j] = *(const float4*)(xr + (j * 64 + lane) * 4);
            else { const uint2 w = *(const uint2*)(xr + (j * 64 + lane) * 4); v[j].x = lo_f(w.x); v[j].y = hi_f(w.x); v[j].z = lo_f(w.y); v[j].w = hi_f(w.y); }
            ss += v[j].x * v[j].x + v[j].y * v[j].y + v[j].z * v[j].z + v[j].w * v[j].w; }
        ss = wave_sum(ss);
        const float rstd = rsqrtf(ss * (1.0f / DM) + EPS);
#pragma unroll
        for (int j = 0; j < 8; ++j) {
            const int col = (j * 64 + lane) * 4;
            const float4 a = *(const float4*)(av + b * 2048 + col), s = *(const float4*)(sv + b * 2048 + col);
            uint2 w; w.x = pack2(v[j].x * rstd * a.x + s.x, v[j].y * rstd * a.y + s.y); w.y = pack2(v[j].z * rstd * a.z + s.z, v[j].w * rstd * a.w + s.w);
            *(uint2*)(dst + (size_t)t * DM + col) = w;
        }
    }
    __syncthreads();
}

__device__ __forceinline__ void phase_rowstats(const Params& p, int bid, int nblk) {
    const int tidf = tid_fresh(p.widx), lane = tidf & 63, wid = tidf >> 6;
    const bf16_t* cq = WS<bf16_t>(p, OFF_CQ); const bf16_t* ckv = WS<bf16_t>(p, OFF_CKV);
    for (int t = bid * 8 + wid; t < TOK; t += nblk * 8) {
        const uint4 a = *(const uint4*)(cq + (size_t)t * 512 + lane * 8);
        float s1 = dot8(a, a), s2 = 0.f;
        if (lane < 32) { const uint4 b = *(const uint4*)(ckv + (size_t)t * 256 + lane * 8); s2 = dot8(b, b); }
        s1 = wave_sum(s1); s2 = wave_sum(s2);
        if (lane == 0) { WS<float>(p, OFF_RSQ)[t] = rsqrtf(s1 * (1.0f / 512.0f) + EPS); WS<float>(p, OFF_RSKV)[t] = rsqrtf(s2 * (1.0f / 256.0f) + EPS); }
    }
}

__device__ __forceinline__ void phase_attn_ref(const Params& p, int bid, int nblk) {
    const int tid = tid_fresh(p.widx), ql = tid >> 2, part = tid & 3;
    const bf16_t* qsb = WS<bf16_t>(p, OFF_QSB); const bf16_t* ksb = WS<bf16_t>(p, OFF_KSB); const bf16_t* vsb = WS<bf16_t>(p, OFF_VSB);
    const bf16_t* qml = WS<bf16_t>(p, OFF_QMLA); const bf16_t* kml = WS<bf16_t>(p, OFF_KMLA); const bf16_t* vml = WS<bf16_t>(p, OFF_VMLA);
    bf16_t* O = WS<bf16_t>(p, OFF_O); float* ssq = WS<float>(p, OFF_SSQ);
    for (int it = bid; it < 1024; it += nblk) {
        const int g = it >> 9, rem = it & 511, b = rem >> 8, h = (rem >> 5) & 7, qb = 31 - (rem & 31);
        const int t = qb * 128 + ql; const size_t tok = (size_t)b * SEQ + t;
        const int tmax = qb * 128 + (ql | 15);
        float o[32];
#pragma unroll
        for (int d = 0; d < 32; ++d) o[d] = 0.f;
        if (g == 0) {
            uint4 q[4];
#pragma unroll
            for (int j = 0; j < 4; ++j) q[j] = *(const uint4*)(qsb + tok * 1024 + h * 128 + part * 32 + j * 8);
            float between = 0.f;
            for (int s = tmax - 1; s >= 0; --s) {
                const size_t kt = (size_t)b * SEQ + s;
                float z2 = 0.f;
#pragma unroll
                for (int j = 0; j < 4; ++j) z2 += dot8(q[j], *(const uint4*)(ksb + kt * 1024 + h * 128 + part * 32 + j * 8));
                z2 += __shfl_xor(z2, 1); z2 += __shfl_xor(z2, 2);
                if (s < t) {
                    const float z = z2 * LN2;
                    const float l1p = log1pf(__expf(-fabsf(z)));
                    const float lsig = fminf(z, 0.f) - l1p, lsign = -fmaxf(z, 0.f) - l1p;
                    const float w = __expf(lsig + between);
                    between += lsign;
#pragma unroll
                    for (int j = 0; j < 4; ++j) { const uint4 vv = *(const uint4*)(vsb + kt * 1024 + h * 128 + part * 32 + j * 8);
                        o[j * 8 + 0] += w * lo_f(vv.x); o[j * 8 + 1] += w * hi_f(vv.x); o[j * 8 + 2] += w * lo_f(vv.y); o[j * 8 + 3] += w * hi_f(vv.y);
                        o[j * 8 + 4] += w * lo_f(vv.z); o[j * 8 + 5] += w * hi_f(vv.z); o[j * 8 + 6] += w * lo_f(vv.w); o[j * 8 + 7] += w * hi_f(vv.w); }
                }
            }
        } else {
            uint4 q[6];
#pragma unroll
            for (int j = 0; j < 6; ++j) q[j] = *(const uint4*)(qml + tok * 1536 + h * 192 + part * 48 + j * 8);
            float m = -1e30f, l = 0.f;
            for (int s = 0; s <= tmax; ++s) {
                const size_t kt = (size_t)b * SEQ + s;
                float sc = 0.f;
#pragma unroll
                for (int j = 0; j < 6; ++j) sc += dot8(q[j], *(const uint4*)(kml + kt * 1536 + h * 192 + part * 48 + j * 8));
                sc += __shfl_xor(sc, 1); sc += __shfl_xor(sc, 2);
                if (s <= t) {
                    const float mn = fmaxf(m, sc), alpha = exp2f(m - mn), pw = exp2f(sc - mn);
                    l = l * alpha + pw; m = mn;
#pragma unroll
                    for (int j = 0; j < 4; ++j) { const uint4 vv = *(const uint4*)(vml + kt * 1024 + h * 128 + part * 32 + j * 8);
                        o[j * 8 + 0] = o[j * 8 + 0] * alpha + pw * lo_f(vv.x); o[j * 8 + 1] = o[j * 8 + 1] * alpha + pw * hi_f(vv.x);
                        o[j * 8 + 2] = o[j * 8 + 2] * alpha + pw * lo_f(vv.y); o[j * 8 + 3] = o[j * 8 + 3] * alpha + pw * hi_f(vv.y);
                        o[j * 8 + 4] = o[j * 8 + 4] * alpha + pw * lo_f(vv.z); o[j * 8 + 5] = o[j * 8 + 5] * alpha + pw * hi_f(vv.z);
                        o[j * 8 + 6] = o[j * 8 + 6] * alpha + pw * lo_f(vv.w); o[j * 8 + 7] = o[j * 8 + 7] * alpha + pw * hi_f(vv.w); }
                }
            }
            const float inv = 1.0f / l;
#pragma unroll
            for (int d = 0; d < 32; ++d) o[d] *= inv;
        }
        float ss = 0.f;
#pragma unroll
        for (int d = 0; d < 32; ++d) ss += o[d] * o[d];
        ss += __shfl_xor(ss, 1); ss += __shfl_xor(ss, 2);
        if (part == 0) ssq[tok * 16 + g * 8 + h] = ss;
        bf16_t* op = O + tok * 2048 + g * 1024 + h * 128 + part * 32;
#pragma unroll
        for (int j = 0; j < 4; ++j) { uint4 w; w.x = pack2(o[j * 8], o[j * 8 + 1]); w.y = pack2(o[j * 8 + 2], o[j * 8 + 3]); w.z = pack2(o[j * 8 + 4], o[j * 8 + 5]); w.w = pack2(o[j * 8 + 6], o[j * 8 + 7]);
            *(uint4*)(op + j * 8) = w; }
    }
}


typedef short bf16x8_t __attribute__((ext_vector_type(8)));
typedef short s16x4_t __attribute__((ext_vector_type(4)));
typedef float f32x16_t __attribute__((ext_vector_type(16)));
typedef float f32x2_t __attribute__((ext_vector_type(2)));
typedef unsigned u32x4_t __attribute__((ext_vector_type(4)));
typedef __bf16 bf16x2_t __attribute__((ext_vector_type(2)));
__device__ __forceinline__ unsigned cvt_pk_bf16(float lo, float hi) { f32x2_t v = {lo, hi}; bf16x2_t b = __builtin_convertvector(v, bf16x2_t); return __builtin_bit_cast(unsigned, b); }
__device__ __forceinline__ void swap32(float a, float& lo, float& hi) {
    auto r = __builtin_amdgcn_permlane32_swap(__float_as_uint(a), __float_as_uint(a), false, false);
    lo = __uint_as_float(r[0]); hi = __uint_as_float(r[1]);
}
constexpr int LDS_TAB_OFF = 131072 + 16;
constexpr int ATT_VSTR = 320;
constexpr int ATT_STAGE_MAX = 64 * (192 * 2 + 16) + 64 * ATT_VSTR;
constexpr int ATT_BC_OFF = 2 * 64 * (192 * 2 + 16) + 3 * 64 * ATT_VSTR;
constexpr int ATT_HEAD_WORD = 3840;

template <int G>
__device__ __forceinline__ void attn_qk(const LAS unsigned char* kbuf, const bf16x8_t (&qf)[G ? 12 : 8], f32x16_t& s0, f32x16_t& s1, unsigned kread) {
    constexpr int DK = G ? 192 : 128, NKS = DK / 16, KSTR = DK * 2 + 16;
#pragma unroll
    for (int r = 0; r < 16; ++r) { s0[r] = 0.f; s1[r] = 0.f; }
    const LAS unsigned char* kp = kbuf + kread;
#pragma unroll
    for (int ks = 0; ks < NKS; ++ks) {
        const bf16x8_t a0 = *(const LAS bf16x8_t*)(kp + ks * 32), a1 = *(const LAS bf16x8_t*)(kp + 32 * KSTR + ks * 32);
        s0 = __builtin_amdgcn_mfma_f32_32x32x16_bf16(a0, qf[ks], s0, 0, 0, 0);
        s1 = __builtin_amdgcn_mfma_f32_32x32x16_bf16(a1, qf[ks], s1, 0, 0, 0);
    }
    __builtin_amdgcn_sched_group_barrier(0x100, 6, 0);
#pragma unroll
    for (int i = 0; i < 2 * NKS - 6; ++i) { __builtin_amdgcn_sched_group_barrier(0x8, 1, 0); __builtin_amdgcn_sched_group_barrier(0x100, 1, 0); }
#pragma unroll
    for (int i = 0; i < 6; ++i) __builtin_amdgcn_sched_group_barrier(0x8, 1, 0);
}
template <int G>
__device__ __forceinline__ void attn_sm(bool need_mask, f32x16_t& s0, f32x16_t& s1, unsigned (&pk)[2][8], f32x16_t (&o)[4], float& st0, float& st1, int lim, int hh) {
    if (need_mask) {
        asm volatile("" ::: "memory");
        const float neg = G ? -INFINITY : -100.0f;
#pragma unroll
        for (int r = 0; r < 16; ++r) { const int kr = (r & 3) + 8 * (r >> 2) + 4 * hh;
            s0[r] = (G ? (kr <= lim) : (kr < lim)) ? s0[r] : neg; s1[r] = (G ? (32 + kr <= lim) : (32 + kr < lim)) ? s1[r] : neg; }
    }
    if (G == 0) {
        float R = st0;
#pragma unroll
        for (int kb = 1; kb >= 0; --kb) {
#pragma unroll
            for (int g = 3; g >= 0; --g) {
                float sg[4], om[4];
#pragma unroll
                for (int rr = 0; rr < 4; ++rr) {
                    const float z2 = kb ? s1[4 * g + rr] : s0[4 * g + rr];
                    const float e = __builtin_amdgcn_exp2f(-z2);
                    const float sig = __builtin_amdgcn_rcpf(1.0f + e);
                    sg[rr] = sig; om[rr] = e * sig;
                }
                const float gown = (om[0] * om[1]) * (om[2] * om[3]);
                float glo, ghi; swap32(gown, glo, ghi);
                const float E = hh ? R : R * ghi;
                const float e2 = E * om[3], e1 = e2 * om[2], e0 = e1 * om[1];
                pk[kb][2 * g] = cvt_pk_bf16(sg[0] * e0, sg[1] * e1); pk[kb][2 * g + 1] = cvt_pk_bf16(sg[2] * e2, sg[3] * E);
                R = R * (glo * ghi);
            }
        }
        st0 = R;
    } else {
        float mx = fmaxf(s0[0], s1[0]);
#pragma unroll
        for (int r = 1; r < 16; ++r) mx = fmaxf(mx, fmaxf(s0[r], s1[r]));
        float mlo, mhi; swap32(mx, mlo, mhi);
        const float mn = fmaxf(st0, fmaxf(mlo, mhi)), alpha = __builtin_amdgcn_exp2f(st0 - mn);
        st0 = mn;
        float ls = 0.f;
#pragma unroll
        for (int g = 0; g < 4; ++g) {
            float a[4], bq[4];
#pragma unroll
            for (int rr = 0; rr < 4; ++rr) { a[rr] = __builtin_amdgcn_exp2f(s0[4 * g + rr] - mn); bq[rr] = __builtin_amdgcn_exp2f(s1[4 * g + rr] - mn); ls += a[rr] + bq[rr]; }
            pk[0][2 * g] = cvt_pk_bf16(a[0], a[1]); pk[0][2 * g + 1] = cvt_pk_bf16(a[2], a[3]);
            pk[1][2 * g] = cvt_pk_bf16(bq[0], bq[1]); pk[1][2 * g + 1] = cvt_pk_bf16(bq[2], bq[3]);
        }
        st1 = st1 * alpha + ls;
        if (__builtin_amdgcn_ballot_w64(alpha != 1.0f) != 0ull) {
#pragma unroll
            for (int d = 0; d < 4; ++d) o[d] = o[d] * alpha;
        }
    }
}
__device__ __forceinline__ void attn_pv(const LAS unsigned char* vbuf, const unsigned (&pk)[2][8], f32x16_t (&o)[4], unsigned vread) {
    constexpr int VSTR = ATT_VSTR;
    const LAS unsigned char* vp = vbuf + vread;
#pragma unroll
    for (int kb = 0; kb < 2; ++kb)
#pragma unroll
        for (int s = 0; s < 2; ++s) {
            bf16x8_t pf;
            { const unsigned w0 = pk[kb][4 * s], w1 = pk[kb][4 * s + 1], w2 = pk[kb][4 * s + 2], w3 = pk[kb][4 * s + 3];
              pf[0] = (short)(w0 & 0xffff); pf[1] = (short)(w0 >> 16); pf[2] = (short)(w1 & 0xffff); pf[3] = (short)(w1 >> 16);
              pf[4] = (short)(w2 & 0xffff); pf[5] = (short)(w2 >> 16); pf[6] = (short)(w3 & 0xffff); pf[7] = (short)(w3 >> 16); }
#pragma unroll
            for (int d = 0; d < 4; ++d) {
                const LAS unsigned char* vq = vp + (32 * kb + 16 * s) * VSTR + d * 64;
                const s16x4_t lo = __builtin_amdgcn_ds_read_tr16_b64_v4i16((LAS s16x4_t*)(vq));
                const s16x4_t hi = __builtin_amdgcn_ds_read_tr16_b64_v4i16((LAS s16x4_t*)(vq + 8 * VSTR));
                const bf16x8_t vf = {lo[0], lo[1], lo[2], lo[3], hi[0], hi[1], hi[2], hi[3]};
                o[d] = __builtin_amdgcn_mfma_f32_32x32x16_bf16(vf, pf, o[d], 0, 0, 0);
            }
        }
    __builtin_amdgcn_sched_group_barrier(0x100, 6, 0);
#pragma unroll
    for (int i = 0; i < 13; ++i) { __builtin_amdgcn_sched_group_barrier(0x8, 1, 0); __builtin_amdgcn_sched_group_barrier(0x100, 2, 0); }
#pragma unroll
    for (int i = 0; i < 3; ++i) __builtin_amdgcn_sched_group_barrier(0x8, 1, 0);
}

__device__ __forceinline__ void sb_half_math(const f32x16_t& s, unsigned (&pkh)[8], float& R, int hh) {
#pragma unroll
    for (int g = 3; g >= 0; --g) {
        float sg[4], om[4];
#pragma unroll
        for (int rr = 0; rr < 4; ++rr) { const float e = __builtin_amdgcn_exp2f(fminf(-s[4 * g + rr], 120.0f)); const float sig = __builtin_amdgcn_rcpf(1.0f + e); sg[rr] = sig; om[rr] = e * sig; }
        const float gown = (om[0] * om[1]) * (om[2] * om[3]);
        float glo, ghi; swap32(gown, glo, ghi);
        const float E = hh ? R : R * ghi;
        const float e2 = E * om[3], e1 = e2 * om[2], e0 = e1 * om[1];
        pkh[2 * g] = cvt_pk_bf16(sg[0] * e0, sg[1] * e1); pkh[2 * g + 1] = cvt_pk_bf16(sg[2] * e2, sg[3] * E);
        R = R * (glo * ghi);
    }
}
__device__ __forceinline__ void pv_half(const LAS unsigned char* vp, int kb, const unsigned (&pkh)[8], f32x16_t (&o)[4]) {
    constexpr int VSTR = ATT_VSTR;
#pragma unroll
    for (int s = 0; s < 2; ++s) {
        bf16x8_t pf;
        { const unsigned w0 = pkh[4 * s], w1 = pkh[4 * s + 1], w2 = pkh[4 * s + 2], w3 = pkh[4 * s + 3];
          pf[0] = (short)(w0 & 0xffff); pf[1] = (short)(w0 >> 16); pf[2] = (short)(w1 & 0xffff); pf[3] = (short)(w1 >> 16);
          pf[4] = (short)(w2 & 0xffff); pf[5] = (short)(w2 >> 16); pf[6] = (short)(w3 & 0xffff); pf[7] = (short)(w3 >> 16); }
#pragma unroll
        for (int d = 0; d < 4; ++d) {
            const LAS unsigned char* vq = vp + (32 * kb + 16 * s) * VSTR + d * 64;
            const s16x4_t lo = __builtin_amdgcn_ds_read_tr16_b64_v4i16((LAS s16x4_t*)(vq));
            const s16x4_t hi = __builtin_amdgcn_ds_read_tr16_b64_v4i16((LAS s16x4_t*)(vq + 8 * VSTR));
            const bf16x8_t vf = {lo[0], lo[1], lo[2], lo[3], hi[0], hi[1], hi[2], hi[3]};
            o[d] = __builtin_amdgcn_mfma_f32_32x32x16_bf16(vf, pf, o[d], 0, 0, 0);
        }
    }
}
__device__ __forceinline__ void attn_tile_sb(bool need_mask, const LAS unsigned char* base, const bf16x8_t (&qf)[8], f32x16_t (&o)[4], float& st0, int lim, unsigned kread, unsigned vread, int hh) {
    constexpr int KSTR = 128 * 2 + 16;
    const LAS unsigned char* kp = base + kread;
    f32x16_t s0, s1;
#pragma unroll
    for (int r = 0; r < 16; ++r) { s0[r] = 0.f; s1[r] = 0.f; }
#pragma unroll
    for (int ks = 0; ks < 8; ++ks) s1 = __builtin_amdgcn_mfma_f32_32x32x16_bf16(*(const LAS bf16x8_t*)(kp + 32 * KSTR + ks * 32), qf[ks], s1, 0, 0, 0);
#pragma unroll
    for (int ks = 0; ks < 8; ++ks) s0 = __builtin_amdgcn_mfma_f32_32x32x16_bf16(*(const LAS bf16x8_t*)(kp + ks * 32), qf[ks], s0, 0, 0, 0);
    if (need_mask) {
        asm volatile("" ::: "memory");
#pragma unroll
        for (int r = 0; r < 16; ++r) { const int kr = (r & 3) + 8 * (r >> 2) + 4 * hh; s0[r] = (kr < lim) ? s0[r] : -100.0f; s1[r] = (32 + kr < lim) ? s1[r] : -100.0f; }
    }
    unsigned pk1[8], pk0[8]; float R = st0;
    sb_half_math(s1, pk1, R, hh);
    pv_half(base + vread, 1, pk1, o);
    sb_half_math(s0, pk0, R, hh);
    pv_half(base + vread, 0, pk0, o);
    st0 = R;
}

__device__ __forceinline__ void attn_tile_mla(bool need_mask, const LAS unsigned char* base, const bf16x8_t (&qf)[12], f32x16_t (&o)[4], float& st0, float& st1, int lim, unsigned kread, unsigned vread, int hh) {
    f32x16_t s0, s1;
    attn_qk<1>(base, qf, s0, s1, kread);
    if (need_mask) {
        asm volatile("" ::: "memory");
#pragma unroll
        for (int r = 0; r < 16; ++r) { const int kr = (r & 3) + 8 * (r >> 2) + 4 * hh; s0[r] = (kr <= lim) ? s0[r] : -INFINITY; s1[r] = (32 + kr <= lim) ? s1[r] : -INFINITY; }
    }
    float mx = fmaxf(s0[0], s1[0]);
#pragma unroll
    for (int r = 1; r < 16; ++r) mx = fmaxf(mx, fmaxf(s0[r], s1[r]));
    float mlo, mhi; swap32(mx, mlo, mhi);
    const float mn = fmaxf(st0, fmaxf(mlo, mhi)), alpha = __builtin_amdgcn_exp2f(st0 - mn);
    st0 = mn;
    if (__builtin_amdgcn_ballot_w64(alpha != 1.0f) != 0ull) {
#pragma unroll
        for (int d = 0; d < 4; ++d) o[d] = o[d] * alpha;
    }
    unsigned pk1[8], pk0[8]; float ls = 0.f;
#pragma unroll
    for (int g = 0; g < 4; ++g) { float a[4];
#pragma unroll
        for (int rr = 0; rr < 4; ++rr) { a[rr] = __builtin_amdgcn_exp2f(s1[4 * g + rr] - mn); ls += a[rr]; }
        pk1[2 * g] = cvt_pk_bf16(a[0], a[1]); pk1[2 * g + 1] = cvt_pk_bf16(a[2], a[3]); }
    pv_half(base + vread, 1, pk1, o);
#pragma unroll
    for (int g = 0; g < 4; ++g) { float a[4];
#pragma unroll
        for (int rr = 0; rr < 4; ++rr) { a[rr] = __builtin_amdgcn_exp2f(s0[4 * g + rr] - mn); ls += a[rr]; }
        pk0[2 * g] = cvt_pk_bf16(a[0], a[1]); pk0[2 * g + 1] = cvt_pk_bf16(a[2], a[3]); }
    pv_half(base + vread, 0, pk0, o);
    st1 = st1 * alpha + ls;
}
template <int G>
__device__ __forceinline__ void attn_tile(bool need_mask, const LAS unsigned char* base, const bf16x8_t (&qf)[G ? 12 : 8], f32x16_t (&o)[4], float& st0, float& st1, int lim, unsigned kread, unsigned vread, int hh) {
    f32x16_t s0, s1; unsigned pk[2][8];
    attn_qk<G>(base, qf, s0, s1, kread);
    attn_sm<G>(need_mask, s0, s1, pk, o, st0, st1, lim, hh);
    attn_pv(base, pk, o, vread);
}
template <int G>
__device__ __forceinline__ void attn_unit2(const Params& p, int b, int h, int qb, LAS unsigned char* lds, int tid_in) {
    int tid = tid_in; asm volatile("" : "+v"(tid));
    constexpr int DK = G ? 192 : 128, NKS = DK / 16, KCH = DK / 8, KSTR = DK * 2 + 16, VSTR = ATT_VSTR;
    constexpr int KTILE = 64 * KSTR, VTILE = 64 * VSTR, NKL = KCH * 64 / 512, QP = G ? 1536 : 1024;
    const int lane = tid & 63, wid = __builtin_amdgcn_readfirstlane(tid >> 6), c = lane & 31, hh = lane >> 5, H = wid >> 2;
    const bf16_t* Qg = WS<bf16_t>(p, G ? OFF_QMLA : OFF_QSB); const bf16_t* Kg = WS<bf16_t>(p, G ? OFF_KMLA : OFF_KSB); const bf16_t* Vg = WS<bf16_t>(p, G ? OFF_VMLA : OFF_VSB);
    const size_t tok0 = (size_t)b * SEQ;
    const int trow = qb * 256 + wid * 32 + c;
    bf16x8_t qf[NKS];
    { const bf16_t* qp = Qg + (tok0 + trow) * QP + h * DK + hh * 8;
#pragma unroll
      for (int ks = 0; ks < NKS; ++ks) qf[ks] = *(const bf16x8_t*)(qp + ks * 16); }
    f32x16_t o[4];
#pragma unroll
    for (int d = 0; d < 4; ++d)
#pragma unroll
        for (int r = 0; r < 16; ++r) o[d][r] = 0.f;
    float st0 = G ? -1e30f : 1.0f, st1 = 0.f;
    const int srow = tid >> 3, sch = tid & 7;
    const bf16_t* Kb = Kg + tok0 * QP + (size_t)srow * QP + h * DK + sch * 8; const bf16_t* Vb = Vg + tok0 * 1024 + (size_t)srow * 1024 + h * 128 + sch * 8;
    const unsigned klds0 = (unsigned)(srow * KSTR + sch * 16), vlds0 = (unsigned)(2 * KTILE + srow * VSTR + sch * 16);
    const unsigned kread = (unsigned)(c * KSTR + hh * 16);
    const unsigned vread = (unsigned)(2 * KTILE + (4 * hh + ((lane & 15) >> 2)) * VSTR + (16 * ((lane >> 4) & 1) + 4 * (lane & 3)) * 2);
    const int jmax = 4 * qb + 3, T = jmax + 1, wb = wid >> 1;
    u32x4_t kreg[NKL], vreg[2];
#pragma unroll
    for (int i = 0; i < NKL; ++i) kreg[i] = *(const u32x4_t*)(Kb + (size_t)jmax * 64 * QP + i * 64);
#pragma unroll
    for (int i = 0; i < NKL; ++i) *(LAS u32x4_t*)(lds + klds0 + i * 128) = kreg[i];
#pragma unroll
    for (int i = 0; i < NKL; ++i) kreg[i] = *(const u32x4_t*)(Kb + (size_t)(jmax - 1) * 64 * QP + i * 64);
#pragma unroll
    for (int i = 0; i < 2; ++i) vreg[i] = *(const u32x4_t*)(Vb + (size_t)jmax * 64 * 1024 + i * 64);
    __syncthreads();
    f32x16_t s0, s1; unsigned pk[2][8];
#pragma unroll
    for (int r = 0; r < 16; ++r) { s0[r] = 0.f; s1[r] = 0.f; }
#pragma unroll
    for (int i = 0; i < 8; ++i) { pk[0][i] = 0u; pk[1][i] = 0u; }
#pragma unroll 1
    for (int slot = 0; slot < 2 * T + 2; ++slot) {
        if ((slot & 1) == 0) {
            const int s = slot >> 1;
            if (s + 1 < T) {
#pragma unroll
                for (int i = 0; i < NKL; ++i) *(LAS u32x4_t*)(lds + ((s + 1) & 1) * KTILE + klds0 + i * 128) = kreg[i];
            }
            if (s < T) {
#pragma unroll
                for (int i = 0; i < 2; ++i) *(LAS u32x4_t*)(lds + (s & 1) * VTILE + vlds0 + i * 128) = vreg[i];
            }
            if (s + 2 < T) {
#pragma unroll
                for (int i = 0; i < NKL; ++i) kreg[i] = *(const u32x4_t*)(Kb + (size_t)(jmax - s - 2) * 64 * QP + i * 64);
            }
            if (s + 1 < T) {
#pragma unroll
                for (int i = 0; i < 2; ++i) vreg[i] = *(const u32x4_t*)(Vb + (size_t)(jmax - s - 1) * 64 * 1024 + i * 64);
            }
        }
        if ((slot & 1) == H) {
            const int sm = (slot - H) >> 1;
            if (sm >= 1) { const int sp = sm - 1, jb = (jmax - sp) - 4 * qb; if (jb <= wb) attn_pv(lds + (sp & 1) * VTILE, pk, o, vread); }
            if (sm < T) { const int jb = (jmax - sm) - 4 * qb; if (jb <= wb) attn_qk<G>(lds + (sm & 1) * KTILE, qf, s0, s1, kread); }
        } else if (slot >= 1 + H) {
            const int sv = (slot - 1 - H) >> 1;
            if (sv < T) { const int j = jmax - sv, jb = j - 4 * qb; if (jb <= wb) attn_sm<G>(jb == wb, s0, s1, pk, o, st0, st1, trow - 64 * j, hh); }
        }
        __syncthreads();
    }
    if (G == 1) { float llo, lhi; swap32(st1, llo, lhi); const float inv = 1.0f / (llo + lhi);
#pragma unroll
        for (int d = 0; d < 4; ++d) o[d] = o[d] * inv; }
    float ss = 0.f;
    bf16_t* op = WS<bf16_t>(p, OFF_O) + (tok0 + trow) * 2048 + G * 1024 + h * 128 + 4 * hh;
#pragma unroll
    for (int d = 0; d < 4; ++d)
#pragma unroll
        for (int g = 0; g < 4; ++g) {
            const float v0 = o[d][4 * g], v1 = o[d][4 * g + 1], v2 = o[d][4 * g + 2], v3 = o[d][4 * g + 3];
            ss += v0 * v0 + v1 * v1 + v2 * v2 + v3 * v3;
            uint2 w; w.x = cvt_pk_bf16(v0, v1); w.y = cvt_pk_bf16(v2, v3);
            *(uint2*)(op + 32 * d + 8 * g) = w;
        }
    float slo, shi; swap32(ss, slo, shi);
    if (hh == 0) WS<float>(p, OFF_SSQ)[(tok0 + trow) * 16 + G * 8 + h] = slo + shi;
}

template <int G>
__device__ __forceinline__ void attn_unit(const Params& p, int b, int h, int qb, LAS unsigned char* lds, int tid_in) {
    int tid = tid_in; asm volatile("" : "+v"(tid));
    constexpr int DK = G ? 192 : 128, NKS = DK / 16, KCH = DK / 8, KSTR = DK * 2 + 16, VSTR = ATT_VSTR;
    constexpr int KTILE = 64 * KSTR, VTILE = 64 * VSTR, STAGE = KTILE + VTILE, NKL = KCH * 64 / 512, QP = G ? 1536 : 1024;
    const int lane = tid & 63, wid = __builtin_amdgcn_readfirstlane(tid >> 6), c = lane & 31, hh = lane >> 5;
    const bf16_t* Qg = WS<bf16_t>(p, G ? OFF_QMLA : OFF_QSB); const bf16_t* Kg = WS<bf16_t>(p, G ? OFF_KMLA : OFF_KSB); const bf16_t* Vg = WS<bf16_t>(p, G ? OFF_VMLA : OFF_VSB);
    const size_t tok0 = (size_t)b * SEQ;
    const int trow = qb * 256 + wid * 32 + c;
    bf16x8_t qf[NKS];
    { const bf16_t* qp = Qg + (tok0 + trow) * QP + h * DK + hh * 8;
#pragma unroll
      for (int ks = 0; ks < NKS; ++ks) qf[ks] = *(const bf16x8_t*)(qp + ks * 16); }
    f32x16_t o[4];
#pragma unroll
    for (int d = 0; d < 4; ++d)
#pragma unroll
        for (int r = 0; r < 16; ++r) o[d][r] = 0.f;
    float st0 = G ? -1e30f : 1.0f, st1 = 0.f;
    const int srow = tid >> 3, sch = tid & 7;
    const bf16_t* Kb = Kg + tok0 * QP + (size_t)srow * QP + h * DK + sch * 8; const bf16_t* Vb = Vg + tok0 * 1024 + (size_t)srow * 1024 + h * 128 + sch * 8;
    const unsigned klds0 = (unsigned)(srow * KSTR + sch * 16), vlds0 = (unsigned)(KTILE + srow * VSTR + sch * 16);
    u32x4_t kreg[NKL], vreg[2];
    const int jmax = 4 * qb + 3;
#pragma unroll
    for (int i = 0; i < NKL; ++i) kreg[i] = *(const u32x4_t*)(Kb + (size_t)jmax * 64 * QP + i * 64);
#pragma unroll
    for (int i = 0; i < 2; ++i) vreg[i] = *(const u32x4_t*)(Vb + (size_t)jmax * 64 * 1024 + i * 64);
    const unsigned kread = (unsigned)(c * KSTR + hh * 16);
    const unsigned vread = (unsigned)(KTILE + (4 * hh + ((lane & 15) >> 2)) * VSTR + (16 * ((lane >> 4) & 1) + 4 * (lane & 3)) * 2);
    LAS unsigned* aflag = (LAS unsigned*)(lds + ATT_BC_OFF + 16);
    if (G == 0) { if (tid < 3) aflag[tid] = 0u; }
    int f_cur = 0, f_prev = 2, f_next = 1;
    for (int j = jmax; j >= 0; --j) {
        LAS unsigned char* base = lds + ((jmax - j) & 1) * STAGE;
#pragma unroll
        for (int i = 0; i < NKL; ++i) *(LAS u32x4_t*)(base + klds0 + i * 128) = kreg[i];
#pragma unroll
        for (int i = 0; i < 2; ++i) *(LAS u32x4_t*)(base + vlds0 + i * 128) = vreg[i];
        __syncthreads();
        if (G == 0) {
            if (j < jmax) { const unsigned alive = (unsigned)__builtin_amdgcn_readfirstlane((int)aflag[f_prev]); if (alive == 0u) break; }
            if (tid == 0) aflag[f_next] = 0u;
        }
        if (j > 0) {
#pragma unroll
            for (int i = 0; i < NKL; ++i) kreg[i] = *(const u32x4_t*)(Kb + (size_t)(j - 1) * 64 * QP + i * 64);
#pragma unroll
            for (int i = 0; i < 2; ++i) vreg[i] = *(const u32x4_t*)(Vb + (size_t)(j - 1) * 64 * 1024 + i * 64);
        }
        const int jb = j - 4 * qb;
        if (jb <= (wid >> 1)) {
            const bool need_mask = (jb == (wid >> 1));
            const int lim = trow - 64 * j;
            if constexpr (G == 0) attn_tile_sb(need_mask, base, qf, o, st0, lim, kread, vread, hh); else attn_tile_mla(need_mask, base, qf, o, st0, st1, lim, kread, vread, hh);
        }
        if (G == 0) {
            if (__builtin_amdgcn_ballot_w64(st0 >= 9.094947e-13f) != 0ull) { if (lane == 0) aflag[f_cur] = 1u; }
            const int t_ = f_prev; f_prev = f_cur; f_cur = f_next; f_next = t_;
        }
    }
    if (G == 1) { float llo, lhi; swap32(st1, llo, lhi); const float inv = 1.0f / (llo + lhi);
#pragma unroll
        for (int d = 0; d < 4; ++d) o[d] = o[d] * inv; }
    float ss = 0.f;
    bf16_t* op = WS<bf16_t>(p, OFF_O) + (tok0 + trow) * 2048 + G * 1024 + h * 128 + 4 * hh;
#pragma unroll
    for (int d = 0; d < 4; ++d)
#pragma unroll
        for (int g = 0; g < 4; ++g) {
            const float v0 = o[d][4 * g], v1 = o[d][4 * g + 1], v2 = o[d][4 * g + 2], v3 = o[d][4 * g + 3];
            ss += v0 * v0 + v1 * v1 + v2 * v2 + v3 * v3;
            uint2 w; w.x = cvt_pk_bf16(v0, v1); w.y = cvt_pk_bf16(v2, v3);
            *(uint2*)(op + 32 * d + 8 * g) = w;
        }
    float slo, shi; swap32(ss, slo, shi);
    if (hh == 0) WS<float>(p, OFF_SSQ)[(tok0 + trow) * 16 + G * 8 + h] = slo + shi;
    __syncthreads();
}


__device__ __forceinline__ void attn_unit_mla_mid(const Params& p, int b, int h, int qb, LAS unsigned char* lds, int tid_in) {
    int tid = tid_in; asm volatile("" : "+v"(tid));
    constexpr int DK = 192, NKS = 12, KSTR = DK * 2 + 16, VSTR = ATT_VSTR, KTILE = 64 * KSTR, VTILE = 64 * VSTR, STAGE = KTILE + VTILE, NKL = 3, QP = 1536;
    const int lane = tid & 63, wid = __builtin_amdgcn_readfirstlane(tid >> 6), c = lane & 31, hh = lane >> 5;
    const bf16_t* Qg = WS<bf16_t>(p, OFF_QMLA); const bf16_t* Kg = WS<bf16_t>(p, OFF_KMLA); const bf16_t* Vg = WS<bf16_t>(p, OFF_VMLA);
    const size_t tok0 = (size_t)b * SEQ;
    const int trow = qb * 256 + wid * 32 + c;
    bf16x8_t qf[NKS];
    { const bf16_t* qp = Qg + (tok0 + trow) * QP + h * DK + hh * 8;
#pragma unroll
      for (int ks = 0; ks < NKS; ++ks) qf[ks] = *(const bf16x8_t*)(qp + ks * 16); }
    f32x16_t o[4];
#pragma unroll
    for (int d = 0; d < 4; ++d)
#pragma unroll
        for (int r = 0; r < 16; ++r) o[d][r] = 0.f;
    float st0 = -1e30f, st1 = 0.f;
    const int srow = tid >> 3, sch = tid & 7;
    const bf16_t* Kb = Kg + tok0 * QP + (size_t)srow * QP + h * DK + sch * 8; const bf16_t* Vb = Vg + tok0 * 1024 + (size_t)srow * 1024 + h * 128 + sch * 8;
    const unsigned klds0 = (unsigned)(srow * KSTR + sch * 16), vlds0 = (unsigned)(KTILE + srow * VSTR + sch * 16);
    u32x4_t kreg[NKL], vreg[2];
    const int jmax = 4 * qb + 3;
#pragma unroll
    for (int i = 0; i < NKL; ++i) kreg[i] = *(const u32x4_t*)(Kb + (size_t)jmax * 64 * QP + i * 64);
#pragma unroll
    for (int i = 0; i < 2; ++i) vreg[i] = *(const u32x4_t*)(Vb + (size_t)jmax * 64 * 1024 + i * 64);
#pragma unroll
    for (int i = 0; i < NKL; ++i) *(LAS u32x4_t*)(lds + klds0 + i * 128) = kreg[i];
#pragma unroll
    for (int i = 0; i < 2; ++i) *(LAS u32x4_t*)(lds + vlds0 + i * 128) = vreg[i];
#pragma unroll
    for (int i = 0; i < NKL; ++i) kreg[i] = *(const u32x4_t*)(Kb + (size_t)(jmax - 1) * 64 * QP + i * 64);
#pragma unroll
    for (int i = 0; i < 2; ++i) vreg[i] = *(const u32x4_t*)(Vb + (size_t)(jmax - 1) * 64 * 1024 + i * 64);
    const unsigned kread = (unsigned)(c * KSTR + hh * 16);
    const unsigned vread = (unsigned)(KTILE + (4 * hh + ((lane & 15) >> 2)) * VSTR + (16 * ((lane >> 4) & 1) + 4 * (lane & 3)) * 2);
    for (int j = jmax; j >= 0; --j) {
        LAS unsigned char* base = lds + ((jmax - j) & 1) * STAGE;
        LAS unsigned char* nbase = lds + ((jmax - j + 1) & 1) * STAGE;
        __syncthreads();
        const int jb = j - 4 * qb;
        const bool act = jb <= (wid >> 1);
        f32x16_t s0, s1; unsigned pk1[8], pk0[8]; float ls = 0.f, alpha = 1.0f, mn = st0;
        if (act) {
            attn_qk<1>(base, qf, s0, s1, kread);
            if (jb == (wid >> 1)) {
                asm volatile("" ::: "memory");
                const int lim = trow - 64 * j;
#pragma unroll
                for (int r = 0; r < 16; ++r) { const int kr = (r & 3) + 8 * (r >> 2) + 4 * hh; s0[r] = (kr <= lim) ? s0[r] : -INFINITY; s1[r] = (32 + kr <= lim) ? s1[r] : -INFINITY; }
            }
            float mx = fmaxf(s0[0], s1[0]);
#pragma unroll
            for (int r = 1; r < 16; ++r) mx = fmaxf(mx, fmaxf(s0[r], s1[r]));
            float mlo, mhi; swap32(mx, mlo, mhi);
            mn = fmaxf(st0, fmaxf(mlo, mhi)); alpha = __builtin_amdgcn_exp2f(st0 - mn);
            st0 = mn;
            if (__builtin_amdgcn_ballot_w64(alpha != 1.0f) != 0ull) {
#pragma unroll
                for (int d = 0; d < 4; ++d) o[d] = o[d] * alpha;
            }
#pragma unroll
            for (int g = 0; g < 4; ++g) { float a[4];
#pragma unroll
                for (int rr = 0; rr < 4; ++rr) { a[rr] = __builtin_amdgcn_exp2f(s1[4 * g + rr] - mn); ls += a[rr]; }
                pk1[2 * g] = cvt_pk_bf16(a[0], a[1]); pk1[2 * g + 1] = cvt_pk_bf16(a[2], a[3]); }
        }
        if (j > 0) {
#pragma unroll
            for (int i = 0; i < NKL; ++i) *(LAS u32x4_t*)(nbase + klds0 + i * 128) = kreg[i];
#pragma unroll
            for (int i = 0; i < 2; ++i) *(LAS u32x4_t*)(nbase + vlds0 + i * 128) = vreg[i];
            if (j > 1) {
#pragma unroll
                for (int i = 0; i < NKL; ++i) kreg[i] = *(const u32x4_t*)(Kb + (size_t)(j - 2) * 64 * QP + i * 64);
#pragma unroll
                for (int i = 0; i < 2; ++i) vreg[i] = *(const u32x4_t*)(Vb + (size_t)(j - 2) * 64 * 1024 + i * 64);
            }
        }
        if (act) {
            pv_half(base + vread, 1, pk1, o);
#pragma unroll
            for (int g = 0; g < 4; ++g) { float a[4];
#pragma unroll
                for (int rr = 0; rr < 4; ++rr) { a[rr] = __builtin_amdgcn_exp2f(s0[4 * g + rr] - mn); ls += a[rr]; }
                pk0[2 * g] = cvt_pk_bf16(a[0], a[1]); pk0[2 * g + 1] = cvt_pk_bf16(a[2], a[3]); }
            pv_half(base + vread, 0, pk0, o);
            st1 = st1 * alpha + ls;
        }
    }
    { float llo, lhi; swap32(st1, llo, lhi); const float inv = 1.0f / (llo + lhi);
#pragma unroll
      for (int d = 0; d < 4; ++d) o[d] = o[d] * inv; }
    float ss = 0.f;
    bf16_t* op = WS<bf16_t>(p, OFF_O) + (tok0 + trow) * 2048 + 1024 + h * 128 + 4 * hh;
#pragma unroll
    for (int d = 0; d < 4; ++d)
#pragma unroll
        for (int g = 0; g < 4; ++g) {
            const float v0 = o[d][4 * g], v1 = o[d][4 * g + 1], v2 = o[d][4 * g + 2], v3 = o[d][4 * g + 3];
            ss += v0 * v0 + v1 * v1 + v2 * v2 + v3 * v3;
            uint2 w; w.x = cvt_pk_bf16(v0, v1); w.y = cvt_pk_bf16(v2, v3);
            *(uint2*)(op + 32 * d + 8 * g) = w;
        }
    float slo, shi; swap32(ss, slo, shi);
    if (hh == 0) WS<float>(p, OFF_SSQ)[(tok0 + trow) * 16 + 8 + h] = slo + shi;
    __syncthreads();
}

template <int G, int NKL>
__device__ __forceinline__ void att3_step(int s, int T, int jmax, int s_first, int trow, int hh, LAS unsigned char* lds, int& vslot,
        u32x4_t (&kreg)[NKL], u32x4_t (&vreg)[2], const bf16_t* Kb, const bf16_t* Vb, unsigned klds0, unsigned vlds0, unsigned kread, unsigned vread,
        const bf16x8_t (&qf)[G ? 12 : 8], f32x16_t (&o)[4], float& st0, float& st1, f32x16_t& n0, f32x16_t& n1, f32x16_t& p0, f32x16_t& p1, unsigned (&pk)[2][8]) {
    constexpr int DK = G ? 192 : 128, KSTR = DK * 2 + 16, KTILE = 64 * KSTR, VTILE = 64 * ATT_VSTR, QP = G ? 1536 : 1024;
#pragma unroll
    for (int i = 0; i < NKL; ++i) *(LAS u32x4_t*)(lds + (s & 1) * KTILE + klds0 + i * 128) = kreg[i];
#pragma unroll
    for (int i = 0; i < 2; ++i) *(LAS u32x4_t*)(lds + vslot * VTILE + vlds0 + i * 128) = vreg[i];
    __syncthreads();
    if (s + 1 < T) {
#pragma unroll
        for (int i = 0; i < NKL; ++i) kreg[i] = *(const u32x4_t*)(Kb + (size_t)(jmax - s - 1) * 64 * QP + i * 64);
#pragma unroll
        for (int i = 0; i < 2; ++i) vreg[i] = *(const u32x4_t*)(Vb + (size_t)(jmax - s - 1) * 64 * 1024 + i * 64);
    }
    const int vprev = vslot == 0 ? 2 : vslot - 1;
    if (s > s_first + 1) {
        attn_qk<G>(lds + (s & 1) * KTILE, qf, n0, n1, kread);
        attn_sm<G>(false, p0, p1, pk, o, st0, st1, 0, hh);
        attn_pv(lds + vprev * VTILE, pk, o, vread);
    } else {
        if (s >= s_first) attn_qk<G>(lds + (s & 1) * KTILE, qf, n0, n1, kread);
        if (s - 1 >= s_first) { attn_sm<G>(s - 1 == s_first, p0, p1, pk, o, st0, st1, trow - 64 * (jmax - s + 1), hh); attn_pv(lds + vprev * VTILE, pk, o, vread); }
    }
    vslot = vslot == 2 ? 0 : vslot + 1;
}
template <int G>
__device__ __forceinline__ void attn_unit3(const Params& p, int b, int h, int qb, LAS unsigned char* lds, int tid_in) {
    int tid = tid_in; asm volatile("" : "+v"(tid));
    constexpr int DK = G ? 192 : 128, NKS = DK / 16, KCH = DK / 8, KSTR = DK * 2 + 16, VSTR = ATT_VSTR;
    constexpr int KTILE = 64 * KSTR, VTILE = 64 * VSTR, NKL = KCH * 64 / 512, QP = G ? 1536 : 1024;
    const int lane = tid & 63, wid = __builtin_amdgcn_readfirstlane(tid >> 6), c = lane & 31, hh = lane >> 5;
    const bf16_t* Qg = WS<bf16_t>(p, G ? OFF_QMLA : OFF_QSB); const bf16_t* Kg = WS<bf16_t>(p, G ? OFF_KMLA : OFF_KSB); const bf16_t* Vg = WS<bf16_t>(p, G ? OFF_VMLA : OFF_VSB);
    const size_t tok0 = (size_t)b * SEQ;
    const int trow = qb * 256 + wid * 32 + c;
    bf16x8_t qf[NKS];
    { const bf16_t* qp = Qg + (tok0 + trow) * QP + h * DK + hh * 8;
#pragma unroll
      for (int ks = 0; ks < NKS; ++ks) qf[ks] = *(const bf16x8_t*)(qp + ks * 16); }
    f32x16_t o[4];
#pragma unroll
    for (int d = 0; d < 4; ++d)
#pragma unroll
        for (int r = 0; r < 16; ++r) o[d][r] = 0.f;
    float st0 = G ? -1e30f : 1.0f, st1 = 0.f;
    const int srow = tid >> 3, sch = tid & 7;
    const bf16_t* Kb = Kg + tok0 * QP + (size_t)srow * QP + h * DK + sch * 8; const bf16_t* Vb = Vg + tok0 * 1024 + (size_t)srow * 1024 + h * 128 + sch * 8;
    const unsigned klds0 = (unsigned)(srow * KSTR + sch * 16), vlds0 = (unsigned)(2 * KTILE + srow * VSTR + sch * 16);
    const unsigned kread = (unsigned)(c * KSTR + hh * 16);
    const unsigned vread = (unsigned)(2 * KTILE + (4 * hh + ((lane & 15) >> 2)) * VSTR + (16 * ((lane >> 4) & 1) + 4 * (lane & 3)) * 2);
    const int jmax = 4 * qb + 3, T = jmax + 1, s_first = 3 - (wid >> 1);
    u32x4_t kreg[NKL], vreg[2];
#pragma unroll
    for (int i = 0; i < NKL; ++i) kreg[i] = *(const u32x4_t*)(Kb + (size_t)jmax * 64 * QP + i * 64);
#pragma unroll
    for (int i = 0; i < 2; ++i) vreg[i] = *(const u32x4_t*)(Vb + (size_t)jmax * 64 * 1024 + i * 64);
    f32x16_t sa0, sa1, sb0, sb1; unsigned pk[2][8];
#pragma unroll
    for (int r = 0; r < 16; ++r) { sa0[r] = 0.f; sa1[r] = 0.f; sb0[r] = 0.f; sb1[r] = 0.f; }
    int vslot = 0;
#pragma unroll 1
    for (int s = 0; s < T; s += 2) {
        att3_step<G, NKL>(s, T, jmax, s_first, trow, hh, lds, vslot, kreg, vreg, Kb, Vb, klds0, vlds0, kread, vread, qf, o, st0, st1, sa0, sa1, sb0, sb1, pk);
        att3_step<G, NKL>(s + 1, T, jmax, s_first, trow, hh, lds, vslot, kreg, vreg, Kb, Vb, klds0, vlds0, kread, vread, qf, o, st0, st1, sb0, sb1, sa0, sa1, pk);
    }
    { const int vprev = vslot == 0 ? 2 : vslot - 1;
      attn_sm<G>(T - 1 == s_first, sb0, sb1, pk, o, st0, st1, trow, hh);
      attn_pv(lds + vprev * VTILE, pk, o, vread); }
    if (G == 1) { float llo, lhi; swap32(st1, llo, lhi); const float inv = 1.0f / (llo + lhi);
#pragma unroll
        for (int d = 0; d < 4; ++d) o[d] = o[d] * inv; }
    float ss = 0.f;
    bf16_t* op = WS<bf16_t>(p, OFF_O) + (tok0 + trow) * 2048 + G * 1024 + h * 128 + 4 * hh;
#pragma unroll
    for (int d = 0; d < 4; ++d)
#pragma unroll
        for (int g = 0; g < 4; ++g) {
            const float v0 = o[d][4 * g], v1 = o[d][4 * g + 1], v2 = o[d][4 * g + 2], v3 = o[d][4 * g + 3];
            ss += v0 * v0 + v1 * v1 + v2 * v2 + v3 * v3;
            uint2 w; w.x = cvt_pk_bf16(v0, v1); w.y = cvt_pk_bf16(v2, v3);
            *(uint2*)(op + 32 * d + 8 * g) = w;
        }
    float slo, shi; swap32(ss, slo, shi);
    if (hh == 0) WS<float>(p, OFF_SSQ)[(tok0 + trow) * 16 + G * 8 + h] = slo + shi;
    __syncthreads();
}

__device__ __forceinline__ void phase_attn_mfma(const Params& p, float* ldsf, int headw = 0) {
    LAS unsigned char* lds = (LAS unsigned char*)ldsf;
    unsigned* head = WS<unsigned>(p, OFF_BAR) + ATT_HEAD_WORD + 64 * headw;
    for (;;) {
        const int tid = tid_fresh(p.widx);
        LAS unsigned* bc = (LAS unsigned*)(lds + ATT_BC_OFF);
        if (tid == 0) *bc = __hip_atomic_fetch_add(head, 1u, __ATOMIC_RELAXED, __HIP_MEMORY_SCOPE_AGENT);
        __syncthreads();
        const unsigned u = (unsigned)__builtin_amdgcn_readfirstlane((int)*bc);
        __syncthreads();
        if (u >= 1536u) break;
        const unsigned u3 = u / 3u, um = u - 3u * u3;
        if (headw != 0 && (um != 0u || (int)(u3 & 1u) != (PROBE_ATTN_G))) continue;
        if (um != 0u) { if (TAB_EB == 6) job_table6(p, (int)(2u * u3 + um - 1u)); else job_table<TAB_EB == 6 ? 1 : TAB_EB>(p, (int)(2u * u3 + um - 1u)); continue; }
        const int qb = 15 - (int)(u3 >> 5), rest = (int)(u3 & 31u), g = rest & 1, b = (rest >> 1) & 1, h = rest >> 2;
#if ATT_ANTIPHASE
        if (g == 0) attn_unit<0>(p, b, h, qb, lds, tid); else attn_unit_mla_mid(p, b, h, qb, lds, tid);
#else
        if (g == 0) attn_unit<0>(p, b, h, qb, lds, tid); else attn_unit<1>(p, b, h, qb, lds, tid);
#endif
    }
}

__device__ __forceinline__ void phase_onorm(const Params& p, int bid, int nblk) {
    const int tidf = tid_fresh(p.widx), lane = tidf & 63, wid = tidf >> 6;
    bf16_t* O = WS<bf16_t>(p, OFF_O); const float* ssq = WS<float>(p, OFF_SSQ);
    for (int t = bid * 8 + wid; t < TOK; t += nblk * 8) {
        float s0 = 0.f, s1 = 0.f;
#pragma unroll
        for (int h = 0; h < 8; ++h) { s0 += ssq[(size_t)t * 16 + h]; s1 += ssq[(size_t)t * 16 + 8 + h]; }
        const float r0 = rsqrtf(s0 * (1.0f / 1024.0f) + EPS), r1 = rsqrtf(s1 * (1.0f / 1024.0f) + EPS);
#pragma unroll
        for (int j = 0; j < 4; ++j) {
            const int off = (j * 64 + lane) * 8; const float r = off < 1024 ? r0 : r1;
            uint4 v = *(uint4*)(O + (size_t)t * 2048 + off);
            v.x = pack2(lo_f(v.x) * r, hi_f(v.x) * r); v.y = pack2(lo_f(v.y) * r, hi_f(v.y) * r); v.z = pack2(lo_f(v.z) * r, hi_f(v.z) * r); v.w = pack2(lo_f(v.w) * r, hi_f(v.w) * r);
            *(uint4*)(O + (size_t)t * 2048 + off) = v;
        }
    }
}

__device__ __forceinline__ void wave_argmax(float& v, int& i) {
#pragma unroll
    for (int o = 32; o > 0; o >>= 1) { const float ov = __shfl_xor(v, o); const int oi = __shfl_xor(i, o); if (ov > v || (ov == v && oi < i)) { v = ov; i = oi; } }
}
__device__ __forceinline__ void phase_route_ref(const Params& p, int bid, int nblk) {
    const int tidf = tid_fresh(p.widx), lane = tidf & 63, wid = tidf >> 6;
    const bf16_t* qp = WS<bf16_t>(p, OFF_QP); const bf16_t* keys = WS<bf16_t>(p, OFF_KEYS);
    int* ridx = WS<int>(p, OFF_RIDX); float* rgate = WS<float>(p, OFF_RGATE);
    for (int it = bid * 8 + wid; it < TOK * 8; it += nblk * 8) {
        const int t = it >> 3, h = it & 7;
        float tv[2]; int ti[2];
#pragma unroll
        for (int half = 0; half < 2; ++half) {
            const bf16_t* q = qp + (size_t)t * 2048 + h * 256 + half * 128;
            const bf16_t* kb = keys + (size_t)(h * 2 + half) * 16384;
            float s0 = 0.f, s1 = 0.f;
            for (int d = 0; d < 128; d += 8) { const uint4 qv = *(const uint4*)(q + d);
                s0 += dot8(qv, *(const uint4*)(kb + (size_t)lane * 128 + d)); s1 += dot8(qv, *(const uint4*)(kb + (size_t)(lane + 64) * 128 + d)); }
            float mv = 0.f; int mi = 0;
            for (int r = 0; r < 16; ++r) {
                float v; int i;
                if (s0 >= s1) { v = s0; i = lane; } else { v = s1; i = lane + 64; }
                wave_argmax(v, i);
                if (i == lane) s0 = -INFINITY;
                if (i == lane + 64) s1 = -INFINITY;
                if (lane == r) { mv = v; mi = i; }
            }
            tv[half] = mv; ti[half] = mi;
        }
        float cv[4];
#pragma unroll
        for (int j = 0; j < 4; ++j) { const int c = lane * 4 + j; cv[j] = __shfl(tv[0], c >> 4) + __shfl(tv[1], c & 15); }
        float bv = 0.f; int bc = 0;
        for (int r = 0; r < 16; ++r) {
            float v = cv[0]; int i = lane * 4;
#pragma unroll
            for (int j = 1; j < 4; ++j) if (cv[j] > v) { v = cv[j]; i = lane * 4 + j; }
            wave_argmax(v, i);
#pragma unroll
            for (int j = 0; j < 4; ++j) if (i == lane * 4 + j) cv[j] = -INFINITY;
            if (lane == r) { bv = v; bc = i; }
        }
        const float mx = __shfl(bv, 0);
        float e = lane < 16 ? __expf(bv - mx) : 0.f;
        const float sum = wave_sum(e);
        const int i1 = __shfl(ti[0], bc >> 4), i2 = __shfl(ti[1], bc & 15);
        if (lane < 16) { ridx[(size_t)t * 128 + h * 16 + lane] = i1 * 128 + i2; rgate[(size_t)t * 128 + h * 16 + lane] = e / sum; }
    }
}


__device__ __forceinline__ unsigned f2key(float f) { const unsigned u = __float_as_uint(f); return (u & 0x80000000u) ? ~u : (u | 0x80000000u); }
__device__ __forceinline__ float key2f(unsigned k) { return __uint_as_float((k & 0x80000000u) ? (k & 0x7fffffffu) : ~k); }
#define RT_CE(a, b) do { const unsigned _h = max((a), (b)), _l = min((a), (b)); (a) = _h; (b) = _l; } while (0)
__device__ __forceinline__ void sort16_desc(unsigned* a) {
#pragma unroll
    for (int k = 2; k <= 16; k <<= 1)
#pragma unroll
        for (int j = k >> 1; j > 0; j >>= 1)
#pragma unroll
            for (int i = 0; i < 16; ++i) { const int l = i ^ j; if (l > i) { if ((i & k) == 0) RT_CE(a[i], a[l]); else RT_CE(a[l], a[i]); } }
}
__device__ __forceinline__ void merge16_desc(unsigned* a, const unsigned* b) {
#pragma unroll
    for (int i = 0; i < 16; ++i) a[i] = max(a[i], b[15 - i]);
#pragma unroll
    for (int j = 8; j > 0; j >>= 1)
#pragma unroll
        for (int i = 0; i < 16; ++i) { const int l = i ^ j; if (l > i) RT_CE(a[i], a[l]); }
}
__device__ __forceinline__ void top16_of_64(unsigned* v) {
    sort16_desc(v); sort16_desc(v + 16); sort16_desc(v + 32); sort16_desc(v + 48);
    merge16_desc(v, v + 16); merge16_desc(v + 32, v + 48); merge16_desc(v, v + 32);
}
constexpr int rt_cand_pos(int i, int j) { int n = 0; for (int a = 0; a < 16; ++a) for (int b = 0; b < 16; ++b) { if (a == i && b == j) return n; if ((a + 1) * (b + 1) <= 16) ++n; } return n; }
static_assert(rt_cand_pos(15, 1) == 50, "50 staircase candidates");

__device__ __forceinline__ void phase_route_mfma(const Params& p, int bid, int nblk, float* ldsf) {
    const int tidf = tid_fresh(p.widx), lane = tidf & 63, wid = __builtin_amdgcn_readfirstlane(tidf >> 6), c = lane & 31, hh = lane >> 5;
    const bf16_t* qp = WS<bf16_t>(p, OFF_QP); const bf16_t* keys = WS<bf16_t>(p, OFF_KEYS);
    int* ridx = WS<int>(p, OFF_RIDX); float* rgate = WS<float>(p, OFF_RGATE);
    LAS unsigned* tbl = (LAS unsigned*)ldsf + wid * 2048;
    for (int it = bid * 8 + wid; it < 2048; it += nblk * 8) {
        const int tile = it >> 3, h = it & 7, t = (nblk * 32 == TOK) ? tile * 8 + (c & 7) + (c >> 3) * (TOK / 4) : tile * 32 + c;
#pragma unroll 1
        for (int half = 0; half < 2; ++half) {
            const bf16_t* kb = keys + (size_t)(h * 2 + half) * 16384 + (size_t)c * 128 + hh * 8;
            const bf16_t* qq = qp + (size_t)t * 2048 + h * 256 + half * 128 + hh * 8;
            bf16x8_t qf[8];
#pragma unroll
            for (int ks = 0; ks < 8; ++ks) qf[ks] = *(const bf16x8_t*)(qq + ks * 16);
            unsigned v[64];
#pragma unroll
            for (int blk = 0; blk < 4; ++blk) {
                f32x16_t s;
#pragma unroll
                for (int r = 0; r < 16; ++r) s[r] = 0.f;
#pragma unroll
                for (int ks = 0; ks < 8; ++ks) { const bf16x8_t a = *(const bf16x8_t*)(kb + (size_t)blk * 32 * 128 + ks * 16); s = __builtin_amdgcn_mfma_f32_32x32x16_bf16(a, qf[ks], s, 0, 0, 0); }
#pragma unroll
                for (int r = 0; r < 16; ++r) { const int n = 32 * blk + (r & 3) + 8 * (r >> 2) + 4 * hh; v[blk * 16 + r] = (f2key(s[r]) & ~127u) | (unsigned)(127 - n); }
            }
            top16_of_64(v);
            unsigned o[16];
#pragma unroll
            for (int i = 0; i < 16; ++i) { auto r2 = __builtin_amdgcn_permlane32_swap(v[i], v[i], false, false); o[i] = hh ? r2[0] : r2[1]; }
            merge16_desc(v, o);
#pragma unroll
            for (int i = 0; i < 16; ++i) tbl[(half * 16 + i) * 64 + lane] = v[i];
        }
        float f1[16], f2[16];
#pragma unroll
        for (int i = 0; i < 16; ++i) { f1[i] = key2f(tbl[i * 64 + lane] & ~127u); f2[i] = key2f(tbl[(16 + i) * 64 + lane] & ~127u); }
        unsigned cd[64];
#pragma unroll
        for (int i = 0; i < 64; ++i) cd[i] = 0u;
#pragma unroll
        for (int i = 0; i < 16; ++i)
#pragma unroll
            for (int j = 0; j < 16; ++j)
                if ((i + 1) * (j + 1) <= 16) cd[rt_cand_pos(i, j)] = (f2key(f1[i] + f2[j]) & ~255u) | (unsigned)(255 - (i * 16 + j));
        top16_of_64(cd);
        float e[16], sum = 0.f; const float mx = key2f(cd[0] & ~255u);
#pragma unroll
        for (int k = 0; k < 16; ++k) { e[k] = __expf(key2f(cd[k] & ~255u) - mx); sum += e[k]; }
        const float inv = 1.0f / sum;
        if (hh == 0) {
#pragma unroll
            for (int k = 0; k < 16; ++k) {
                const int pid = 255 - (int)(cd[k] & 255u), i = pid >> 4, j = pid & 15;
                const int n1 = 127 - (int)(tbl[i * 64 + lane] & 127u), n2 = 127 - (int)(tbl[(16 + j) * 64 + lane] & 127u);
                ridx[(size_t)t * 128 + h * 16 + k] = n1 * 128 + n2; rgate[(size_t)t * 128 + h * 16 + k] = e[k] * inv;
            }
        }
    }
}

__device__ __forceinline__ void phase_peer_ref(const Params& p, int bid, int nblk) {
    const int tidf = tid_fresh(p.widx), lane = tidf & 63, wid = tidf >> 6;
    const bf16_t* h2 = WS<bf16_t>(p, OFF_H); const float* x1 = WS<float>(p, OFF_X1); const float* mod = WS<float>(p, OFF_MOD);
    const int* ridx = WS<int>(p, OFF_RIDX); const float* rgate = WS<float>(p, OFF_RGATE);
    for (int t = bid * 8 + wid; t < TOK; t += nblk * 8) {
        const int b = t >> 12;
        float4 hv[8], y[8];
#pragma unroll
        for (int j = 0; j < 8; ++j) { const uint2 w = *(const uint2*)(h2 + (size_t)t * DM + (j * 64 + lane) * 4);
            hv[j].x = lo_f(w.x); hv[j].y = hi_f(w.x); hv[j].z = lo_f(w.y); hv[j].w = hi_f(w.y); y[j] = (float4){0.f, 0.f, 0.f, 0.f}; }
        for (int e = 0; e < 128; ++e) {
            const int ex = ridx[(size_t)t * 128 + e]; const float gt = rgate[(size_t)t * 128 + e];
            const float* ur = p.u_tab + (size_t)ex * DM; const float* vr = p.v_tab + (size_t)ex * DM;
            float d = 0.f;
#pragma unroll
            for (int j = 0; j < 8; ++j) { const float4 u = *(const float4*)(ur + (j * 64 + lane) * 4); d += u.x * hv[j].x + u.y * hv[j].y + u.z * hv[j].z + u.w * hv[j].w; }
            d = wave_sum(d);
            const float cf = gt * gelu_exact(d);
#pragma unroll
            for (int j = 0; j < 8; ++j) { const float4 v = *(const float4*)(vr + (j * 64 + lane) * 4); y[j].x += cf * v.x; y[j].y += cf * v.y; y[j].z += cf * v.z; y[j].w += cf * v.w; }
        }
        float ss = 0.f;
#pragma unroll
        for (int j = 0; j < 8; ++j) { const int col = (j * 64 + lane) * 4;
            const float4 xv = *(const float4*)(x1 + (size_t)t * DM + col); const float4 g2 = *(const float4*)(mod + (size_t)b * 12288 + 5 * 2048 + col);
            y[j].x = xv.x + g2.x * y[j].x; y[j].y = xv.y + g2.y * y[j].y; y[j].z = xv.z + g2.z * y[j].z; y[j].w = xv.w + g2.w * y[j].w;
            ss += y[j].x * y[j].x + y[j].y * y[j].y + y[j].z * y[j].z + y[j].w * y[j].w; }
        ss = wave_sum(ss);
        const float rstd = rsqrtf(ss * (1.0f / DM) + EPS);
#pragma unroll
        for (int j = 0; j < 8; ++j) { const int col = (j * 64 + lane) * 4; const float4 fg = *(const float4*)(p.fin_g + col);
            float4 o; o.x = y[j].x * rstd * fg.x; o.y = y[j].y * rstd * fg.y; o.z = y[j].z * rstd * fg.z; o.w = y[j].w * rstd * fg.w;
            *(float4*)(p.out + (size_t)t * DM + col) = o; }
    }
}


template <int EB> __device__ __forceinline__ void job_table(const Params& p, int it) {
    const int tidf = tid_fresh(p.widx), lane = tidf & 63, wid = tidf >> 6;
    const int tab = it >> 9, r0 = (it & 511) * 32;
    const float* src = tab ? p.v_tab : p.u_tab;
    unsigned char* dst = p.ws + (tab ? OFF_VTAB : OFF_UTAB);
    float* scl = WS<float>(p, tab ? OFF_VSC : OFF_USC);
#pragma unroll 1
    for (int rr = 0; rr < 4; ++rr) {
        const int row = r0 + wid * 4 + rr;
        float4 v[8]; float am = 0.f;
#pragma unroll
        for (int j = 0; j < 8; ++j) { v[j] = *(const float4*)(src + (size_t)row * DM + (j * 64 + lane) * 4);
            am = fmaxf(am, fmaxf(fmaxf(fabsf(v[j].x), fabsf(v[j].y)), fmaxf(fabsf(v[j].z), fabsf(v[j].w)))); }
#pragma unroll
        for (int o = 32; o > 0; o >>= 1) am = fmaxf(am, __shfl_xor(am, o));
        if (EB == 1) {
            const int e = (int)((__float_as_uint(am) >> 23) & 255u) - 127;
            const float sc = am > 0.f ? __uint_as_float((unsigned)(127 + 7 - e) << 23) : 1.0f;
            if (lane == 0) scl[row] = am > 0.f ? __uint_as_float((unsigned)(127 - 7 + e) << 23) : 1.0f;
#pragma unroll
            for (int j = 0; j < 8; ++j) {
                int w = __builtin_amdgcn_cvt_pk_fp8_f32(v[j].x * sc, v[j].y * sc, 0, false);
                w = __builtin_amdgcn_cvt_pk_fp8_f32(v[j].z * sc, v[j].w * sc, w, true);
                *(int*)(dst + (size_t)row * 2048 + (j * 64 + lane) * 4) = w;
            }
        } else {
            if (lane == 0) scl[row] = 1.0f;
#pragma unroll
            for (int j = 0; j < 8; ++j) { uint2 w; w.x = pack2(v[j].x, v[j].y); w.y = pack2(v[j].z, v[j].w);
                *(uint2*)(dst + (size_t)row * 4096 + (j * 64 + lane) * 8) = w; }
        }
    }
}

template <int EB> __device__ __forceinline__ void dec_chunk(const u32x4_t r, float* f) {
    if (EB == 1) {
#pragma unroll
        for (int w = 0; w < 4; ++w) { const f32x2_t a = __builtin_amdgcn_cvt_pk_f32_fp8((int)r[w], false), b = __builtin_amdgcn_cvt_pk_f32_fp8((int)r[w], true);
            f[4 * w] = a[0]; f[4 * w + 1] = a[1]; f[4 * w + 2] = b[0]; f[4 * w + 3] = b[1]; }
    } else {
#pragma unroll
        for (int w = 0; w < 4; ++w) { f[2 * w] = lo_f(r[w]); f[2 * w + 1] = hi_f(r[w]); }
    }
}

template <int EB> __device__ __forceinline__ void phase_peer_gather(const Params& p, int bid, int nblk) {
    constexpr int EPC = 16 / EB, NCH = 32 / EPC, ROWB = 2048 * EB;
    const int tidf = tid_fresh(p.widx), lane = tidf & 63, wid = tidf >> 6;
    const unsigned char* utab = p.ws + OFF_UTAB; const unsigned char* vtab = p.ws + OFF_VTAB;
    const float* usc = WS<float>(p, OFF_USC); const float* vsc = WS<float>(p, OFF_VSC);
    const bf16_t* h2 = WS<bf16_t>(p, OFF_H); const float* x1 = WS<float>(p, OFF_X1); const float* mod = WS<float>(p, OFF_MOD);
    const int* ridx = WS<int>(p, OFF_RIDX); const float* rgate = WS<float>(p, OFF_RGATE);
    for (int t = bid * 8 + wid; t < TOK; t += nblk * 8) {
        const int b = t >> 12;
        float hv[32];
#pragma unroll
        for (int j = 0; j < NCH; ++j) {
            const bf16_t* hp = h2 + (size_t)t * DM + (j * 64 + lane) * EPC;
#pragma unroll
            for (int q8 = 0; q8 < EPC / 8; ++q8) { const uint4 w = *(const uint4*)(hp + q8 * 8);
                float* f = hv + j * EPC + q8 * 8;
                f[0] = lo_f(w.x); f[1] = hi_f(w.x); f[2] = lo_f(w.y); f[3] = hi_f(w.y); f[4] = lo_f(w.z); f[5] = hi_f(w.z); f[6] = lo_f(w.w); f[7] = hi_f(w.w); }
        }
        const int myi0 = ridx[(size_t)t * 128 + lane], myi1 = ridx[(size_t)t * 128 + 64 + lane];
        const float myg0 = rgate[(size_t)t * 128 + lane], myg1 = rgate[(size_t)t * 128 + 64 + lane];
        float dots0 = 0.f, dots1 = 0.f;
#pragma unroll 1
        for (int eb = 0; eb < 128; eb += 8) {
            const int idxv = eb < 64 ? myi0 : myi1;
            u32x4_t r[8][NCH];
#pragma unroll
            for (int k = 0; k < 8; ++k) {
                const int idx = __builtin_amdgcn_readlane(idxv, (eb & 63) + k);
                const unsigned char* row = utab + (size_t)idx * ROWB + lane * 16;
#pragma unroll
                for (int j = 0; j < NCH; ++j) r[k][j] = *(const u32x4_t*)(row + j * 1024);
            }
            float d[8];
#pragma unroll
            for (int k = 0; k < 8; ++k) {
                float s = 0.f;
#pragma unroll
                for (int j = 0; j < NCH; ++j) { float f[EPC]; dec_chunk<EB>(r[k][j], f);
#pragma unroll
                    for (int q = 0; q < EPC; ++q) s += f[q] * hv[j * EPC + q]; }
                asm volatile("" : "+v"(s));
                d[k] = s;
                __builtin_amdgcn_sched_barrier(0);
            }
            float n4[4], n2[2];
#pragma unroll
            for (int i = 0; i < 4; ++i) { const bool hi = lane & 1; const float send = hi ? d[2 * i] : d[2 * i + 1], keep = hi ? d[2 * i + 1] : d[2 * i]; n4[i] = keep + __shfl_xor(send, 1); }
#pragma unroll
            for (int i = 0; i < 2; ++i) { const bool hi = lane & 2; const float send = hi ? n4[2 * i] : n4[2 * i + 1], keep = hi ? n4[2 * i + 1] : n4[2 * i]; n2[i] = keep + __shfl_xor(send, 2); }
            float tot;
            { const bool hi = lane & 4; const float send = hi ? n2[0] : n2[1], keep = hi ? n2[1] : n2[0]; tot = keep + __shfl_xor(send, 4); }
            tot += __shfl_xor(tot, 8); tot += __shfl_xor(tot, 16); tot += __shfl_xor(tot, 32);
            const bool mine = (lane >> 3) == ((eb & 63) >> 3);
            if (eb < 64) dots0 = mine ? tot : dots0; else dots1 = mine ? tot : dots1;
        }
        const float cf0 = myg0 * gelu_exact(dots0 * usc[myi0]) * vsc[myi0], cf1 = myg1 * gelu_exact(dots1 * usc[myi1]) * vsc[myi1];
        float y[32];
#pragma unroll
        for (int q = 0; q < 32; ++q) y[q] = 0.f;
#pragma unroll 1
        for (int eb = 0; eb < 128; eb += 8) {
            const int idxv = eb < 64 ? myi0 : myi1; const float cfv = eb < 64 ? cf0 : cf1;
            u32x4_t r[8][NCH];
#pragma unroll
            for (int k = 0; k < 8; ++k) {
                const int idx = __builtin_amdgcn_readlane(idxv, (eb & 63) + k);
                const unsigned char* row = vtab + (size_t)idx * ROWB + lane * 16;
#pragma unroll
                for (int j = 0; j < NCH; ++j) r[k][j] = *(const u32x4_t*)(row + j * 1024);
            }
#pragma unroll
            for (int k = 0; k < 8; ++k) {
                const float cf = __uint_as_float((unsigned)__builtin_amdgcn_readlane((int)__float_as_uint(cfv), (eb & 63) + k));
#pragma unroll
                for (int j = 0; j < NCH; ++j) { float f[EPC]; dec_chunk<EB>(r[k][j], f);
#pragma unroll
                    for (int q = 0; q < EPC; ++q) y[j * EPC + q] += cf * f[q]; }
                asm volatile("" : "+v"(y[0]), "+v"(y[1]), "+v"(y[2]), "+v"(y[3]), "+v"(y[4]), "+v"(y[5]), "+v"(y[6]), "+v"(y[7]), "+v"(y[8]), "+v"(y[9]), "+v"(y[10]), "+v"(y[11]), "+v"(y[12]), "+v"(y[13]), "+v"(y[14]), "+v"(y[15]));
                asm volatile("" : "+v"(y[16]), "+v"(y[17]), "+v"(y[18]), "+v"(y[19]), "+v"(y[20]), "+v"(y[21]), "+v"(y[22]), "+v"(y[23]), "+v"(y[24]), "+v"(y[25]), "+v"(y[26]), "+v"(y[27]), "+v"(y[28]), "+v"(y[29]), "+v"(y[30]), "+v"(y[31]));
                __builtin_amdgcn_sched_barrier(0);
            }
        }
        float ss = 0.f;
#pragma unroll
        for (int j = 0; j < NCH; ++j)
#pragma unroll
            for (int q4 = 0; q4 < EPC / 4; ++q4) {
                const int col = (j * 64 + lane) * EPC + q4 * 4;
                const float4 xv = *(const float4*)(x1 + (size_t)t * DM + col); const float4 g2 = *(const float4*)(mod + (size_t)b * 12288 + 5 * 2048 + col);
                float* yy = y + j * EPC + q4 * 4;
                yy[0] = xv.x + g2.x * yy[0]; yy[1] = xv.y + g2.y * yy[1]; yy[2] = xv.z + g2.z * yy[2]; yy[3] = xv.w + g2.w * yy[3];
                ss += yy[0] * yy[0] + yy[1] * yy[1] + yy[2] * yy[2] + yy[3] * yy[3];
                if (q4 & 1) __builtin_amdgcn_sched_barrier(0);
            }
        ss = wave_sum(ss);
        const float rstd = rsqrtf(ss * (1.0f / DM) + EPS);
#pragma unroll
        for (int j = 0; j < NCH; ++j)
#pragma unroll
            for (int q4 = 0; q4 < EPC / 4; ++q4) {
                const int col = (j * 64 + lane) * EPC + q4 * 4; const float4 fg = *(const float4*)(p.fin_g + col);
                const float* yy = y + j * EPC + q4 * 4;
                float4 o; o.x = yy[0] * rstd * fg.x; o.y = yy[1] * rstd * fg.y; o.z = yy[2] * rstd * fg.z; o.w = yy[3] * rstd * fg.w;
                *(float4*)(p.out + (size_t)t * DM + col) = o;
                if (q4 & 1) __builtin_amdgcn_sched_barrier(0);
            }
    }
}


typedef float v32f_t __attribute__((ext_vector_type(32)));
typedef float v16f_t __attribute__((ext_vector_type(16)));
typedef unsigned v6u_t __attribute__((ext_vector_type(6)));
typedef _Float16 v32h_t __attribute__((ext_vector_type(32)));
typedef _Float16 h2_t __attribute__((ext_vector_type(2)));
typedef _Float16 h4_t __attribute__((ext_vector_type(4)));
typedef float f32x4v_t __attribute__((ext_vector_type(4)));
typedef unsigned u32x2_t __attribute__((ext_vector_type(2)));
__device__ __forceinline__ float wave_max_noaddr(float v) {
    v = fmaxf(v, __int_as_float(__builtin_amdgcn_ds_swizzle(__float_as_int(v), (1 << 10) | 0x1f)));
    v = fmaxf(v, __int_as_float(__builtin_amdgcn_ds_swizzle(__float_as_int(v), (2 << 10) | 0x1f)));
    v = fmaxf(v, __int_as_float(__builtin_amdgcn_ds_swizzle(__float_as_int(v), (4 << 10) | 0x1f)));
    v = fmaxf(v, __int_as_float(__builtin_amdgcn_ds_swizzle(__float_as_int(v), (8 << 10) | 0x1f)));
    v = fmaxf(v, __int_as_float(__builtin_amdgcn_ds_swizzle(__float_as_int(v), (16 << 10) | 0x1f)));
    auto r = __builtin_amdgcn_permlane32_swap(__float_as_uint(v), __float_as_uint(v), false, false);
    return fmaxf(__uint_as_float(r[0]), __uint_as_float(r[1]));
}
__device__ __forceinline__ void job_table6(const Params& p, int it) {
    const int tidf = tid_fresh(p.widx), lane = tidf & 63, wid = tidf >> 6;
    const int tab = it >> 9, r0 = (it & 511) * 32;
    const float* src = tab ? p.v_tab : p.u_tab;
    unsigned char* dst = p.ws + (tab ? OFF_VTAB : OFF_UTAB);
    float* scl = WS<float>(p, tab ? OFF_VSC : OFF_USC);
    typedef float f32x4v __attribute__((ext_vector_type(4)));
    f32x4v v[4][8];
#pragma unroll
    for (int rr = 0; rr < 4; ++rr)
#pragma unroll
        for (int j = 0; j < 8; ++j) v[rr][j] = __builtin_nontemporal_load((const f32x4v*)(src + (size_t)(r0 + wid * 4 + rr) * DM + (j * 64 + lane) * 4));
#pragma unroll
    for (int rr = 0; rr < 4; ++rr) {
        const int row = r0 + wid * 4 + rr;
        v16f_t a, b; float am = 0.f;
#pragma unroll
        for (int j = 0; j < 8; ++j) { const f32x4v w = v[rr][j];
            a[2 * j] = w.x; b[2 * j] = w.y; a[2 * j + 1] = w.z; b[2 * j + 1] = w.w; am = fmaxf(am, fmaxf(fmaxf(fabsf(w.x), fabsf(w.y)), fmaxf(fabsf(w.z), fabsf(w.w)))); }
        am = wave_max_noaddr(am);
        const int e = (int)((__float_as_uint(am) >> 23) & 255u) - 127;
        const float sc = am > 0.f ? __uint_as_float((unsigned)(127 + 2 - e) << 23) : 1.0f;
        if (lane == 0) scl[row] = am > 0.f ? __uint_as_float((unsigned)(127 - 2 + e) << 23) : 1.0f;
        a = a * sc; b = b * sc;
        const v6u_t pk = __builtin_amdgcn_cvt_scalef32_2xpk16_fp6_f32(a, b, 1.0f);
#if PEER_SLICED
        { unsigned char* d6 = dst + ((size_t)(lane >> 3) * NEXP + row) * 192;
          u32x4_t w0 = {pk[0], pk[1], pk[2], pk[3]}; u32x2_t w1 = {pk[4], pk[5]};
          *(u32x4_t*)(d6 + (lane & 7) * 16) = w0; *(u32x2_t*)(d6 + 128 + (lane & 7) * 8) = w1; }
#else
        u32x4_t w0 = {pk[0], pk[1], pk[2], pk[3]}; u32x2_t w1 = {pk[4], pk[5]};
        *(u32x4_t*)(dst + (size_t)row * 1536 + lane * 16) = w0;
        *(u32x2_t*)(dst + (size_t)row * 1536 + 1024 + lane * 8) = w1;
#endif
    }
}

#define PG6_LOAD(RA, RB, tab, iv, e0) do { _Pragma("unroll") for (int k = 0; k < 8; ++k) { \
        const unsigned idx_ = (unsigned)__builtin_amdgcn_readlane((iv), (e0) + k); const unsigned char* row_ = (tab) + (size_t)idx_ * 1536u;     \
        RA[k] = *(const u32x4_t*)(row_ + lane16); RB[k] = *(const u32x2_t*)(row_ + 1024u + lane8); } } while (0)
#define PG6_CU(RA, RB, eb) do { float d[8]; \
        _Pragma("unroll") for (int k = 0; k < 8; ++k) { \
            const v6u_t pk_ = {RA[k][0], RA[k][1], RA[k][2], RA[k][3], RB[k][0], RB[k][1]}; \
            const v32h_t f_ = __builtin_amdgcn_cvt_scalef32_pk32_f16_fp6(pk_, 1.0f); float s0_ = 0.f, s1_ = 0.f, s2_ = 0.f, s3_ = 0.f; \
            _Pragma("unroll") for (int q = 0; q < 16; q += 4) { \
                s0_ = __builtin_amdgcn_fdot2((h2_t){f_[2 * q], f_[2 * q + 1]}, hvh[q], s0_, false); s1_ = __builtin_amdgcn_fdot2((h2_t){f_[2 * q + 2], f_[2 * q + 3]}, hvh[q + 1], s1_, false); \
                s2_ = __builtin_amdgcn_fdot2((h2_t){f_[2 * q + 4], f_[2 * q + 5]}, hvh[q + 2], s2_, false); s3_ = __builtin_amdgcn_fdot2((h2_t){f_[2 * q + 6], f_[2 * q + 7]}, hvh[q + 3], s3_, false); } \
            float s_ = (s0_ + s1_) + (s2_ + s3_);             \
            asm volatile("" : "+v"(s_)); d[k] = s_; __builtin_amdgcn_sched_barrier(0); } \
        float n4[4], n2[2], tot; \
        _Pragma("unroll") for (int i_ = 0; i_ < 4; ++i_) { const bool hi_ = lane & 1; const float send = hi_ ? d[2 * i_] : d[2 * i_ + 1], keep = hi_ ? d[2 * i_ + 1] : d[2 * i_]; n4[i_] = keep + __shfl_xor(send, 1); } \
        _Pragma("unroll") for (int i_ = 0; i_ < 2; ++i_) { const bool hi_ = lane & 2; const float send = hi_ ? n4[2 * i_] : n4[2 * i_ + 1], keep = hi_ ? n4[2 * i_ + 1] : n4[2 * i_]; n2[i_] = keep + __shfl_xor(send, 2); } \
        { const bool hi_ = lane & 4; const float send = hi_ ? n2[0] : n2[1], keep = hi_ ? n2[1] : n2[0]; tot = keep + __shfl_xor(send, 4); } \
        tot += __shfl_xor(tot, 8); tot += __shfl_xor(tot, 16); tot += __shfl_xor(tot, 32); \
        const bool mine_ = (lane >> 3) == (((eb) & 63) >> 3); \
        if ((eb) < 64) dots0 = mine_ ? tot : dots0; else dots1 = mine_ ? tot : dots1; } while (0)
#define PG6_CU4(RA, RB, eb) do { float d[8]; \
        _Pragma("unroll") for (int k = 0; k < 8; k += 2) { \
            const v6u_t pka_ = {RA[k][0], RA[k][1], RA[k][2], RA[k][3], RB[k][0], RB[k][1]}; const v6u_t pkb_ = {RA[k + 1][0], RA[k + 1][1], RA[k + 1][2], RA[k + 1][3], RB[k + 1][0], RB[k + 1][1]}; \
            const v32h_t fa_ = __builtin_amdgcn_cvt_scalef32_pk32_f16_fp6(pka_, 1.0f), fb_ = __builtin_amdgcn_cvt_scalef32_pk32_f16_fp6(pkb_, 1.0f); \
            f32x4v_t ca_ = {0.f, 0.f, 0.f, 0.f}, cb_ = {0.f, 0.f, 0.f, 0.f}; \
            _Pragma("unroll") for (int q = 0; q < 8; ++q) { \
                ca_ = __builtin_amdgcn_mfma_f32_4x4x4f16((h4_t){fa_[4 * q], fa_[4 * q + 1], fa_[4 * q + 2], fa_[4 * q + 3]}, hv4[q], ca_, 0, 0, 0); \
                cb_ = __builtin_amdgcn_mfma_f32_4x4x4f16((h4_t){fb_[4 * q], fb_[4 * q + 1], fb_[4 * q + 2], fb_[4 * q + 3]}, hv4[q], cb_, 0, 0, 0); } \
            float sa_ = l3b1 ? (l3b0 ? ca_[3] : ca_[2]) : (l3b0 ? ca_[1] : ca_[0]), sb_ = l3b1 ? (l3b0 ? cb_[3] : cb_[2]) : (l3b0 ? cb_[1] : cb_[0]); \
            asm volatile("" : "+v"(sa_), "+v"(sb_)); d[k] = sa_; d[k + 1] = sb_; __builtin_amdgcn_sched_barrier(0); } \
        float n4[4], n2[2], tot; \
        _Pragma("unroll") for (int i_ = 0; i_ < 4; ++i_) { const bool hi_ = lane & 1; const float send = hi_ ? d[2 * i_] : d[2 * i_ + 1], keep = hi_ ? d[2 * i_ + 1] : d[2 * i_]; n4[i_] = keep + __shfl_xor(send, 1); } \
        _Pragma("unroll") for (int i_ = 0; i_ < 2; ++i_) { const bool hi_ = lane & 2; const float send = hi_ ? n4[2 * i_] : n4[2 * i_ + 1], keep = hi_ ? n4[2 * i_ + 1] : n4[2 * i_]; n2[i_] = keep + __shfl_xor(send, 2); } \
        { const bool hi_ = lane & 4; const float send = hi_ ? n2[0] : n2[1], keep = hi_ ? n2[1] : n2[0]; tot = keep + __shfl_xor(send, 4); } \
        tot += __shfl_xor(tot, 8); tot += __shfl_xor(tot, 16); tot += __shfl_xor(tot, 32); \
        const bool mine_ = (lane >> 3) == (((eb) & 63) >> 3); \
        if ((eb) < 64) dots0 = mine_ ? tot : dots0; else dots1 = mine_ ? tot : dots1; } while (0)
#define PG6_CV(RA, RB, eb) do { const float cfv_ = (eb) < 64 ? cf0 : cf1; \
        _Pragma("unroll") for (int k = 0; k < 8; ++k) { \
            const _Float16 ch_ = (_Float16)__uint_as_float((unsigned)__builtin_amdgcn_readlane((int)__float_as_uint(cfv_), ((eb) & 63) + k)); const h2_t c2_ = {ch_, ch_}; \
            const v6u_t pk_ = {RA[k][0], RA[k][1], RA[k][2], RA[k][3], RB[k][0], RB[k][1]}; \
            const v32h_t f_ = __builtin_amdgcn_cvt_scalef32_pk32_f16_fp6(pk_, 1.0f); \
            _Pragma("unroll") for (int q = 0; q < 16; ++q) yh[q] = (h2_t){f_[2 * q], f_[2 * q + 1]} * c2_ + yh[q]; \
            asm volatile("" : "+v"(yh[0]), "+v"(yh[1]), "+v"(yh[2]), "+v"(yh[3]), "+v"(yh[4]), "+v"(yh[5]), "+v"(yh[6]), "+v"(yh[7]), "+v"(yh[8]), "+v"(yh[9]), "+v"(yh[10]), "+v"(yh[11]), "+v"(yh[12]), "+v"(yh[13]), "+v"(yh[14]), "+v"(yh[15])); \
            __builtin_amdgcn_sched_barrier(0); } } while (0)
#define PG6_CV4(RA, RB, eb) do { const unsigned ccv_ = (eb) < 64 ? cc0 : cc1; \
        _Pragma("unroll") for (int k = 0; k < 8; ++k) { \
            const unsigned cs_ = (unsigned)__builtin_amdgcn_readlane((int)ccv_, ((eb) & 63) + k); \
            union { unsigned u[2]; h4_t h; } am_; am_.u[0] = cs_ & am0; am_.u[1] = cs_ & am1; \
            const v6u_t pk_ = {RA[k][0], RA[k][1], RA[k][2], RA[k][3], RB[k][0], RB[k][1]}; \
            const v32h_t f_ = __builtin_amdgcn_cvt_scalef32_pk32_f16_fp6(pk_, 1.0f); \
            _Pragma("unroll") for (int q = 0; q < 8; ++q) ya[q] = __builtin_amdgcn_mfma_f32_4x4x4f16(am_.h, (h4_t){f_[4 * q], f_[4 * q + 1], f_[4 * q + 2], f_[4 * q + 3]}, ya[q], 0, 0, 0); \
            if (k & 1) __builtin_amdgcn_sched_barrier(0); } } while (0)
__device__ __forceinline__ void phase_peer_gather6(const Params& p, int bid, int nblk) {
    const int tidf = tid_fresh(p.widx), lane = tidf & 63, wid = tidf >> 6;
    const unsigned lane16 = (unsigned)lane * 16u, lane8 = (unsigned)lane * 8u;
    const unsigned char* utab = p.ws + OFF_UTAB; const unsigned char* vtab = p.ws + OFF_VTAB;
    const float* usc = WS<float>(p, OFF_USC); const float* vsc = WS<float>(p, OFF_VSC);
    const bf16_t* h2 = WS<bf16_t>(p, OFF_H); const float* x1 = WS<float>(p, OFF_X1); const float* mod = WS<float>(p, OFF_MOD);
    const int* ridx = WS<int>(p, OFF_RIDX); const float* rgate = WS<float>(p, OFF_RGATE);
    const int tstep = nblk * 8;
    int t = bid * 8 + wid;
    if (t >= TOK) return;
    int myi0 = ridx[(size_t)t * 128 + lane], myi1 = ridx[(size_t)t * 128 + 64 + lane];
    u32x4_t a4[8], b4[8]; u32x2_t a2[8], b2[8];
    PG6_LOAD(a4, a2, utab, myi0, 0);
    for (; t < TOK; t += tstep) {
        const int b = t >> 12;
        const int tn = t + tstep; const bool more = tn < TOK;
        const int ni0 = more ? ridx[(size_t)tn * 128 + lane] : 0, ni1 = more ? ridx[(size_t)tn * 128 + 64 + lane] : 0;
        const float myg0 = rgate[(size_t)t * 128 + lane], myg1 = rgate[(size_t)t * 128 + 64 + lane];
        float hv[32];
        { const bf16_t* hp = h2 + (size_t)t * DM + lane * 4;
#pragma unroll
          for (int j = 0; j < 8; ++j) { const uint2 w = *(const uint2*)(hp + j * 256); float* f = hv + j * 4;
              f[0] = lo_f(w.x); f[1] = hi_f(w.x); f[2] = lo_f(w.y); f[3] = hi_f(w.y); } }
        h2_t hvh[16];
#pragma unroll
        for (int q = 0; q < 16; ++q) hvh[q] = (h2_t){(_Float16)hv[2 * q], (_Float16)hv[2 * q + 1]};
        float dots0 = 0.f, dots1 = 0.f;
#pragma unroll 1
        for (int eb = 0; eb < 128; eb += 16) {
            { const int e1 = eb + 8; PG6_LOAD(b4, b2, utab, (e1 < 64 ? myi0 : myi1), (e1 & 63)); }
            PG6_CU(a4, a2, eb);
            if (eb + 16 < 128) { const int e2 = eb + 16; PG6_LOAD(a4, a2, utab, (e2 < 64 ? myi0 : myi1), (e2 & 63)); }
            else PG6_LOAD(a4, a2, vtab, myi0, 0);
            PG6_CU(b4, b2, eb + 8);
        }
        const float cf0 = myg0 * gelu_exact(dots0 * usc[myi0]) * vsc[myi0], cf1 = myg1 * gelu_exact(dots1 * usc[myi1]) * vsc[myi1];
        h2_t yh[16];
#pragma unroll
        for (int q = 0; q < 16; ++q) yh[q] = (h2_t){(_Float16)0.f, (_Float16)0.f};
#pragma unroll 1
        for (int eb = 0; eb < 128; eb += 16) {
            { const int e1 = eb + 8; PG6_LOAD(b4, b2, vtab, (e1 < 64 ? myi0 : myi1), (e1 & 63)); }
            PG6_CV(a4, a2, eb);
            if (eb + 16 < 128) { const int e2 = eb + 16; PG6_LOAD(a4, a2, vtab, (e2 < 64 ? myi0 : myi1), (e2 & 63)); }
            else if (more) PG6_LOAD(a4, a2, utab, ni0, 0);
            PG6_CV(b4, b2, eb + 8);
        }
        myi0 = ni0; myi1 = ni1;
        float y[32];
#pragma unroll
        for (int q = 0; q < 16; ++q) { y[2 * q] = (float)yh[q][0]; y[2 * q + 1] = (float)yh[q][1]; }
        float ss = 0.f;
#pragma unroll
        for (int q4 = 0; q4 < 8; ++q4) {
            const int col = (q4 * 64 + lane) * 4;
            const float4 xv = *(const float4*)(x1 + (size_t)t * DM + col); const float4 g2 = *(const float4*)(mod + (size_t)b * 12288 + 5 * 2048 + col);
            float* yy = y + q4 * 4;
            yy[0] = xv.x + g2.x * yy[0]; yy[1] = xv.y + g2.y * yy[1]; yy[2] = xv.z + g2.z * yy[2]; yy[3] = xv.w + g2.w * yy[3];
            ss += yy[0] * yy[0] + yy[1] * yy[1] + yy[2] * yy[2] + yy[3] * yy[3];
            if (q4 & 1) __builtin_amdgcn_sched_barrier(0);
        }
        ss = wave_sum(ss);
        const float rstd = rsqrtf(ss * (1.0f / DM) + EPS);
#pragma unroll
        for (int q4 = 0; q4 < 8; ++q4) {
            const int col = (q4 * 64 + lane) * 4; const float4 fg = *(const float4*)(p.fin_g + col);
            const float* yy = y + q4 * 4;
            float4 o; o.x = yy[0] * rstd * fg.x; o.y = yy[1] * rstd * fg.y; o.z = yy[2] * rstd * fg.z; o.w = yy[3] * rstd * fg.w;
            *(float4*)(p.out + (size_t)t * DM + col) = o;
            if (q4 & 1) __builtin_amdgcn_sched_barrier(0);
        }
    }
}


__device__ __forceinline__ int ld_agent(const int* q) { return __hip_atomic_load(q, __ATOMIC_RELAXED, __HIP_MEMORY_SCOPE_AGENT); }
__device__ __forceinline__ float ld_agent(const float* q) { return __hip_atomic_load(q, __ATOMIC_RELAXED, __HIP_MEMORY_SCOPE_AGENT); }
__device__ __forceinline__ void phase_peer_u6(const Params& p, int bid, int nblk) {
    const int tidf = tid_fresh(p.widx), lane = tidf & 63, wid = tidf >> 6;
    const unsigned lane16 = (unsigned)lane * 16u, lane8 = (unsigned)lane * 8u;
    const unsigned char* utab = p.ws + OFF_UTAB;
    const float* usc = WS<float>(p, OFF_USC); const float* vsc = WS<float>(p, OFF_VSC);
    const bf16_t* h2 = WS<bf16_t>(p, OFF_H); const int* ridx = WS<int>(p, OFF_RIDX); const float* rgate = WS<float>(p, OFF_RGATE); float* cfo = WS<float>(p, OFF_PD);
    const int tstep = nblk * 8;
    const bool l3b0 = (lane & 1) != 0, l3b1 = (lane & 2) != 0;
    int t = bid * 8 + wid;
    if (t >= TOK) return;
    int myi0 = ld_agent(ridx + (size_t)t * 128 + lane), myi1 = ld_agent(ridx + (size_t)t * 128 + 64 + lane);
    u32x4_t a4[8], b4[8]; u32x2_t a2[8], b2[8];
    PG6_LOAD(a4, a2, utab, myi0, 0);
    for (; t < TOK; t += tstep) {
        const int tn = t + tstep; const bool more = tn < TOK;
        const int ni0 = more ? ld_agent(ridx + (size_t)tn * 128 + lane) : 0, ni1 = more ? ld_agent(ridx + (size_t)tn * 128 + 64 + lane) : 0;
        const float myg0 = ld_agent(rgate + (size_t)t * 128 + lane), myg1 = ld_agent(rgate + (size_t)t * 128 + 64 + lane);
        const float us0 = usc[myi0], us1 = usc[myi1], vs0 = vsc[myi0], vs1 = vsc[myi1];
        h4_t hv4[8];
        { const bf16_t* hp = h2 + (size_t)t * DM + lane * 4;
#pragma unroll
          for (int j = 0; j < 8; ++j) { const uint2 w = *(const uint2*)(hp + j * 256);
              hv4[j] = (h4_t){(_Float16)lo_f(w.x), (_Float16)hi_f(w.x), (_Float16)lo_f(w.y), (_Float16)hi_f(w.y)}; } }
        float dots0 = 0.f, dots1 = 0.f;
#pragma unroll 1
        for (int eb = 0; eb < 128; eb += 16) {
            { const int e1 = eb + 8; PG6_LOAD(b4, b2, utab, (e1 < 64 ? myi0 : myi1), (e1 & 63)); }
            PG6_CU4(a4, a2, eb);
            if (eb + 16 < 128) { const int e2 = eb + 16; PG6_LOAD(a4, a2, utab, (e2 < 64 ? myi0 : myi1), (e2 & 63)); }
            else if (more) PG6_LOAD(a4, a2, utab, ni0, 0);
            PG6_CU4(b4, b2, eb + 8);
        }
        cfo[(size_t)t * 128 + lane] = myg0 * gelu_exact(dots0 * us0) * vs0;
        cfo[(size_t)t * 128 + 64 + lane] = myg1 * gelu_exact(dots1 * us1) * vs1;
        myi0 = ni0; myi1 = ni1;
    }
}
__device__ __forceinline__ void phase_peer_v6(const Params& p, int bid, int nblk) {
    const int tidf = tid_fresh(p.widx), lane = tidf & 63, wid = tidf >> 6;
    const unsigned lane16 = (unsigned)lane * 16u, lane8 = (unsigned)lane * 8u;
    const unsigned char* vtab = p.ws + OFF_VTAB;
    const bf16_t* x1 = WS<bf16_t>(p, OFF_X1); const float* mod = WS<float>(p, OFF_MOD);
    const int* ridx = WS<int>(p, OFF_RIDX); const float* cfi = WS<float>(p, OFF_PD);
    const int tstep = nblk * 8;
    int t = bid * 8 + wid;
    if (t >= TOK) return;
    int myi0 = ld_agent(ridx + (size_t)t * 128 + lane), myi1 = ld_agent(ridx + (size_t)t * 128 + 64 + lane);
    const unsigned am0 = (lane & 3) == 0 ? 0x0000ffffu : ((lane & 3) == 1 ? 0xffff0000u : 0u), am1 = (lane & 3) == 2 ? 0x0000ffffu : ((lane & 3) == 3 ? 0xffff0000u : 0u);
    float cf0 = __hip_atomic_load(cfi + (size_t)t * 128 + lane, __ATOMIC_RELAXED, __HIP_MEMORY_SCOPE_AGENT), cf1 = __hip_atomic_load(cfi + (size_t)t * 128 + 64 + lane, __ATOMIC_RELAXED, __HIP_MEMORY_SCOPE_AGENT);
    u32x4_t a4[8], b4[8]; u32x2_t a2[8], b2[8];
    PG6_LOAD(a4, a2, vtab, myi0, 0);
    for (; t < TOK; t += tstep) {
        const int b = t >> 12;
        const int tn = t + tstep; const bool more = tn < TOK;
        const int ni0 = more ? ld_agent(ridx + (size_t)tn * 128 + lane) : 0, ni1 = more ? ld_agent(ridx + (size_t)tn * 128 + 64 + lane) : 0;
        const float nc0 = more ? __hip_atomic_load(cfi + (size_t)tn * 128 + lane, __ATOMIC_RELAXED, __HIP_MEMORY_SCOPE_AGENT) : 0.f, nc1 = more ? __hip_atomic_load(cfi + (size_t)tn * 128 + 64 + lane, __ATOMIC_RELAXED, __HIP_MEMORY_SCOPE_AGENT) : 0.f;
        uint2 xr[8];
#pragma unroll
        for (int q4 = 0; q4 < 8; ++q4) xr[q4] = *(const uint2*)(x1 + (size_t)t * DM + (q4 * 64 + lane) * 4);
        f32x4v_t ya[8];
#pragma unroll
        for (int q = 0; q < 8; ++q) ya[q] = (f32x4v_t){0.f, 0.f, 0.f, 0.f};
        unsigned cc0, cc1;
        { union { h2_t h; unsigned u; } c_; c_.h = (h2_t){(_Float16)cf0, (_Float16)cf0}; cc0 = c_.u; c_.h = (h2_t){(_Float16)cf1, (_Float16)cf1}; cc1 = c_.u; }
#pragma unroll 1
        for (int eb = 0; eb < 128; eb += 16) {
            { const int e1 = eb + 8; PG6_LOAD(b4, b2, vtab, (e1 < 64 ? myi0 : myi1), (e1 & 63)); }
            PG6_CV4(a4, a2, eb);
            if (eb + 16 < 128) { const int e2 = eb + 16; PG6_LOAD(a4, a2, vtab, (e2 < 64 ? myi0 : myi1), (e2 & 63)); }
            else if (more) PG6_LOAD(a4, a2, vtab, ni0, 0);
            PG6_CV4(b4, b2, eb + 8);
        }
        myi0 = ni0; myi1 = ni1; cf0 = nc0; cf1 = nc1;
        float y[32];
#pragma unroll
        for (int q = 0; q < 8; ++q) { y[4 * q] = ya[q][0]; y[4 * q + 1] = ya[q][1]; y[4 * q + 2] = ya[q][2]; y[4 * q + 3] = ya[q][3]; }
        float ss = 0.f;
#pragma unroll
        for (int q4 = 0; q4 < 8; ++q4) {
            const int col = (q4 * 64 + lane) * 4;
            const uint2 xw = xr[q4]; const float4 g2 = *(const float4*)(mod + (size_t)b * 12288 + 5 * 2048 + col);
            float4 xv; xv.x = lo_f(xw.x); xv.y = hi_f(xw.x); xv.z = lo_f(xw.y); xv.w = hi_f(xw.y);
            float* yy = y + q4 * 4;
            yy[0] = xv.x + g2.x * yy[0]; yy[1] = xv.y + g2.y * yy[1]; yy[2] = xv.z + g2.z * yy[2]; yy[3] = xv.w + g2.w * yy[3];
            ss += yy[0] * yy[0] + yy[1] * yy[1] + yy[2] * yy[2] + yy[3] * yy[3];
            if (q4 & 1) __builtin_amdgcn_sched_barrier(0);
        }
        ss = wave_sum(ss);
        const float rstd = rsqrtf(ss * (1.0f / DM) + EPS);
#pragma unroll
        for (int q4 = 0; q4 < 8; ++q4) {
            const int col = (q4 * 64 + lane) * 4; const float4 fg = *(const float4*)(p.fin_g + col);
            const float* yy = y + q4 * 4;
            float4 o; o.x = yy[0] * rstd * fg.x; o.y = yy[1] * rstd * fg.y; o.z = yy[2] * rstd * fg.z; o.w = yy[3] * rstd * fg.w;
            *(float4*)(p.out + (size_t)t * DM + col) = o;
            if (q4 & 1) __builtin_amdgcn_sched_barrier(0);
        }
    }
}

#define XB_TMO      128
#define XB_XCNT(j)  (256  + 64 * (j))
#define XB_XSUB(j)  (1280 + 64 * (j))
#define XB_XGEN(j)  (2304 + 64 * (j))
#define XB_TOP      3328
#define XB_TOPGEN   3392
#define XCD_BAR_WORDS 3456
#define XB_SPIN_CAP (1u << 18)

__device__ __forceinline__ unsigned xb_ld(unsigned* p)              { return __hip_atomic_load(p, __ATOMIC_RELAXED, __HIP_MEMORY_SCOPE_AGENT); }
__device__ __forceinline__ unsigned xb_add(unsigned* p, unsigned v) { return __hip_atomic_fetch_add(p, v, __ATOMIC_RELAXED, __HIP_MEMORY_SCOPE_AGENT); }
__device__ __forceinline__ unsigned xb_xcc_id() { return (unsigned)__builtin_amdgcn_s_getreg((3 << 11) | 20) & 0xFu; }
#define XB_SPIN(cond, bar) do { unsigned _sp = 0; while (cond) { __builtin_amdgcn_s_sleep(1); \
    if ((++_sp & 255u) == 0u) { if (xb_ld(&(bar)[XB_TMO])) break; if (_sp > XB_SPIN_CAP) { atomicAdd(&(bar)[XB_TMO], 1u); break; } } } } while (0)

struct XcdBarrier {
    int widx;
    unsigned* bar; unsigned x;
    volatile LAS unsigned* st;
};

__device__ __forceinline__ bool xb_thread0(int widx) { unsigned m = ~0u; asm volatile("" : "+s"(m)); return widx == 0 && __builtin_amdgcn_mbcnt_hi(m, __builtin_amdgcn_mbcnt_lo(m, 0u)) == 0u; }
__device__ __forceinline__ XcdBarrier xcd_barrier_post(unsigned* bar, volatile LAS unsigned* st, int widx) {
    XcdBarrier b; b.widx = widx; b.bar = bar; b.x = xb_xcc_id(); b.st = st;
    if (xb_thread0(widx)) (void)xb_add(&bar[XB_XCNT(b.x)], 1u);
    return b;
}
__device__ __forceinline__ void xcd_barrier_complete(unsigned* bar, unsigned x, unsigned& nloc, unsigned& nx) {
    const unsigned G = gridDim.x * gridDim.y * gridDim.z;
    unsigned sum, cnt, mine, sp = 0u;
    for (;;) {
        sum = 0u; cnt = 0u; mine = 0u;
#pragma unroll
        for (unsigned j = 0; j < 16; ++j) { const unsigned c = xb_ld(&bar[XB_XCNT(j)]); sum += c; cnt += (c > 0u) ? 1u : 0u; mine = (j == x) ? c : mine; }
        if (sum == G) break;
        __builtin_amdgcn_s_sleep(1);
        if ((++sp & 255u) == 0u) { if (xb_ld(&bar[XB_TMO])) break; if (sp > XB_SPIN_CAP) { atomicAdd(&bar[XB_TMO], 1u); break; } }
    }
    nloc = mine > 0u ? mine : 1u; nx = cnt > 0u ? cnt : 1u;
}

__device__ __forceinline__ void xcd_barrier(const XcdBarrier& b) {
    asm volatile("s_waitcnt vmcnt(0)" ::: "memory");
    __syncthreads();
    if (xb_thread0(b.widx)) {
        unsigned* bar = b.bar;
        __builtin_amdgcn_s_waitcnt(0);
        unsigned nloc = b.st[0], nx = b.st[1];
        if (nloc == 0u) { xcd_barrier_complete(bar, b.x, nloc, nx); b.st[0] = nloc; b.st[1] = nx; }
        const unsigned old = xb_add(&bar[XB_XSUB(b.x)], 1u);
        const unsigned gen = old / nloc;
        if (old + 1u == (gen + 1u) * nloc) {
            __builtin_amdgcn_fence(__ATOMIC_RELEASE, "agent");
            asm volatile("s_waitcnt vmcnt(0)" ::: "memory");
            const unsigned og = xb_add(&bar[XB_TOP], 1u);
            const unsigned tg = og / nx;
            if (og + 1u == (tg + 1u) * nx) xb_add(&bar[XB_TOPGEN], 1u);
            else XB_SPIN(xb_ld(&bar[XB_TOPGEN]) == tg, bar);
            __builtin_amdgcn_fence(__ATOMIC_ACQUIRE, "agent");
            xb_add(&bar[XB_XGEN(b.x)], 1u);
            asm volatile("s_waitcnt vmcnt(0)" ::: "memory");
        } else {
            XB_SPIN(xb_ld(&bar[XB_XGEN(b.x)]) == gen, bar);
            __builtin_amdgcn_fence(__ATOMIC_ACQUIRE, "agent");
            asm volatile("s_waitcnt vmcnt(0)" ::: "memory");
        }
    }
    __syncthreads();
}


constexpr int PS_Q_WORD = 3968;
__device__ __forceinline__ unsigned ps_next(unsigned* q, LAS unsigned* bc, int tid) {
    if (tid == 0) *bc = __hip_atomic_fetch_add(q, 1u, __ATOMIC_RELAXED, __HIP_MEMORY_SCOPE_AGENT);
    __syncthreads();
    const unsigned u = (unsigned)__builtin_amdgcn_readfirstlane((int)*bc);
    __syncthreads();
    return u;
}
#define PS_LOADH(RA, RB, tb, idv) do { _Pragma("unroll") for (int bt = 0; bt < 8; ++bt) { const int idx_ = __shfl((idv), bt * 8 + g); const unsigned char* rp_ = (tb) + (size_t)idx_ * 192; \
        RA[bt] = *(const u32x4_t*)(rp_ + j * 16); RB[bt] = *(const u32x2_t*)(rp_ + 128 + j * 8); } } while (0)
#define PS_CU(RA, RB, outp) do { float mine_ = 0.f; \
        _Pragma("unroll") for (int bt = 0; bt < 8; ++bt) { \
            const v6u_t pk_ = {RA[bt][0], RA[bt][1], RA[bt][2], RA[bt][3], RB[bt][0], RB[bt][1]}; \
            const v32f_t f_ = __builtin_amdgcn_cvt_scalef32_pk32_f32_fp6(pk_, 1.0f); float sd_ = 0.f; \
            _Pragma("unroll") for (int qq = 0; qq < 32; ++qq) sd_ += f_[qq] * hv[qq]; \
            sd_ += __shfl_xor(sd_, 1); sd_ += __shfl_xor(sd_, 2); sd_ += __shfl_xor(sd_, 4); \
            mine_ = (j == bt) ? sd_ : mine_; __builtin_amdgcn_sched_barrier(0); } \
        __builtin_nontemporal_store(mine_, (outp) + j * 8 + g); } while (0)
#define PS_CV(RA, RB, cfv) do { \
        _Pragma("unroll") for (int bt = 0; bt < 8; ++bt) { const float cf_ = __shfl((cfv), bt * 8 + g); \
            const v6u_t pk_ = {RA[bt][0], RA[bt][1], RA[bt][2], RA[bt][3], RB[bt][0], RB[bt][1]}; \
            const v32f_t f_ = __builtin_amdgcn_cvt_scalef32_pk32_f32_fp6(pk_, 1.0f); \
            _Pragma("unroll") for (int qq = 0; qq < 32; ++qq) y[qq] += cf_ * f_[qq]; \
            asm volatile("" : "+v"(y[0]), "+v"(y[1]), "+v"(y[2]), "+v"(y[3]), "+v"(y[4]), "+v"(y[5]), "+v"(y[6]), "+v"(y[7]), "+v"(y[8]), "+v"(y[9]), "+v"(y[10]), "+v"(y[11]), "+v"(y[12]), "+v"(y[13]), "+v"(y[14]), "+v"(y[15])); \
            asm volatile("" : "+v"(y[16]), "+v"(y[17]), "+v"(y[18]), "+v"(y[19]), "+v"(y[20]), "+v"(y[21]), "+v"(y[22]), "+v"(y[23]), "+v"(y[24]), "+v"(y[25]), "+v"(y[26]), "+v"(y[27]), "+v"(y[28]), "+v"(y[29]), "+v"(y[30]), "+v"(y[31])); \
            __builtin_amdgcn_sched_barrier(0); } } while (0)
constexpr int PS_CHUNK = 64;
__device__ __forceinline__ void phase_peer_u_sliced(const Params& p, float* ldsf) {
    const int tid = tid_fresh(p.widx), lane = tid & 63, wid = tid >> 6, g = lane >> 3, j = lane & 7;
    LAS unsigned* bc = (LAS unsigned*)ldsf;
    const unsigned char* utab = p.ws + OFF_UTAB;
    const bf16_t* h2 = WS<bf16_t>(p, OFF_H); const int* ridx = WS<int>(p, OFF_RIDX); float* pd = WS<float>(p, OFF_PD);
    const int x0 = (int)(xb_xcc_id() & 7u);
#pragma unroll 1
    for (int so = 0; so < 8; ++so) {
        const int s = (x0 + so) & 7;
        unsigned* q = WS<unsigned>(p, OFF_BAR) + PS_Q_WORD + 8 * s;
        const unsigned char* tb = utab + (size_t)s * NEXP * 192;
        const bf16_t* hb = h2 + s * 256 + j * 32;
#pragma unroll 1
        for (;;) {
            const unsigned ch = ps_next(q, bc, tid);
            if (ch >= TOK / PS_CHUNK) break;
            int t = (int)ch * PS_CHUNK + wid;
            int i0 = __builtin_nontemporal_load(ridx + (size_t)t * 128 + lane), i1 = __builtin_nontemporal_load(ridx + (size_t)t * 128 + 64 + lane);
            uint4 hp[4];
#pragma unroll
            for (int q8 = 0; q8 < 4; ++q8) hp[q8] = *(const uint4*)(hb + (size_t)t * DM + q8 * 8);
            u32x4_t a4[8], b4[8]; u32x2_t a2[8], b2[8];
            PS_LOADH(a4, a2, tb, i0);
#pragma unroll 1
            for (int k = 0; k < PS_CHUNK / 8; ++k, t += 8) {
                float hv[32];
#pragma unroll
                for (int q8 = 0; q8 < 4; ++q8) { const uint4 w = hp[q8]; float* f = hv + q8 * 8;
                    f[0] = lo_f(w.x); f[1] = hi_f(w.x); f[2] = lo_f(w.y); f[3] = hi_f(w.y); f[4] = lo_f(w.z); f[5] = hi_f(w.z); f[6] = lo_f(w.w); f[7] = hi_f(w.w); }
                const bool more = k + 1 < PS_CHUNK / 8; const int tn = more ? t + 8 : t;
                const int n0 = __builtin_nontemporal_load(ridx + (size_t)tn * 128 + lane), n1 = __builtin_nontemporal_load(ridx + (size_t)tn * 128 + 64 + lane);
#pragma unroll
                for (int q8 = 0; q8 < 4; ++q8) hp[q8] = *(const uint4*)(hb + (size_t)tn * DM + q8 * 8);
                PS_LOADH(b4, b2, tb, i1);
                PS_CU(a4, a2, pd + ((size_t)s * TOK + t) * 128);
                if (more) PS_LOADH(a4, a2, tb, n0);
                PS_CU(b4, b2, pd + ((size_t)s * TOK + t) * 128 + 64);
                i0 = n0; i1 = n1;
            }
        }
    }
}
__device__ __forceinline__ void phase_peer_v_sliced(const Params& p, float* ldsf) {
    const int tid = tid_fresh(p.widx), lane = tid & 63, wid = tid >> 6, g = lane >> 3, j = lane & 7;
    LAS unsigned* bc = (LAS unsigned*)ldsf;
    const unsigned char* vtab = p.ws + OFF_VTAB;
    const float* usc = WS<float>(p, OFF_USC); const float* vsc = WS<float>(p, OFF_VSC);
    const int* ridx = WS<int>(p, OFF_RIDX); const float* rgate = WS<float>(p, OFF_RGATE); const float* pd = WS<float>(p, OFF_PD);
    float* x1 = WS<float>(p, OFF_X1); const float* mod = WS<float>(p, OFF_MOD); float* ssqp = WS<float>(p, OFF_SSQP);
    const int x0 = (int)(xb_xcc_id() & 7u);
    const int cofs = j * 32 + 16 * (g & 1) + 8 * ((g >> 1) & 1) + 4 * (g >> 2);
#pragma unroll 1
    for (int so = 0; so < 8; ++so) {
        const int s = (x0 + so) & 7;
        unsigned* q = WS<unsigned>(p, OFF_BAR) + PS_Q_WORD + 64 + 8 * s;
        const unsigned char* tb = vtab + (size_t)s * NEXP * 192;
#pragma unroll 1
        for (;;) {
            const unsigned ch = ps_next(q, bc, tid);
            if (ch >= TOK / PS_CHUNK) break;
            int t = (int)ch * PS_CHUNK + wid;
            int i0 = __builtin_nontemporal_load(ridx + (size_t)t * 128 + lane), i1 = __builtin_nontemporal_load(ridx + (size_t)t * 128 + 64 + lane);
            float d0 = 0.f, d1 = 0.f;
#pragma unroll
            for (int x = 0; x < 8; ++x) { d0 += __builtin_nontemporal_load(pd + ((size_t)x * TOK + t) * 128 + lane); d1 += __builtin_nontemporal_load(pd + ((size_t)x * TOK + t) * 128 + 64 + lane); }
            float g0 = __builtin_nontemporal_load(rgate + (size_t)t * 128 + lane), g1 = __builtin_nontemporal_load(rgate + (size_t)t * 128 + 64 + lane);
            u32x4_t a4[8], b4[8]; u32x2_t a2[8], b2[8];
            PS_LOADH(a4, a2, tb, i0);
#pragma unroll 1
            for (int k = 0; k < PS_CHUNK / 8; ++k, t += 8) {
                const int b = t >> 12, col = s * 256 + cofs;
                const float cf0 = g0 * gelu_exact(d0 * usc[i0]) * vsc[i0], cf1 = g1 * gelu_exact(d1 * usc[i1]) * vsc[i1];
                const float4 xv = *(const float4*)(x1 + (size_t)t * DM + col); const float4 gg = *(const float4*)(mod + (size_t)b * 12288 + 5 * 2048 + col);
                const bool more = k + 1 < PS_CHUNK / 8; const int tn = more ? t + 8 : t;
                const int n0 = __builtin_nontemporal_load(ridx + (size_t)tn * 128 + lane), n1 = __builtin_nontemporal_load(ridx + (size_t)tn * 128 + 64 + lane);
                float e0 = 0.f, e1 = 0.f;
#pragma unroll
                for (int x = 0; x < 8; ++x) { e0 += __builtin_nontemporal_load(pd + ((size_t)x * TOK + tn) * 128 + lane); e1 += __builtin_nontemporal_load(pd + ((size_t)x * TOK + tn) * 128 + 64 + lane); }
                const float ng0 = __builtin_nontemporal_load(rgate + (size_t)tn * 128 + lane), ng1 = __builtin_nontemporal_load(rgate + (size_t)tn * 128 + 64 + lane);
                float y[32];
#pragma unroll
                for (int qq = 0; qq < 32; ++qq) y[qq] = 0.f;
                PS_LOADH(b4, b2, tb, i1);
                PS_CV(a4, a2, cf0);
                if (more) PS_LOADH(a4, a2, tb, n0);
                PS_CV(b4, b2, cf1);
                float w16[16], w8[8], w4[4];
                { const bool hi = (g & 1) != 0;
#pragma unroll
                  for (int i = 0; i < 16; ++i) { const float send = hi ? y[i] : y[16 + i], keep = hi ? y[16 + i] : y[i]; w16[i] = keep + __shfl_xor(send, 8); } }
                { const bool hi = (g & 2) != 0;
#pragma unroll
                  for (int i = 0; i < 8; ++i) { const float send = hi ? w16[i] : w16[8 + i], keep = hi ? w16[8 + i] : w16[i]; w8[i] = keep + __shfl_xor(send, 16); } }
                { const bool hi = (g & 4) != 0;
#pragma unroll
                  for (int i = 0; i < 4; ++i) { const float send = hi ? w8[i] : w8[4 + i], keep = hi ? w8[4 + i] : w8[i]; w4[i] = keep + __shfl_xor(send, 32); } }
                float4 o; o.x = xv.x + gg.x * w4[0]; o.y = xv.y + gg.y * w4[1]; o.z = xv.z + gg.z * w4[2]; o.w = xv.w + gg.w * w4[3];
                *(float4*)(x1 + (size_t)t * DM + col) = o;
                const float ss = wave_sum(o.x * o.x + o.y * o.y + o.z * o.z + o.w * o.w);
                if (lane == 0) ssqp[(size_t)s * TOK + t] = ss;
                i0 = n0; i1 = n1; d0 = e0; d1 = e1; g0 = ng0; g1 = ng1;
            }
        }
    }
}
__device__ __forceinline__ void phase_peer_final(const Params& p, int bid, int nblk) {
    const int tidf = tid_fresh(p.widx), lane = tidf & 63, wid = tidf >> 6;
    const float* x2 = WS<float>(p, OFF_X1); const float* ssqp = WS<float>(p, OFF_SSQP);
    for (int t = bid * 8 + wid; t < TOK; t += nblk * 8) {
        float ss = 0.f;
#pragma unroll
        for (int s = 0; s < 8; ++s) ss += ssqp[(size_t)s * TOK + t];
        const float rstd = rsqrtf(ss * (1.0f / DM) + EPS);
#pragma unroll
        for (int jj = 0; jj < 8; ++jj) { const int col = (jj * 64 + lane) * 4;
            const float4 v = *(const float4*)(x2 + (size_t)t * DM + col), fg = *(const float4*)(p.fin_g + col);
            float4 o; o.x = v.x * rstd * fg.x; o.y = v.y * rstd * fg.y; o.z = v.z * rstd * fg.z; o.w = v.w * rstd * fg.w;
            *(float4*)(p.out + (size_t)t * DM + col) = o; }
    }
}

constexpr int NPHASE = 12;
#ifndef USE_FAST_ROUTE
#define USE_FAST_ROUTE 1
#endif
#ifndef USE_FAST_PEER
#define USE_FAST_PEER 1
#endif
#ifndef USE_MFMA_ATTN
#define USE_MFMA_ATTN 1
#endif
#ifndef USE_MFMA_GEMM
#define USE_MFMA_GEMM 1
#endif
#if !(FUSED && USE_FAST_PEER && PEER_SPLIT && TAB_EB == 6 && !PEER_SLICED)
#error "x1 is kept in bf16: only the default (live) path reads it that way"
#endif
#if USE_MFMA_GEMM
#define GEMM(A, Bt, M, N, K, E) gemm_mfma(A, Bt, M, N, K, E, bid, nblk, (unsigned char*)lds, p.widx)
#else
#define GEMM(A, Bt, M, N, K, E) gemm_ref(A, K, Bt, K, M, N, K, E, bid, nblk)
#endif
template <int PH, int RERUN = 0> __device__ __forceinline__ void run_phase(const Params& p, int bid, int nblk, float* lds) {
    if (PH == 0) phase0(p, bid, nblk, lds);
    if (PH == 1) phase_norm_mod(p, p.x, p.norm1_g, 0, 1, WS<bf16_t>(p, OFF_H), bid, nblk, lds);
    if (PH == 2) { EpiInProj E{WS<bf16_t>(p, OFF_QSB), WS<bf16_t>(p, OFF_KSB), WS<bf16_t>(p, OFF_VSB), WS<bf16_t>(p, OFF_CQ), WS<bf16_t>(p, OFF_CKV), WS<bf16_t>(p, OFF_KMLA),
                                WS<float>(p, OFF_COS), WS<float>(p, OFF_SIN), WS<float>(p, OFF_RSP)};
        GEMM(WS<bf16_t>(p, OFF_H), WS<bf16_t>(p, OFF_WIN_T), TOK, NINP, DM, E); }
    if (PH == 3) phase_rowstats(p, bid, nblk);
    if (PH == 4) {
        LAS float* tab = (LAS float*)((LAS unsigned char*)lds + LDS_TAB_OFF); const int tid = tid_fresh(p.widx);
        { pg8::StaticOrder S; S.init(TOK, 1536, nblk, bid); pg8::Unit u0; const int pm0 = S.next(0, u0) ? u0.pm : -1;
          EpiUq E1{WS<bf16_t>(p, OFF_QMLA), WS<float>(p, OFF_RSP), WS<float>(p, OFF_COS), WS<float>(p, OFF_SIN), tab, pm0};
          if (pm0 >= 0 && tid < 256) tab[tid] = E1.slow_scale(pm0 * 256 + tid);
          __syncthreads();
          GEMM(WS<bf16_t>(p, OFF_CQ), WS<bf16_t>(p, OFF_WUQ_T), TOK, 1536, 512, E1); }
        __syncthreads();
        { pg8::StaticOrder S; S.init(TOK, 2048, nblk, bid); pg8::Unit u0; const int pm0 = S.next(0, u0) ? u0.pm : -1;
          EpiUkv E2{WS<bf16_t>(p, OFF_KMLA), WS<bf16_t>(p, OFF_VMLA), WS<float>(p, OFF_RSP), tab, pm0};
          if (pm0 >= 0 && tid < 256) tab[tid] = E2.slow_scale(pm0 * 256 + tid);
          __syncthreads();
          GEMM(WS<bf16_t>(p, OFF_CKV), WS<bf16_t>(p, OFF_WUKV_T), TOK, 2048, 256, E2); } }
#if USE_MFMA_ATTN
    if (PH == 5) phase_attn_mfma(p, lds, RERUN);
#else
    if (PH == 5) phase_attn_ref(p, bid, nblk);
#endif
    if (PH == 6) phase_onorm(p, bid, nblk);
    if (PH == 7) { LAS float* tab = (LAS float*)((LAS unsigned char*)lds + LDS_TAB_OFF); const int tid = tid_fresh(p.widx);
        pg8::StaticOrder S; S.init(TOK, DM, nblk, bid); pg8::Unit u0; const int pm0 = S.next(0, u0) ? u0.pm : -1;
        EpiWo E{p.x, WS<float>(p, OFF_MOD), WS<bf16_t>(p, OFF_X1), WS<float>(p, OFF_SSQ), tab, pm0};
        if (pm0 >= 0 && tid < 256) { float r0, r1; E.rstd2(pm0 * 256 + tid, r0, r1); tab[2 * tid] = r0 / r1; tab[2 * tid + 1] = r1; }
        __syncthreads();
        GEMM(WS<bf16_t>(p, OFF_O), WS<bf16_t>(p, OFF_WO_T), TOK, DM, DM, E); }
    if (PH == 8) phase_norm_mod(p, WS<bf16_t>(p, OFF_X1), p.norm2_g, 3, 4, WS<bf16_t>(p, OFF_H), bid, nblk, lds);
    if (PH == 9) { EpiQp E{WS<bf16_t>(p, OFF_QP)};
        GEMM(WS<bf16_t>(p, OFF_H), WS<bf16_t>(p, OFF_WPQ_T), TOK, DM, DM, E); }
#if USE_FAST_ROUTE
    if (PH == 10) phase_route_mfma(p, bid, nblk, lds);
#else
    if (PH == 10) phase_route_ref(p, bid, nblk);
#endif
#if USE_FAST_PEER && PEER_SLICED
    if (PH == 11) phase_peer_u_sliced(p, lds);
    if (PH == 12) phase_peer_v_sliced(p, lds);
    if (PH == 13) phase_peer_final(p, bid, nblk);
#elif USE_FAST_PEER && PEER_SPLIT && TAB_EB == 6
    if (PH == 11) phase_peer_u6(p, bid, nblk);
    if (PH == 12) phase_peer_v6(p, bid, nblk);
#elif USE_FAST_PEER
    if (PH == 11) { if (TAB_EB == 6) phase_peer_gather6(p, bid, nblk); else phase_peer_gather<TAB_EB == 6 ? 1 : TAB_EB>(p, bid, nblk); }
#else
    if (PH == 11) phase_peer_ref(p, bid, nblk);
#endif
}

extern __shared__ __attribute__((aligned(16))) unsigned char dynlds[];
constexpr int LDS_MAIN = 131072;
constexpr int LDS_BYTES = LDS_MAIN + 16 + 2048;

template <int PH> __global__ void __launch_bounds__(512, 2) k_phase(Params pin) {
    Params p = pin; p.widx = __builtin_amdgcn_readfirstlane((int)(threadIdx.x >> 6));
    run_phase<PH>(p, blockIdx.x, gridDim.x, (float*)dynlds);
}

__global__ void __launch_bounds__(512, 2) k_fused(Params pin) {
    Params p = pin; p.widx = __builtin_amdgcn_readfirstlane((int)(threadIdx.x >> 6));
    float* lds = (float*)dynlds;
    volatile LAS unsigned* xbw = (volatile LAS unsigned*)(dynlds + LDS_MAIN);
    if (xb_thread0(p.widx)) { xbw[0] = 0u; xbw[1] = 0u; xbw[2] = 0u; xbw[3] = 0u; }
    __syncthreads();
    XcdBarrier bar = xcd_barrier_post(WS<unsigned>(p, OFF_BAR), xbw, p.widx);
    const int bid = blockIdx.x, nblk = gridDim.x;
    run_phase<0>(p, bid, nblk, lds); if (PROBE_DOUBLE & (1 << 0)) run_phase<0, 1>(p, bid, nblk, lds); xcd_barrier(bar);
    run_phase<1>(p, bid, nblk, lds); if (PROBE_DOUBLE & (1 << 1)) run_phase<1, 1>(p, bid, nblk, lds); xcd_barrier(bar);
    run_phase<2>(p, bid, nblk, lds); if (PROBE_DOUBLE & (1 << 2)) run_phase<2, 1>(p, bid, nblk, lds); xcd_barrier(bar);
    run_phase<4>(p, bid, nblk, lds); if (PROBE_DOUBLE & (1 << 4)) run_phase<4, 1>(p, bid, nblk, lds); xcd_barrier(bar);
    run_phase<5>(p, bid, nblk, lds); if (PROBE_DOUBLE & (1 << 5)) run_phase<5, 1>(p, bid, nblk, lds); xcd_barrier(bar);
    run_phase<7>(p, bid, nblk, lds); if (PROBE_DOUBLE & (1 << 7)) run_phase<7, 1>(p, bid, nblk, lds); xcd_barrier(bar);
    run_phase<8>(p, bid, nblk, lds); if (PROBE_DOUBLE & (1 << 8)) run_phase<8, 1>(p, bid, nblk, lds); xcd_barrier(bar);
    run_phase<9>(p, bid, nblk, lds); if (PROBE_DOUBLE & (1 << 9)) run_phase<9, 1>(p, bid, nblk, lds); xcd_barrier(bar);
    run_phase<10>(p, bid, nblk, lds); if (PROBE_DOUBLE & (1 << 10)) run_phase<10, 1>(p, bid, nblk, lds);
#if USE_FAST_ROUTE && USE_FAST_PEER && PEER_SPLIT && TAB_EB == 6 && !PEER_SLICED
    if (nblk * 32 == TOK) { asm volatile("s_waitcnt vmcnt(0)" ::: "memory"); __syncthreads(); }
    else xcd_barrier(bar);
#else
    xcd_barrier(bar);
#endif
    run_phase<11>(p, bid, nblk, lds); if (PROBE_DOUBLE & (1 << 11)) run_phase<11, 1>(p, bid, nblk, lds);
#if USE_FAST_PEER && PEER_SLICED
    xcd_barrier(bar); run_phase<12>(p, bid, nblk, lds);
    xcd_barrier(bar); run_phase<13>(p, bid, nblk, lds);
#elif USE_FAST_PEER && PEER_SPLIT && TAB_EB == 6
    asm volatile("s_waitcnt vmcnt(0)" ::: "memory");
    run_phase<12>(p, bid, nblk, lds);
#endif
}

template <int PH> static void launch_phase(const Params& p, int grid, hipStream_t st) {
    hipLaunchKernelGGL((k_phase<PH>), dim3(grid), dim3(512), LDS_BYTES, st, p);
}

extern "C" void kernel_launch(void* const* d_in, const int* in_sizes, int n_in, void* d_out, int out_size, void* d_ws, size_t ws_size, hipStream_t stream) {
    Params p{};
    p.x = (const float*)d_in[0]; p.c = (const float*)d_in[1]; p.pos = (const int*)d_in[2]; p.w_ada = (const float*)d_in[3]; p.b_ada = (const float*)d_in[4];
    p.norm1_g = (const float*)d_in[5]; p.w_in = (const float*)d_in[6]; p.qn_g = (const float*)d_in[7]; p.w_uq = (const float*)d_in[8]; p.kvn_g = (const float*)d_in[9];
    p.w_ukv = (const float*)d_in[10]; p.osb_g = (const float*)d_in[11]; p.omla_g = (const float*)d_in[12]; p.w_o = (const float*)d_in[13]; p.norm2_g = (const float*)d_in[14];
    p.w_pq = (const float*)d_in[15]; p.keys1 = (const float*)d_in[16]; p.keys2 = (const float*)d_in[17]; p.u_tab = (const float*)d_in[18]; p.v_tab = (const float*)d_in[19];
    p.fin_g = (const float*)d_in[20]; p.out = (float*)d_out; p.ws = (unsigned char*)d_ws;
#if FUSED
    static int grid = 0;
    if (!grid) {
        int dev = 0, cus = 0, per_cu = 0;
        hipGetDevice(&dev);
        hipDeviceGetAttribute(&cus, hipDeviceAttributeMultiprocessorCount, dev);
        hipFuncSetAttribute((const void*)k_fused, hipFuncAttributeMaxDynamicSharedMemorySize, LDS_BYTES);
        hipOccupancyMaxActiveBlocksPerMultiprocessor(&per_cu, k_fused, 512, LDS_BYTES);
        grid = per_cu >= 1 ? cus : 0;
    }
    hipMemsetAsync((unsigned char*)d_ws + OFF_BAR, 0, 16384, stream);
    if (grid) hipLaunchKernelGGL(k_fused, dim3(grid), dim3(512), LDS_BYTES, stream, p);
#else
    const int G = 1024;
    launch_phase<0>(p, G, stream); launch_phase<1>(p, G, stream); launch_phase<2>(p, G, stream); launch_phase<3>(p, G, stream);
    launch_phase<4>(p, G, stream); launch_phase<5>(p, G, stream); launch_phase<6>(p, G, stream); launch_phase<7>(p, G, stream);
    launch_phase<8>(p, G, stream); launch_phase<9>(p, G, stream); launch_phase<10>(p, G, stream); launch_phase<11>(p, G, stream);
#endif
}
```
